# Optimizing an MI355X kernel written in HIP

```python
import jax, jax.numpy as jnp
from jax import lax
import numpy as np


D_MODEL = 1024
BATCH = 1
SEQ = 16384
DEPTH = 2

HEAD_DIM = 64
A_Q_HEADS = 8
A_KV_HEADS = 2
A_GROUP = A_Q_HEADS // A_KV_HEADS
A_WINDOW = 128
A_BLOCK = 128
B_HEADS = 8
GRID_W = 64
NA_KH = 8
NA_KW = 16
RET_HEADS = 8
RET_DK = D_MODEL // RET_HEADS
RET_DV = 2 * D_MODEL // RET_HEADS
RET_CHUNK = 128
D_FF = 4 * D_MODEL
N_EVEN = (DEPTH + 1) // 2
N_ODD = DEPTH // 2
EVEN_SPLITS = (A_Q_HEADS * HEAD_DIM, A_KV_HEADS * HEAD_DIM, A_KV_HEADS * HEAD_DIM,
               B_HEADS * HEAD_DIM, B_HEADS * HEAD_DIM, B_HEADS * HEAD_DIM)
EVEN_IN = sum(EVEN_SPLITS)
EVEN_MIX = (A_Q_HEADS + B_HEADS) * HEAD_DIM
ODD_SPLITS = (RET_HEADS * RET_DK, RET_HEADS * RET_DK, RET_HEADS * RET_DV, RET_HEADS * RET_DV)
ODD_IN = sum(ODD_SPLITS)
ODD_MIX = RET_HEADS * RET_DV
RMS_EPS = 1e-6
GN_EPS = 1e-5

kernel_name = 'hybrid_swa_natten_retention_encoder'


def _split(t, sizes):
    idx = np.cumsum(sizes)[:-1].tolist()
    return jnp.split(t, idx, axis=-1)


def _rmsnorm(x, g):
    xf = x.astype(jnp.float32)
    y = xf * lax.rsqrt(jnp.mean(xf * xf, axis=-1, keepdims=True) + RMS_EPS)
    return (y * g.astype(jnp.float32)).astype(x.dtype)


def _alibi_slopes(n):
    return 2.0 ** (-(8.0 / n) * (jnp.arange(n, dtype=jnp.float32) + 1.0))


def _window_gqa(q, k, v, sink):
    B, S = q.shape[0], q.shape[1]
    nb = S // A_BLOCK
    qb = q.reshape(B, nb, A_BLOCK, A_KV_HEADS, A_GROUP, HEAD_DIM)
    pad = ((0, 0), (A_BLOCK, A_BLOCK), (0, 0), (0, 0))
    kp = jnp.pad(k, pad).reshape(B, nb + 2, A_BLOCK, A_KV_HEADS, HEAD_DIM)
    vp = jnp.pad(v, pad).reshape(B, nb + 2, A_BLOCK, A_KV_HEADS, HEAD_DIM)
    kb = jnp.concatenate([kp[:, :-2], kp[:, 1:-1], kp[:, 2:]], axis=2)
    vb = jnp.concatenate([vp[:, :-2], vp[:, 1:-1], vp[:, 2:]], axis=2)
    s = jnp.einsum('bnqhgd,bnkhd->bnhgqk', qb, kb).astype(jnp.float32) * (HEAD_DIM ** -0.5)
    qi = jnp.arange(A_BLOCK)[:, None]
    kj = jnp.arange(3 * A_BLOCK)[None, :]
    rel = kj - A_BLOCK - qi
    kpos = jnp.arange(nb)[:, None, None] * A_BLOCK + kj[None] - A_BLOCK
    valid = (jnp.abs(rel) <= A_WINDOW)[None] & (kpos >= 0) & (kpos < S)
    slopes = _alibi_slopes(A_Q_HEADS).reshape(A_KV_HEADS, A_GROUP, 1, 1)
    s = s - slopes * jnp.abs(rel).astype(jnp.float32)
    s = jnp.where(valid[None, :, None, None], s, -jnp.inf)
    sk = sink.astype(jnp.float32).reshape(A_KV_HEADS, A_GROUP)[None, None, :, :, None, None]
    m = jnp.maximum(jnp.max(s, axis=-1, keepdims=True), sk)
    p = jnp.exp(s - m)
    p = p / (jnp.sum(p, axis=-1, keepdims=True) + jnp.exp(sk - m))
    o = jnp.einsum('bnhgqk,bnkhd->bnqhgd', p.astype(v.dtype), vb)
    return o.reshape(B, S, A_Q_HEADS * HEAD_DIM)


def _neighbourhood_attn(q, k, v, rpb):
    B, S = q.shape[0], q.shape[1]
    rows = S // GRID_W
    kh = min(NA_KH, rows)
    kw = NA_KW
    qg = q.reshape(B, rows, GRID_W, B_HEADS, HEAD_DIM)
    kg = k.reshape(B, rows, GRID_W, B_HEADS, HEAD_DIM)
    vg = v.reshape(B, rows, GRID_W, B_HEADS, HEAD_DIM)
    qc = jnp.arange(GRID_W)
    cstart = jnp.clip(qc - kw // 2, 0, GRID_W - kw)
    kc = jnp.arange(GRID_W)
    col_valid = (kc[None, :] >= cstart[:, None]) & (kc[None, :] < cstart[:, None] + kw)
    col_idx = jnp.clip(kc[None, :] - qc[:, None] + NA_KW - 1, 0, 2 * NA_KW - 2)
    rpb_f = rpb.astype(jnp.float32)
    scale = HEAD_DIM ** -0.5

    def row_fn(r):
        rstart = jnp.clip(r - kh // 2, 0, rows - kh)
        qr = lax.dynamic_index_in_dim(qg, r, axis=1, keepdims=False)
        kr = lax.dynamic_slice_in_dim(kg, rstart, kh, axis=1)
        vr = lax.dynamic_slice_in_dim(vg, rstart, kh, axis=1)
        s = jnp.einsum('bqhd,brkhd->bhqrk', qr, kr).astype(jnp.float32) * scale
        row_idx = rstart + jnp.arange(kh) - r + NA_KH - 1
        bias = rpb_f[:, row_idx[None, :, None], col_idx[:, None, :]]
        s = jnp.where(col_valid[:, None, :], s + bias, -jnp.inf)
        p = jax.nn.softmax(s.reshape(B, B_HEADS, GRID_W, kh * GRID_W), axis=-1)
        p = p.reshape(B, B_HEADS, GRID_W, kh, GRID_W).astype(v.dtype)
        return jnp.einsum('bhqrk,brkhd->bqhd', p, vr)

    out = lax.map(row_fn, jnp.arange(rows))
    return out.transpose(1, 0, 2, 3, 4).reshape(B, S, B_HEADS * HEAD_DIM)


def _retention_dir(q, k, v, log_gamma, strict):
    B, S, H, dk = q.shape
    dv = v.shape[-1]
    nc = S // RET_CHUNK
    dt = q.dtype

    def chunks(t):
        return t.reshape(B, nc, RET_CHUNK, H, t.shape[-1]).transpose(1, 0, 3, 2, 4)

    lg = log_gamma[:, None]
    pos = jnp.arange(RET_CHUNK, dtype=jnp.float32)
    diff = pos[:, None] - pos[None, :]
    allowed = (diff > 0) if strict else (diff >= 0)
    dmask = jnp.where(allowed[None], jnp.exp(lg[:, :, None] * jnp.maximum(diff, 0.0)[None]), 0.0).astype(dt)
    cross = jnp.exp(lg * (pos + 1.0)).astype(dt)
    zeta = jnp.exp(lg * (RET_CHUNK - 1.0 - pos)).astype(dt)
    chunk_decay = jnp.exp(log_gamma * RET_CHUNK).astype(dt)

    def step(R, inp):
        qc, kc, vc = inp
        a = jnp.einsum('bhid,bhjd->bhij', qc, kc) * dmask
        o = jnp.einsum('bhij,bhjv->bhiv', a, vc) + jnp.einsum('bhid,bhdv->bhiv', qc, R) * cross[:, :, None]
        R = R * chunk_decay[:, None, None] + jnp.einsum('bhjd,bhjv->bhdv', kc * zeta[:, :, None], vc)
        return R, o

    R0 = jnp.zeros((B, H, dk, dv), dt)
    _, o = lax.scan(step, R0, (chunks(q), chunks(k), chunks(v)))
    return o.transpose(1, 0, 3, 2, 4).reshape(B, S, H, dv)


def _even_mixer(x, norm_g, w_in, qn_a, kn_a, sink_a, qn_b, kn_b, rpb_b, w_out):
    B, S, _ = x.shape
    h = _rmsnorm(x, norm_g)
    qa, ka, va, qb, kb, vb = _split(h @ w_in, EVEN_SPLITS)
    qa = _rmsnorm(qa.reshape(B, S, A_KV_HEADS, A_GROUP, HEAD_DIM), qn_a)
    ka = _rmsnorm(ka.reshape(B, S, A_KV_HEADS, HEAD_DIM), kn_a)
    va = va.reshape(B, S, A_KV_HEADS, HEAD_DIM)
    oa = _window_gqa(qa, ka, va, sink_a)
    qb = _rmsnorm(qb.reshape(B, S, B_HEADS, HEAD_DIM), qn_b)
    kb = _rmsnorm(kb.reshape(B, S, B_HEADS, HEAD_DIM), kn_b)
    vb = vb.reshape(B, S, B_HEADS, HEAD_DIM)
    ob = _neighbourhood_attn(qb, kb, vb, rpb_b)
    return jnp.concatenate([oa, ob], axis=-1) @ w_out


def _odd_mixer(x, norm_g, w_in, dec_f, dec_b, gn_g, w_out):
    B, S, _ = x.shape
    h = _rmsnorm(x, norm_g)
    q, k, v, g = _split(h @ w_in, ODD_SPLITS)
    q = q.reshape(B, S, RET_HEADS, RET_DK)
    k = k.reshape(B, S, RET_HEADS, RET_DK) * (RET_DK ** -0.5)
    v = v.reshape(B, S, RET_HEADS, RET_DV)
    lgf = jax.nn.log_sigmoid(dec_f.astype(jnp.float32))
    lgb = jax.nn.log_sigmoid(dec_b.astype(jnp.float32))
    y_f = _retention_dir(q, k, v, lgf, False)
    y_b = jnp.flip(_retention_dir(jnp.flip(q, 1), jnp.flip(k, 1), jnp.flip(v, 1), lgb, True), 1)
    yf = (y_f + y_b).astype(jnp.float32)
    mu = jnp.mean(yf, axis=-1, keepdims=True)
    var = jnp.mean(jnp.square(yf - mu), axis=-1, keepdims=True)
    yn = (yf - mu) * lax.rsqrt(var + GN_EPS) * gn_g.astype(jnp.float32).reshape(RET_HEADS, RET_DV)
    yn = yn.astype(x.dtype).reshape(B, S, ODD_MIX)
    return (jax.nn.silu(g) * yn) @ w_out


def _mlp(x, norm_g, w1, w2):
    h = _rmsnorm(x, norm_g)
    return jnp.square(jax.nn.relu(h @ w1)) @ w2


def setup_inputs(seed: int = 0) -> dict:
    key = jax.random.key(seed)
    ks = jax.random.split(key, 20)
    f32 = jnp.float32

    def nrm(k, shape, scale):
        return jax.random.normal(k, shape, f32) * scale

    def gain(k, shape):
        return 1.0 + 0.02 * jax.random.normal(k, shape, f32)

    hr = jnp.arange(RET_HEADS, dtype=f32)
    gamma = 1.0 - 2.0 ** (-5.0 - hr)
    base_logit = jnp.log(gamma) - jnp.log1p(-gamma)
    return {
        'x': nrm(ks[0], (BATCH, SEQ, D_MODEL), 1.0),
        'attn_norm_e': gain(ks[1], (N_EVEN, D_MODEL)),
        'w_in_e': nrm(ks[2], (N_EVEN, D_MODEL, EVEN_IN), D_MODEL ** -0.5),
        'q_norm_a': gain(ks[3], (N_EVEN, HEAD_DIM)),
        'k_norm_a': gain(ks[4], (N_EVEN, HEAD_DIM)),
        'sink_a': nrm(ks[5], (N_EVEN, A_Q_HEADS), 0.5),
        'q_norm_b': gain(ks[6], (N_EVEN, HEAD_DIM)),
        'k_norm_b': gain(ks[7], (N_EVEN, HEAD_DIM)),
        'rpb_b': nrm(ks[8], (N_EVEN, B_HEADS, 2 * NA_KH - 1, 2 * NA_KW - 1), 0.02),
        'w_out_e': nrm(ks[9], (N_EVEN, EVEN_MIX, D_MODEL), EVEN_MIX ** -0.5),
        'ret_norm_o': gain(ks[10], (N_ODD, D_MODEL)),
        'w_in_o': nrm(ks[11], (N_ODD, D_MODEL, ODD_IN), D_MODEL ** -0.5),
        'decay_fwd_o': base_logit[None] + nrm(ks[12], (N_ODD, RET_HEADS), 0.05),
        'decay_bwd_o': base_logit[None] + nrm(ks[13], (N_ODD, RET_HEADS), 0.05),
        'ret_gn_o': gain(ks[14], (N_ODD, ODD_MIX)),
        'w_out_o': nrm(ks[15], (N_ODD, ODD_MIX, D_MODEL), ODD_MIX ** -0.5),
        'mlp_norm': gain(ks[16], (DEPTH, D_MODEL)),
        'w_mlp_in': nrm(ks[17], (DEPTH, D_MODEL, D_FF), D_MODEL ** -0.5),
        'w_mlp_out': nrm(ks[18], (DEPTH, D_FF, D_MODEL), D_FF ** -0.5),
    }


def reference(x, attn_norm_e, w_in_e, q_norm_a, k_norm_a, sink_a, q_norm_b, k_norm_b, rpb_b, w_out_e,
              ret_norm_o, w_in_o, decay_fwd_o, decay_bwd_o, ret_gn_o, w_out_o,
              mlp_norm, w_mlp_in, w_mlp_out):
    for layer in range(DEPTH):
        i = layer // 2
        if layer % 2 == 0:
            x = x + _even_mixer(x, attn_norm_e[i], w_in_e[i], q_norm_a[i], k_norm_a[i], sink_a[i],
                                q_norm_b[i], k_norm_b[i], rpb_b[i], w_out_e[i])
        else:
            x = x + _odd_mixer(x, ret_norm_o[i], w_in_o[i], decay_fwd_o[i], decay_bwd_o[i],
                               ret_gn_o[i], w_out_o[i])
        x = x + _mlp(x, mlp_norm[layer], w_mlp_in[layer], w_mlp_out[layer])
    return x
```

```cpp
#include <hip/hip_runtime.h>
#include <hip/hip_cooperative_groups.h>
#include <cstdio>
#include <cstdint>
#include <cmath>
namespace cg = cooperative_groups;
namespace pg8 {
#define PG8_LAS __attribute__((address_space(3)))
typedef unsigned short bf16_t;
typedef short bf16x8 __attribute__((ext_vector_type(8)));
typedef float f32x4 __attribute__((ext_vector_type(4)));
typedef float f32x2 __attribute__((ext_vector_type(2)));
typedef unsigned u32x4 __attribute__((ext_vector_type(4)));
typedef unsigned u32x2 __attribute__((ext_vector_type(2)));
constexpr int BM = 256, BK = 64, HALF = 128, HTB = HALF * BK * 2  , STAGE_BYTES = 8 * HTB, NXCD = 8, WGM = 8;

__host__ __device__ __forceinline__ int lds_byte(int r, int c) { const int st = (r >> 4) * 2 + (c >> 5), rr = r & 15, cc = c & 31, ob = rr * 64 + cc * 2; return st * 1024 + (ob ^ (((ob >> 9) & 1) << 5)); }
__host__ __device__ __forceinline__ void stage_rc(int b, int& R, int& C) { const int st = b / 1024, sb = b % 1024, swz = sb ^ (((sb >> 9) & 1) << 5); R = (st >> 1) * 16 + swz / 64; C = (st & 1) * 32 + (swz % 64) / 2; }
__host__ __device__ __forceinline__ int perm32(int rho) { const int n = rho >> 4, i = rho & 15; return 8 * (i >> 2) + 4 * n + (i & 3); }

struct Unit { int pm, pn; };
struct Gemm { const bf16_t* A; const bf16_t* Bt; int lda, ldb, M, N, K; };

struct StaticOrder {
    int nM, nN, nwg, G, c;
    __host__ __device__ void init(int M, int N, int G_, int c_) { nM = M / BM; nN = N / BM; nwg = nM * nN; G = G_; c = c_; }
    __host__ __device__ bool next(int i, Unit& u) const {
        const long L = (long)i * G + c; if (L >= nwg) return false;
        int wgid = (int)L; { const int q = nwg / NXCD, r = nwg % NXCD, xcd = wgid % NXCD, off = wgid / NXCD; wgid = (xcd < r ? xcd * (q + 1) : r * (q + 1) + (xcd - r) * q) + off; }
        const int nig = WGM * nN, gid = wgid / nig, fm = gid * WGM, gsz = (nM - fm) < WGM ? (nM - fm) : WGM;
        u.pm = fm + ((wgid % nig) % gsz); u.pn = (wgid % nig) / gsz; return true;
    }
};

typedef float f32x2_cv __attribute__((ext_vector_type(2))); typedef __bf16 bf16x2_cv __attribute__((ext_vector_type(2)));
__device__ __forceinline__ unsigned cvt_pk_bf16(float lo, float hi) { const f32x2_cv v = {lo, hi}; const bf16x2_cv b = __builtin_convertvector(v, bf16x2_cv); return __builtin_bit_cast(unsigned, b); }


__device__ __forceinline__ float row_rstd(const float* ssq, int row) { const f32x4 p = *(const f32x4*)(ssq + 4 * (size_t)row); return rsqrtf(((p[0] + p[1]) + (p[2] + p[3])) * (1.0f / 1024.0f) + 1e-6f); }

struct EpiBf16 {
    static constexpr bool PERM = true, AFTER_DRAIN = false;
    bf16_t* O; int ldc; const float* ssq; int silu_pn0; int act;
    __device__ __forceinline__ void operator()(const f32x4 (&acc)[2][2][4][2], const Unit& u, int wr, int wc, int fr, int fq) const {
        const int row0 = u.pm * BM + wr * 64 + fr; const int col0 = u.pn * BM + wc * 32 + 8 * fq;
        const bool do_silu = (act == 2) && (u.pn >= silu_pn0);
#pragma unroll
        for (int ai = 0; ai < 2; ++ai)
#pragma unroll
            for (int m = 0; m < 4; ++m) { const int row = row0 + ai * HALF + m * 16; const float rs = row_rstd(ssq, row); bf16_t* rowp = O + (size_t)row * ldc + col0;
#pragma unroll
                for (int bj = 0; bj < 2; ++bj) { f32x4 v0 = acc[ai][bj][m][0] * rs, v1 = acc[ai][bj][m][1] * rs;
                    if (act == 1) {
#pragma unroll
                        for (int e = 0; e < 4; ++e) { const float a = fmaxf(v0[e], 0.f), b = fmaxf(v1[e], 0.f); v0[e] = a * a; v1[e] = b * b; } }
                    if (do_silu) {
#pragma unroll
                        for (int e = 0; e < 4; ++e) { v0[e] = v0[e] / (1.0f + __expf(-v0[e])); v1[e] = v1[e] / (1.0f + __expf(-v1[e])); } }
                    u32x4 w; w.x = cvt_pk_bf16(v0[0], v0[1]); w.y = cvt_pk_bf16(v0[2], v0[3]); w.z = cvt_pk_bf16(v1[0], v1[1]); w.w = cvt_pk_bf16(v1[2], v1[3]);
                    *(u32x4*)(rowp + bj * HALF) = w; } }
    }
};

struct EpiResid {
    static constexpr bool PERM = false, AFTER_DRAIN = true;
    const float* base; float* out; bf16_t* xb; float* ssq_out; int ldc;
    __device__ __forceinline__ void fused(f32x4 (&acc)[2][2][4][2], const Unit& u, int wr, int wc, int fr, int fq, PG8_LAS unsigned char* lds, int wid, int lane) const {
        PG8_LAS float* P = (PG8_LAS float*)lds;
        const int col0 = u.pn * BM + wc * 32 + 4 * fq;
#pragma unroll
        for (int ai = 0; ai < 2; ++ai)
#pragma unroll
            for (int m = 0; m < 4; ++m) { const int r = ai * HALF + wr * 64 + m * 16 + fr; const size_t off = (size_t)(u.pm * BM + r) * ldc + col0; float s = 0.f;
#pragma unroll
                for (int bj = 0; bj < 2; ++bj)
#pragma unroll
                    for (int n = 0; n < 2; ++n) { const f32x4 bs = *(const f32x4*)(base + off + bj * HALF + n * 16); const f32x4 o = bs + acc[ai][bj][m][n];
                        *(f32x4*)(out + off + bj * HALF + n * 16) = o;
                        if (xb) { u32x2 w; w.x = cvt_pk_bf16(o[0], o[1]); w.y = cvt_pk_bf16(o[2], o[3]); *(u32x2*)(xb + off + bj * HALF + n * 16) = w; }
                        s += (o[0] * o[0] + o[1] * o[1]) + (o[2] * o[2] + o[3] * o[3]); }
                if (ssq_out) { s += __shfl_xor(s, 16); s += __shfl_xor(s, 32); if (fq == 0) P[r * 4 + wc] = s; }
                if (m & 1) asm volatile("" ::: "memory"); }
        if (ssq_out) {
            __syncthreads();
            const int t = wid * 64 + lane;
            if (t < 256) { const float s = (P[t * 4 + 0] + P[t * 4 + 1]) + (P[t * 4 + 2] + P[t * 4 + 3]); ssq_out[(size_t)(u.pm * BM + t) * 4 + u.pn] = s; }
            __syncthreads();
        }
    }
};

template <class Epi, class Sched, bool ALIGN_EPI = false, bool SP2 = false>
__device__ __forceinline__ void gemm_phase(PG8_LAS unsigned char* lds, const Gemm g, const Sched& S, const Epi& E, const int tid) {
    const int wid = __builtin_amdgcn_readfirstlane(tid >> 6), lane = tid & 63, wr = wid >> 2, wc = wid & 3, fr = lane & 15, fq = lane >> 4;
    const int K = g.K, nt = K / BK;
    unsigned voffA[2], voffB[2];
#pragma unroll
    for (int i = 0; i < 2; ++i) { int R, C; stage_rc(tid * 16 + i * 8192, R, C); const int Rb = Epi::PERM ? ((R & ~31) + perm32(R & 31)) : R;
        voffA[i] = (unsigned)(R * g.lda + C) * 2u; voffB[i] = (unsigned)(Rb * g.ldb + C) * 2u; }
    const size_t kstep = (size_t)(BK * 2);
    const size_t hstepA = (size_t)HALF * g.lda * 2, hstepB = (size_t)HALF * g.ldb * 2;
    const size_t tstepA = 2 * hstepA, tstepB = 2 * hstepB;
    const unsigned ldsw = (unsigned)wid * 1024u;
    const int aoff = lds_byte(wr * 64 + fr, fq * 8), boff = lds_byte(wc * 32 + fr, fq * 8);
#define PG8_SA(b, h) (((b) * 2 + (h)) * HTB)
#define PG8_SB(b, h) ((4 + (b) * 2 + (h)) * HTB)
#define PG8_STAGE(bufoff, gbase, voff) do { _Pragma("unroll") for (int _i = 0; _i < 2; ++_i) \
        __builtin_amdgcn_global_load_lds((const unsigned*)((const char*)(gbase) + (voff)[_i]), (PG8_LAS unsigned*)(lds + (bufoff) + ldsw + _i * 8192), 16, 0, 0); } while (0)
#define PG8_LDA(dst, b, h) do { _Pragma("unroll") for (int m = 0; m < 4; ++m) _Pragma("unroll") for (int k = 0; k < 2; ++k) dst[m][k] = *(const PG8_LAS bf16x8*)(lds + PG8_SA(b, h) + aoff + m * 2048 + k * 1024); } while (0)
#define PG8_LDB(dst, b, h) do { _Pragma("unroll") for (int n = 0; n < 2; ++n) _Pragma("unroll") for (int k = 0; k < 2; ++k) dst[n][k] = *(const PG8_LAS bf16x8*)(lds + PG8_SB(b, h) + boff + n * 2048 + k * 1024); } while (0)
#define PG8_MMA(ai, bj, At, Bt) do { __builtin_amdgcn_s_setprio(1); _Pragma("unroll") for (int m = 0; m < 4; ++m) _Pragma("unroll") for (int n = 0; n < 2; ++n) _Pragma("unroll") for (int k = 0; k < 2; ++k) \
        acc[ai][bj][m][n] = __builtin_amdgcn_mfma_f32_16x16x32_bf16(Bt[n][k], At[m][k], acc[ai][bj][m][n], 0, 0, 0); __builtin_amdgcn_s_setprio(0); } while (0)
#define PG8_WAIT_V(n) asm volatile("s_waitcnt vmcnt(" #n ")" ::: "memory")
#define PG8_WAIT_L(n) asm volatile("s_waitcnt lgkmcnt(" #n ")" ::: "memory")
#define PG8_BAR __builtin_amdgcn_s_barrier()
#define PG8_SCHED __builtin_amdgcn_sched_barrier(0)
    Unit cur, nxt; int ui = 0;
    if (!S.next(0, cur)) return;
    f32x4 acc[2][2][4][2];
#pragma unroll
    for (int a = 0; a < 2; ++a)
#pragma unroll
        for (int b = 0; b < 2; ++b)
#pragma unroll
            for (int m = 0; m < 4; ++m)
#pragma unroll
                for (int n = 0; n < 2; ++n) acc[a][b][m][n] = (f32x4){0.f, 0.f, 0.f, 0.f};
    bf16x8 At[4][2], B0[2][2], B1[2][2];
    const char* cA = (const char*)g.A + (size_t)cur.pm * tstepA; const char* cB = (const char*)g.Bt + (size_t)cur.pn * tstepB;
    if constexpr (SP2) {
        PG8_STAGE(PG8_SB(0, 0), cB, voffB); PG8_STAGE(PG8_SB(0, 1), cB + hstepB, voffB); PG8_STAGE(PG8_SA(0, 0), cA, voffA); PG8_STAGE(PG8_SA(0, 1), cA + hstepA, voffA);
        if (wr == 1) PG8_BAR;
        PG8_WAIT_V(2); PG8_BAR;
        PG8_STAGE(PG8_SB(1, 0), cB + kstep, voffB); PG8_STAGE(PG8_SA(1, 0), cA + kstep, voffA); PG8_STAGE(PG8_SB(1, 1), cB + hstepB + kstep, voffB);
        PG8_WAIT_V(6); PG8_BAR;
    } else {
        PG8_STAGE(PG8_SB(0, 0), cB, voffB); PG8_STAGE(PG8_SA(0, 0), cA, voffA); PG8_STAGE(PG8_SB(0, 1), cB + hstepB, voffB); PG8_STAGE(PG8_SA(0, 1), cA + hstepA, voffA);
        if (wr == 1) PG8_BAR;
        PG8_WAIT_V(4); PG8_BAR;
        PG8_STAGE(PG8_SB(1, 0), cB + kstep, voffB); PG8_STAGE(PG8_SA(1, 0), cA + kstep, voffA); PG8_STAGE(PG8_SB(1, 1), cB + hstepB + kstep, voffB);
        PG8_WAIT_V(6); PG8_BAR;
    }
    for (;;) {
        const bool has_next = S.next(ui + 1, nxt);
        const char* nA = has_next ? (const char*)g.A + (size_t)nxt.pm * tstepA : cA; const char* nB = has_next ? (const char*)g.Bt + (size_t)nxt.pn * tstepB : cB;
        for (int t = 0; t < nt; t += 2) {
            const bool last = (t == nt - 2);
            const char* a1 = cA + (size_t)(t + 1) * kstep;
            const char* a2 = last ? nA : cA + (size_t)(t + 2) * kstep; const char* b2 = last ? nB : cB + (size_t)(t + 2) * kstep;
            const char* a3 = a2 + kstep; const char* b3 = b2 + kstep;
            if constexpr (SP2) {
            PG8_LDB(B0, 0, 0); PG8_LDB(B1, 0, 1); PG8_SCHED; PG8_LDA(At, 0, 0); PG8_STAGE(PG8_SA(1, 1), a1 + hstepA, voffA);
            PG8_WAIT_V(8); PG8_WAIT_L(0); PG8_BAR; PG8_MMA(0, 0, At, B0); PG8_MMA(0, 1, At, B1); PG8_BAR; PG8_SCHED;
            PG8_LDA(At, 0, 1); PG8_STAGE(PG8_SB(0, 0), b2, voffB); PG8_STAGE(PG8_SB(0, 1), b2 + hstepB, voffB); PG8_STAGE(PG8_SA(0, 0), a2, voffA);
            PG8_WAIT_V(8); PG8_WAIT_L(0); PG8_BAR; PG8_MMA(1, 0, At, B0); PG8_MMA(1, 1, At, B1); PG8_BAR; PG8_SCHED;
            PG8_LDB(B0, 1, 0); PG8_LDB(B1, 1, 1); PG8_SCHED; PG8_LDA(At, 1, 0); PG8_STAGE(PG8_SA(0, 1), a2 + hstepA, voffA);
            PG8_WAIT_V(8); PG8_WAIT_L(0); PG8_BAR; PG8_MMA(0, 0, At, B0); PG8_MMA(0, 1, At, B1); PG8_BAR; PG8_SCHED;
            PG8_LDA(At, 1, 1); PG8_STAGE(PG8_SB(1, 0), b3, voffB); PG8_STAGE(PG8_SB(1, 1), b3 + hstepB, voffB); PG8_STAGE(PG8_SA(1, 0), a3, voffA);
            PG8_WAIT_V(8); PG8_WAIT_L(0); PG8_BAR; PG8_MMA(1, 0, At, B0); PG8_MMA(1, 1, At, B1); PG8_BAR; PG8_SCHED;
            } else {
            PG8_LDB(B0, 0, 0); PG8_SCHED; PG8_LDA(At, 0, 0); PG8_STAGE(PG8_SA(1, 1), a1 + hstepA, voffA);
            PG8_WAIT_L(8); PG8_BAR; PG8_WAIT_L(0); PG8_MMA(0, 0, At, B0); PG8_BAR; PG8_SCHED;
            PG8_LDB(B1, 0, 1); PG8_STAGE(PG8_SB(0, 0), b2, voffB);
            PG8_BAR; PG8_WAIT_L(0); PG8_MMA(0, 1, At, B1); PG8_BAR;
            PG8_LDA(At, 0, 1); PG8_STAGE(PG8_SA(0, 0), a2, voffA);
            PG8_BAR; PG8_WAIT_L(0); PG8_MMA(1, 0, At, B0); PG8_BAR; PG8_SCHED;
            PG8_STAGE(PG8_SB(0, 1), b2 + hstepB, voffB);
            PG8_WAIT_V(6); PG8_BAR; PG8_MMA(1, 1, At, B1); PG8_BAR;
            PG8_LDB(B0, 1, 0); PG8_SCHED; PG8_LDA(At, 1, 0); PG8_STAGE(PG8_SA(0, 1), a2 + hstepA, voffA);
            PG8_WAIT_L(8); PG8_BAR; PG8_WAIT_L(0); PG8_MMA(0, 0, At, B0); PG8_BAR; PG8_SCHED;
            PG8_LDB(B1, 1, 1); PG8_STAGE(PG8_SB(1, 0), b3, voffB);
            PG8_BAR; PG8_WAIT_L(0); PG8_MMA(0, 1, At, B1); PG8_BAR;
            PG8_LDA(At, 1, 1); PG8_STAGE(PG8_SA(1, 0), a3, voffA);
            PG8_BAR; PG8_WAIT_L(0); PG8_MMA(1, 0, At, B0); PG8_BAR; PG8_SCHED;
            PG8_STAGE(PG8_SB(1, 1), b3 + hstepB, voffB);
            PG8_WAIT_V(6); PG8_BAR; PG8_MMA(1, 1, At, B1); PG8_BAR;
            }
        }
        if constexpr (ALIGN_EPI) { if (wr == 0) PG8_BAR; }
        if constexpr (!Epi::AFTER_DRAIN) { E(acc, cur, wr, wc, fr, fq); }
        if (!has_next) break;
#pragma unroll
        for (int a = 0; a < 2; ++a)
#pragma unroll
            for (int b = 0; b < 2; ++b)
#pragma unroll
                for (int m = 0; m < 4; ++m)
#pragma unroll
                    for (int n = 0; n < 2; ++n) acc[a][b][m][n] = (f32x4){0.f, 0.f, 0.f, 0.f};
        cur = nxt; cA = nA; cB = nB; ++ui;
        if constexpr (ALIGN_EPI) { if (wr == 1) PG8_BAR; }
    }
    PG8_WAIT_V(0);
    if constexpr (!ALIGN_EPI) { if (wr == 0) PG8_BAR; }
    PG8_BAR;
    if constexpr (Epi::AFTER_DRAIN) { E.fused(acc, cur, wr, wc, fr, fq, lds, wid, lane); }
#undef PG8_SA
#undef PG8_SB
#undef PG8_STAGE
#undef PG8_LDA
#undef PG8_LDB
#undef PG8_MMA
#undef PG8_WAIT_V
#undef PG8_WAIT_L
#undef PG8_BAR
#undef PG8_SCHED
}
}
#define LAS __attribute__((address_space(3)))
typedef unsigned short bf16;
typedef short bf16x8 __attribute__((ext_vector_type(8)));
typedef short s16x4 __attribute__((ext_vector_type(4)));
typedef float f32x4 __attribute__((ext_vector_type(4)));
typedef unsigned u32x4 __attribute__((ext_vector_type(4)));
typedef unsigned u32x2 __attribute__((ext_vector_type(2)));
typedef LAS unsigned char* ldsp;
constexpr float LOG2E = 1.4426950408889634f;

__device__ __forceinline__ float bf_lo(unsigned w) { return __uint_as_float(w << 16); }
__device__ __forceinline__ float bf_hi(unsigned w) { return __uint_as_float(w & 0xffff0000u); }
__device__ __forceinline__ unsigned pk2(float lo, float hi) { return pg8::cvt_pk_bf16(lo, hi); }
__device__ __forceinline__ s16x4 vtr(ldsp p) { typedef short v4i16_t __attribute__((ext_vector_type(4))); return __builtin_bit_cast(s16x4, __builtin_amdgcn_ds_read_tr16_b64_v4i16((LAS v4i16_t*)p)); }
__device__ __forceinline__ bf16x8 cat8(s16x4 lo, s16x4 hi) { return (bf16x8){lo[0], lo[1], lo[2], lo[3], hi[0], hi[1], hi[2], hi[3]}; }
__device__ __forceinline__ f32x4 mfma16(bf16x8 a, bf16x8 b, f32x4 c) { return __builtin_amdgcn_mfma_f32_16x16x32_bf16(a, b, c, 0, 0, 0); }
__device__ __forceinline__ float ex2(float x) { return __builtin_amdgcn_exp2f(x); }

namespace att {
constexpr int SEQ = 16384, LDQ = 2304, LDO = 1024;
constexpr int KPB = 160;
constexpr int COL_QA = 0, COL_KA = 512, COL_VA = 640, COL_QB = 768, COL_KB = 1280, COL_VB = 1792;

template <bool NORM>
__device__ __forceinline__ void stage_rows(ldsp dst, const bf16* src, int tok0, int nrows, int nvalid, const float* gain, int tid) {
    const int sub = tid & 7;
    float gn[8];
    if (NORM) {
#pragma unroll
        for (int j = 0; j < 8; ++j) gn[j] = gain[sub * 8 + j];
    }
    for (int r = tid >> 3; r < nrows; r += 64) {
        const int tok = tok0 + r; const bool ok = (tok >= 0) && (tok < SEQ) && (r < nvalid);
        u32x4 v = (u32x4){0u, 0u, 0u, 0u};
        if (ok) v = *(const u32x4*)(src + (size_t)tok * LDQ + sub * 8);
        if (NORM) {
            float f[8]; f[0] = bf_lo(v.x); f[1] = bf_hi(v.x); f[2] = bf_lo(v.y); f[3] = bf_hi(v.y); f[4] = bf_lo(v.z); f[5] = bf_hi(v.z); f[6] = bf_lo(v.w); f[7] = bf_hi(v.w);
            float ss = 0.f;
#pragma unroll
            for (int j = 0; j < 8; ++j) ss += f[j] * f[j];
            ss += __shfl_xor(ss, 1); ss += __shfl_xor(ss, 2); ss += __shfl_xor(ss, 4);
            const float rs = rsqrtf(ss * (1.0f / 64.0f) + 1e-6f);
#pragma unroll
            for (int j = 0; j < 8; ++j) f[j] = f[j] * rs * gn[j];
            v.x = pk2(f[0], f[1]); v.y = pk2(f[2], f[3]); v.z = pk2(f[4], f[5]); v.w = pk2(f[6], f[7]);
        }
        *(LAS u32x4*)(dst + r * KPB + sub * 16) = v;
    }
}

__device__ __forceinline__ void load_q(bf16x8 (&qf)[2], const bf16* qrow  , const float* gain, int g) {
    float f[2][8]; float ss = 0.f;
#pragma unroll
    for (int s = 0; s < 2; ++s) { const u32x4 v = *(const u32x4*)(qrow + 32 * s + 8 * g);
        f[s][0] = bf_lo(v.x); f[s][1] = bf_hi(v.x); f[s][2] = bf_lo(v.y); f[s][3] = bf_hi(v.y); f[s][4] = bf_lo(v.z); f[s][5] = bf_hi(v.z); f[s][6] = bf_lo(v.w); f[s][7] = bf_hi(v.w);
#pragma unroll
        for (int j = 0; j < 8; ++j) ss += f[s][j] * f[s][j]; }
    ss += __shfl_xor(ss, 16); ss += __shfl_xor(ss, 32);
    const float rs = rsqrtf(ss * (1.0f / 64.0f) + 1e-6f) * (0.125f * LOG2E);
#pragma unroll
    for (int s = 0; s < 2; ++s) { float o[8];
#pragma unroll
        for (int j = 0; j < 8; ++j) o[j] = f[s][j] * rs * gain[32 * s + 8 * g + j];
        u32x4 w; w.x = pk2(o[0], o[1]); w.y = pk2(o[2], o[3]); w.z = pk2(o[4], o[5]); w.w = pk2(o[6], o[7]);
        qf[s] = __builtin_bit_cast(bf16x8, w); }
}

template <int NT, class RB>
__device__ __forceinline__ void scores(f32x4 (&sc)[NT], ldsp Kb, const bf16x8 (&qf)[2], const RB& rb, int lane) {
    const int fr = lane & 15, g = lane >> 4;
#pragma unroll
    for (int t = 0; t < NT; ++t) { ldsp kp = Kb + (rb(t) + fr) * KPB + g * 16; f32x4 a = (f32x4){0.f, 0.f, 0.f, 0.f};
#pragma unroll
        for (int s = 0; s < 2; ++s) { const bf16x8 kf = *(const LAS bf16x8*)(kp + s * 64); a = mfma16(kf, qf[s], a); }
        sc[t] = a; }
}
template <int NT>
__device__ __forceinline__ float softmax_pack(f32x4 (&sc)[NT], bf16x8 (&pf)[NT / 2], float sink2, bool has_sink) {
    float m = -INFINITY;
#pragma unroll
    for (int t = 0; t < NT; ++t)
#pragma unroll
        for (int r = 0; r < 4; ++r) m = fmaxf(m, sc[t][r]);
    m = fmaxf(m, __shfl_xor(m, 16)); m = fmaxf(m, __shfl_xor(m, 32));
    if (has_sink) m = fmaxf(m, sink2);
    float sum = 0.f;
#pragma unroll
    for (int t = 0; t < NT; ++t)
#pragma unroll
        for (int r = 0; r < 4; ++r) { const float p = ex2(sc[t][r] - m); sc[t][r] = p; sum += p; }
    sum += __shfl_xor(sum, 16); sum += __shfl_xor(sum, 32);
    if (has_sink) sum += ex2(sink2 - m);
#pragma unroll
    for (int k = 0; k < NT / 2; ++k) { u32x4 w; w.x = pk2(sc[2 * k][0], sc[2 * k][1]); w.y = pk2(sc[2 * k][2], sc[2 * k][3]); w.z = pk2(sc[2 * k + 1][0], sc[2 * k + 1][1]); w.w = pk2(sc[2 * k + 1][2], sc[2 * k + 1][3]);
        pf[k] = __builtin_bit_cast(bf16x8, w); }
    return sum;
}
template <int NT, class RB>
__device__ __forceinline__ void pv_store(ldsp Vb, const bf16x8 (&pf)[NT / 2], const RB& rb, float sum, bf16* orow  , int lane) {
    const int g = lane >> 4, q4 = (lane & 15) >> 2, p4 = lane & 3;
    f32x4 o[4];
#pragma unroll
    for (int dt = 0; dt < 4; ++dt) o[dt] = (f32x4){0.f, 0.f, 0.f, 0.f};
#pragma unroll
    for (int k = 0; k < NT / 2; ++k) { ldsp v0 = Vb + (rb(2 * k) + 4 * g + q4) * KPB + p4 * 8; ldsp v1 = Vb + (rb(2 * k + 1) + 4 * g + q4) * KPB + p4 * 8;
#pragma unroll
        for (int dt = 0; dt < 4; ++dt) { const bf16x8 vf = cat8(vtr(v0 + dt * 32), vtr(v1 + dt * 32)); o[dt] = mfma16(vf, pf[k], o[dt]); } }
    const float inv = 1.0f / sum;
#pragma unroll
    for (int dt = 0; dt < 4; ++dt) { u32x2 w; w.x = pk2(o[dt][0] * inv, o[dt][1] * inv); w.y = pk2(o[dt][2] * inv, o[dt][3] * inv); *(u32x2*)(orow + dt * 16 + 4 * g) = w; }
}

struct RbWin { int mt; __device__ __forceinline__ int operator()(int t) const { return 16 * (mt + t); } };
struct RbNa { int off, ctb; __device__ __forceinline__ int operator()(int t) const { return (off + t / 3) * 64 + (ctb + t % 3) * 16; } };

struct AttnArgs { const bf16* qkv; bf16* o; const float* qn_a; const float* kn_a; const float* sink_a; const float* qn_b; const float* kn_b; const float* rpb; };

__device__ __forceinline__ void window_unit(ldsp lds, const AttnArgs& A, int unit, int tid) {
    const int n = unit >> 1, kvh = unit & 1, lane = tid & 63, wid = __builtin_amdgcn_readfirstlane(tid >> 6);
    ldsp Kb = lds, Vb = lds + 400 * KPB;
    const int tok0 = (n - 1) * 128;
    stage_rows<true>(Kb, A.qkv + COL_KA + kvh * 64, tok0, 400, 384, A.kn_a, tid);
    stage_rows<false>(Vb, A.qkv + COL_VA + kvh * 64, tok0, 400, 384, nullptr, tid);
    __syncthreads();
    const int fr = lane & 15, g = lane >> 4;
    for (int it = 0; it < 4; ++it) {
        const int idx = wid * 4 + it, g4 = idx >> 3, mt = idx & 7, hq = kvh * 4 + g4;
        const int qtok = n * 128 + mt * 16 + fr;
        bf16x8 qf[2]; load_q(qf, A.qkv + (size_t)qtok * LDQ + COL_QA + hq * 64, A.qn_a, g);
        RbWin rb{mt};
        f32x4 sc[18]; scores<18>(sc, Kb, qf, rb, lane);
        const float slope2 = exp2f(-(float)(hq + 1)) * LOG2E;
        const int il = mt * 16 + fr;
#pragma unroll
        for (int t = 0; t < 18; ++t)
#pragma unroll
            for (int r = 0; r < 4; ++r) { const int j = 16 * (mt + t) + 4 * g + r; const int rel = j - 128 - il; const int arel = rel < 0 ? -rel : rel; const int kpos = tok0 + j;
                const bool ok = (arel <= 128) && (kpos >= 0) && (kpos < SEQ);
                sc[t][r] = ok ? sc[t][r] - slope2 * (float)arel : -INFINITY; }
        bf16x8 pf[9]; const float sum = softmax_pack<18>(sc, pf, A.sink_a[hq] * LOG2E, true);
        pv_store<18>(Vb, pf, rb, sum, A.o + (size_t)qtok * LDO + hq * 64, lane);
    }
    __syncthreads();
}

__device__ __forceinline__ void na_unit(ldsp lds, const AttnArgs& A, int unit, int tid) {
    const int rp = unit >> 3, h = unit & 7, lane = tid & 63, wid = __builtin_amdgcn_readfirstlane(tid >> 6);
    const int r0 = 2 * rp; const int base = min(max(r0 - 4, 0), 248);
    const int qsel = wid >> 2, mt = wid & 3; const int rq = r0 + qsel; const int rstart = min(max(rq - 4, 0), 248);
    const int fr = lane & 15, g = lane >> 4;
    stage_rows<true>(lds, A.qkv + COL_KB + h * 64, base * 64, 576, 576, A.kn_b, tid);
    __syncthreads();
    const int qc = mt * 16 + fr; const int qtok = rq * 64 + qc;
    bf16x8 qf[2]; load_q(qf, A.qkv + (size_t)qtok * LDQ + COL_QB + h * 64, A.qn_b, g);
    RbNa rb{rstart - base, mt <= 1 ? 0 : 1};
    f32x4 sc[24]; scores<24>(sc, lds, qf, rb, lane);
    const int cstart = min(max(qc - 8, 0), 48);
    const float* rp_h = A.rpb + h * (15 * 31);
#pragma unroll
    for (int t = 0; t < 24; ++t)
#pragma unroll
        for (int r = 0; r < 4; ++r) { const int kr = t / 3; const int kc = (rb.ctb + t % 3) * 16 + 4 * g + r; const bool ok = (kc >= cstart) && (kc < cstart + 16);
            const int ri = rstart + kr - rq + 7; int ci = kc - qc + 15; ci = min(max(ci, 0), 30);
            const float b = rp_h[ri * 31 + ci] * LOG2E;
            sc[t][r] = ok ? sc[t][r] + b : -INFINITY; }
    bf16x8 pf[12]; const float sum = softmax_pack<24>(sc, pf, 0.f, false);
    __syncthreads();
    stage_rows<false>(lds, A.qkv + COL_VB + h * 64, base * 64, 576, 576, nullptr, tid);
    __syncthreads();
    pv_store<24>(lds, pf, rb, sum, A.o + (size_t)qtok * LDO + 512 + h * 64, lane);
    __syncthreads();
}

__device__ __forceinline__ void attn_phase(ldsp lds, const AttnArgs& A, int vcu, int G, int tid) {
    for (int u = vcu; u < 256; u += G) window_unit(lds, A, u, tid);
    for (int u = vcu; u < 1024; u += G) na_unit(lds, A, u, tid);
}
}
namespace ret {
constexpr int SEQ = 16384, LDG = 3072, NCH = 128;
constexpr int COL_Q = 0, COL_K = 512, COL_V = 1024, COL_G = 2048;
constexpr int KPB = 288;
constexpr int VPB = 544;
constexpr int R0 = 0, R1 = 128 * KPB, R2 = 2 * 128 * KPB, RSTAT = R2 + 128 * VPB;
constexpr size_t ST_CHUNK = 128 * 256;

struct RetArgs { bf16* G; bf16* ST; const float* l2;   const float* gn; int grp; };

template <bool SCALE>
__device__ __forceinline__ void stage128(ldsp dst, const bf16* src, int ld, float a, float b, int tid) {
#pragma unroll
    for (int i = 0; i < 4; ++i) { const int idx = tid + i * 512, row = idx >> 4, ch = idx & 15;
        u32x4 v = *(const u32x4*)(src + (size_t)row * ld + ch * 8);
        if (SCALE) { const float s = ex2(a * (float)row + b);
            v.x = pk2(bf_lo(v.x) * s, bf_hi(v.x) * s); v.y = pk2(bf_lo(v.y) * s, bf_hi(v.y) * s); v.z = pk2(bf_lo(v.z) * s, bf_hi(v.z) * s); v.w = pk2(bf_lo(v.w) * s, bf_hi(v.w) * s); }
        *(LAS u32x4*)(dst + row * KPB + ch * 16) = v; }
}
__device__ __forceinline__ void stage256(ldsp dst, const bf16* src, int ld, int tid) {
#pragma unroll
    for (int i = 0; i < 8; ++i) { const int idx = tid + i * 512, row = idx >> 5, ch = idx & 31;
        const u32x4 v = *(const u32x4*)(src + (size_t)row * ld + ch * 8);
        *(LAS u32x4*)(dst + row * VPB + ch * 16) = v; }
}
__device__ __forceinline__ bf16x8 trfrag(ldsp X, int pitch, int k0, int n0, int lane) {
    const int g = lane >> 4, q4 = (lane & 15) >> 2, p4 = lane & 3;
    ldsp p = X + (k0 + 8 * g + q4) * pitch + (n0 + 4 * p4) * 2;
    return cat8(vtr(p), vtr(p + 4 * pitch));
}

__device__ __forceinline__ void ret_a_unit(ldsp lds, const RetArgs& A, int unit, int tid) {
    const int hl = unit & 3, c = unit >> 2, h = A.grp * 4 + hl, lane = tid & 63, wid = __builtin_amdgcn_readfirstlane(tid >> 6);
    const float l2f = A.l2[h], l2b = A.l2[8 + h];
    const bf16* rows = A.G + (size_t)c * 128 * LDG;
    stage128<true>(lds + R0, rows + COL_K + hl * 128, LDG, -l2f, 127.0f * l2f, tid);
    stage128<true>(lds + R1, rows + COL_K + hl * 128, LDG, l2b, 0.f, tid);
    stage256(lds + R2, rows + COL_V + hl * 256, LDG, tid);
    __syncthreads();
    const int fr = lane & 15, g = lane >> 4;
    for (int dir = 0; dir < 2; ++dir) {
        ldsp Kx = lds + (dir ? R1 : R0);
        f32x4 acc[2][8];
#pragma unroll
        for (int et = 0; et < 2; ++et)
#pragma unroll
            for (int dt = 0; dt < 8; ++dt) acc[et][dt] = (f32x4){0.f, 0.f, 0.f, 0.f};
#pragma unroll
        for (int ks = 0; ks < 4; ++ks) {
            bf16x8 vf[2];
#pragma unroll
            for (int et = 0; et < 2; ++et) vf[et] = trfrag(lds + R2, VPB, 32 * ks, 32 * wid + 16 * et, lane);
#pragma unroll
            for (int dt = 0; dt < 8; ++dt) { const bf16x8 kf = trfrag(Kx, KPB, 32 * ks, 16 * dt, lane);
#pragma unroll
                for (int et = 0; et < 2; ++et) acc[et][dt] = mfma16(vf[et], kf, acc[et][dt]); }
        }
        bf16* st = A.ST + ((size_t)((dir * 4 + hl) * NCH + c)) * ST_CHUNK;
#pragma unroll
        for (int et = 0; et < 2; ++et)
#pragma unroll
            for (int dt = 0; dt < 8; ++dt) { u32x2 w; w.x = pk2(acc[et][dt][0], acc[et][dt][1]); w.y = pk2(acc[et][dt][2], acc[et][dt][3]);
                *(u32x2*)(st + (size_t)(16 * dt + fr) * 256 + 32 * wid + 16 * et + 4 * g) = w; }
    }
    __syncthreads();
}

__device__ __forceinline__ void ret_b(const RetArgs& A, int vcu, int G, int tid) {
    const int NT = 8 * 16384;
    for (int T = vcu * 512 + tid; T < NT; T += G * 512) {
        const int dh = T >> 14, w = T & 16383, dir = dh >> 2, hl = dh & 3, h = A.grp * 4 + hl;
        const float dec = ex2(128.0f * A.l2[dir * 8 + h]);
        unsigned* p = (unsigned*)(A.ST + (size_t)dh * NCH * ST_CHUNK) + w;
        const ptrdiff_t cs = dir ? -(ptrdiff_t)(ST_CHUNK / 2) : (ptrdiff_t)(ST_CHUNK / 2);
        if (dir) p += (size_t)(NCH - 1) * (ST_CHUNK / 2);
        float s0 = 0.f, s1 = 0.f;
        for (int c = 0; c < NCH; c += 8) {
            unsigned u[8];
#pragma unroll
            for (int k = 0; k < 8; ++k) u[k] = p[(ptrdiff_t)k * cs];
#pragma unroll
            for (int k = 0; k < 8; ++k) { p[(ptrdiff_t)k * cs] = pk2(s0, s1); s0 = dec * s0 + bf_lo(u[k]); s1 = dec * s1 + bf_hi(u[k]); }
            p += 8 * cs;
        }
    }
}

__device__ __forceinline__ void ret_c_unit(ldsp lds, const RetArgs& A, int unit, int tid) {
    const int hl = unit & 3, c = unit >> 2, h = A.grp * 4 + hl, lane = tid & 63, wid = __builtin_amdgcn_readfirstlane(tid >> 6);
    const float l2f = A.l2[h], l2b = A.l2[8 + h];
    bf16* rows = A.G + (size_t)c * 128 * LDG;
    const int fr = lane & 15, g = lane >> 4;
    f32x4 acc[2][8];
#pragma unroll
    for (int et = 0; et < 2; ++et)
#pragma unroll
        for (int it = 0; it < 8; ++it) acc[et][it] = (f32x4){0.f, 0.f, 0.f, 0.f};
    for (int dir = 0; dir < 2; ++dir) {
        if (dir == 0) stage128<true>(lds + R0, rows + COL_Q + hl * 128, LDG, l2f, l2f, tid);
        else          stage128<true>(lds + R0, rows + COL_Q + hl * 128, LDG, -l2b, 128.0f * l2b, tid);
        stage256(lds + R2, A.ST + ((size_t)((dir * 4 + hl) * NCH + c)) * ST_CHUNK, 256, tid);
        __syncthreads();
#pragma unroll
        for (int ks = 0; ks < 4; ++ks) {
            bf16x8 sf[2];
#pragma unroll
            for (int et = 0; et < 2; ++et) sf[et] = trfrag(lds + R2, VPB, 32 * ks, 32 * wid + 16 * et, lane);
#pragma unroll
            for (int it = 0; it < 8; ++it) { const bf16x8 qf = *(const LAS bf16x8*)(lds + R0 + (16 * it + fr) * KPB + (32 * ks + 8 * g) * 2);
#pragma unroll
                for (int et = 0; et < 2; ++et) acc[et][it] = mfma16(sf[et], qf, acc[et][it]); }
        }
        __syncthreads();
    }
    stage128<false>(lds + R0, rows + COL_Q + hl * 128, LDG, 0.f, 0.f, tid);
    stage128<false>(lds + R1, rows + COL_K + hl * 128, LDG, 0.f, 0.f, tid);
    stage256(lds + R2, rows + COL_V + hl * 256, LDG, tid);
    __syncthreads();
    {
        f32x4 sa[8];
#pragma unroll
        for (int it = 0; it < 8; ++it) sa[it] = (f32x4){0.f, 0.f, 0.f, 0.f};
#pragma unroll
        for (int ks = 0; ks < 4; ++ks) { const bf16x8 kf = *(const LAS bf16x8*)(lds + R1 + (16 * wid + fr) * KPB + (32 * ks + 8 * g) * 2);
#pragma unroll
            for (int it = 0; it < 8; ++it) { const bf16x8 qf = *(const LAS bf16x8*)(lds + R0 + (16 * it + fr) * KPB + (32 * ks + 8 * g) * 2); sa[it] = mfma16(kf, qf, sa[it]); } }
        __syncthreads();
#pragma unroll
        for (int it = 0; it < 8; ++it) { const int i = 16 * it + fr; float v[4];
#pragma unroll
            for (int r = 0; r < 4; ++r) { const int j = 16 * wid + 4 * g + r; const int dl = i - j; const float dm = dl >= 0 ? ex2((float)dl * l2f) : ex2((float)(-dl) * l2b); v[r] = sa[it][r] * dm; }
            u32x2 w; w.x = pk2(v[0], v[1]); w.y = pk2(v[2], v[3]);
            *(LAS u32x2*)(lds + R1 + i * KPB + (16 * wid + 4 * g) * 2) = w; }
        __syncthreads();
    }
#pragma unroll
    for (int ks = 0; ks < 4; ++ks) {
        bf16x8 vf[2];
#pragma unroll
        for (int et = 0; et < 2; ++et) vf[et] = trfrag(lds + R2, VPB, 32 * ks, 32 * wid + 16 * et, lane);
#pragma unroll
        for (int it = 0; it < 8; ++it) { const bf16x8 af = *(const LAS bf16x8*)(lds + R1 + (16 * it + fr) * KPB + (32 * ks + 8 * g) * 2);
#pragma unroll
            for (int et = 0; et < 2; ++et) acc[et][it] = mfma16(vf[et], af, acc[et][it]); }
    }
    LAS float* stat = (LAS float*)(lds + RSTAT);
#pragma unroll
    for (int it = 0; it < 8; ++it) { float s1 = 0.f, s2 = 0.f;
#pragma unroll
        for (int et = 0; et < 2; ++et)
#pragma unroll
            for (int r = 0; r < 4; ++r) { const float y = acc[et][it][r]; s1 += y; s2 += y * y; }
        s1 += __shfl_xor(s1, 16); s1 += __shfl_xor(s1, 32); s2 += __shfl_xor(s2, 16); s2 += __shfl_xor(s2, 32);
        if (g == 0) { stat[((16 * it + fr) * 8 + wid) * 2] = s1; stat[((16 * it + fr) * 8 + wid) * 2 + 1] = s2; } }
    __syncthreads();
    const float* gnh = A.gn + h * 256;
#pragma unroll
    for (int it = 0; it < 8; ++it) { float s1 = 0.f, s2 = 0.f;
#pragma unroll
        for (int w = 0; w < 8; ++w) { s1 += stat[((16 * it + fr) * 8 + w) * 2]; s2 += stat[((16 * it + fr) * 8 + w) * 2 + 1]; }
        const float mu = s1 * (1.0f / 256.0f); const float var = fmaxf(s2 * (1.0f / 256.0f) - mu * mu, 0.f); const float rs = rsqrtf(var + 1e-5f);
#pragma unroll
        for (int et = 0; et < 2; ++et) { const int e = 32 * wid + 16 * et + 4 * g;
            bf16* gp = rows + (size_t)(16 * it + fr) * LDG + COL_G + hl * 256 + e;
            const u32x2 gv = *(const u32x2*)gp; const f32x4 gw = *(const f32x4*)(gnh + e);
            const f32x4 y = acc[et][it];
            u32x2 w; w.x = pk2(bf_lo(gv.x) * ((y[0] - mu) * rs * gw[0]), bf_hi(gv.x) * ((y[1] - mu) * rs * gw[1]));
            w.y = pk2(bf_lo(gv.y) * ((y[2] - mu) * rs * gw[2]), bf_hi(gv.y) * ((y[3] - mu) * rs * gw[3]));
            *(u32x2*)gp = w; } }
    __syncthreads();
}
}
#define XB_TMO      128
#define XB_XCNT(j)  (256  + 64 * (j))
#define XB_XSUB(j)  (1280 + 64 * (j))
#define XB_XGEN(j)  (2304 + 64 * (j))
#define XB_TOP      3328
#define XB_TOPGEN   3392
#define XCD_BAR_WORDS 3456
#define XB_SPIN_CAP (1u << 18)

__device__ __forceinline__ unsigned xb_ld(unsigned* p)              { return __hip_atomic_load(p, __ATOMIC_RELAXED, __HIP_MEMORY_SCOPE_AGENT); }
__device__ __forceinline__ unsigned xb_add(unsigned* p, unsigned v) { return __hip_atomic_fetch_add(p, v, __ATOMIC_RELAXED, __HIP_MEMORY_SCOPE_AGENT); }
__device__ __forceinline__ unsigned xb_xcc_id() { return (unsigned)__builtin_amdgcn_s_getreg((3 << 11) | 20) & 0xFu; }
#define XB_SPIN(cond, bar) do { unsigned _sp = 0; while (cond) { __builtin_amdgcn_s_sleep(1); \
    if ((++_sp & 255u) == 0u) { if (xb_ld(&(bar)[XB_TMO])) break; if (_sp > XB_SPIN_CAP) { atomicAdd(&(bar)[XB_TMO], 1u); break; } } } } while (0)

struct XcdBarrier {
    unsigned* bar; unsigned x;
    volatile LAS unsigned* st;
};

__device__ __forceinline__ XcdBarrier xcd_barrier_post(unsigned* bar, volatile LAS unsigned* st) {
    XcdBarrier b; b.bar = bar; b.x = xb_xcc_id(); b.st = st;
    if (threadIdx.x == 0) (void)xb_add(&bar[XB_XCNT(b.x)], 1u);
    return b;
}
__device__ __forceinline__ void xcd_barrier_complete(unsigned* bar, unsigned x, unsigned& nloc, unsigned& nx) {
    const unsigned G = gridDim.x * gridDim.y * gridDim.z;
    unsigned sum, cnt, mine, sp = 0u;
    for (;;) {
        sum = 0u; cnt = 0u; mine = 0u;
#pragma unroll
        for (unsigned j = 0; j < 16; ++j) { const unsigned c = xb_ld(&bar[XB_XCNT(j)]); sum += c; cnt += (c > 0u) ? 1u : 0u; mine = (j == x) ? c : mine; }
        if (sum == G) break;
        __builtin_amdgcn_s_sleep(1);
        if ((++sp & 255u) == 0u) { if (xb_ld(&bar[XB_TMO])) break; if (sp > XB_SPIN_CAP) { atomicAdd(&bar[XB_TMO], 1u); break; } }
    }
    nloc = mine > 0u ? mine : 1u; nx = cnt > 0u ? cnt : 1u;
}

__device__ __forceinline__ void xcd_barrier(const XcdBarrier& b) {
    asm volatile("s_waitcnt vmcnt(0)" ::: "memory");
    __syncthreads();
    if (threadIdx.x == 0) {
        unsigned* bar = b.bar;
        __builtin_amdgcn_s_waitcnt(0);
        unsigned nloc = b.st[0], nx = b.st[1];
        if (nloc == 0u) { xcd_barrier_complete(bar, b.x, nloc, nx); b.st[0] = nloc; b.st[1] = nx; }
        const unsigned old = xb_add(&bar[XB_XSUB(b.x)], 1u);
        const unsigned gen = old / nloc;
        if (old + 1u == (gen + 1u) * nloc) {
            __builtin_amdgcn_fence(__ATOMIC_RELEASE, "agent");
            asm volatile("s_waitcnt vmcnt(0)" ::: "memory");
            const unsigned og = xb_add(&bar[XB_TOP], 1u);
            const unsigned tg = og / nx;
            if (og + 1u == (tg + 1u) * nx) xb_add(&bar[XB_TOPGEN], 1u);
            else XB_SPIN(xb_ld(&bar[XB_TOPGEN]) == tg, bar);
            __builtin_amdgcn_fence(__ATOMIC_ACQUIRE, "agent");
            xb_add(&bar[XB_XGEN(b.x)], 1u);
            asm volatile("s_waitcnt vmcnt(0)" ::: "memory");
        } else {
            XB_SPIN(xb_ld(&bar[XB_XGEN(b.x)]) == gen, bar);
            __builtin_amdgcn_fence(__ATOMIC_ACQUIRE, "agent");
            asm volatile("s_waitcnt vmcnt(0)" ::: "memory");
        }
    }
    __syncthreads();
}
constexpr int M_TOK = 16384, DM = 1024, DFF = 4096, N_IN_E = 2304, N_IN_O = 6144;
constexpr size_t MiB = 1u << 20;
constexpr size_t WS_CTL = 0;
constexpr size_t WS_L2 = 4096, WS_SSQ = 512 * 1024;
constexpr int CW_BAR = 4096;
constexpr size_t WS_W_IN_E = 1 * MiB;
constexpr size_t WS_W_OUT_E = WS_W_IN_E + (size_t)N_IN_E * DM * 2;
constexpr size_t WS_W_MLP_IN = WS_W_OUT_E + (size_t)DM * DM * 2;
constexpr size_t WS_W_MLP_OUT = WS_W_MLP_IN + 2 * (size_t)DFF * DM * 2;
constexpr size_t WS_W_IN_O = WS_W_MLP_OUT + 2 * (size_t)DFF * DM * 2;
constexpr size_t WS_W_OUT_O = WS_W_IN_O + (size_t)N_IN_O * DM * 2;
constexpr size_t WS_XB = 56 * MiB;
constexpr size_t WS_BIG = 88 * MiB;
constexpr size_t WS_END = 256 * MiB;
static_assert(WS_W_OUT_O + (size_t)DM * 2048 * 2 <= WS_XB, "weights fit below XB");

constexpr int RING_BYTES = 155648;
constexpr int LDS_BYTES = 159744;

struct Args { const float* in[19]; float* out; unsigned char* ws; int ph_lo, ph_hi; };

__device__ __forceinline__ float wave_sum(float v) {
#pragma unroll
    for (int o = 1; o < 64; o <<= 1) v += __shfl_xor(v, o);
    return v;
}
__device__ __forceinline__ void transpose_item(const float* W, int N, bf16* WT, int ldo, int k0, int n0, int orow0, const float* gain, float nscale, LAS float* scr, int lane) {
#pragma unroll 8
    for (int i = 0; i < 32; ++i) { const int kk = 2 * i + (lane >> 5); const float gsc = gain ? gain[k0 + kk] * nscale : nscale;
        scr[kk * 33 + (lane & 31)] = W[(size_t)(k0 + kk) * N + n0 + (lane & 31)] * gsc; }
    asm volatile("s_waitcnt lgkmcnt(0)" ::: "memory");
    const int c = lane & 7;
#pragma unroll
    for (int j = 0; j < 4; ++j) { const int n = (lane >> 3) + 8 * j; const LAS float* s = scr + (8 * c) * 33 + n;
        u32x4 o; o.x = pk2(s[0 * 33], s[1 * 33]); o.y = pk2(s[2 * 33], s[3 * 33]); o.z = pk2(s[4 * 33], s[5 * 33]); o.w = pk2(s[6 * 33], s[7 * 33]);
        *(u32x4*)(WT + (size_t)(orow0 + n) * ldo + k0 + 8 * c) = o; }
    asm volatile("s_waitcnt lgkmcnt(0)" ::: "memory");
}
__device__ __forceinline__ void wjob(const float* W, int K, int N, bf16* WT, const float* gain, int mode, int& it0, int gw, int NGW, LAS float* scr, int lane) {
    const int nblk = N / 32, nitems = (K / 64) * nblk;
    int first = (gw - it0) % NGW; if (first < 0) first += NGW;
    for (int item = first; item < nitems; item += NGW) {
        const int kb = item / nblk, nb = item % nblk, n0 = 32 * nb; int orow0 = n0; float nscale = 1.0f;
        if (mode == 1) {
            if (n0 < 1024) { orow0 = (n0 >> 9) * 3072 + (n0 & 511); }
            else if (n0 < 2048) { const int nk = n0 - 1024; orow0 = (nk >> 9) * 3072 + 512 + (nk & 511); nscale = 0.08838834764831845f; }
            else if (n0 < 4096) { const int nv = n0 - 2048; orow0 = (nv >> 10) * 3072 + 1024 + (nv & 1023); }
            else { const int ng = n0 - 4096; orow0 = (ng >> 10) * 3072 + 2048 + (ng & 1023); }
        }
        transpose_item(W, N, WT, K, 64 * kb, n0, orow0, gain, nscale, scr, lane);
    }
    it0 = (it0 + nitems) % NGW;
}
__device__ __forceinline__ void prologue(const Args& a, ldsp lds, int vcu, int G, int tid) {
    const int lane = tid & 63, wave = __builtin_amdgcn_readfirstlane(tid >> 6);
    unsigned char* ws = a.ws;
    LAS float* scr = (LAS float*)(lds + wave * 16384);
    const int gw = vcu * 8 + wave, NGW = G * 8;
    int it0 = 0;
    wjob(a.in[2], DM, N_IN_E, (bf16*)(ws + WS_W_IN_E), a.in[1], 0, it0, gw, NGW, scr, lane);
    wjob(a.in[9], DM, DM, (bf16*)(ws + WS_W_OUT_E), nullptr, 0, it0, gw, NGW, scr, lane);
    wjob(a.in[17], DM, DFF, (bf16*)(ws + WS_W_MLP_IN), a.in[16], 0, it0, gw, NGW, scr, lane);
    wjob(a.in[17] + (size_t)DM * DFF, DM, DFF, (bf16*)(ws + WS_W_MLP_IN) + (size_t)DFF * DM, a.in[16] + DM, 0, it0, gw, NGW, scr, lane);
    wjob(a.in[18], DFF, DM, (bf16*)(ws + WS_W_MLP_OUT), nullptr, 0, it0, gw, NGW, scr, lane);
    wjob(a.in[18] + (size_t)DFF * DM, DFF, DM, (bf16*)(ws + WS_W_MLP_OUT) + (size_t)DFF * DM, nullptr, 0, it0, gw, NGW, scr, lane);
    wjob(a.in[11], DM, N_IN_O, (bf16*)(ws + WS_W_IN_O), a.in[10], 1, it0, gw, NGW, scr, lane);
    wjob(a.in[15], 2048, DM, (bf16*)(ws + WS_W_OUT_O), nullptr, 0, it0, gw, NGW, scr, lane);
    const float* x = a.in[0]; bf16* XB = (bf16*)(ws + WS_XB); float* ssq = (float*)(ws + WS_SSQ);
    for (int m = gw; m < M_TOK; m += NGW) {
        const f32x4* xr = (const f32x4*)(x + (size_t)m * DM) + lane; unsigned long long* o8 = (unsigned long long*)(XB + (size_t)m * DM) + lane;
        float s = 0.f;
#pragma unroll
        for (int j = 0; j < 4; ++j) { const f32x4 v = xr[64 * j]; s += (v[0] * v[0] + v[1] * v[1]) + (v[2] * v[2] + v[3] * v[3]);
            o8[64 * j] = (unsigned long long)pk2(v[0], v[1]) | ((unsigned long long)pk2(v[2], v[3]) << 32); }
        s = wave_sum(s);
        if (lane == 0) *(f32x4*)(ssq + 4 * (size_t)m) = (f32x4){s, 0.f, 0.f, 0.f};
    }
    if (vcu == 0 && tid < 16) { const float d = (tid < 8 ? a.in[12] : a.in[13])[tid & 7]; const float ls = -log1pf(__expf(-d)); ((float*)(ws + WS_L2))[tid] = ls * LOG2E; }
}

#ifndef DBG_DUMP
#define DBG_DUMP 0
#endif
#ifndef DBG_STRIDE
#define DBG_STRIDE 1
#endif
#ifndef DBG_HI
#define DBG_HI PH_COUNT
#endif
enum { PH_PRO = 0, PH_IN_E, PH_ATTN, PH_OUT_E, PH_MLP_IN0, PH_MLP_OUT0, PH_IN_O0, PH_RA0, PH_RB0, PH_RC0, PH_OUT_O0, PH_IN_O1, PH_RA1, PH_RB1, PH_RC1, PH_OUT_O1, PH_MLP_IN1, PH_MLP_OUT1, PH_COUNT };

__global__ void __launch_bounds__(512, 2) mk_fwd(Args a) {
    extern __shared__ __attribute__((aligned(16))) unsigned char lds_raw[];
    cg::grid_group grid = cg::this_grid();
    const ldsp lds = (ldsp)lds_raw;
    volatile LAS unsigned* MISC = (volatile LAS unsigned*)(lds + RING_BYTES);
    if (threadIdx.x < 32) MISC[threadIdx.x] = 0u;
    __syncthreads();
    const XcdBarrier bar = xcd_barrier_post((unsigned*)(a.ws + WS_CTL) + CW_BAR, MISC + 8);
    const int G = gridDim.x;
    unsigned char* ws = a.ws;
    bf16* XB = (bf16*)(ws + WS_XB); float* ssq = (float*)(ws + WS_SSQ);
    bf16* BIG = (bf16*)(ws + WS_BIG);
    bf16* QKV = BIG; bf16* OE = BIG + (size_t)M_TOK * N_IN_E; bf16* HM = BIG; bf16* GB = BIG; bf16* ST = BIG + (size_t)M_TOK * 3072;
    for (int ph = a.ph_lo; ph < a.ph_hi; ++ph) {
        int tid = threadIdx.x, bx = blockIdx.x;
        asm volatile("" : "+v"(tid)); asm volatile("" : "+s"(bx));
        const int vcu = (G % 8 == 0) ? (bx % 8) * (G / 8) + bx / 8 : bx;
        if (ph == PH_PRO) { prologue(a, lds, vcu, G, tid); }
        else if (ph == PH_ATTN) {
            att::AttnArgs A{QKV, OE, a.in[3], a.in[4], a.in[5], a.in[6], a.in[7], a.in[8]};
            att::attn_phase(lds, A, vcu, G, tid);
        }
        else if (ph == PH_RA0 || ph == PH_RA1 || ph == PH_RB0 || ph == PH_RB1 || ph == PH_RC0 || ph == PH_RC1) {
            ret::RetArgs R{GB, ST, (const float*)(ws + WS_L2), a.in[14], (ph >= PH_IN_O1) ? 1 : 0};
            if (ph == PH_RA0 || ph == PH_RA1) { for (int u = vcu; u < 512; u += G) ret::ret_a_unit(lds, R, u, tid); }
            else if (ph == PH_RB0 || ph == PH_RB1) { ret::ret_b(R, vcu, G, tid); }
            else { for (int u = vcu; u < 512; u += G) ret::ret_c_unit(lds, R, u, tid); }
        }
        else if (ph == PH_IN_E || ph == PH_MLP_IN0 || ph == PH_MLP_IN1 || ph == PH_IN_O0 || ph == PH_IN_O1) {
            pg8::Gemm g; pg8::EpiBf16 E; E.ssq = ssq; E.silu_pn0 = 1 << 30; E.act = 0;
            g.A = XB; g.lda = DM; g.M = M_TOK; g.K = DM; g.ldb = DM;
            if (ph == PH_IN_E) { g.Bt = (const bf16*)(ws + WS_W_IN_E); g.N = N_IN_E; E.O = QKV; E.ldc = N_IN_E; }
            else if (ph == PH_MLP_IN0 || ph == PH_MLP_IN1) { g.Bt = (const bf16*)(ws + WS_W_MLP_IN) + (ph == PH_MLP_IN1 ? (size_t)DFF * DM : 0); g.N = DFF; E.O = HM; E.ldc = DFF; E.act = 1; }
            else { g.Bt = (const bf16*)(ws + WS_W_IN_O) + (ph == PH_IN_O1 ? (size_t)3072 * DM : 0); g.N = 3072; E.O = GB; E.ldc = 3072; E.act = 2; E.silu_pn0 = 8; }
            pg8::StaticOrder S; S.init(g.M, g.N, G, bx);
            pg8::gemm_phase<pg8::EpiBf16, pg8::StaticOrder, true, true>(lds, g, S, E, tid);
        }
        else {
            pg8::Gemm g; pg8::EpiResid E; g.M = M_TOK; g.N = DM; E.ldc = DM; E.out = a.out; E.base = a.out; E.xb = XB; E.ssq_out = ssq;
            if (ph == PH_OUT_E) { g.A = OE; g.lda = DM; g.K = DM; g.Bt = (const bf16*)(ws + WS_W_OUT_E); g.ldb = DM; E.base = a.in[0]; }
            else if (ph == PH_MLP_OUT0 || ph == PH_MLP_OUT1) { g.A = HM; g.lda = DFF; g.K = DFF; g.Bt = (const bf16*)(ws + WS_W_MLP_OUT) + (ph == PH_MLP_OUT1 ? (size_t)DFF * DM : 0); g.ldb = DFF;
                if (ph == PH_MLP_OUT1) { E.xb = nullptr; E.ssq_out = nullptr; } }
            else { const int grp = (ph == PH_OUT_O1) ? 1 : 0; g.A = GB + 2048; g.lda = 3072; g.K = 1024; g.Bt = (const bf16*)(ws + WS_W_OUT_O) + grp * 1024; g.ldb = 2048;
                if (grp == 0) { E.xb = nullptr; E.ssq_out = nullptr; } }
            pg8::StaticOrder S; S.init(g.M, g.N, G, bx);
            pg8::gemm_phase<pg8::EpiResid, pg8::StaticOrder, false, true>(lds, g, S, E, tid);
        }
        if (ph + 1 == a.ph_hi && DBG_DUMP) {
            xcd_barrier(bar);
            const bf16* srcb = (DBG_DUMP == 1) ? GB : ST;
            for (size_t i = (size_t)bx * 512 + tid; i < (size_t)M_TOK * DM; i += (size_t)G * 512) a.out[i] = bf_lo((unsigned)srcb[i * DBG_STRIDE]);
        }
        if (ph + 1 < a.ph_hi) {
            if (ph == PH_PRO) {
                asm volatile("s_waitcnt vmcnt(0)" ::: "memory");
                grid.sync();
                __builtin_amdgcn_fence(__ATOMIC_ACQUIRE, "agent");
                asm volatile("s_waitcnt vmcnt(0)" ::: "memory");
                __syncthreads();
            } else xcd_barrier(bar);
        }
    }
}

extern "C" void kernel_launch(void* const* d_in, const int* in_sizes, int n_in, void* d_out, int out_size, void* d_ws, size_t ws_size, hipStream_t stream) {
    static int grid = 0;
    if (grid == 0) {
        int dev = 0, cus = 0, per_cu = 0;
        (void)hipGetDevice(&dev);
        (void)hipDeviceGetAttribute(&cus, hipDeviceAttributeMultiprocessorCount, dev);
        (void)hipFuncSetAttribute((const void*)mk_fwd, hipFuncAttributeMaxDynamicSharedMemorySize, LDS_BYTES);
        (void)hipOccupancyMaxActiveBlocksPerMultiprocessor(&per_cu, (const void*)mk_fwd, 512, LDS_BYTES);
        grid = (n_in == 19 && per_cu >= 1 && cus == 256 && ws_size >= WS_END && out_size == M_TOK * DM) ? 256 : -1;
        if (grid < 0) fprintf(stderr, "kernel_launch: unsupported configuration (cus %d per_cu %d ws %zu n_in %d)\n", cus, per_cu, ws_size, n_in);
    }
    if (grid < 0) return;
    if (hipMemsetAsync((char*)d_ws + WS_CTL, 0, 65536, stream) != hipSuccess) { fprintf(stderr, "kernel_launch: memset failed\n"); return; }
    Args a{};
    for (int i = 0; i < 19; ++i) a.in[i] = (const float*)d_in[i];
    a.out = (float*)d_out; a.ws = (unsigned char*)d_ws; a.ph_lo = 0; a.ph_hi = DBG_HI;
    void* args[] = {&a};
    hipError_t e = hipLaunchCooperativeKernel((void*)mk_fwd, dim3(grid), dim3(512), args, LDS_BYTES, stream);
    if (e != hipSuccess) fprintf(stderr, "cooperative launch failed: %s\n", hipGetErrorString(e));
}
```

```cpp
#include <hip/hip_runtime.h>
#include <hip/hip_cooperative_groups.h>
#include <cstdio>
#include <cstdint>
#include <cmath>
namespace cg = cooperative_groups;
namespace pg8 {
#define PG8_LAS __attribute__((address_space(3)))
typedef unsigned short bf16_t;
typedef short bf16x8 __attribute__((ext_vector_type(8)));
typedef float f32x4 __attribute__((ext_vector_type(4)));
typedef float f32x2 __attribute__((ext_vector_type(2)));
typedef unsigned u32x4 __attribute__((ext_vector_type(4)));
typedef unsigned u32x2 __attribute__((ext_vector_type(2)));
constexpr int BM = 256, BK = 64, HALF = 128, HTB = HALF * BK * 2  , STAGE_BYTES = 8 * HTB, NXCD = 8, WGM = 8;

__host__ __device__ __forceinline__ int lds_byte(int r, int c) { const int st = (r >> 4) * 2 + (c >> 5), rr = r & 15, cc = c & 31, ob = rr * 64 + cc * 2; return st * 1024 + (ob ^ (((ob >> 9) & 1) << 5)); }
__host__ __device__ __forceinline__ void stage_rc(int b, int& R, int& C) { const int st = b / 1024, sb = b % 1024, swz = sb ^ (((sb >> 9) & 1) << 5); R = (st >> 1) * 16 + swz / 64; C = (st & 1) * 32 + (swz % 64) / 2; }
__host__ __device__ __forceinline__ int perm32(int rho) { const int n = rho >> 4, i = rho & 15; return 8 * (i >> 2) + 4 * n + (i & 3); }

struct Unit { int pm, pn; };
struct Gemm { const bf16_t* A; const bf16_t* Bt; int lda, ldb, M, N, K; };

struct StaticOrder {
    int nM, nN, nwg, G, c;
    __host__ __device__ void init(int M, int N, int G_, int c_) { nM = M / BM; nN = N / BM; nwg = nM * nN; G = G_; c = c_; }
    __host__ __device__ bool next(int i, Unit& u) const {
        const long L = (long)i * G + c; if (L >= nwg) return false;
        int wgid = (int)L; { const int q = nwg / NXCD, r = nwg % NXCD, xcd = wgid % NXCD, off = wgid / NXCD; wgid = (xcd < r ? xcd * (q + 1) : r * (q + 1) + (xcd - r) * q) + off; }
        const int nig = WGM * nN, gid = wgid / nig, fm = gid * WGM, gsz = (nM - fm) < WGM ? (nM - fm) : WGM;
        u.pm = fm + ((wgid % nig) % gsz); u.pn = (wgid % nig) / gsz; return true;
    }
};

typedef float f32x2_cv __attribute__((ext_vector_type(2))); typedef __bf16 bf16x2_cv __attribute__((ext_vector_type(2)));
__device__ __forceinline__ unsigned cvt_pk_bf16(float lo, float hi) { const f32x2_cv v = {lo, hi}; const bf16x2_cv b = __builtin_convertvector(v, bf16x2_cv); return __builtin_bit_cast(unsigned, b); }


__device__ __forceinline__ float row_rstd(const float* ssq, int row) { const f32x4 p = *(const f32x4*)(ssq + 4 * (size_t)row); return rsqrtf(((p[0] + p[1]) + (p[2] + p[3])) * (1.0f / 1024.0f) + 1e-6f); }

struct EpiBf16 {
    static constexpr bool PERM = true, AFTER_DRAIN = false;
    bf16_t* O; int ldc; const float* ssq; int silu_pn0; int act;
    __device__ __forceinline__ void operator()(const f32x4 (&acc)[2][2][4][2], const Unit& u, int wr, int wc, int fr, int fq) const {
        const int row0 = u.pm * BM + wr * 64 + fr; const int col0 = u.pn * BM + wc * 32 + 8 * fq;
        const bool do_silu = (act == 2) && (u.pn >= silu_pn0);
#pragma unroll
        for (int ai = 0; ai < 2; ++ai)
#pragma unroll
            for (int m = 0; m < 4; ++m) { const int row = row0 + ai * HALF + m * 16; const float rs = row_rstd(ssq, row); bf16_t* rowp = O + (size_t)row * ldc + col0;
#pragma unroll
                for (int bj = 0; bj < 2; ++bj) { f32x4 v0 = acc[ai][bj][m][0] * rs, v1 = acc[ai][bj][m][1] * rs;
                    if (act == 1) {
#pragma unroll
                        for (int e = 0; e < 4; ++e) { const float a = fmaxf(v0[e], 0.f), b = fmaxf(v1[e], 0.f); v0[e] = a * a; v1[e] = b * b; } }
                    if (do_silu) {
#pragma unroll
                        for (int e = 0; e < 4; ++e) { v0[e] = v0[e] / (1.0f + __expf(-v0[e])); v1[e] = v1[e] / (1.0f + __expf(-v1[e])); } }
                    u32x4 w; w.x = cvt_pk_bf16(v0[0], v0[1]); w.y = cvt_pk_bf16(v0[2], v0[3]); w.z = cvt_pk_bf16(v1[0], v1[1]); w.w = cvt_pk_bf16(v1[2], v1[3]);
                    *(u32x4*)(rowp + bj * HALF) = w; } }
    }
};

struct EpiResid {
    static constexpr bool PERM = false, AFTER_DRAIN = true;
    const float* base; float* out; bf16_t* xb; float* ssq_out; int ldc; float accscale;
    __device__ __forceinline__ void fused(f32x4 (&acc)[2][2][4][2], const Unit& u, int wr, int wc, int fr, int fq, PG8_LAS unsigned char* lds, int wid, int lane) const {
        PG8_LAS float* P = (PG8_LAS float*)lds;
        const int col0 = u.pn * BM + wc * 32 + 4 * fq;
#pragma unroll
        for (int ai = 0; ai < 2; ++ai)
#pragma unroll
            for (int m = 0; m < 4; ++m) { const int r = ai * HALF + wr * 64 + m * 16 + fr; const size_t off = (size_t)(u.pm * BM + r) * ldc + col0; float s = 0.f;
#pragma unroll
                for (int bj = 0; bj < 2; ++bj)
#pragma unroll
                    for (int n = 0; n < 2; ++n) { const f32x4 bs = *(const f32x4*)(base + off + bj * HALF + n * 16); const f32x4 o = bs + acc[ai][bj][m][n] * accscale;
                        *(f32x4*)(out + off + bj * HALF + n * 16) = o;
                        if (xb) { u32x2 w; w.x = cvt_pk_bf16(o[0], o[1]); w.y = cvt_pk_bf16(o[2], o[3]); *(u32x2*)(xb + off + bj * HALF + n * 16) = w; }
                        s += (o[0] * o[0] + o[1] * o[1]) + (o[2] * o[2] + o[3] * o[3]); }
                if (ssq_out) { s += __shfl_xor(s, 16); s += __shfl_xor(s, 32); if (fq == 0) P[r * 4 + wc] = s; }
                if (m & 1) asm volatile("" ::: "memory"); }
        if (ssq_out) {
            __syncthreads();
            const int t = wid * 64 + lane;
            if (t < 256) { const float s = (P[t * 4 + 0] + P[t * 4 + 1]) + (P[t * 4 + 2] + P[t * 4 + 3]); ssq_out[(size_t)(u.pm * BM + t) * 4 + u.pn] = s; }
            __syncthreads();
        }
    }
};

template <class Epi, class Sched, bool ALIGN_EPI = false, bool SP2 = false>
__device__ __forceinline__ void gemm_phase(PG8_LAS unsigned char* lds, const Gemm g, const Sched& S, const Epi& E, const int tid) {
    const int wid = __builtin_amdgcn_readfirstlane(tid >> 6), lane = tid & 63, wr = wid >> 2, wc = wid & 3, fr = lane & 15, fq = lane >> 4;
    const int K = g.K, nt = K / BK;
    unsigned voffA[2], voffB[2];
#pragma unroll
    for (int i = 0; i < 2; ++i) { int R, C; stage_rc(tid * 16 + i * 8192, R, C); const int Rb = Epi::PERM ? ((R & ~31) + perm32(R & 31)) : R;
        voffA[i] = (unsigned)(R * g.lda + C) * 2u; voffB[i] = (unsigned)(Rb * g.ldb + C) * 2u; }
    const size_t kstep = (size_t)(BK * 2);
    const size_t hstepA = (size_t)HALF * g.lda * 2, hstepB = (size_t)HALF * g.ldb * 2;
    const size_t tstepA = 2 * hstepA, tstepB = 2 * hstepB;
    const unsigned ldsw = (unsigned)wid * 1024u;
    const int aoff = lds_byte(wr * 64 + fr, fq * 8), boff = lds_byte(wc * 32 + fr, fq * 8);
#define PG8_SA(b, h) (((b) * 2 + (h)) * HTB)
#define PG8_SB(b, h) ((4 + (b) * 2 + (h)) * HTB)
#define PG8_STAGE(bufoff, gbase, voff) do { _Pragma("unroll") for (int _i = 0; _i < 2; ++_i) \
        __builtin_amdgcn_global_load_lds((const unsigned*)((const char*)(gbase) + (voff)[_i]), (PG8_LAS unsigned*)(lds + (bufoff) + ldsw + _i * 8192), 16, 0, 0); } while (0)
#define PG8_LDA(dst, b, h) do { _Pragma("unroll") for (int m = 0; m < 4; ++m) _Pragma("unroll") for (int k = 0; k < 2; ++k) dst[m][k] = *(const PG8_LAS bf16x8*)(lds + PG8_SA(b, h) + aoff + m * 2048 + k * 1024); } while (0)
#define PG8_LDB(dst, b, h) do { _Pragma("unroll") for (int n = 0; n < 2; ++n) _Pragma("unroll") for (int k = 0; k < 2; ++k) dst[n][k] = *(const PG8_LAS bf16x8*)(lds + PG8_SB(b, h) + boff + n * 2048 + k * 1024); } while (0)
#define PG8_MMA(ai, bj, At, Bt) do { __builtin_amdgcn_s_setprio(1); _Pragma("unroll") for (int m = 0; m < 4; ++m) _Pragma("unroll") for (int n = 0; n < 2; ++n) _Pragma("unroll") for (int k = 0; k < 2; ++k) \
        acc[ai][bj][m][n] = __builtin_amdgcn_mfma_f32_16x16x32_bf16(Bt[n][k], At[m][k], acc[ai][bj][m][n], 0, 0, 0); __builtin_amdgcn_s_setprio(0); } while (0)
#define PG8_WAIT_V(n) asm volatile("s_waitcnt vmcnt(" #n ")" ::: "memory")
#define PG8_WAIT_L(n) asm volatile("s_waitcnt lgkmcnt(" #n ")" ::: "memory")
#define PG8_BAR __builtin_amdgcn_s_barrier()
#define PG8_SCHED __builtin_amdgcn_sched_barrier(0)
    Unit cur, nxt; int ui = 0;
    if (!S.next(0, cur)) return;
    f32x4 acc[2][2][4][2];
#pragma unroll
    for (int a = 0; a < 2; ++a)
#pragma unroll
        for (int b = 0; b < 2; ++b)
#pragma unroll
            for (int m = 0; m < 4; ++m)
#pragma unroll
                for (int n = 0; n < 2; ++n) acc[a][b][m][n] = (f32x4){0.f, 0.f, 0.f, 0.f};
    bf16x8 At[4][2], B0[2][2], B1[2][2];
    const char* cA = (const char*)g.A + (size_t)cur.pm * tstepA; const char* cB = (const char*)g.Bt + (size_t)cur.pn * tstepB;
    if constexpr (SP2) {
        PG8_STAGE(PG8_SB(0, 0), cB, voffB); PG8_STAGE(PG8_SB(0, 1), cB + hstepB, voffB); PG8_STAGE(PG8_SA(0, 0), cA, voffA); PG8_STAGE(PG8_SA(0, 1), cA + hstepA, voffA);
        if (wr == 1) PG8_BAR;
        PG8_WAIT_V(2); PG8_BAR;
        PG8_STAGE(PG8_SB(1, 0), cB + kstep, voffB); PG8_STAGE(PG8_SA(1, 0), cA + kstep, voffA); PG8_STAGE(PG8_SB(1, 1), cB + hstepB + kstep, voffB);
        PG8_WAIT_V(6); PG8_BAR;
    } else {
        PG8_STAGE(PG8_SB(0, 0), cB, voffB); PG8_STAGE(PG8_SA(0, 0), cA, voffA); PG8_STAGE(PG8_SB(0, 1), cB + hstepB, voffB); PG8_STAGE(PG8_SA(0, 1), cA + hstepA, voffA);
        if (wr == 1) PG8_BAR;
        PG8_WAIT_V(4); PG8_BAR;
        PG8_STAGE(PG8_SB(1, 0), cB + kstep, voffB); PG8_STAGE(PG8_SA(1, 0), cA + kstep, voffA); PG8_STAGE(PG8_SB(1, 1), cB + hstepB + kstep, voffB);
        PG8_WAIT_V(6); PG8_BAR;
    }
    for (;;) {
        const bool has_next = S.next(ui + 1, nxt);
        const char* nA = has_next ? (const char*)g.A + (size_t)nxt.pm * tstepA : cA; const char* nB = has_next ? (const char*)g.Bt + (size_t)nxt.pn * tstepB : cB;
        for (int t = 0; t < nt; t += 2) {
            const bool last = (t == nt - 2);
            const char* a1 = cA + (size_t)(t + 1) * kstep;
            const char* a2 = last ? nA : cA + (size_t)(t + 2) * kstep; const char* b2 = last ? nB : cB + (size_t)(t + 2) * kstep;
            const char* a3 = a2 + kstep; const char* b3 = b2 + kstep;
            if constexpr (SP2) {
            PG8_LDB(B0, 0, 0); PG8_LDB(B1, 0, 1); PG8_SCHED; PG8_LDA(At, 0, 0); PG8_STAGE(PG8_SA(1, 1), a1 + hstepA, voffA);
            PG8_WAIT_V(8); PG8_WAIT_L(0); PG8_BAR; PG8_MMA(0, 0, At, B0); PG8_MMA(0, 1, At, B1); PG8_BAR; PG8_SCHED;
            PG8_LDA(At, 0, 1); PG8_STAGE(PG8_SB(0, 0), b2, voffB); PG8_STAGE(PG8_SB(0, 1), b2 + hstepB, voffB); PG8_STAGE(PG8_SA(0, 0), a2, voffA);
            PG8_WAIT_V(8); PG8_WAIT_L(0); PG8_BAR; PG8_MMA(1, 0, At, B0); PG8_MMA(1, 1, At, B1); PG8_BAR; PG8_SCHED;
            PG8_LDB(B0, 1, 0); PG8_LDB(B1, 1, 1); PG8_SCHED; PG8_LDA(At, 1, 0); PG8_STAGE(PG8_SA(0, 1), a2 + hstepA, voffA);
            PG8_WAIT_V(8); PG8_WAIT_L(0); PG8_BAR; PG8_MMA(0, 0, At, B0); PG8_MMA(0, 1, At, B1); PG8_BAR; PG8_SCHED;
            PG8_LDA(At, 1, 1); PG8_STAGE(PG8_SB(1, 0), b3, voffB); PG8_STAGE(PG8_SB(1, 1), b3 + hstepB, voffB); PG8_STAGE(PG8_SA(1, 0), a3, voffA);
            PG8_WAIT_V(8); PG8_WAIT_L(0); PG8_BAR; PG8_MMA(1, 0, At, B0); PG8_MMA(1, 1, At, B1); PG8_BAR; PG8_SCHED;
            } else {
            PG8_LDB(B0, 0, 0); PG8_SCHED; PG8_LDA(At, 0, 0); PG8_STAGE(PG8_SA(1, 1), a1 + hstepA, voffA);
            PG8_WAIT_L(8); PG8_BAR; PG8_WAIT_L(0); PG8_MMA(0, 0, At, B0); PG8_BAR; PG8_SCHED;
            PG8_LDB(B1, 0, 1); PG8_STAGE(PG8_SB(0, 0), b2, voffB);
            PG8_BAR; PG8_WAIT_L(0); PG8_MMA(0, 1, At, B1); PG8_BAR;
            PG8_LDA(At, 0, 1); PG8_STAGE(PG8_SA(0, 0), a2, voffA);
            PG8_BAR; PG8_WAIT_L(0); PG8_MMA(1, 0, At, B0); PG8_BAR; PG8_SCHED;
            PG8_STAGE(PG8_SB(0, 1), b2 + hstepB, voffB);
            PG8_WAIT_V(6); PG8_BAR; PG8_MMA(1, 1, At, B1); PG8_BAR;
            PG8_LDB(B0, 1, 0); PG8_SCHED; PG8_LDA(At, 1, 0); PG8_STAGE(PG8_SA(0, 1), a2 + hstepA, voffA);
            PG8_WAIT_L(8); PG8_BAR; PG8_WAIT_L(0); PG8_MMA(0, 0, At, B0); PG8_BAR; PG8_SCHED;
            PG8_LDB(B1, 1, 1); PG8_STAGE(PG8_SB(1, 0), b3, voffB);
            PG8_BAR; PG8_WAIT_L(0); PG8_MMA(0, 1, At, B1); PG8_BAR;
            PG8_LDA(At, 1, 1); PG8_STAGE(PG8_SA(1, 0), a3, voffA);
            PG8_BAR; PG8_WAIT_L(0); PG8_MMA(1, 0, At, B0); PG8_BAR; PG8_SCHED;
            PG8_STAGE(PG8_SB(1, 1), b3 + hstepB, voffB);
            PG8_WAIT_V(6); PG8_BAR; PG8_MMA(1, 1, At, B1); PG8_BAR;
            }
        }
        if constexpr (ALIGN_EPI) { if (wr == 0) PG8_BAR; }
        if constexpr (!Epi::AFTER_DRAIN) { E(acc, cur, wr, wc, fr, fq); }
        if (!has_next) break;
#pragma unroll
        for (int a = 0; a < 2; ++a)
#pragma unroll
            for (int b = 0; b < 2; ++b)
#pragma unroll
                for (int m = 0; m < 4; ++m)
#pragma unroll
                    for (int n = 0; n < 2; ++n) acc[a][b][m][n] = (f32x4){0.f, 0.f, 0.f, 0.f};
        cur = nxt; cA = nA; cB = nB; ++ui;
        if constexpr (ALIGN_EPI) { if (wr == 1) PG8_BAR; }
    }
    PG8_WAIT_V(0);
    if constexpr (!ALIGN_EPI) { if (wr == 0) PG8_BAR; }
    PG8_BAR;
    if constexpr (Epi::AFTER_DRAIN) { E.fused(acc, cur, wr, wc, fr, fq, lds, wid, lane); }
#undef PG8_SA
#undef PG8_SB
#undef PG8_STAGE
#undef PG8_LDA
#undef PG8_LDB
#undef PG8_MMA
#undef PG8_WAIT_V
#undef PG8_WAIT_L
#undef PG8_BAR
#undef PG8_SCHED
}
}
#define LAS __attribute__((address_space(3)))
typedef unsigned short bf16;
typedef short bf16x8 __attribute__((ext_vector_type(8)));
typedef short s16x4 __attribute__((ext_vector_type(4)));
typedef float f32x4 __attribute__((ext_vector_type(4)));
typedef unsigned u32x4 __attribute__((ext_vector_type(4)));
typedef unsigned u32x2 __attribute__((ext_vector_type(2)));
typedef LAS unsigned char* ldsp;
constexpr float LOG2E = 1.4426950408889634f;

__device__ __forceinline__ float bf_lo(unsigned w) { return __uint_as_float(w << 16); }
__device__ __forceinline__ float bf_hi(unsigned w) { return __uint_as_float(w & 0xffff0000u); }
__device__ __forceinline__ unsigned pk2(float lo, float hi) { return pg8::cvt_pk_bf16(lo, hi); }
__device__ __forceinline__ s16x4 vtr(ldsp p) { typedef short v4i16_t __attribute__((ext_vector_type(4))); return __builtin_bit_cast(s16x4, __builtin_amdgcn_ds_read_tr16_b64_v4i16((LAS v4i16_t*)p)); }
__device__ __forceinline__ bf16x8 cat8(s16x4 lo, s16x4 hi) { return (bf16x8){lo[0], lo[1], lo[2], lo[3], hi[0], hi[1], hi[2], hi[3]}; }
__device__ __forceinline__ f32x4 mfma16(bf16x8 a, bf16x8 b, f32x4 c) { return __builtin_amdgcn_mfma_f32_16x16x32_bf16(a, b, c, 0, 0, 0); }
__device__ __forceinline__ float ex2(float x) { return __builtin_amdgcn_exp2f(x); }

namespace att {
constexpr int SEQ = 16384, LDQ = 2304, LDO = 1024;
constexpr int KPB = 160;
constexpr int COL_QA = 0, COL_KA = 512, COL_VA = 640, COL_QB = 768, COL_KB = 1280, COL_VB = 1792;

template <int NP>
__device__ __forceinline__ void load_rows(u32x4 (&v)[NP], const bf16* src, int tok0, int nvalid, int tid) {
    const int sub = tid & 7;
#pragma unroll
    for (int p = 0; p < NP; ++p) { const int r = (tid >> 3) + 64 * p, tok = tok0 + r; const bool ok = (tok >= 0) && (tok < SEQ) && (r < nvalid);
        v[p] = (u32x4){0u, 0u, 0u, 0u};
        if (ok) v[p] = *(const u32x4*)(src + (size_t)tok * LDQ + sub * 8); }
}
template <int NP, bool NORM>
__device__ __forceinline__ void store_rows(ldsp dst, const u32x4 (&v)[NP], int nrows, const float* gain, int tid) {
    const int sub = tid & 7;
    float gn[8];
    if (NORM) {
#pragma unroll
        for (int j = 0; j < 8; ++j) gn[j] = gain[sub * 8 + j];
    }
#pragma unroll
    for (int p = 0; p < NP; ++p) { const int r = (tid >> 3) + 64 * p;
        if (r < nrows) {
            u32x4 w = v[p];
            if (NORM) {
                float f[8]; f[0] = bf_lo(w.x); f[1] = bf_hi(w.x); f[2] = bf_lo(w.y); f[3] = bf_hi(w.y); f[4] = bf_lo(w.z); f[5] = bf_hi(w.z); f[6] = bf_lo(w.w); f[7] = bf_hi(w.w);
                float ss = 0.f;
#pragma unroll
                for (int j = 0; j < 8; ++j) ss += f[j] * f[j];
                ss += __shfl_xor(ss, 1); ss += __shfl_xor(ss, 2); ss += __shfl_xor(ss, 4);
                const float rs = rsqrtf(ss * (1.0f / 64.0f) + 1e-6f);
#pragma unroll
                for (int j = 0; j < 8; ++j) f[j] = f[j] * rs * gn[j];
                w.x = pk2(f[0], f[1]); w.y = pk2(f[2], f[3]); w.z = pk2(f[4], f[5]); w.w = pk2(f[6], f[7]);
            }
            *(LAS u32x4*)(dst + r * KPB + sub * 16) = w;
        } }
}

__device__ __forceinline__ void load_q(bf16x8 (&qf)[2], const bf16* qrow  , const float* gain, int g) {
    float f[2][8]; float ss = 0.f;
#pragma unroll
    for (int s = 0; s < 2; ++s) { const u32x4 v = *(const u32x4*)(qrow + 32 * s + 8 * g);
        f[s][0] = bf_lo(v.x); f[s][1] = bf_hi(v.x); f[s][2] = bf_lo(v.y); f[s][3] = bf_hi(v.y); f[s][4] = bf_lo(v.z); f[s][5] = bf_hi(v.z); f[s][6] = bf_lo(v.w); f[s][7] = bf_hi(v.w);
#pragma unroll
        for (int j = 0; j < 8; ++j) ss += f[s][j] * f[s][j]; }
    ss += __shfl_xor(ss, 16); ss += __shfl_xor(ss, 32);
    const float rs = rsqrtf(ss * (1.0f / 64.0f) + 1e-6f) * (0.125f * LOG2E);
#pragma unroll
    for (int s = 0; s < 2; ++s) { float o[8];
#pragma unroll
        for (int j = 0; j < 8; ++j) o[j] = f[s][j] * rs * gain[32 * s + 8 * g + j];
        u32x4 w; w.x = pk2(o[0], o[1]); w.y = pk2(o[2], o[3]); w.z = pk2(o[4], o[5]); w.w = pk2(o[6], o[7]);
        qf[s] = __builtin_bit_cast(bf16x8, w); }
}

template <int NT, class RB>
__device__ __forceinline__ void scores(f32x4 (&sc)[NT], ldsp Kb, const bf16x8 (&qf)[2], const RB& rb, int lane) {
    const int fr = lane & 15, g = lane >> 4;
#pragma unroll
    for (int t = 0; t < NT; ++t) { ldsp kp = Kb + (rb(t) + fr) * KPB + g * 16; f32x4 a = (f32x4){0.f, 0.f, 0.f, 0.f};
#pragma unroll
        for (int s = 0; s < 2; ++s) { const bf16x8 kf = *(const LAS bf16x8*)(kp + s * 64); a = mfma16(kf, qf[s], a); }
        sc[t] = a; }
}
template <int NT>
__device__ __forceinline__ float softmax_pack(f32x4 (&sc)[NT], bf16x8 (&pf)[NT / 2], float sink2, bool has_sink) {
    float m = -INFINITY;
#pragma unroll
    for (int t = 0; t < NT; ++t)
#pragma unroll
        for (int r = 0; r < 4; ++r) m = fmaxf(m, sc[t][r]);
    m = fmaxf(m, __shfl_xor(m, 16)); m = fmaxf(m, __shfl_xor(m, 32));
    if (has_sink) m = fmaxf(m, sink2);
    float sum = 0.f;
#pragma unroll
    for (int t = 0; t < NT; ++t)
#pragma unroll
        for (int r = 0; r < 4; ++r) { const float p = ex2(sc[t][r] - m); sc[t][r] = p; sum += p; }
    sum += __shfl_xor(sum, 16); sum += __shfl_xor(sum, 32);
    if (has_sink) sum += ex2(sink2 - m);
#pragma unroll
    for (int k = 0; k < NT / 2; ++k) { u32x4 w; w.x = pk2(sc[2 * k][0], sc[2 * k][1]); w.y = pk2(sc[2 * k][2], sc[2 * k][3]); w.z = pk2(sc[2 * k + 1][0], sc[2 * k + 1][1]); w.w = pk2(sc[2 * k + 1][2], sc[2 * k + 1][3]);
        pf[k] = __builtin_bit_cast(bf16x8, w); }
    return sum;
}
template <int NT, class RB>
__device__ __forceinline__ void pv_store(ldsp Vb, const bf16x8 (&pf)[NT / 2], const RB& rb, float sum, bf16* orow  , int lane) {
    const int g = lane >> 4, q4 = (lane & 15) >> 2, p4 = lane & 3;
    f32x4 o[4];
#pragma unroll
    for (int dt = 0; dt < 4; ++dt) o[dt] = (f32x4){0.f, 0.f, 0.f, 0.f};
#pragma unroll
    for (int k = 0; k < NT / 2; ++k) { ldsp v0 = Vb + (rb(2 * k) + 4 * g + q4) * KPB + p4 * 8; ldsp v1 = Vb + (rb(2 * k + 1) + 4 * g + q4) * KPB + p4 * 8;
#pragma unroll
        for (int dt = 0; dt < 4; ++dt) { const bf16x8 vf = cat8(vtr(v0 + dt * 32), vtr(v1 + dt * 32)); o[dt] = mfma16(vf, pf[k], o[dt]); } }
    const float inv = 1.0f / sum;
#pragma unroll
    for (int dt = 0; dt < 4; ++dt) { u32x2 w; w.x = pk2(o[dt][0] * inv, o[dt][1] * inv); w.y = pk2(o[dt][2] * inv, o[dt][3] * inv); *(u32x2*)(orow + dt * 16 + 4 * g) = w; }
}

struct RbWin { int mt; __device__ __forceinline__ int operator()(int t) const { return 16 * (mt + t); } };
struct RbNa { int off, ctb; __device__ __forceinline__ int operator()(int t) const { return (off + t / 3) * 64 + (ctb + t % 3) * 16; } };

struct AttnArgs { const bf16* qkv; bf16* o; const float* qn_a; const float* kn_a; const float* sink_a; const float* qn_b; const float* kn_b; const float* rpb; };

__device__ __forceinline__ void window_compute(ldsp lds, const AttnArgs& A, int unit, int tid) {
    const int n = unit >> 1, kvh = unit & 1, lane = tid & 63, wid = __builtin_amdgcn_readfirstlane(tid >> 6);
    ldsp Kb = lds, Vb = lds + 400 * KPB;
    const int tok0 = (n - 1) * 128;
    const int fr = lane & 15, g = lane >> 4;
    for (int it = 0; it < 4; ++it) {
        const int idx = wid * 4 + it, g4 = idx >> 3, mt = idx & 7, hq = kvh * 4 + g4;
        const int qtok = n * 128 + mt * 16 + fr;
        bf16x8 qf[2]; load_q(qf, A.qkv + (size_t)qtok * LDQ + COL_QA + hq * 64, A.qn_a, g);
        RbWin rb{mt};
        f32x4 sc[18]; scores<18>(sc, Kb, qf, rb, lane);
        const float slope2 = exp2f(-(float)(hq + 1)) * LOG2E;
        const int il = mt * 16 + fr;
#pragma unroll
        for (int t = 0; t < 18; ++t)
#pragma unroll
            for (int r = 0; r < 4; ++r) { const int j = 16 * (mt + t) + 4 * g + r; const int rel = j - 128 - il; const int arel = rel < 0 ? -rel : rel; const int kpos = tok0 + j;
                const bool ok = (arel <= 128) && (kpos >= 0) && (kpos < SEQ);
                sc[t][r] = ok ? sc[t][r] - slope2 * (float)arel : -INFINITY; }
        bf16x8 pf[9]; const float sum = softmax_pack<18>(sc, pf, A.sink_a[hq] * LOG2E, true);
        pv_store<18>(Vb, pf, rb, sum, A.o + (size_t)qtok * LDO + hq * 64, lane);
    }
}

constexpr int NA_RPB_OFF = 576 * KPB;

__device__ __forceinline__ void na_unit(ldsp lds, const AttnArgs& A, int unit, int next_unit, u32x4 (&kreg)[9], int tid) {
    const int rp = unit >> 3, h = unit & 7, lane = tid & 63, wid = __builtin_amdgcn_readfirstlane(tid >> 6);
    const int r0 = 2 * rp; const int base = min(max(r0 - 4, 0), 248);
    const int qsel = wid >> 2, mt = wid & 3; const int rq = r0 + qsel; const int rstart = min(max(rq - 4, 0), 248);
    const int fr = lane & 15, g = lane >> 4;
    store_rows<9, true>(lds, kreg, 576, A.kn_b, tid);
    __syncthreads();
    const int qc = mt * 16 + fr; const int qtok = rq * 64 + qc;
    bf16x8 qf[2]; load_q(qf, A.qkv + (size_t)qtok * LDQ + COL_QB + h * 64, A.qn_b, g);
    RbNa rb{rstart - base, mt <= 1 ? 0 : 1};
    f32x4 sc[24]; scores<24>(sc, lds, qf, rb, lane);
    const int cstart = min(max(qc - 8, 0), 48);
    const LAS float* rpl = (const LAS float*)(lds + NA_RPB_OFF);
#pragma unroll
    for (int t = 0; t < 24; ++t)
#pragma unroll
        for (int r = 0; r < 4; ++r) { const int kr = t / 3; const int kc = (rb.ctb + t % 3) * 16 + 4 * g + r; const bool ok = (kc >= cstart) && (kc < cstart + 16);
            const int ri = rstart + kr - rq + 7; int ci = kc - qc + 15; ci = min(max(ci, 0), 30);
            sc[t][r] = ok ? sc[t][r] + rpl[ri * 31 + ci] : -INFINITY; }
    bf16x8 pf[12]; const float sum = softmax_pack<24>(sc, pf, 0.f, false);
    u32x4 vreg[9]; load_rows<9>(vreg, A.qkv + COL_VB + h * 64, base * 64, 576, tid);
    __syncthreads();
    store_rows<9, false>(lds, vreg, 576, nullptr, tid);
    if (next_unit >= 0) { const int nrp = next_unit >> 3; const int nbase = min(max(2 * nrp - 4, 0), 248); load_rows<9>(kreg, A.qkv + COL_KB + h * 64, nbase * 64, 576, tid); }
    __syncthreads();
    pv_store<24>(lds, pf, rb, sum, A.o + (size_t)qtok * LDO + 512 + h * 64, lane);
    __syncthreads();
}

__device__ __forceinline__ void attn_phase(ldsp lds, const AttnArgs& A, int vcu, int G, int tid) {
    const int h = vcu & 7;
    u32x4 kreg[9];
    {
        const int n = vcu >> 1, kvh = vcu & 1, tok0 = (n - 1) * 128;
        u32x4 kw[7], vw[7];
        load_rows<7>(kw, A.qkv + COL_KA + kvh * 64, tok0, 384, tid);
        load_rows<7>(vw, A.qkv + COL_VA + kvh * 64, tok0, 384, tid);
        store_rows<7, true>(lds, kw, 400, A.kn_a, tid);
        store_rows<7, false>(lds + 400 * KPB, vw, 400, nullptr, tid);
        __syncthreads();
        window_compute(lds, A, vcu, tid);
        __syncthreads();
    }
    { const int rp0 = vcu >> 3; const int b0 = min(max(2 * rp0 - 4, 0), 248); load_rows<9>(kreg, A.qkv + COL_KB + h * 64, b0 * 64, 576, tid); }
    if (tid < 465) ((LAS float*)(lds + NA_RPB_OFF))[tid] = A.rpb[h * 465 + tid] * LOG2E;
    for (int k = 0; k < 4; ++k) na_unit(lds, A, vcu + 256 * k, (k < 3) ? vcu + 256 * (k + 1) : -1, kreg, tid);
}
}
namespace ret {
constexpr int SEQ = 16384, LDG = 3072, NCH = 128;
constexpr int COL_Q = 0, COL_K = 512, COL_V = 1024, COL_G = 2048;
constexpr int KPB = 288;
constexpr int VPB = 544;
constexpr int R0 = 0, R1 = 128 * KPB, R2 = 2 * 128 * KPB, RSTAT = R2 + 128 * VPB;
constexpr size_t ST_CHUNK = 128 * 256;

__device__ __forceinline__ unsigned pk2a(float lo, float hi) { unsigned r; asm volatile("v_cvt_pk_bf16_f32 %0, %1, %2" : "=v"(r) : "v"(lo), "v"(hi)); return r; }
struct RetArgs { bf16* G; bf16* ST; const float* l2;   const float* gn; int grp; int dry; bf16* dryY; };

template <bool SCALE>
__device__ __forceinline__ void stage128(ldsp dst, const bf16* src, int ld, float a, float b, int tid) {
#pragma unroll
    for (int i = 0; i < 4; ++i) { const int idx = tid + i * 512, row = idx >> 4, ch = idx & 15;
        u32x4 v = *(const u32x4*)(src + (size_t)row * ld + ch * 8);
        if (SCALE) { const float s = ex2(a * (float)row + b);
            v.x = pk2a(bf_lo(v.x) * s, bf_hi(v.x) * s); v.y = pk2a(bf_lo(v.y) * s, bf_hi(v.y) * s); v.z = pk2a(bf_lo(v.z) * s, bf_hi(v.z) * s); v.w = pk2a(bf_lo(v.w) * s, bf_hi(v.w) * s); }
        *(LAS u32x4*)(dst + row * KPB + ch * 16) = v; }
}
__device__ __forceinline__ void stage256(ldsp dst, const bf16* src, int ld, int tid) {
#pragma unroll
    for (int i = 0; i < 8; ++i) { const int idx = tid + i * 512, row = idx >> 5, ch = idx & 31;
        const u32x4 v = *(const u32x4*)(src + (size_t)row * ld + ch * 8);
        *(LAS u32x4*)(dst + row * VPB + ch * 16) = v; }
}
__device__ __forceinline__ bf16x8 trfrag(ldsp X, int pitch, int k0, int n0, int lane) {
    const int g = lane >> 4, q4 = (lane & 15) >> 2, p4 = lane & 3;
    ldsp p = X + (k0 + 8 * g + q4) * pitch + (n0 + 4 * p4) * 2;
    return cat8(vtr(p), vtr(p + 4 * pitch));
}

__device__ __forceinline__ void ret_a_unit(ldsp lds, const RetArgs& A, int unit, int tid) {
    const int hl = unit & 3, c = unit >> 2, h = A.grp * 4 + hl, lane = tid & 63, wid = __builtin_amdgcn_readfirstlane(tid >> 6);
    const float l2f = A.l2[h], l2b = A.l2[8 + h];
    const bf16* rows = A.G + (size_t)c * 128 * LDG;
    stage128<true>(lds + R0, rows + COL_K + hl * 128, LDG, -l2f, 127.0f * l2f, tid);
    stage128<true>(lds + R1, rows + COL_K + hl * 128, LDG, l2b, 0.f, tid);
    stage256(lds + R2, rows + COL_V + hl * 256, LDG, tid);
    __syncthreads();
    const int fr = lane & 15, g = lane >> 4;
    for (int dir = 0; dir < 2; ++dir) {
        ldsp Kx = lds + (dir ? R1 : R0);
        f32x4 acc[2][8];
#pragma unroll
        for (int et = 0; et < 2; ++et)
#pragma unroll
            for (int dt = 0; dt < 8; ++dt) acc[et][dt] = (f32x4){0.f, 0.f, 0.f, 0.f};
#pragma unroll
        for (int ks = 0; ks < 4; ++ks) {
            bf16x8 vf[2];
#pragma unroll
            for (int et = 0; et < 2; ++et) vf[et] = trfrag(lds + R2, VPB, 32 * ks, 32 * wid + 16 * et, lane);
#pragma unroll
            for (int dt = 0; dt < 8; ++dt) { const bf16x8 kf = trfrag(Kx, KPB, 32 * ks, 16 * dt, lane);
#pragma unroll
                for (int et = 0; et < 2; ++et) acc[et][dt] = mfma16(vf[et], kf, acc[et][dt]); }
        }
        bf16* st = A.ST + ((size_t)((dir * 4 + hl) * NCH + c)) * ST_CHUNK;
#pragma unroll
        for (int et = 0; et < 2; ++et)
#pragma unroll
            for (int dt = 0; dt < 8; ++dt) { u32x2 w; w.x = pk2(acc[et][dt][0], acc[et][dt][1]); w.y = pk2(acc[et][dt][2], acc[et][dt][3]);
                *(u32x2*)(st + (size_t)(16 * dt + fr) * 256 + 32 * wid + 16 * et + 4 * g) = w; }
    }
    __syncthreads();
}

__device__ __forceinline__ void ret_b(const RetArgs& A, int vcu, int G, int tid) {
    const int NT = 8 * 16384;
    for (int T = vcu * 512 + tid; T < NT; T += G * 512) {
        const int dh = T >> 14, w = T & 16383, dir = dh >> 2, hl = dh & 3, h = A.grp * 4 + hl;
        const float dec = ex2(128.0f * A.l2[dir * 8 + h]);
        unsigned* p = (unsigned*)(A.ST + (size_t)dh * NCH * ST_CHUNK) + w;
        const ptrdiff_t cs = dir ? -(ptrdiff_t)(ST_CHUNK / 2) : (ptrdiff_t)(ST_CHUNK / 2);
        if (dir) p += (size_t)(NCH - 1) * (ST_CHUNK / 2);
        float s0 = 0.f, s1 = 0.f;
        for (int c = 0; c < NCH; c += 32) {
            unsigned u[32];
#pragma unroll
            for (int k = 0; k < 32; ++k) u[k] = p[(ptrdiff_t)k * cs];
#pragma unroll
            for (int k = 0; k < 32; ++k) { p[(ptrdiff_t)k * cs] = A.dry ? u[k] : pk2(s0, s1); s0 = dec * s0 + bf_lo(u[k]); s1 = dec * s1 + bf_hi(u[k]); }
            p += 32 * cs;
        }
    }
}

__device__ __forceinline__ void ret_c_unit(ldsp lds, const RetArgs& A, int unit, int tid) {
    const int hl = unit & 3, c = unit >> 2, h = A.grp * 4 + hl, lane = tid & 63, wid = __builtin_amdgcn_readfirstlane(tid >> 6);
    const float l2f = A.l2[h], l2b = A.l2[8 + h];
    bf16* rows = A.G + (size_t)c * 128 * LDG;
    const int fr = lane & 15, g = lane >> 4;
    f32x4 acc[2][8];
#pragma unroll
    for (int et = 0; et < 2; ++et)
#pragma unroll
        for (int it = 0; it < 8; ++it) acc[et][it] = (f32x4){0.f, 0.f, 0.f, 0.f};
    for (int dir = 0; dir < 2; ++dir) {
        if (dir == 0) stage128<true>(lds + R0, rows + COL_Q + hl * 128, LDG, l2f, l2f, tid);
        else          stage128<true>(lds + R0, rows + COL_Q + hl * 128, LDG, -l2b, 128.0f * l2b, tid);
        stage256(lds + R2, A.ST + ((size_t)((dir * 4 + hl) * NCH + c)) * ST_CHUNK, 256, tid);
        __syncthreads();
#pragma unroll
        for (int ks = 0; ks < 4; ++ks) {
            bf16x8 sf[2];
#pragma unroll
            for (int et = 0; et < 2; ++et) sf[et] = trfrag(lds + R2, VPB, 32 * ks, 32 * wid + 16 * et, lane);
#pragma unroll
            for (int it = 0; it < 8; ++it) { const bf16x8 qf = *(const LAS bf16x8*)(lds + R0 + (16 * it + fr) * KPB + (32 * ks + 8 * g) * 2);
#pragma unroll
                for (int et = 0; et < 2; ++et) acc[et][it] = mfma16(sf[et], qf, acc[et][it]); }
        }
        __syncthreads();
    }
    stage128<false>(lds + R0, rows + COL_Q + hl * 128, LDG, 0.f, 0.f, tid);
    stage128<false>(lds + R1, rows + COL_K + hl * 128, LDG, 0.f, 0.f, tid);
    stage256(lds + R2, rows + COL_V + hl * 256, LDG, tid);
    __syncthreads();
    {
        f32x4 sa[8];
#pragma unroll
        for (int it = 0; it < 8; ++it) sa[it] = (f32x4){0.f, 0.f, 0.f, 0.f};
#pragma unroll
        for (int ks = 0; ks < 4; ++ks) { const bf16x8 kf = *(const LAS bf16x8*)(lds + R1 + (16 * wid + fr) * KPB + (32 * ks + 8 * g) * 2);
#pragma unroll
            for (int it = 0; it < 8; ++it) { const bf16x8 qf = *(const LAS bf16x8*)(lds + R0 + (16 * it + fr) * KPB + (32 * ks + 8 * g) * 2); sa[it] = mfma16(kf, qf, sa[it]); } }
        __syncthreads();
#pragma unroll
        for (int it = 0; it < 8; ++it) { const int i = 16 * it + fr; float v[4];
#pragma unroll
            for (int r = 0; r < 4; ++r) { const int j = 16 * wid + 4 * g + r; const int dl = i - j; const float dm = dl >= 0 ? ex2((float)dl * l2f) : ex2((float)(-dl) * l2b); v[r] = sa[it][r] * dm; }
            u32x2 w; w.x = pk2(v[0], v[1]); w.y = pk2(v[2], v[3]);
            *(LAS u32x2*)(lds + R1 + i * KPB + (16 * wid + 4 * g) * 2) = w; }
        __syncthreads();
    }
#pragma unroll
    for (int ks = 0; ks < 4; ++ks) {
        bf16x8 vf[2];
#pragma unroll
        for (int et = 0; et < 2; ++et) vf[et] = trfrag(lds + R2, VPB, 32 * ks, 32 * wid + 16 * et, lane);
#pragma unroll
        for (int it = 0; it < 8; ++it) { const bf16x8 af = *(const LAS bf16x8*)(lds + R1 + (16 * it + fr) * KPB + (32 * ks + 8 * g) * 2);
#pragma unroll
            for (int et = 0; et < 2; ++et) acc[et][it] = mfma16(vf[et], af, acc[et][it]); }
    }
    LAS float* stat = (LAS float*)(lds + RSTAT);
#pragma unroll
    for (int it = 0; it < 8; ++it) { float s1 = 0.f, s2 = 0.f;
#pragma unroll
        for (int et = 0; et < 2; ++et)
#pragma unroll
            for (int r = 0; r < 4; ++r) { const float y = acc[et][it][r]; s1 += y; s2 += y * y; }
        s1 += __shfl_xor(s1, 16); s1 += __shfl_xor(s1, 32); s2 += __shfl_xor(s2, 16); s2 += __shfl_xor(s2, 32);
        if (g == 0) { stat[((16 * it + fr) * 8 + wid) * 2] = s1; stat[((16 * it + fr) * 8 + wid) * 2 + 1] = s2; } }
    __syncthreads();
    const float* gnh = A.gn + h * 256;
#pragma unroll
    for (int it = 0; it < 8; ++it) { float s1 = 0.f, s2 = 0.f;
#pragma unroll
        for (int w = 0; w < 8; ++w) { s1 += stat[((16 * it + fr) * 8 + w) * 2]; s2 += stat[((16 * it + fr) * 8 + w) * 2 + 1]; }
        const float mu = s1 * (1.0f / 256.0f); const float var = fmaxf(s2 * (1.0f / 256.0f) - mu * mu, 0.f); const float rs = rsqrtf(var + 1e-5f);
#pragma unroll
        for (int et = 0; et < 2; ++et) { const int e = 32 * wid + 16 * et + 4 * g;
            bf16* gp = rows + (size_t)(16 * it + fr) * LDG + COL_G + hl * 256 + e;
            const u32x2 gv = *(const u32x2*)gp; const f32x4 gw = *(const f32x4*)(gnh + e);
            const f32x4 y = acc[et][it];
            u32x2 w; w.x = pk2(bf_lo(gv.x) * ((y[0] - mu) * rs * gw[0]), bf_hi(gv.x) * ((y[1] - mu) * rs * gw[1]));
            w.y = pk2(bf_lo(gv.y) * ((y[2] - mu) * rs * gw[2]), bf_hi(gv.y) * ((y[3] - mu) * rs * gw[3]));
            if (A.dry) *(u32x2*)(A.dryY + (size_t)(c * 128 + 16 * it + fr) * 1024 + hl * 256 + e) = w; else *(u32x2*)gp = w; }
        asm volatile("" ::: "memory"); }
    __syncthreads();
}
}
#define XB_TMO      128
#define XB_XCNT(j)  (256  + 64 * (j))
#define XB_XSUB(j)  (1280 + 64 * (j))
#define XB_XGEN(j)  (2304 + 64 * (j))
#define XB_TOP      3328
#define XB_TOPGEN   3392
#define XCD_BAR_WORDS 3456
#define XB_SPIN_CAP (1u << 18)

__device__ __forceinline__ unsigned xb_ld(unsigned* p)              { return __hip_atomic_load(p, __ATOMIC_RELAXED, __HIP_MEMORY_SCOPE_AGENT); }
__device__ __forceinline__ unsigned xb_add(unsigned* p, unsigned v) { return __hip_atomic_fetch_add(p, v, __ATOMIC_RELAXED, __HIP_MEMORY_SCOPE_AGENT); }
__device__ __forceinline__ unsigned xb_xcc_id() { return (unsigned)__builtin_amdgcn_s_getreg((3 << 11) | 20) & 0xFu; }
#define XB_SPIN(cond, bar) do { unsigned _sp = 0; while (cond) { __builtin_amdgcn_s_sleep(1); \
    if ((++_sp & 255u) == 0u) { if (xb_ld(&(bar)[XB_TMO])) break; if (_sp > XB_SPIN_CAP) { atomicAdd(&(bar)[XB_TMO], 1u); break; } } } } while (0)

struct XcdBarrier {
    unsigned* bar; unsigned x;
    volatile LAS unsigned* st;
};

__device__ __forceinline__ XcdBarrier xcd_barrier_post(unsigned* bar, volatile LAS unsigned* st) {
    XcdBarrier b; b.bar = bar; b.x = xb_xcc_id(); b.st = st;
    if (threadIdx.x == 0) (void)xb_add(&bar[XB_XCNT(b.x)], 1u);
    return b;
}
__device__ __forceinline__ void xcd_barrier_complete(unsigned* bar, unsigned x, unsigned& nloc, unsigned& nx) {
    const unsigned G = gridDim.x * gridDim.y * gridDim.z;
    unsigned sum, cnt, mine, sp = 0u;
    for (;;) {
        sum = 0u; cnt = 0u; mine = 0u;
#pragma unroll
        for (unsigned j = 0; j < 16; ++j) { const unsigned c = xb_ld(&bar[XB_XCNT(j)]); sum += c; cnt += (c > 0u) ? 1u : 0u; mine = (j == x) ? c : mine; }
        if (sum == G) break;
        __builtin_amdgcn_s_sleep(1);
        if ((++sp & 255u) == 0u) { if (xb_ld(&bar[XB_TMO])) break; if (sp > XB_SPIN_CAP) { atomicAdd(&bar[XB_TMO], 1u); break; } }
    }
    nloc = mine > 0u ? mine : 1u; nx = cnt > 0u ? cnt : 1u;
}

__device__ __forceinline__ void xcd_barrier(const XcdBarrier& b) {
    asm volatile("s_waitcnt vmcnt(0)" ::: "memory");
    __syncthreads();
    if (threadIdx.x == 0) {
        unsigned* bar = b.bar;
        __builtin_amdgcn_s_waitcnt(0);
        unsigned nloc = b.st[0], nx = b.st[1];
        if (nloc == 0u) { xcd_barrier_complete(bar, b.x, nloc, nx); b.st[0] = nloc; b.st[1] = nx; }
        const unsigned old = xb_add(&bar[XB_XSUB(b.x)], 1u);
        const unsigned gen = old / nloc;
        if (old + 1u == (gen + 1u) * nloc) {
            __builtin_amdgcn_fence(__ATOMIC_RELEASE, "agent");
            asm volatile("s_waitcnt vmcnt(0)" ::: "memory");
            const unsigned og = xb_add(&bar[XB_TOP], 1u);
            const unsigned tg = og / nx;
            if (og + 1u == (tg + 1u) * nx) xb_add(&bar[XB_TOPGEN], 1u);
            else XB_SPIN(xb_ld(&bar[XB_TOPGEN]) == tg, bar);
            __builtin_amdgcn_fence(__ATOMIC_ACQUIRE, "agent");
            xb_add(&bar[XB_XGEN(b.x)], 1u);
            asm volatile("s_waitcnt vmcnt(0)" ::: "memory");
        } else {
            XB_SPIN(xb_ld(&bar[XB_XGEN(b.x)]) == gen, bar);
            __builtin_amdgcn_fence(__ATOMIC_ACQUIRE, "agent");
            asm volatile("s_waitcnt vmcnt(0)" ::: "memory");
        }
    }
    __syncthreads();
}
constexpr int M_TOK = 16384, DM = 1024, DFF = 4096, N_IN_E = 2304, N_IN_O = 6144;
constexpr size_t MiB = 1u << 20;
constexpr size_t WS_CTL = 0;
constexpr size_t WS_L2 = 4096, WS_SSQ = 512 * 1024;
constexpr int CW_BAR = 4096;
constexpr size_t WS_W_IN_E = 1 * MiB;
constexpr size_t WS_W_OUT_E = WS_W_IN_E + (size_t)N_IN_E * DM * 2;
constexpr size_t WS_W_MLP_IN = WS_W_OUT_E + (size_t)DM * DM * 2;
constexpr size_t WS_W_MLP_OUT = WS_W_MLP_IN + 2 * (size_t)DFF * DM * 2;
constexpr size_t WS_W_IN_O = WS_W_MLP_OUT + 2 * (size_t)DFF * DM * 2;
constexpr size_t WS_W_OUT_O = WS_W_IN_O + (size_t)N_IN_O * DM * 2;
constexpr size_t WS_XB = 56 * MiB;
constexpr size_t WS_BIG = 88 * MiB;
constexpr size_t WS_END = 256 * MiB;
static_assert(WS_W_OUT_O + (size_t)DM * 2048 * 2 <= WS_XB, "weights fit below XB");

constexpr int RING_BYTES = 155648;
constexpr int LDS_BYTES = 159744;

struct Args { const float* in[19]; float* out; unsigned char* ws; int ph_lo, ph_hi; };

__device__ __forceinline__ float wave_sum(float v) {
#pragma unroll
    for (int o = 1; o < 64; o <<= 1) v += __shfl_xor(v, o);
    return v;
}
struct WItem { const float* W; int N; bf16* WT; int ldo; int k0, n0, orow0; const float* gain; float nscale; };
constexpr int WI_C0 = 1152, WI_C1 = WI_C0 + 512, WI_C2 = WI_C1 + 2048, WI_C3 = WI_C2 + 2048, WI_C4 = WI_C3 + 2048, WI_C5 = WI_C4 + 2048, WI_C6 = WI_C5 + 3072, WI_C7 = WI_C6 + 1024;
__device__ __forceinline__ void witem_decode(const Args& a, unsigned char* ws, int gi, WItem& d) {
    int item, K, mode = 0; d.gain = nullptr; d.nscale = 1.0f;
    if (gi < WI_C0)      { item = gi;         d.W = a.in[2];  K = DM;  d.N = N_IN_E; d.WT = (bf16*)(ws + WS_W_IN_E); d.gain = a.in[1]; }
    else if (gi < WI_C1) { item = gi - WI_C0; d.W = a.in[9];  K = DM;  d.N = DM;     d.WT = (bf16*)(ws + WS_W_OUT_E); }
    else if (gi < WI_C2) { item = gi - WI_C1; d.W = a.in[17]; K = DM;  d.N = DFF;    d.WT = (bf16*)(ws + WS_W_MLP_IN); d.gain = a.in[16]; }
    else if (gi < WI_C3) { item = gi - WI_C2; d.W = a.in[17] + (size_t)DM * DFF; K = DM; d.N = DFF; d.WT = (bf16*)(ws + WS_W_MLP_IN) + (size_t)DFF * DM; d.gain = a.in[16] + DM; }
    else if (gi < WI_C4) { item = gi - WI_C3; d.W = a.in[18]; K = DFF; d.N = DM;     d.WT = (bf16*)(ws + WS_W_MLP_OUT); }
    else if (gi < WI_C5) { item = gi - WI_C4; d.W = a.in[18] + (size_t)DFF * DM; K = DFF; d.N = DM; d.WT = (bf16*)(ws + WS_W_MLP_OUT) + (size_t)DFF * DM; }
    else if (gi < WI_C6) { item = gi - WI_C5; d.W = a.in[11]; K = DM;  d.N = N_IN_O; d.WT = (bf16*)(ws + WS_W_IN_O); d.gain = a.in[10]; mode = 1; }
    else                 { item = gi - WI_C6; d.W = a.in[15]; K = 2048; d.N = DM;    d.WT = (bf16*)(ws + WS_W_OUT_O); }
    const int nblk = d.N / 32, kb = item / nblk, nb = item % nblk; d.k0 = 64 * kb; d.n0 = 32 * nb; d.orow0 = d.n0; d.ldo = K;
    if (mode == 1) {
        const int n0 = d.n0;
        if (n0 < 1024) { d.orow0 = (n0 >> 9) * 3072 + (n0 & 511); }
        else if (n0 < 2048) { const int nk = n0 - 1024; d.orow0 = (nk >> 9) * 3072 + 512 + (nk & 511); d.nscale = 0.08838834764831845f; }
        else if (n0 < 4096) { const int nv = n0 - 2048; d.orow0 = (nv >> 10) * 3072 + 1024 + (nv & 1023); }
        else { const int ng = n0 - 4096; d.orow0 = (ng >> 10) * 3072 + 2048 + (ng & 1023); }
    }
}
__device__ __forceinline__ void witem_load(const WItem& d, float (&v)[32], int lane) {
#pragma unroll
    for (int i = 0; i < 32; ++i) { const int kk = 2 * i + (lane >> 5); v[i] = d.W[(size_t)(d.k0 + kk) * d.N + d.n0 + (lane & 31)]; }
}
__device__ __forceinline__ void witem_finish(const WItem& d, const float (&v)[32], LAS float* scr, int lane) {
#pragma unroll
    for (int i = 0; i < 32; ++i) { const int kk = 2 * i + (lane >> 5); const float gsc = d.gain ? d.gain[d.k0 + kk] * d.nscale : d.nscale; scr[kk * 33 + (lane & 31)] = v[i] * gsc; }
    asm volatile("s_waitcnt lgkmcnt(0)" ::: "memory");
    const int c = lane & 7;
#pragma unroll
    for (int j = 0; j < 4; ++j) { const int n = (lane >> 3) + 8 * j; const LAS float* s = scr + (8 * c) * 33 + n;
        u32x4 o; o.x = pk2(s[0 * 33], s[1 * 33]); o.y = pk2(s[2 * 33], s[3 * 33]); o.z = pk2(s[4 * 33], s[5 * 33]); o.w = pk2(s[6 * 33], s[7 * 33]);
        *(u32x4*)(d.WT + (size_t)(d.orow0 + n) * d.ldo + d.k0 + 8 * c) = o; }
    asm volatile("s_waitcnt lgkmcnt(0)" ::: "memory");
}
__device__ __forceinline__ void prologue(const Args& a, ldsp lds, int vcu, int G, int tid) {
    const int lane = tid & 63, wave = __builtin_amdgcn_readfirstlane(tid >> 6);
    unsigned char* ws = a.ws;
    LAS float* scr = (LAS float*)(lds + wave * 16384);
    const int gw = vcu * 8 + wave, NGW = G * 8;
    {
        WItem cur, nxt; float va[32], vb[32];
        int gi = gw;
        if (gi < WI_C7) { witem_decode(a, ws, gi, cur); witem_load(cur, va, lane); }
        while (gi < WI_C7) {
            const int g1 = gi + NGW, g2 = gi + 2 * NGW;
            if (g1 < WI_C7) { witem_decode(a, ws, g1, nxt); witem_load(nxt, vb, lane); }
            witem_finish(cur, va, scr, lane);
            if (g1 >= WI_C7) break;
            if (g2 < WI_C7) { witem_decode(a, ws, g2, cur); witem_load(cur, va, lane); }
            witem_finish(nxt, vb, scr, lane);
            gi = g2;
        }
    }
    const float* x = a.in[0]; bf16* XB = (bf16*)(ws + WS_XB); float* ssq = (float*)(ws + WS_SSQ);
    for (int m = gw; m < M_TOK; m += 2 * NGW) {
        const int m2 = m + NGW;
        const f32x4* xr0 = (const f32x4*)(x + (size_t)m * DM) + lane; const f32x4* xr1 = (const f32x4*)(x + (size_t)m2 * DM) + lane;
        f32x4 v0[4], v1[4];
#pragma unroll
        for (int j = 0; j < 4; ++j) { v0[j] = xr0[64 * j]; v1[j] = xr1[64 * j]; }
        unsigned long long* o0 = (unsigned long long*)(XB + (size_t)m * DM) + lane; unsigned long long* o1 = (unsigned long long*)(XB + (size_t)m2 * DM) + lane;
        float s0 = 0.f, s1 = 0.f;
#pragma unroll
        for (int j = 0; j < 4; ++j) { s0 += (v0[j][0] * v0[j][0] + v0[j][1] * v0[j][1]) + (v0[j][2] * v0[j][2] + v0[j][3] * v0[j][3]);
            s1 += (v1[j][0] * v1[j][0] + v1[j][1] * v1[j][1]) + (v1[j][2] * v1[j][2] + v1[j][3] * v1[j][3]);
            o0[64 * j] = (unsigned long long)pk2(v0[j][0], v0[j][1]) | ((unsigned long long)pk2(v0[j][2], v0[j][3]) << 32);
            o1[64 * j] = (unsigned long long)pk2(v1[j][0], v1[j][1]) | ((unsigned long long)pk2(v1[j][2], v1[j][3]) << 32); }
        s0 = wave_sum(s0); s1 = wave_sum(s1);
        if (lane == 0) { *(f32x4*)(ssq + 4 * (size_t)m) = (f32x4){s0, 0.f, 0.f, 0.f}; *(f32x4*)(ssq + 4 * (size_t)m2) = (f32x4){s1, 0.f, 0.f, 0.f}; }
    }
    if (vcu == 0 && tid < 16) { const float d = (tid < 8 ? a.in[12] : a.in[13])[tid & 7]; const float ls = -log1pf(__expf(-d)); ((float*)(ws + WS_L2))[tid] = ls * LOG2E; }
}

#define REP_N 0
#define REP_PH (-1)
#ifndef DBG_DUMP
#define DBG_DUMP 0
#endif
#ifndef REP_PH
#define REP_PH (-1)
#define REP_N 0
#endif
#ifndef DBG_STRIDE
#define DBG_STRIDE 1
#endif
#ifndef DBG_HI
#define DBG_HI PH_COUNT
#endif
enum { PH_PRO = 0, PH_IN_E, PH_ATTN, PH_OUT_E, PH_MLP_IN0, PH_MLP_OUT0, PH_IN_O0, PH_RA0, PH_RB0, PH_RC0, PH_OUT_O0, PH_IN_O1, PH_RA1, PH_RB1, PH_RC1, PH_OUT_O1, PH_MLP_IN1, PH_MLP_OUT1, PH_COUNT };

__global__ void __launch_bounds__(512, 2) mk_fwd(Args a) {
    extern __shared__ __attribute__((aligned(16))) unsigned char lds_raw[];
    cg::grid_group grid = cg::this_grid();
    const ldsp lds = (ldsp)lds_raw;
    volatile LAS unsigned* MISC = (volatile LAS unsigned*)(lds + RING_BYTES);
    if (threadIdx.x < 32) MISC[threadIdx.x] = 0u;
    __syncthreads();
    const XcdBarrier bar = xcd_barrier_post((unsigned*)(a.ws + WS_CTL) + CW_BAR, MISC + 8);
    const int G = gridDim.x;
    unsigned char* ws = a.ws;
    bf16* XB = (bf16*)(ws + WS_XB); float* ssq = (float*)(ws + WS_SSQ);
    bf16* BIG = (bf16*)(ws + WS_BIG);
    bf16* QKV = BIG; bf16* OE = BIG + (size_t)M_TOK * N_IN_E; bf16* HM = BIG; bf16* GB = BIG; bf16* ST = BIG + (size_t)M_TOK * 3072;
    int repcnt = 0;
    for (int ph = a.ph_lo; ph < a.ph_hi; ++ph) {
        int tid = threadIdx.x, bx = blockIdx.x;
        asm volatile("" : "+v"(tid)); asm volatile("" : "+s"(bx));
        const int vcu = (G % 8 == 0) ? (bx % 8) * (G / 8) + bx / 8 : bx;
        if (ph == PH_PRO) { prologue(a, lds, vcu, G, tid); }
        else if (ph == PH_ATTN) {
            att::AttnArgs A{QKV, OE, a.in[3], a.in[4], a.in[5], a.in[6], a.in[7], a.in[8]};
            att::attn_phase(lds, A, vcu, G, tid);
        }
        else if (ph == PH_RA0 || ph == PH_RA1 || ph == PH_RB0 || ph == PH_RB1 || ph == PH_RC0 || ph == PH_RC1) {
            ret::RetArgs R{GB, ST, (const float*)(ws + WS_L2), a.in[14], (ph >= PH_IN_O1) ? 1 : 0, (REP_N > 0 && ph == REP_PH && repcnt > 0) ? 1 : 0, XB};
            if (ph == PH_RA0 || ph == PH_RA1) { for (int u = vcu; u < 512; u += G) ret::ret_a_unit(lds, R, u, tid); }
            else if (ph == PH_RB0 || ph == PH_RB1) { ret::ret_b(R, vcu, G, tid); }
            else { for (int u = vcu; u < 512; u += G) ret::ret_c_unit(lds, R, u, tid); }
        }
        else if (ph == PH_IN_E || ph == PH_MLP_IN0 || ph == PH_MLP_IN1 || ph == PH_IN_O0 || ph == PH_IN_O1) {
            pg8::Gemm g; pg8::EpiBf16 E; E.ssq = ssq; E.silu_pn0 = 1 << 30; E.act = 0;
            g.A = XB; g.lda = DM; g.M = M_TOK; g.K = DM; g.ldb = DM;
            if (ph == PH_IN_E) { g.Bt = (const bf16*)(ws + WS_W_IN_E); g.N = N_IN_E; E.O = QKV; E.ldc = N_IN_E; }
            else if (ph == PH_MLP_IN0 || ph == PH_MLP_IN1) { g.Bt = (const bf16*)(ws + WS_W_MLP_IN) + (ph == PH_MLP_IN1 ? (size_t)DFF * DM : 0); g.N = DFF; E.O = HM; E.ldc = DFF; E.act = 1; }
            else { g.Bt = (const bf16*)(ws + WS_W_IN_O) + (ph == PH_IN_O1 ? (size_t)3072 * DM : 0); g.N = 3072; E.O = GB; E.ldc = 3072; E.act = 2; E.silu_pn0 = 8; }
            pg8::StaticOrder S; S.init(g.M, g.N, G, bx);
            pg8::gemm_phase<pg8::EpiBf16, pg8::StaticOrder, true, true>(lds, g, S, E, tid);
        }
        else {
            pg8::Gemm g; pg8::EpiResid E; g.M = M_TOK; g.N = DM; E.ldc = DM; E.out = a.out; E.base = a.out; E.xb = XB; E.ssq_out = ssq; E.accscale = (REP_N > 0 && ph == REP_PH && repcnt > 0 && ph != PH_OUT_E) ? 0.f : 1.f;
            if (ph == PH_OUT_E) { g.A = OE; g.lda = DM; g.K = DM; g.Bt = (const bf16*)(ws + WS_W_OUT_E); g.ldb = DM; E.base = a.in[0]; }
            else if (ph == PH_MLP_OUT0 || ph == PH_MLP_OUT1) { g.A = HM; g.lda = DFF; g.K = DFF; g.Bt = (const bf16*)(ws + WS_W_MLP_OUT) + (ph == PH_MLP_OUT1 ? (size_t)DFF * DM : 0); g.ldb = DFF;
                if (ph == PH_MLP_OUT1) { E.xb = nullptr; E.ssq_out = nullptr; } }
            else { const int grp = (ph == PH_OUT_O1) ? 1 : 0; g.A = GB + 2048; g.lda = 3072; g.K = 1024; g.Bt = (const bf16*)(ws + WS_W_OUT_O) + grp * 1024; g.ldb = 2048;
                if (grp == 0) { E.xb = nullptr; E.ssq_out = nullptr; } }
            pg8::StaticOrder S; S.init(g.M, g.N, G, bx);
            pg8::gemm_phase<pg8::EpiResid, pg8::StaticOrder, false, true>(lds, g, S, E, tid);
        }
        if (ph + 1 == a.ph_hi && DBG_DUMP) {
            xcd_barrier(bar);
            const bf16* srcb = (DBG_DUMP == 1) ? GB : ST;
            for (size_t i = (size_t)bx * 512 + tid; i < (size_t)M_TOK * DM; i += (size_t)G * 512) a.out[i] = bf_lo((unsigned)srcb[i * DBG_STRIDE]);
        }
        if (ph + 1 < a.ph_hi) {
            if (a.ph_lo < 0) {
                asm volatile("s_waitcnt vmcnt(0)" ::: "memory");
                grid.sync();
                __builtin_amdgcn_fence(__ATOMIC_ACQUIRE, "agent");
                asm volatile("s_waitcnt vmcnt(0)" ::: "memory");
                __syncthreads();
            }
            xcd_barrier(bar);
        }
        if (REP_N > 0 && ph == REP_PH && repcnt < REP_N) { ++repcnt; --ph; }
    }
}

extern "C" void kernel_launch(void* const* d_in, const int* in_sizes, int n_in, void* d_out, int out_size, void* d_ws, size_t ws_size, hipStream_t stream) {
    static int grid = 0;
    if (grid == 0) {
        int dev = 0, cus = 0, per_cu = 0;
        (void)hipGetDevice(&dev);
        (void)hipDeviceGetAttribute(&cus, hipDeviceAttributeMultiprocessorCount, dev);
        (void)hipFuncSetAttribute((const void*)mk_fwd, hipFuncAttributeMaxDynamicSharedMemorySize, LDS_BYTES);
        (void)hipOccupancyMaxActiveBlocksPerMultiprocessor(&per_cu, (const void*)mk_fwd, 512, LDS_BYTES);
        grid = (n_in == 19 && per_cu >= 1 && cus == 256 && ws_size >= WS_END && out_size == M_TOK * DM) ? 256 : -1;
        if (grid < 0) fprintf(stderr, "kernel_launch: unsupported configuration (cus %d per_cu %d ws %zu n_in %d)\n", cus, per_cu, ws_size, n_in);
    }
    if (grid < 0) return;
    if (hipMemsetAsync((char*)d_ws + WS_CTL, 0, 65536, stream) != hipSuccess) { fprintf(stderr, "kernel_launch: memset failed\n"); return; }
    Args a{};
    for (int i = 0; i < 19; ++i) a.in[i] = (const float*)d_in[i];
    a.out = (float*)d_out; a.ws = (unsigned char*)d_ws; a.ph_lo = 0; a.ph_hi = DBG_HI;
    void* args[] = {&a};
    hipError_t e = hipLaunchCooperativeKernel((void*)mk_fwd, dim3(grid), dim3(512), args, LDS_BYTES, stream);
    if (e != hipSuccess) fprintf(stderr, "cooperative launch failed: %s\n", hipGetErrorString(e));
}
```

```cpp
#include <hip/hip_runtime.h>
#include <hip/hip_cooperative_groups.h>
#include <cstdio>
#include <cstdint>
#include <cmath>
namespace cg = cooperative_groups;
namespace pg8 {
#define PG8_LAS __attribute__((address_space(3)))
typedef unsigned short bf16_t;
typedef short bf16x8 __attribute__((ext_vector_type(8)));
typedef float f32x4 __attribute__((ext_vector_type(4)));
typedef float f32x2 __attribute__((ext_vector_type(2)));
typedef unsigned u32x4 __attribute__((ext_vector_type(4)));
typedef unsigned u32x2 __attribute__((ext_vector_type(2)));
constexpr int BM = 256, BK = 64, HALF = 128, HTB = HALF * BK * 2  , STAGE_BYTES = 8 * HTB, NXCD = 8, WGM = 8;

__host__ __device__ __forceinline__ int lds_byte(int r, int c) { const int st = (r >> 4) * 2 + (c >> 5), rr = r & 15, cc = c & 31, ob = rr * 64 + cc * 2; return st * 1024 + (ob ^ (((ob >> 9) & 1) << 5)); }
__host__ __device__ __forceinline__ void stage_rc(int b, int& R, int& C) { const int st = b / 1024, sb = b % 1024, swz = sb ^ (((sb >> 9) & 1) << 5); R = (st >> 1) * 16 + swz / 64; C = (st & 1) * 32 + (swz % 64) / 2; }
__host__ __device__ __forceinline__ int perm32(int rho) { const int n = rho >> 4, i = rho & 15; return 8 * (i >> 2) + 4 * n + (i & 3); }

struct Unit { int pm, pn; };
struct Gemm { const bf16_t* A; const bf16_t* Bt; int lda, ldb, M, N, K; };

struct StaticOrder {
    int nM, nN, nwg, G, c;
    __host__ __device__ void init(int M, int N, int G_, int c_) { nM = M / BM; nN = N / BM; nwg = nM * nN; G = G_; c = c_; }
    __host__ __device__ bool next(int i, Unit& u) const {
        const long L = (long)i * G + c; if (L >= nwg) return false;
        int wgid = (int)L; { const int q = nwg / NXCD, r = nwg % NXCD, xcd = wgid % NXCD, off = wgid / NXCD; wgid = (xcd < r ? xcd * (q + 1) : r * (q + 1) + (xcd - r) * q) + off; }
        const int nig = WGM * nN, gid = wgid / nig, fm = gid * WGM, gsz = (nM - fm) < WGM ? (nM - fm) : WGM;
        u.pm = fm + ((wgid % nig) % gsz); u.pn = (wgid % nig) / gsz; return true;
    }
};

typedef float f32x2_cv __attribute__((ext_vector_type(2))); typedef __bf16 bf16x2_cv __attribute__((ext_vector_type(2)));
__device__ __forceinline__ unsigned cvt_pk_bf16(float lo, float hi) { const f32x2_cv v = {lo, hi}; const bf16x2_cv b = __builtin_convertvector(v, bf16x2_cv); return __builtin_bit_cast(unsigned, b); }


__device__ __forceinline__ float row_rstd(const float* ssq, int row) { const f32x4 p = *(const f32x4*)(ssq + 4 * (size_t)row); return rsqrtf(((p[0] + p[1]) + (p[2] + p[3])) * (1.0f / 1024.0f) + 1e-6f); }

struct EpiBf16 {
    static constexpr bool PERM = true, AFTER_DRAIN = false;
    bf16_t* O; int ldc; const float* ssq; int silu_pn0; int act;
    __device__ __forceinline__ void operator()(const f32x4 (&acc)[2][2][4][2], const Unit& u, int wr, int wc, int fr, int fq) const {
        const int row0 = u.pm * BM + wr * 64 + fr; const int col0 = u.pn * BM + wc * 32 + 8 * fq;
        const bool do_silu = (act == 2) && (u.pn >= silu_pn0);
#pragma unroll
        for (int ai = 0; ai < 2; ++ai)
#pragma unroll
            for (int m = 0; m < 4; ++m) { const int row = row0 + ai * HALF + m * 16; const float rs = row_rstd(ssq, row); bf16_t* rowp = O + (size_t)row * ldc + col0;
#pragma unroll
                for (int bj = 0; bj < 2; ++bj) { f32x4 v0 = acc[ai][bj][m][0] * rs, v1 = acc[ai][bj][m][1] * rs;
                    if (act == 1) {
#pragma unroll
                        for (int e = 0; e < 4; ++e) { const float a = fmaxf(v0[e], 0.f), b = fmaxf(v1[e], 0.f); v0[e] = a * a; v1[e] = b * b; } }
                    if (do_silu) {
#pragma unroll
                        for (int e = 0; e < 4; ++e) { v0[e] = v0[e] / (1.0f + __expf(-v0[e])); v1[e] = v1[e] / (1.0f + __expf(-v1[e])); } }
                    u32x4 w; w.x = cvt_pk_bf16(v0[0], v0[1]); w.y = cvt_pk_bf16(v0[2], v0[3]); w.z = cvt_pk_bf16(v1[0], v1[1]); w.w = cvt_pk_bf16(v1[2], v1[3]);
                    *(u32x4*)(rowp + bj * HALF) = w; } }
    }
};

struct EpiResid {
    static constexpr bool PERM = false, AFTER_DRAIN = true;
    const float* basef; const bf16_t* baseb; float* outf; bf16_t* xb; float* ssq_out; int ldc; float accscale;
    __device__ __forceinline__ void fused(f32x4 (&acc)[2][2][4][2], const Unit& u, int wr, int wc, int fr, int fq, PG8_LAS unsigned char* lds, int wid, int lane) const {
        PG8_LAS float* P = (PG8_LAS float*)lds;
        const int col0 = u.pn * BM + wc * 32 + 4 * fq;
#pragma unroll
        for (int ai = 0; ai < 2; ++ai)
#pragma unroll
            for (int m = 0; m < 4; ++m) { const int r = ai * HALF + wr * 64 + m * 16 + fr; const size_t off = (size_t)(u.pm * BM + r) * ldc + col0; float s = 0.f;
#pragma unroll
                for (int bj = 0; bj < 2; ++bj)
#pragma unroll
                    for (int n = 0; n < 2; ++n) { const size_t o2 = off + bj * HALF + n * 16; f32x4 bs;
                        if (basef) bs = *(const f32x4*)(basef + o2);
                        else { const u32x2 b = *(const u32x2*)(baseb + o2); bs = (f32x4){__uint_as_float(b.x << 16), __uint_as_float(b.x & 0xffff0000u), __uint_as_float(b.y << 16), __uint_as_float(b.y & 0xffff0000u)}; }
                        const f32x4 o = bs + acc[ai][bj][m][n] * accscale;
                        if (outf) *(f32x4*)(outf + o2) = o;
                        if (xb) { u32x2 w; w.x = cvt_pk_bf16(o[0], o[1]); w.y = cvt_pk_bf16(o[2], o[3]); *(u32x2*)(xb + o2) = w; }
                        s += (o[0] * o[0] + o[1] * o[1]) + (o[2] * o[2] + o[3] * o[3]); }
                if (ssq_out) { s += __shfl_xor(s, 16); s += __shfl_xor(s, 32); if (fq == 0) P[r * 4 + wc] = s; }
                if (m & 1) asm volatile("" ::: "memory"); }
        if (ssq_out) {
            __syncthreads();
            const int t = wid * 64 + lane;
            if (t < 256) { const float s = (P[t * 4 + 0] + P[t * 4 + 1]) + (P[t * 4 + 2] + P[t * 4 + 3]); ssq_out[(size_t)(u.pm * BM + t) * 4 + u.pn] = s; }
            __syncthreads();
        }
    }
};

template <class Epi, class Sched, bool ALIGN_EPI = false, bool SP2 = false>
__device__ __forceinline__ void gemm_phase(PG8_LAS unsigned char* lds, const Gemm g, const Sched& S, const Epi& E, const int tid) {
    const int wid = __builtin_amdgcn_readfirstlane(tid >> 6), lane = tid & 63, wr = wid >> 2, wc = wid & 3, fr = lane & 15, fq = lane >> 4;
    const int K = g.K, nt = K / BK;
    unsigned voffA[2], voffB[2];
#pragma unroll
    for (int i = 0; i < 2; ++i) { int R, C; stage_rc(tid * 16 + i * 8192, R, C); const int Rb = Epi::PERM ? ((R & ~31) + perm32(R & 31)) : R;
        voffA[i] = (unsigned)(R * g.lda + C) * 2u; voffB[i] = (unsigned)(Rb * g.ldb + C) * 2u; }
    const size_t kstep = (size_t)(BK * 2);
    const size_t hstepA = (size_t)HALF * g.lda * 2, hstepB = (size_t)HALF * g.ldb * 2;
    const size_t tstepA = 2 * hstepA, tstepB = 2 * hstepB;
    const unsigned ldsw = (unsigned)wid * 1024u;
    const int aoff = lds_byte(wr * 64 + fr, fq * 8), boff = lds_byte(wc * 32 + fr, fq * 8);
#define PG8_SA(b, h) (((b) * 2 + (h)) * HTB)
#define PG8_SB(b, h) ((4 + (b) * 2 + (h)) * HTB)
#define PG8_STAGE(bufoff, gbase, voff) do { _Pragma("unroll") for (int _i = 0; _i < 2; ++_i) \
        __builtin_amdgcn_global_load_lds((const unsigned*)((const char*)(gbase) + (voff)[_i]), (PG8_LAS unsigned*)(lds + (bufoff) + ldsw + _i * 8192), 16, 0, 0); } while (0)
#define PG8_LDA(dst, b, h) do { _Pragma("unroll") for (int m = 0; m < 4; ++m) _Pragma("unroll") for (int k = 0; k < 2; ++k) dst[m][k] = *(const PG8_LAS bf16x8*)(lds + PG8_SA(b, h) + aoff + m * 2048 + k * 1024); } while (0)
#define PG8_LDB(dst, b, h) do { _Pragma("unroll") for (int n = 0; n < 2; ++n) _Pragma("unroll") for (int k = 0; k < 2; ++k) dst[n][k] = *(const PG8_LAS bf16x8*)(lds + PG8_SB(b, h) + boff + n * 2048 + k * 1024); } while (0)
#define PG8_MMA(ai, bj, At, Bt) do { __builtin_amdgcn_s_setprio(1); _Pragma("unroll") for (int m = 0; m < 4; ++m) _Pragma("unroll") for (int n = 0; n < 2; ++n) _Pragma("unroll") for (int k = 0; k < 2; ++k) \
        acc[ai][bj][m][n] = __builtin_amdgcn_mfma_f32_16x16x32_bf16(Bt[n][k], At[m][k], acc[ai][bj][m][n], 0, 0, 0); __builtin_amdgcn_s_setprio(0); } while (0)
#define PG8_WAIT_V(n) asm volatile("s_waitcnt vmcnt(" #n ")" ::: "memory")
#define PG8_WAIT_L(n) asm volatile("s_waitcnt lgkmcnt(" #n ")" ::: "memory")
#define PG8_BAR __builtin_amdgcn_s_barrier()
#define PG8_SCHED __builtin_amdgcn_sched_barrier(0)
    Unit cur, nxt; int ui = 0;
    if (!S.next(0, cur)) return;
    f32x4 acc[2][2][4][2];
#pragma unroll
    for (int a = 0; a < 2; ++a)
#pragma unroll
        for (int b = 0; b < 2; ++b)
#pragma unroll
            for (int m = 0; m < 4; ++m)
#pragma unroll
                for (int n = 0; n < 2; ++n) acc[a][b][m][n] = (f32x4){0.f, 0.f, 0.f, 0.f};
    bf16x8 At[4][2], B0[2][2], B1[2][2];
    const char* cA = (const char*)g.A + (size_t)cur.pm * tstepA; const char* cB = (const char*)g.Bt + (size_t)cur.pn * tstepB;
    if constexpr (SP2) {
        PG8_STAGE(PG8_SB(0, 0), cB, voffB); PG8_STAGE(PG8_SB(0, 1), cB + hstepB, voffB); PG8_STAGE(PG8_SA(0, 0), cA, voffA); PG8_STAGE(PG8_SA(0, 1), cA + hstepA, voffA);
        if (wr == 1) PG8_BAR;
        PG8_WAIT_V(2); PG8_BAR;
        PG8_STAGE(PG8_SB(1, 0), cB + kstep, voffB); PG8_STAGE(PG8_SA(1, 0), cA + kstep, voffA); PG8_STAGE(PG8_SB(1, 1), cB + hstepB + kstep, voffB);
        PG8_WAIT_V(6); PG8_BAR;
    } else {
        PG8_STAGE(PG8_SB(0, 0), cB, voffB); PG8_STAGE(PG8_SA(0, 0), cA, voffA); PG8_STAGE(PG8_SB(0, 1), cB + hstepB, voffB); PG8_STAGE(PG8_SA(0, 1), cA + hstepA, voffA);
        if (wr == 1) PG8_BAR;
        PG8_WAIT_V(4); PG8_BAR;
        PG8_STAGE(PG8_SB(1, 0), cB + kstep, voffB); PG8_STAGE(PG8_SA(1, 0), cA + kstep, voffA); PG8_STAGE(PG8_SB(1, 1), cB + hstepB + kstep, voffB);
        PG8_WAIT_V(6); PG8_BAR;
    }
    for (;;) {
        const bool has_next = S.next(ui + 1, nxt);
        const char* nA = has_next ? (const char*)g.A + (size_t)nxt.pm * tstepA : cA; const char* nB = has_next ? (const char*)g.Bt + (size_t)nxt.pn * tstepB : cB;
        for (int t = 0; t < nt; t += 2) {
            const bool last = (t == nt - 2);
            const char* a1 = cA + (size_t)(t + 1) * kstep;
            const char* a2 = last ? nA : cA + (size_t)(t + 2) * kstep; const char* b2 = last ? nB : cB + (size_t)(t + 2) * kstep;
            const char* a3 = a2 + kstep; const char* b3 = b2 + kstep;
            if constexpr (SP2) {
            PG8_LDB(B0, 0, 0); PG8_LDB(B1, 0, 1); PG8_SCHED; PG8_LDA(At, 0, 0); PG8_STAGE(PG8_SA(1, 1), a1 + hstepA, voffA);
            PG8_WAIT_V(8); PG8_WAIT_L(0); PG8_BAR; PG8_MMA(0, 0, At, B0); PG8_MMA(0, 1, At, B1); PG8_BAR; PG8_SCHED;
            PG8_LDA(At, 0, 1); PG8_STAGE(PG8_SB(0, 0), b2, voffB); PG8_STAGE(PG8_SB(0, 1), b2 + hstepB, voffB); PG8_STAGE(PG8_SA(0, 0), a2, voffA);
            PG8_WAIT_V(8); PG8_WAIT_L(0); PG8_BAR; PG8_MMA(1, 0, At, B0); PG8_MMA(1, 1, At, B1); PG8_BAR; PG8_SCHED;
            PG8_LDB(B0, 1, 0); PG8_LDB(B1, 1, 1); PG8_SCHED; PG8_LDA(At, 1, 0); PG8_STAGE(PG8_SA(0, 1), a2 + hstepA, voffA);
            PG8_WAIT_V(8); PG8_WAIT_L(0); PG8_BAR; PG8_MMA(0, 0, At, B0); PG8_MMA(0, 1, At, B1); PG8_BAR; PG8_SCHED;
            PG8_LDA(At, 1, 1); PG8_STAGE(PG8_SB(1, 0), b3, voffB); PG8_STAGE(PG8_SB(1, 1), b3 + hstepB, voffB); PG8_STAGE(PG8_SA(1, 0), a3, voffA);
            PG8_WAIT_V(8); PG8_WAIT_L(0); PG8_BAR; PG8_MMA(1, 0, At, B0); PG8_MMA(1, 1, At, B1); PG8_BAR; PG8_SCHED;
            } else {
            PG8_LDB(B0, 0, 0); PG8_SCHED; PG8_LDA(At, 0, 0); PG8_STAGE(PG8_SA(1, 1), a1 + hstepA, voffA);
            PG8_WAIT_L(8); PG8_BAR; PG8_WAIT_L(0); PG8_MMA(0, 0, At, B0); PG8_BAR; PG8_SCHED;
            PG8_LDB(B1, 0, 1); PG8_STAGE(PG8_SB(0, 0), b2, voffB);
            PG8_BAR; PG8_WAIT_L(0); PG8_MMA(0, 1, At, B1); PG8_BAR;
            PG8_LDA(At, 0, 1); PG8_STAGE(PG8_SA(0, 0), a2, voffA);
            PG8_BAR; PG8_WAIT_L(0); PG8_MMA(1, 0, At, B0); PG8_BAR; PG8_SCHED;
            PG8_STAGE(PG8_SB(0, 1), b2 + hstepB, voffB);
            PG8_WAIT_V(6); PG8_BAR; PG8_MMA(1, 1, At, B1); PG8_BAR;
            PG8_LDB(B0, 1, 0); PG8_SCHED; PG8_LDA(At, 1, 0); PG8_STAGE(PG8_SA(0, 1), a2 + hstepA, voffA);
            PG8_WAIT_L(8); PG8_BAR; PG8_WAIT_L(0); PG8_MMA(0, 0, At, B0); PG8_BAR; PG8_SCHED;
            PG8_LDB(B1, 1, 1); PG8_STAGE(PG8_SB(1, 0), b3, voffB);
            PG8_BAR; PG8_WAIT_L(0); PG8_MMA(0, 1, At, B1); PG8_BAR;
            PG8_LDA(At, 1, 1); PG8_STAGE(PG8_SA(1, 0), a3, voffA);
            PG8_BAR; PG8_WAIT_L(0); PG8_MMA(1, 0, At, B0); PG8_BAR; PG8_SCHED;
            PG8_STAGE(PG8_SB(1, 1), b3 + hstepB, voffB);
            PG8_WAIT_V(6); PG8_BAR; PG8_MMA(1, 1, At, B1); PG8_BAR;
            }
        }
        if constexpr (ALIGN_EPI) { if (wr == 0) PG8_BAR; }
        if constexpr (!Epi::AFTER_DRAIN) { E(acc, cur, wr, wc, fr, fq); }
        if (!has_next) break;
#pragma unroll
        for (int a = 0; a < 2; ++a)
#pragma unroll
            for (int b = 0; b < 2; ++b)
#pragma unroll
                for (int m = 0; m < 4; ++m)
#pragma unroll
                    for (int n = 0; n < 2; ++n) acc[a][b][m][n] = (f32x4){0.f, 0.f, 0.f, 0.f};
        cur = nxt; cA = nA; cB = nB; ++ui;
        if constexpr (ALIGN_EPI) { if (wr == 1) PG8_BAR; }
    }
    PG8_WAIT_V(0);
    if constexpr (!ALIGN_EPI) { if (wr == 0) PG8_BAR; }
    PG8_BAR;
    if constexpr (Epi::AFTER_DRAIN) { E.fused(acc, cur, wr, wc, fr, fq, lds, wid, lane); }
#undef PG8_SA
#undef PG8_SB
#undef PG8_STAGE
#undef PG8_LDA
#undef PG8_LDB
#undef PG8_MMA
#undef PG8_WAIT_V
#undef PG8_WAIT_L
#undef PG8_BAR
#undef PG8_SCHED
}
}
#define LAS __attribute__((address_space(3)))
typedef unsigned short bf16;
typedef short bf16x8 __attribute__((ext_vector_type(8)));
typedef short s16x4 __attribute__((ext_vector_type(4)));
typedef float f32x4 __attribute__((ext_vector_type(4)));
typedef unsigned u32x4 __attribute__((ext_vector_type(4)));
typedef unsigned u32x2 __attribute__((ext_vector_type(2)));
typedef LAS unsigned char* ldsp;
constexpr float LOG2E = 1.4426950408889634f;

__device__ __forceinline__ float bf_lo(unsigned w) { return __uint_as_float(w << 16); }
__device__ __forceinline__ float bf_hi(unsigned w) { return __uint_as_float(w & 0xffff0000u); }
__device__ __forceinline__ unsigned pk2(float lo, float hi) { return pg8::cvt_pk_bf16(lo, hi); }
__device__ __forceinline__ s16x4 vtr(ldsp p) { typedef short v4i16_t __attribute__((ext_vector_type(4))); return __builtin_bit_cast(s16x4, __builtin_amdgcn_ds_read_tr16_b64_v4i16((LAS v4i16_t*)p)); }
__device__ __forceinline__ bf16x8 cat8(s16x4 lo, s16x4 hi) { return (bf16x8){lo[0], lo[1], lo[2], lo[3], hi[0], hi[1], hi[2], hi[3]}; }
__device__ __forceinline__ f32x4 mfma16(bf16x8 a, bf16x8 b, f32x4 c) { return __builtin_amdgcn_mfma_f32_16x16x32_bf16(a, b, c, 0, 0, 0); }
__device__ __forceinline__ float ex2(float x) { return __builtin_amdgcn_exp2f(x); }

namespace att {
constexpr int SEQ = 16384, LDQ = 2304, LDO = 1024;
constexpr int KPB = 160;
constexpr int COL_QA = 0, COL_KA = 512, COL_VA = 640, COL_QB = 768, COL_KB = 1280, COL_VB = 1792;

template <int NP>
__device__ __forceinline__ void load_rows(u32x4 (&v)[NP], const bf16* src, int tok0, int nvalid, int tid) {
    const int sub = tid & 7;
#pragma unroll
    for (int p = 0; p < NP; ++p) { const int r = (tid >> 3) + 64 * p, tok = tok0 + r; const bool ok = (tok >= 0) && (tok < SEQ) && (r < nvalid);
        v[p] = (u32x4){0u, 0u, 0u, 0u};
        if (ok) v[p] = *(const u32x4*)(src + (size_t)tok * LDQ + sub * 8); }
}
template <int NP, bool NORM>
__device__ __forceinline__ void store_rows(ldsp dst, const u32x4 (&v)[NP], int nrows, const float* gain, int tid) {
    const int sub = tid & 7;
    float gn[8];
    if (NORM) {
#pragma unroll
        for (int j = 0; j < 8; ++j) gn[j] = gain[sub * 8 + j];
    }
#pragma unroll
    for (int p = 0; p < NP; ++p) { const int r = (tid >> 3) + 64 * p;
        if (r < nrows) {
            u32x4 w = v[p];
            if (NORM) {
                float f[8]; f[0] = bf_lo(w.x); f[1] = bf_hi(w.x); f[2] = bf_lo(w.y); f[3] = bf_hi(w.y); f[4] = bf_lo(w.z); f[5] = bf_hi(w.z); f[6] = bf_lo(w.w); f[7] = bf_hi(w.w);
                float ss = 0.f;
#pragma unroll
                for (int j = 0; j < 8; ++j) ss += f[j] * f[j];
                ss += __shfl_xor(ss, 1); ss += __shfl_xor(ss, 2); ss += __shfl_xor(ss, 4);
                const float rs = rsqrtf(ss * (1.0f / 64.0f) + 1e-6f);
#pragma unroll
                for (int j = 0; j < 8; ++j) f[j] = f[j] * rs * gn[j];
                w.x = pk2(f[0], f[1]); w.y = pk2(f[2], f[3]); w.z = pk2(f[4], f[5]); w.w = pk2(f[6], f[7]);
            }
            *(LAS u32x4*)(dst + r * KPB + sub * 16) = w;
        } }
}

__device__ __forceinline__ void load_q(bf16x8 (&qf)[2], const bf16* qrow  , const float* gain, int g) {
    float f[2][8]; float ss = 0.f;
#pragma unroll
    for (int s = 0; s < 2; ++s) { const u32x4 v = *(const u32x4*)(qrow + 32 * s + 8 * g);
        f[s][0] = bf_lo(v.x); f[s][1] = bf_hi(v.x); f[s][2] = bf_lo(v.y); f[s][3] = bf_hi(v.y); f[s][4] = bf_lo(v.z); f[s][5] = bf_hi(v.z); f[s][6] = bf_lo(v.w); f[s][7] = bf_hi(v.w);
#pragma unroll
        for (int j = 0; j < 8; ++j) ss += f[s][j] * f[s][j]; }
    ss += __shfl_xor(ss, 16); ss += __shfl_xor(ss, 32);
    const float rs = rsqrtf(ss * (1.0f / 64.0f) + 1e-6f) * (0.125f * LOG2E);
#pragma unroll
    for (int s = 0; s < 2; ++s) { float o[8];
#pragma unroll
        for (int j = 0; j < 8; ++j) o[j] = f[s][j] * rs * gain[32 * s + 8 * g + j];
        u32x4 w; w.x = pk2(o[0], o[1]); w.y = pk2(o[2], o[3]); w.z = pk2(o[4], o[5]); w.w = pk2(o[6], o[7]);
        qf[s] = __builtin_bit_cast(bf16x8, w); }
}

template <int NT, class RB>
__device__ __forceinline__ void scores(f32x4 (&sc)[NT], ldsp Kb, const bf16x8 (&qf)[2], const RB& rb, int lane) {
    const int fr = lane & 15, g = lane >> 4;
#pragma unroll
    for (int t = 0; t < NT; ++t) { ldsp kp = Kb + (rb(t) + fr) * KPB + g * 16; f32x4 a = (f32x4){0.f, 0.f, 0.f, 0.f};
#pragma unroll
        for (int s = 0; s < 2; ++s) { const bf16x8 kf = *(const LAS bf16x8*)(kp + s * 64); a = mfma16(kf, qf[s], a); }
        sc[t] = a; if ((t & 3) == 3) __builtin_amdgcn_sched_barrier(0); }
}
template <int NT>
__device__ __forceinline__ float softmax_pack(f32x4 (&sc)[NT], bf16x8 (&pf)[NT / 2], float sink2, bool has_sink) {
    float m = -INFINITY;
#pragma unroll
    for (int t = 0; t < NT; ++t)
#pragma unroll
        for (int r = 0; r < 4; ++r) m = fmaxf(m, sc[t][r]);
    m = fmaxf(m, __shfl_xor(m, 16)); m = fmaxf(m, __shfl_xor(m, 32));
    if (has_sink) m = fmaxf(m, sink2);
    float sum = 0.f;
#pragma unroll
    for (int t = 0; t < NT; ++t)
#pragma unroll
        for (int r = 0; r < 4; ++r) { const float p = ex2(sc[t][r] - m); sc[t][r] = p; sum += p; }
    sum += __shfl_xor(sum, 16); sum += __shfl_xor(sum, 32);
    if (has_sink) sum += ex2(sink2 - m);
#pragma unroll
    for (int k = 0; k < NT / 2; ++k) { u32x4 w; w.x = pk2(sc[2 * k][0], sc[2 * k][1]); w.y = pk2(sc[2 * k][2], sc[2 * k][3]); w.z = pk2(sc[2 * k + 1][0], sc[2 * k + 1][1]); w.w = pk2(sc[2 * k + 1][2], sc[2 * k + 1][3]);
        pf[k] = __builtin_bit_cast(bf16x8, w); }
    return sum;
}
template <int NT, class RB>
__device__ __forceinline__ void pv_store(ldsp Vb, const bf16x8 (&pf)[NT / 2], const RB& rb, float sum, bf16* orow  , int lane) {
    const int g = lane >> 4, q4 = (lane & 15) >> 2, p4 = lane & 3;
    f32x4 o[4];
#pragma unroll
    for (int dt = 0; dt < 4; ++dt) o[dt] = (f32x4){0.f, 0.f, 0.f, 0.f};
#pragma unroll
    for (int k = 0; k < NT / 2; ++k) { ldsp v0 = Vb + (rb(2 * k) + 4 * g + q4) * KPB + p4 * 8; ldsp v1 = Vb + (rb(2 * k + 1) + 4 * g + q4) * KPB + p4 * 8;
#pragma unroll
        for (int dt = 0; dt < 4; ++dt) { const bf16x8 vf = cat8(vtr(v0 + dt * 32), vtr(v1 + dt * 32)); o[dt] = mfma16(vf, pf[k], o[dt]); } }
    const float inv = 1.0f / sum;
#pragma unroll
    for (int dt = 0; dt < 4; ++dt) { u32x2 w; w.x = pk2(o[dt][0] * inv, o[dt][1] * inv); w.y = pk2(o[dt][2] * inv, o[dt][3] * inv); *(u32x2*)(orow + dt * 16 + 4 * g) = w; }
}

struct RbWin { int mt; __device__ __forceinline__ int operator()(int t) const { return 16 * (mt + t); } };
struct RbNa { int off, ctb; __device__ __forceinline__ int operator()(int t) const { return (off + t / 3) * 64 + (ctb + t % 3) * 16; } };

struct AttnArgs { const bf16* qkv; bf16* o; const float* qn_a; const float* kn_a; const float* sink_a; const float* qn_b; const float* kn_b; const float* rpb; };

__device__ __forceinline__ void window_compute(ldsp lds, const AttnArgs& A, int unit, int tid) {
    const int n = unit >> 1, kvh = unit & 1, lane = tid & 63, wid = __builtin_amdgcn_readfirstlane(tid >> 6);
    ldsp Kb = lds, Vb = lds + 400 * KPB;
    const int tok0 = (n - 1) * 128;
    const int fr = lane & 15, g = lane >> 4;
    for (int it = 0; it < 4; ++it) {
        const int idx = wid * 4 + it, g4 = idx >> 3, mt = idx & 7, hq = kvh * 4 + g4;
        const int qtok = n * 128 + mt * 16 + fr;
        bf16x8 qf[2]; load_q(qf, A.qkv + (size_t)qtok * LDQ + COL_QA + hq * 64, A.qn_a, g);
        RbWin rb{mt};
        f32x4 sc[18]; scores<18>(sc, Kb, qf, rb, lane);
        const float slope2 = exp2f(-(float)(hq + 1)) * LOG2E;
        const int il = mt * 16 + fr;
#pragma unroll
        for (int t = 0; t < 18; ++t)
#pragma unroll
            for (int r = 0; r < 4; ++r) { const int j = 16 * (mt + t) + 4 * g + r; const int rel = j - 128 - il; const int arel = rel < 0 ? -rel : rel; const int kpos = tok0 + j;
                const bool ok = (arel <= 128) && (kpos >= 0) && (kpos < SEQ);
                sc[t][r] = ok ? sc[t][r] - slope2 * (float)arel : -INFINITY; }
        bf16x8 pf[9]; const float sum = softmax_pack<18>(sc, pf, A.sink_a[hq] * LOG2E, true);
        pv_store<18>(Vb, pf, rb, sum, A.o + (size_t)qtok * LDO + hq * 64, lane);
    }
}

constexpr int NA_RPB_OFF = 576 * KPB;

__device__ __forceinline__ void na_unit(ldsp lds, const AttnArgs& A, int unit, int next_unit, u32x4 (&kreg)[9], int tid) {
    const int rp = unit >> 3, h = unit & 7, lane = tid & 63, wid = __builtin_amdgcn_readfirstlane(tid >> 6);
    const int r0 = 2 * rp; const int base = min(max(r0 - 4, 0), 248);
    const int qsel = wid >> 2, mt = wid & 3; const int rq = r0 + qsel; const int rstart = min(max(rq - 4, 0), 248);
    const int fr = lane & 15, g = lane >> 4;
    store_rows<9, true>(lds, kreg, 576, A.kn_b, tid);
    __syncthreads();
    const int qc = mt * 16 + fr; const int qtok = rq * 64 + qc;
    bf16x8 qf[2]; load_q(qf, A.qkv + (size_t)qtok * LDQ + COL_QB + h * 64, A.qn_b, g);
    RbNa rb{rstart - base, mt <= 1 ? 0 : 1};
    f32x4 sc[24]; scores<24>(sc, lds, qf, rb, lane);
    const int cstart = min(max(qc - 8, 0), 48);
    const LAS float* rpl = (const LAS float*)(lds + NA_RPB_OFF);
#pragma unroll
    for (int t = 0; t < 24; ++t)
#pragma unroll
        for (int r = 0; r < 4; ++r) { const int kr = t / 3; const int kc = (rb.ctb + t % 3) * 16 + 4 * g + r; const bool ok = (kc >= cstart) && (kc < cstart + 16);
            const int ri = rstart + kr - rq + 7; int ci = kc - qc + 15; ci = min(max(ci, 0), 30);
            sc[t][r] = ok ? sc[t][r] + rpl[ri * 31 + ci] : -INFINITY; if (r == 3 && (t % 6) == 5) __builtin_amdgcn_sched_barrier(0); }
    bf16x8 pf[12]; const float sum = softmax_pack<24>(sc, pf, 0.f, false);
    u32x4 vreg[9]; load_rows<9>(vreg, A.qkv + COL_VB + h * 64, base * 64, 576, tid);
    __syncthreads();
    store_rows<9, false>(lds, vreg, 576, nullptr, tid);
    if (next_unit >= 0) { const int nrp = next_unit >> 3; const int nbase = min(max(2 * nrp - 4, 0), 248); load_rows<9>(kreg, A.qkv + COL_KB + h * 64, nbase * 64, 576, tid); }
    __syncthreads();
    pv_store<24>(lds, pf, rb, sum, A.o + (size_t)qtok * LDO + 512 + h * 64, lane);
    __syncthreads();
}

__device__ __forceinline__ void attn_phase(ldsp lds, const AttnArgs& A, int vcu, int G, int tid) {
    const int h = vcu & 7;
    u32x4 kreg[9];
    {
        const int n = vcu >> 1, kvh = vcu & 1, tok0 = (n - 1) * 128;
        u32x4 kw[7], vw[7];
        load_rows<7>(kw, A.qkv + COL_KA + kvh * 64, tok0, 384, tid);
        load_rows<7>(vw, A.qkv + COL_VA + kvh * 64, tok0, 384, tid);
        store_rows<7, true>(lds, kw, 400, A.kn_a, tid);
        store_rows<7, false>(lds + 400 * KPB, vw, 400, nullptr, tid);
        __syncthreads();
        window_compute(lds, A, vcu, tid);
        __syncthreads();
    }
    { const int rp0 = vcu >> 3; const int b0 = min(max(2 * rp0 - 4, 0), 248); load_rows<9>(kreg, A.qkv + COL_KB + h * 64, b0 * 64, 576, tid); }
    if (tid < 465) ((LAS float*)(lds + NA_RPB_OFF))[tid] = A.rpb[h * 465 + tid] * LOG2E;
    for (int k = 0; k < 4; ++k) { int t2 = tid; asm volatile("" : "+v"(t2));
        na_unit(lds, A, vcu + 256 * k, (k < 3) ? vcu + 256 * (k + 1) : -1, kreg, t2); }
}
}
namespace ret {
constexpr int SEQ = 16384, LDG = 3072, NCH = 128;
constexpr int COL_Q = 0, COL_K = 512, COL_V = 1024, COL_G = 2048;
constexpr int KPB = 288;
constexpr int VPB = 544;
constexpr int R0 = 0, R1 = 128 * KPB, R2 = 2 * 128 * KPB, RSTAT = R2 + 128 * VPB;
constexpr size_t ST_CHUNK = 128 * 256;

__device__ __forceinline__ unsigned pk2a(float lo, float hi) { unsigned r; asm volatile("v_cvt_pk_bf16_f32 %0, %1, %2" : "=v"(r) : "v"(lo), "v"(hi)); return r; }
struct RetArgs { bf16* G; bf16* ST; const float* l2;   const float* gn; int grp; int dry; bf16* dryY; };

template <bool SCALE>
__device__ __forceinline__ void stage128(ldsp dst, const bf16* src, int ld, float a, float b, int tid) {
#pragma unroll
    for (int i = 0; i < 4; ++i) { const int idx = tid + i * 512, row = idx >> 4, ch = idx & 15;
        u32x4 v = *(const u32x4*)(src + (size_t)row * ld + ch * 8);
        if (SCALE) { const float s = ex2(a * (float)row + b);
            v.x = pk2a(bf_lo(v.x) * s, bf_hi(v.x) * s); v.y = pk2a(bf_lo(v.y) * s, bf_hi(v.y) * s); v.z = pk2a(bf_lo(v.z) * s, bf_hi(v.z) * s); v.w = pk2a(bf_lo(v.w) * s, bf_hi(v.w) * s); }
        *(LAS u32x4*)(dst + row * KPB + ch * 16) = v; }
}
__device__ __forceinline__ void stage256(ldsp dst, const bf16* src, int ld, int tid) {
#pragma unroll
    for (int i = 0; i < 8; ++i) { const int idx = tid + i * 512, row = idx >> 5, ch = idx & 31;
        const u32x4 v = *(const u32x4*)(src + (size_t)row * ld + ch * 8);
        *(LAS u32x4*)(dst + row * VPB + ch * 16) = v; }
}
__device__ __forceinline__ bf16x8 trfrag(ldsp X, int pitch, int k0, int n0, int lane) {
    const int g = lane >> 4, q4 = (lane & 15) >> 2, p4 = lane & 3;
    ldsp p = X + (k0 + 8 * g + q4) * pitch + (n0 + 4 * p4) * 2;
    return cat8(vtr(p), vtr(p + 4 * pitch));
}

__device__ __forceinline__ void ld128(u32x4 (&r)[4], const bf16* src, int ld, int tid) {
    const unsigned off0 = (unsigned)(((tid >> 4) * ld + (tid & 15) * 8) * 2);
#pragma unroll
    for (int i = 0; i < 4; ++i) r[i] = *(const u32x4*)((const char*)src + (size_t)i * 32 * ld * 2 + off0);
}
__device__ __forceinline__ void st128(ldsp dst, const u32x4 (&r)[4], int tid) {
    ldsp d0 = dst + (tid >> 4) * KPB + (tid & 15) * 16;
#pragma unroll
    for (int i = 0; i < 4; ++i) *(LAS u32x4*)(d0 + i * 32 * KPB) = r[i];
}
__device__ __forceinline__ void st128s(ldsp dst, const u32x4 (&r)[4], float a, float b, int tid) {
    ldsp d0 = dst + (tid >> 4) * KPB + (tid & 15) * 16;
#pragma unroll
    for (int i = 0; i < 4; ++i) { const int row = (tid >> 4) + 32 * i; const float s = ex2(a * (float)row + b); u32x4 v = r[i];
        v.x = pk2(bf_lo(v.x) * s, bf_hi(v.x) * s); v.y = pk2(bf_lo(v.y) * s, bf_hi(v.y) * s); v.z = pk2(bf_lo(v.z) * s, bf_hi(v.z) * s); v.w = pk2(bf_lo(v.w) * s, bf_hi(v.w) * s);
        *(LAS u32x4*)(d0 + i * 32 * KPB) = v; }
}
__device__ __forceinline__ void ld64(u32x4 (&r)[4], const bf16* src, int ld, int tid) {
    const unsigned off0 = (unsigned)(((tid >> 5) * ld + (tid & 31) * 8) * 2);
#pragma unroll
    for (int i = 0; i < 4; ++i) r[i] = *(const u32x4*)((const char*)src + (size_t)i * 16 * ld * 2 + off0);
}
__device__ __forceinline__ void st64(ldsp dst, const u32x4 (&r)[4], int tid) {
    ldsp d0 = dst + (tid >> 5) * VPB + (tid & 31) * 16;
#pragma unroll
    for (int i = 0; i < 4; ++i) *(LAS u32x4*)(d0 + i * 16 * VPB) = r[i];
}

__device__ __forceinline__ void ret_a_phase(ldsp lds, const RetArgs& A, int vcu, int G, int tid_in) {
    int tid = tid_in;
    const int wid = __builtin_amdgcn_readfirstlane(tid >> 6);
    int u = vcu; if (u >= 512) return;
    u32x4 rk[4], rv0[4], rv1[4];
    { const bf16* rows = A.G + (size_t)(u >> 2) * 128 * LDG; const int hl = u & 3;
      ld128(rk, rows + COL_K + hl * 128, LDG, tid); ld64(rv0, rows + COL_V + hl * 256, LDG, tid); ld64(rv1, rows + (size_t)64 * LDG + COL_V + hl * 256, LDG, tid); }
    for (;;) {
        asm volatile("" : "+v"(tid));
        const int lane = tid & 63, fr = lane & 15, g = lane >> 4;
        const int hl = u & 3, c = u >> 2, h = A.grp * 4 + hl;
        const float l2f = A.l2[h], l2b = A.l2[8 + h];
        st128s(lds + R0, rk, -l2f, 127.0f * l2f, tid);
        st128s(lds + R1, rk, l2b, 0.f, tid);
        st64(lds + R2, rv0, tid); st64(lds + R2 + 64 * VPB, rv1, tid);
        const int un = u + G; const bool has_next = un < 512;
        if (has_next) { const bf16* rows = A.G + (size_t)(un >> 2) * 128 * LDG; const int nhl = un & 3;
            ld128(rk, rows + COL_K + nhl * 128, LDG, tid); ld64(rv0, rows + COL_V + nhl * 256, LDG, tid); ld64(rv1, rows + (size_t)64 * LDG + COL_V + nhl * 256, LDG, tid); }
        __syncthreads();
        for (int dir = 0; dir < 2; ++dir) {
            ldsp Kx = lds + (dir ? R1 : R0);
            f32x4 acc[2][8];
#pragma unroll
            for (int et = 0; et < 2; ++et)
#pragma unroll
                for (int dt = 0; dt < 8; ++dt) acc[et][dt] = (f32x4){0.f, 0.f, 0.f, 0.f};
#pragma unroll
            for (int ks = 0; ks < 4; ++ks) {
                bf16x8 vf[2];
#pragma unroll
                for (int et = 0; et < 2; ++et) vf[et] = trfrag(lds + R2, VPB, 32 * ks, 32 * wid + 16 * et, lane);
#pragma unroll
                for (int dt = 0; dt < 8; ++dt) { const bf16x8 kf = trfrag(Kx, KPB, 32 * ks, 16 * dt, lane);
#pragma unroll
                    for (int et = 0; et < 2; ++et) acc[et][dt] = mfma16(vf[et], kf, acc[et][dt]);
                    if ((dt & 3) == 3) __builtin_amdgcn_sched_barrier(0); }
            }
            bf16* st = A.ST + ((size_t)((dir * 4 + hl) * NCH + c)) * ST_CHUNK; const unsigned soff = (unsigned)((fr * 256 + 32 * wid + 4 * g) * 2);
#pragma unroll
            for (int et = 0; et < 2; ++et)
#pragma unroll
                for (int dt = 0; dt < 8; ++dt) { u32x2 w; w.x = pk2(acc[et][dt][0], acc[et][dt][1]); w.y = pk2(acc[et][dt][2], acc[et][dt][3]);
                    *(u32x2*)((char*)st + (size_t)(16 * dt * 256 + 16 * et) * 2 + soff) = w; }
        }
        __syncthreads();
        if (!has_next) break;
        u = un;
    }
}

__device__ __forceinline__ void ret_b(const RetArgs& A, int vcu, int G, int tid) {
    const int NT = 8 * 16384;
    for (int T = vcu * 512 + tid; T < NT; T += G * 512) {
        const int dh = T >> 14, w = T & 16383, dir = dh >> 2, hl = dh & 3, h = A.grp * 4 + hl;
        const float dec = ex2(128.0f * A.l2[dir * 8 + h]);
        unsigned* p = (unsigned*)(A.ST + (size_t)dh * NCH * ST_CHUNK) + w;
        const ptrdiff_t cs = dir ? -(ptrdiff_t)(ST_CHUNK / 2) : (ptrdiff_t)(ST_CHUNK / 2);
        if (dir) p += (size_t)(NCH - 1) * (ST_CHUNK / 2);
        float s0 = 0.f, s1 = 0.f;
        for (int c = 0; c < NCH; c += 32) {
            unsigned u[32];
#pragma unroll
            for (int k = 0; k < 32; ++k) u[k] = p[(ptrdiff_t)k * cs];
#pragma unroll
            for (int k = 0; k < 32; ++k) { p[(ptrdiff_t)k * cs] = A.dry ? u[k] : pk2(s0, s1); s0 = dec * s0 + bf_lo(u[k]); s1 = dec * s1 + bf_hi(u[k]); }
            p += 32 * cs;
        }
    }
}

constexpr int C_Q = 0, C_KA = 128 * KPB, C_B0 = 2 * 128 * KPB, C_B1 = C_B0 + 64 * VPB, C_STAT = C_B1 + 64 * VPB;
struct CPtrs { const bf16 *q, *k, *v, *sf, *sb; bf16* g; };
__device__ __forceinline__ CPtrs cptrs(const RetArgs& A, int unit) {
    const int hl = unit & 3, c = unit >> 2; bf16* rows = A.G + (size_t)c * 128 * LDG; CPtrs P;
    P.q = rows + COL_Q + hl * 128; P.k = rows + COL_K + hl * 128; P.v = rows + COL_V + hl * 256; P.g = rows + COL_G + hl * 256;
    P.sf = A.ST + ((size_t)((0 * 4 + hl) * NCH + c)) * ST_CHUNK; P.sb = A.ST + ((size_t)((1 * 4 + hl) * NCH + c)) * ST_CHUNK; return P;
}
__device__ __forceinline__ void half_mma(f32x4 (&acc)[2][8], ldsp buf, ldsp Bop, int kofs, int wid, int lane) {
    const int fr = lane & 15, g = lane >> 4;
#pragma unroll
    for (int ks = 0; ks < 2; ++ks) {
        bf16x8 xf[2];
#pragma unroll
        for (int et = 0; et < 2; ++et) xf[et] = trfrag(buf, VPB, 32 * ks, 32 * wid + 16 * et, lane);
#pragma unroll
        for (int it = 0; it < 8; ++it) { const bf16x8 bfrag = *(const LAS bf16x8*)(Bop + (16 * it + fr) * KPB + (kofs + 32 * ks + 8 * g) * 2);
#pragma unroll
            for (int et = 0; et < 2; ++et) acc[et][it] = mfma16(xf[et], bfrag, acc[et][it]);
            if ((it & 3) == 3) __builtin_amdgcn_sched_barrier(0); }
    }
}
__device__ __forceinline__ void ret_c_phase(ldsp lds, const RetArgs& A, int vcu, int G, int tid_in) {
    int tid = tid_in;
    const int wid = __builtin_amdgcn_readfirstlane(tid >> 6);
    int u = vcu; if (u >= 512) return;
    CPtrs P = cptrs(A, u);
    u32x4 r0[4], r1[4], r2[4], r3[4];
    ld128(r0, P.q, LDG, tid); ld128(r1, P.k, LDG, tid); ld64(r2, P.sf, 256, tid); ld64(r3, P.sf + 64 * 256, 256, tid);
    LAS float* stat = (LAS float*)(lds + C_STAT);
    for (;;) {
        asm volatile("" : "+v"(tid));
        const int lane = tid & 63, fr = lane & 15, g = lane >> 4;
        const int un = u + G; const bool has_next = un < 512;
        CPtrs N = P; if (has_next) N = cptrs(A, un);
        const int hl = u & 3, c = u >> 2, h = A.grp * 4 + hl;
        const float l2f = A.l2[h], l2b = A.l2[8 + h];
        st128(lds + C_Q, r0, tid); st128(lds + C_KA, r1, tid);
        ld64(r0, P.sb, 256, tid); ld64(r1, P.sb + 64 * 256, 256, tid);
        __syncthreads();
        f32x4 sa[8];
#pragma unroll
        for (int it = 0; it < 8; ++it) sa[it] = (f32x4){0.f, 0.f, 0.f, 0.f};
#pragma unroll
        for (int ks = 0; ks < 4; ++ks) { const bf16x8 kf = *(const LAS bf16x8*)(lds + C_KA + (16 * wid + fr) * KPB + (32 * ks + 8 * g) * 2);
#pragma unroll
            for (int it = 0; it < 8; ++it) { const bf16x8 qf = *(const LAS bf16x8*)(lds + C_Q + (16 * it + fr) * KPB + (32 * ks + 8 * g) * 2); sa[it] = mfma16(kf, qf, sa[it]); if ((it & 3) == 3) __builtin_amdgcn_sched_barrier(0); } }
        st64(lds + C_B0, r2, tid); ld64(r2, P.v, LDG, tid);
        __syncthreads();
#pragma unroll
        for (int it = 0; it < 8; ++it) { const int i = 16 * it + fr; float v[4];
#pragma unroll
            for (int r = 0; r < 4; ++r) { const int j = 16 * wid + 4 * g + r; const int dl = i - j; const float dm = dl >= 0 ? ex2((float)dl * l2f) : ex2((float)(-dl) * l2b); v[r] = sa[it][r] * dm; }
            u32x2 w; w.x = pk2(v[0], v[1]); w.y = pk2(v[2], v[3]);
            *(LAS u32x2*)(lds + C_KA + i * KPB + (16 * wid + 4 * g) * 2) = w; if (it & 1) __builtin_amdgcn_sched_barrier(0); }
        st64(lds + C_B1, r3, tid); ld64(r3, P.v + (size_t)64 * LDG, LDG, tid);
        f32x4 acc[2][8];
#pragma unroll
        for (int et = 0; et < 2; ++et)
#pragma unroll
            for (int it = 0; it < 8; ++it) acc[et][it] = (f32x4){0.f, 0.f, 0.f, 0.f};
        half_mma(acc, lds + C_B0, lds + C_Q, 0, wid, lane);
        __syncthreads();
        st64(lds + C_B0, r0, tid); if (has_next) ld128(r0, N.q, LDG, tid);
        half_mma(acc, lds + C_B1, lds + C_Q, 64, wid, lane);
        __syncthreads();
#pragma unroll
        for (int it = 0; it < 8; ++it) { const float fi = (float)(16 * it + fr); const float rt = ex2((fi + 1.0f) * l2f - (128.0f - fi) * l2b); acc[0][it] *= rt; acc[1][it] *= rt; }
        st64(lds + C_B1, r1, tid); if (has_next) ld128(r1, N.k, LDG, tid);
        half_mma(acc, lds + C_B0, lds + C_Q, 0, wid, lane);
        __syncthreads();
        st64(lds + C_B0, r2, tid); if (has_next) ld64(r2, N.sf, 256, tid);
        half_mma(acc, lds + C_B1, lds + C_Q, 64, wid, lane);
        __syncthreads();
#pragma unroll
        for (int it = 0; it < 8; ++it) { const float fi = (float)(16 * it + fr); const float sb = ex2((128.0f - fi) * l2b); acc[0][it] *= sb; acc[1][it] *= sb; }
        st64(lds + C_B1, r3, tid); if (has_next) ld64(r3, N.sf + 64 * 256, 256, tid);
        u32x2 gv[8][2]; f32x4 gw[2]; const unsigned goff = (unsigned)((fr * LDG + 32 * wid + 4 * g) * 2);
#pragma unroll
        for (int et = 0; et < 2; ++et) { const int e = 32 * wid + 16 * et + 4 * g; gw[et] = *(const f32x4*)(A.gn + h * 256 + e);
#pragma unroll
            for (int it = 0; it < 8; ++it) gv[it][et] = *(const u32x2*)((const char*)P.g + (size_t)(16 * it * LDG + 16 * et) * 2 + goff); }
        half_mma(acc, lds + C_B0, lds + C_KA, 0, wid, lane);
        __syncthreads();
        half_mma(acc, lds + C_B1, lds + C_KA, 64, wid, lane);
#pragma unroll
        for (int it = 0; it < 8; ++it) { float s1 = 0.f, s2 = 0.f;
#pragma unroll
            for (int et = 0; et < 2; ++et)
#pragma unroll
                for (int r = 0; r < 4; ++r) { const float y = acc[et][it][r]; s1 += y; s2 += y * y; }
            s1 += __shfl_xor(s1, 16); s1 += __shfl_xor(s1, 32); s2 += __shfl_xor(s2, 16); s2 += __shfl_xor(s2, 32);
            if (g == 0) { stat[((16 * it + fr) * 8 + wid) * 2] = s1; stat[((16 * it + fr) * 8 + wid) * 2 + 1] = s2; }
            if (it & 1) __builtin_amdgcn_sched_barrier(0); }
        __syncthreads();
#pragma unroll
        for (int it = 0; it < 8; ++it) { float s1 = 0.f, s2 = 0.f;
#pragma unroll
            for (int w = 0; w < 8; ++w) { s1 += stat[((16 * it + fr) * 8 + w) * 2]; s2 += stat[((16 * it + fr) * 8 + w) * 2 + 1]; }
            const float mu = s1 * (1.0f / 256.0f); const float var = fmaxf(s2 * (1.0f / 256.0f) - mu * mu, 0.f); const float rs = rsqrtf(var + 1e-5f);
#pragma unroll
            for (int et = 0; et < 2; ++et) { const int e = 32 * wid + 16 * et + 4 * g; const f32x4 y = acc[et][it]; const u32x2 gg = gv[it][et];
                u32x2 w; w.x = pk2(bf_lo(gg.x) * ((y[0] - mu) * rs * gw[et][0]), bf_hi(gg.x) * ((y[1] - mu) * rs * gw[et][1]));
                w.y = pk2(bf_lo(gg.y) * ((y[2] - mu) * rs * gw[et][2]), bf_hi(gg.y) * ((y[3] - mu) * rs * gw[et][3]));
                if (A.dry) *(u32x2*)(A.dryY + (size_t)(c * 128 + 16 * it + fr) * 1024 + hl * 256 + e) = w; else *(u32x2*)((char*)P.g + (size_t)(16 * it * LDG + 16 * et) * 2 + goff) = w; }
            __builtin_amdgcn_sched_barrier(0); }
        if (!has_next) break;
        u = un; P = N;
    }
    __syncthreads();
}
}
#define XB_TMO      128
#define XB_XCNT(j)  (256  + 64 * (j))
#define XB_XSUB(j)  (1280 + 64 * (j))
#define XB_XGEN(j)  (2304 + 64 * (j))
#define XB_TOP      3328
#define XB_TOPGEN   3392
#define XCD_BAR_WORDS 3456
#define XB_SPIN_CAP (1u << 18)

__device__ __forceinline__ unsigned xb_ld(unsigned* p)              { return __hip_atomic_load(p, __ATOMIC_RELAXED, __HIP_MEMORY_SCOPE_AGENT); }
__device__ __forceinline__ unsigned xb_add(unsigned* p, unsigned v) { return __hip_atomic_fetch_add(p, v, __ATOMIC_RELAXED, __HIP_MEMORY_SCOPE_AGENT); }
__device__ __forceinline__ unsigned xb_xcc_id() { return (unsigned)__builtin_amdgcn_s_getreg((3 << 11) | 20) & 0xFu; }
#define XB_SPIN(cond, bar) do { unsigned _sp = 0; while (cond) { __builtin_amdgcn_s_sleep(1); \
    if ((++_sp & 255u) == 0u) { if (xb_ld(&(bar)[XB_TMO])) break; if (_sp > XB_SPIN_CAP) { atomicAdd(&(bar)[XB_TMO], 1u); break; } } } } while (0)

struct XcdBarrier {
    unsigned* bar; unsigned x;
    volatile LAS unsigned* st;
};

__device__ __forceinline__ XcdBarrier xcd_barrier_post(unsigned* bar, volatile LAS unsigned* st) {
    XcdBarrier b; b.bar = bar; b.x = xb_xcc_id(); b.st = st;
    if (threadIdx.x == 0) (void)xb_add(&bar[XB_XCNT(b.x)], 1u);
    return b;
}
__device__ __forceinline__ void xcd_barrier_complete(unsigned* bar, unsigned x, unsigned& nloc, unsigned& nx) {
    const unsigned G = gridDim.x * gridDim.y * gridDim.z;
    unsigned sum, cnt, mine, sp = 0u;
    for (;;) {
        sum = 0u; cnt = 0u; mine = 0u;
#pragma unroll
        for (unsigned j = 0; j < 16; ++j) { const unsigned c = xb_ld(&bar[XB_XCNT(j)]); sum += c; cnt += (c > 0u) ? 1u : 0u; mine = (j == x) ? c : mine; }
        if (sum == G) break;
        __builtin_amdgcn_s_sleep(1);
        if ((++sp & 255u) == 0u) { if (xb_ld(&bar[XB_TMO])) break; if (sp > XB_SPIN_CAP) { atomicAdd(&bar[XB_TMO], 1u); break; } }
    }
    nloc = mine > 0u ? mine : 1u; nx = cnt > 0u ? cnt : 1u;
}

__device__ __forceinline__ void xcd_barrier(const XcdBarrier& b) {
    asm volatile("s_waitcnt vmcnt(0)" ::: "memory");
    __syncthreads();
    if (threadIdx.x == 0) {
        unsigned* bar = b.bar;
        __builtin_amdgcn_s_waitcnt(0);
        unsigned nloc = b.st[0], nx = b.st[1];
        if (nloc == 0u) { xcd_barrier_complete(bar, b.x, nloc, nx); b.st[0] = nloc; b.st[1] = nx; }
        const unsigned old = xb_add(&bar[XB_XSUB(b.x)], 1u);
        const unsigned gen = old / nloc;
        if (old + 1u == (gen + 1u) * nloc) {
            __builtin_amdgcn_fence(__ATOMIC_RELEASE, "agent");
            asm volatile("s_waitcnt vmcnt(0)" ::: "memory");
            const unsigned og = xb_add(&bar[XB_TOP], 1u);
            const unsigned tg = og / nx;
            if (og + 1u == (tg + 1u) * nx) xb_add(&bar[XB_TOPGEN], 1u);
            else XB_SPIN(xb_ld(&bar[XB_TOPGEN]) == tg, bar);
            __builtin_amdgcn_fence(__ATOMIC_ACQUIRE, "agent");
            xb_add(&bar[XB_XGEN(b.x)], 1u);
            asm volatile("s_waitcnt vmcnt(0)" ::: "memory");
        } else {
            XB_SPIN(xb_ld(&bar[XB_XGEN(b.x)]) == gen, bar);
            __builtin_amdgcn_fence(__ATOMIC_ACQUIRE, "agent");
            asm volatile("s_waitcnt vmcnt(0)" ::: "memory");
        }
    }
    __syncthreads();
}
constexpr int M_TOK = 16384, DM = 1024, DFF = 4096, N_IN_E = 2304, N_IN_O = 6144;
constexpr size_t MiB = 1u << 20;
constexpr size_t WS_CTL = 0;
constexpr size_t WS_L2 = 4096, WS_SSQ = 512 * 1024;
constexpr int CW_BAR = 4096;
constexpr size_t WS_W_IN_E = 1 * MiB;
constexpr size_t WS_W_OUT_E = WS_W_IN_E + (size_t)N_IN_E * DM * 2;
constexpr size_t WS_W_MLP_IN = WS_W_OUT_E + (size_t)DM * DM * 2;
constexpr size_t WS_W_MLP_OUT = WS_W_MLP_IN + 2 * (size_t)DFF * DM * 2;
constexpr size_t WS_W_IN_O = WS_W_MLP_OUT + 2 * (size_t)DFF * DM * 2;
constexpr size_t WS_W_OUT_O = WS_W_IN_O + (size_t)N_IN_O * DM * 2;
constexpr size_t WS_XB = 56 * MiB;
constexpr size_t WS_BIG = 88 * MiB;
constexpr size_t WS_END = 256 * MiB;
static_assert(WS_W_OUT_O + (size_t)DM * 2048 * 2 <= WS_XB, "weights fit below XB");

constexpr int RING_BYTES = 155648;
constexpr int LDS_BYTES = 159744;

struct Args { const float* in[19]; float* out; unsigned char* ws; int ph_lo, ph_hi; };
typedef const __attribute__((address_space(4))) Args* KArgs;

__device__ __forceinline__ float wave_sum(float v) {
#pragma unroll
    for (int o = 1; o < 64; o <<= 1) v += __shfl_xor(v, o);
    return v;
}
struct WItem { const float* W; int N; bf16* WT; int ldo; int k0, n0, orow0; const float* gain; float nscale; };
constexpr int WI_C0 = 1152, WI_C1 = WI_C0 + 512, WI_C2 = WI_C1 + 2048, WI_C3 = WI_C2 + 2048, WI_C4 = WI_C3 + 2048, WI_C5 = WI_C4 + 2048, WI_C6 = WI_C5 + 3072, WI_C7 = WI_C6 + 1024;
__device__ __forceinline__ void witem_decode(KArgs a, unsigned char* ws, int gi, WItem& d) {
    int item, K, mode = 0; d.gain = nullptr; d.nscale = 1.0f;
    if (gi < WI_C0)      { item = gi;         d.W = a->in[2];  K = DM;  d.N = N_IN_E; d.WT = (bf16*)(ws + WS_W_IN_E); d.gain = a->in[1]; }
    else if (gi < WI_C1) { item = gi - WI_C0; d.W = a->in[9];  K = DM;  d.N = DM;     d.WT = (bf16*)(ws + WS_W_OUT_E); }
    else if (gi < WI_C2) { item = gi - WI_C1; d.W = a->in[17]; K = DM;  d.N = DFF;    d.WT = (bf16*)(ws + WS_W_MLP_IN); d.gain = a->in[16]; }
    else if (gi < WI_C3) { item = gi - WI_C2; d.W = a->in[17] + (size_t)DM * DFF; K = DM; d.N = DFF; d.WT = (bf16*)(ws + WS_W_MLP_IN) + (size_t)DFF * DM; d.gain = a->in[16] + DM; }
    else if (gi < WI_C4) { item = gi - WI_C3; d.W = a->in[18]; K = DFF; d.N = DM;     d.WT = (bf16*)(ws + WS_W_MLP_OUT); }
    else if (gi < WI_C5) { item = gi - WI_C4; d.W = a->in[18] + (size_t)DFF * DM; K = DFF; d.N = DM; d.WT = (bf16*)(ws + WS_W_MLP_OUT) + (size_t)DFF * DM; }
    else if (gi < WI_C6) { item = gi - WI_C5; d.W = a->in[11]; K = DM;  d.N = N_IN_O; d.WT = (bf16*)(ws + WS_W_IN_O); d.gain = a->in[10]; mode = 1; }
    else                 { item = gi - WI_C6; d.W = a->in[15]; K = 2048; d.N = DM;    d.WT = (bf16*)(ws + WS_W_OUT_O); }
    const int nblk = d.N / 32, kb = item / nblk, nb = item % nblk; d.k0 = 64 * kb; d.n0 = 32 * nb; d.orow0 = d.n0; d.ldo = K;
    if (mode == 1) {
        const int n0 = d.n0;
        if (n0 < 1024) { d.orow0 = (n0 >> 9) * 3072 + (n0 & 511); }
        else if (n0 < 2048) { const int nk = n0 - 1024; d.orow0 = (nk >> 9) * 3072 + 512 + (nk & 511); d.nscale = 0.08838834764831845f; }
        else if (n0 < 4096) { const int nv = n0 - 2048; d.orow0 = (nv >> 10) * 3072 + 1024 + (nv & 1023); }
        else { const int ng = n0 - 4096; d.orow0 = (ng >> 10) * 3072 + 2048 + (ng & 1023); }
    }
}
__device__ __forceinline__ void witem_load(const WItem& d, float (&v)[32], int lane) {
#pragma unroll
    for (int i = 0; i < 32; ++i) { const int kk = 2 * i + (lane >> 5); v[i] = d.W[(size_t)(d.k0 + kk) * d.N + d.n0 + (lane & 31)]; }
}
__device__ __forceinline__ void witem_finish(const WItem& d, const float (&v)[32], LAS float* scr, int lane) {
#pragma unroll
    for (int i = 0; i < 32; ++i) { const int kk = 2 * i + (lane >> 5); const float gsc = d.gain ? d.gain[d.k0 + kk] * d.nscale : d.nscale; scr[kk * 33 + (lane & 31)] = v[i] * gsc; }
    asm volatile("s_waitcnt lgkmcnt(0)" ::: "memory");
    const int c = lane & 7;
#pragma unroll
    for (int j = 0; j < 4; ++j) { const int n = (lane >> 3) + 8 * j; const LAS float* s = scr + (8 * c) * 33 + n;
        u32x4 o; o.x = pk2(s[0 * 33], s[1 * 33]); o.y = pk2(s[2 * 33], s[3 * 33]); o.z = pk2(s[4 * 33], s[5 * 33]); o.w = pk2(s[6 * 33], s[7 * 33]);
        *(u32x4*)(d.WT + (size_t)(d.orow0 + n) * d.ldo + d.k0 + 8 * c) = o; }
    asm volatile("s_waitcnt lgkmcnt(0)" ::: "memory");
}
__device__ __forceinline__ void prologue(KArgs a, ldsp lds, int vcu, int G, int tid) {
    const int lane = tid & 63, wave = __builtin_amdgcn_readfirstlane(tid >> 6);
    unsigned char* ws = a->ws;
    LAS float* scr = (LAS float*)(lds + wave * 16384);
    const int gw = vcu * 8 + wave, NGW = G * 8;
    {
        WItem cur, nxt; float va[32], vb[32];
        int gi = gw;
        if (gi < WI_C7) { witem_decode(a, ws, gi, cur); witem_load(cur, va, lane); }
        while (gi < WI_C7) {
            const int g1 = gi + NGW, g2 = gi + 2 * NGW;
            if (g1 < WI_C7) { witem_decode(a, ws, g1, nxt); witem_load(nxt, vb, lane); }
            witem_finish(cur, va, scr, lane);
            if (g1 >= WI_C7) break;
            if (g2 < WI_C7) { witem_decode(a, ws, g2, cur); witem_load(cur, va, lane); }
            witem_finish(nxt, vb, scr, lane);
            gi = g2;
        }
    }
    const float* x = a->in[0]; bf16* XB = (bf16*)(ws + WS_XB); float* ssq = (float*)(ws + WS_SSQ);
    for (int m = gw; m < M_TOK; m += 2 * NGW) {
        const int m2 = m + NGW;
        const f32x4* xr0 = (const f32x4*)(x + (size_t)m * DM) + lane; const f32x4* xr1 = (const f32x4*)(x + (size_t)m2 * DM) + lane;
        f32x4 v0[4], v1[4];
#pragma unroll
        for (int j = 0; j < 4; ++j) { v0[j] = xr0[64 * j]; v1[j] = xr1[64 * j]; }
        unsigned long long* o0 = (unsigned long long*)(XB + (size_t)m * DM) + lane; unsigned long long* o1 = (unsigned long long*)(XB + (size_t)m2 * DM) + lane;
        float s0 = 0.f, s1 = 0.f;
#pragma unroll
        for (int j = 0; j < 4; ++j) { s0 += (v0[j][0] * v0[j][0] + v0[j][1] * v0[j][1]) + (v0[j][2] * v0[j][2] + v0[j][3] * v0[j][3]);
            s1 += (v1[j][0] * v1[j][0] + v1[j][1] * v1[j][1]) + (v1[j][2] * v1[j][2] + v1[j][3] * v1[j][3]);
            o0[64 * j] = (unsigned long long)pk2(v0[j][0], v0[j][1]) | ((unsigned long long)pk2(v0[j][2], v0[j][3]) << 32);
            o1[64 * j] = (unsigned long long)pk2(v1[j][0], v1[j][1]) | ((unsigned long long)pk2(v1[j][2], v1[j][3]) << 32); }
        s0 = wave_sum(s0); s1 = wave_sum(s1);
        if (lane == 0) { *(f32x4*)(ssq + 4 * (size_t)m) = (f32x4){s0, 0.f, 0.f, 0.f}; *(f32x4*)(ssq + 4 * (size_t)m2) = (f32x4){s1, 0.f, 0.f, 0.f}; }
    }
    if (vcu == 0 && tid < 16) { const float d = (tid < 8 ? a->in[12] : a->in[13])[tid & 7]; const float e = __expf(-d);
        const float l1p = (e < 0.0625f) ? e * (1.0f - e * (0.5f - e * ((1.0f / 3.0f) - e * (0.25f - e * 0.2f)))) : __logf(1.0f + e);
        ((float*)(ws + WS_L2))[tid] = -l1p * LOG2E; }
}

#define REP_N 0
#define REP_PH (-1)
#ifndef DBG_DUMP
#define DBG_DUMP 0
#endif
#ifndef REP_PH
#define REP_PH (-1)
#define REP_N 0
#endif
#ifndef REP_COND
#define REP_COND true
#endif
#ifndef DBG_STRIDE
#define DBG_STRIDE 1
#endif
#ifndef DBG_HI
#define DBG_HI PH_COUNT
#endif
#ifndef DBG_LO
#define DBG_LO 0
#endif
#ifndef DBG_AOFF
#define DBG_AOFF 2048
#endif
#ifndef DBG_LDA
#define DBG_LDA 3072
#endif
#ifndef DBG_LDB
#define DBG_LDB 2048
#endif
#ifndef DBG_K
#define DBG_K 1024
#endif
enum { PH_PRO = 0, PH_IN_E, PH_ATTN, PH_OUT_E, PH_MLP_IN0, PH_MLP_OUT0, PH_IN_O0, PH_RA0, PH_RB0, PH_RC0, PH_OUT_O0, PH_IN_O1, PH_RA1, PH_RB1, PH_RC1, PH_OUT_O1, PH_MLP_IN1, PH_MLP_OUT1, PH_COUNT };

__global__ void __launch_bounds__(512, 2) mk_fwd(Args a_unused) {
    extern __shared__ __attribute__((aligned(16))) unsigned char lds_raw[];
    cg::grid_group grid = cg::this_grid();
    const ldsp lds = (ldsp)lds_raw;
    volatile LAS unsigned* MISC = (volatile LAS unsigned*)(lds + RING_BYTES);
    if (threadIdx.x < 32) MISC[threadIdx.x] = 0u;
    __syncthreads();
    const XcdBarrier bar = xcd_barrier_post((unsigned*)(((KArgs)__builtin_amdgcn_kernarg_segment_ptr())->ws + WS_CTL) + CW_BAR, MISC + 8);
    const int G = gridDim.x;
    int repcnt = 0;
    const int ph_lo = ((KArgs)__builtin_amdgcn_kernarg_segment_ptr())->ph_lo, ph_hi = ((KArgs)__builtin_amdgcn_kernarg_segment_ptr())->ph_hi;
    for (int ph = ph_lo; ph < ph_hi; ++ph) {
        const __attribute__((address_space(4))) char* kp = (const __attribute__((address_space(4))) char*)__builtin_amdgcn_kernarg_segment_ptr();
        asm volatile("" : "+s"(kp));
        KArgs a = (KArgs)kp;
        unsigned char* ws = a->ws;
        bf16* XB = (bf16*)(ws + WS_XB); float* ssq = (float*)(ws + WS_SSQ);
        bf16* BIG = (bf16*)(ws + WS_BIG);
        bf16* QKV = BIG; bf16* OE = BIG + (size_t)M_TOK * N_IN_E; bf16* HM = BIG; bf16* GB = BIG; bf16* ST = BIG + (size_t)M_TOK * 3072;
        int tid = threadIdx.x, bx = blockIdx.x;
        asm volatile("" : "+v"(tid)); asm volatile("" : "+s"(bx));
        const int vcu = (G % 8 == 0) ? (bx % 8) * (G / 8) + bx / 8 : bx;
        if (ph == PH_PRO) { prologue(a, lds, vcu, G, tid); }
        else if (ph == PH_ATTN) {
            att::AttnArgs A{QKV, OE, a->in[3], a->in[4], a->in[5], a->in[6], a->in[7], a->in[8]};
            att::attn_phase(lds, A, vcu, G, tid);
        }
        else if (ph == PH_RA0 || ph == PH_RA1 || ph == PH_RB0 || ph == PH_RB1 || ph == PH_RC0 || ph == PH_RC1) {
            ret::RetArgs R{GB, ST, (const float*)(ws + WS_L2), a->in[14], (ph >= PH_IN_O1) ? 1 : 0, (REP_N > 0 && ph == REP_PH && repcnt > 0) ? 1 : 0, XB};
            if (ph == PH_RA0 || ph == PH_RA1) { ret::ret_a_phase(lds, R, vcu, G, tid); }
            else if (ph == PH_RB0 || ph == PH_RB1) { ret::ret_b(R, vcu, G, tid); }
            else { ret::ret_c_phase(lds, R, vcu, G, tid); }
        }
        else if (ph == PH_IN_E || ph == PH_MLP_IN0 || ph == PH_MLP_IN1 || ph == PH_IN_O0 || ph == PH_IN_O1) {
            const bf16* Bt; int N, act, silu0; bf16* O;
            if (ph == PH_IN_E)           { Bt = (const bf16*)(ws + WS_W_IN_E); N = N_IN_E; O = QKV; act = 0; silu0 = 1 << 30; }
            else if (ph == PH_MLP_IN0)   { Bt = (const bf16*)(ws + WS_W_MLP_IN); N = DFF; O = HM; act = 1; silu0 = 1 << 30; }
            else if (ph == PH_MLP_IN1)   { Bt = (const bf16*)(ws + WS_W_MLP_IN) + (size_t)DFF * DM; N = DFF; O = HM; act = 1; silu0 = 1 << 30; }
            else if (ph == PH_IN_O0)     { Bt = (const bf16*)(ws + WS_W_IN_O); N = 3072; O = GB; act = 2; silu0 = 8; }
            else                         { Bt = (const bf16*)(ws + WS_W_IN_O) + (size_t)3072 * DM; N = 3072; O = GB; act = 2; silu0 = 8; }
            pg8::Gemm g; g.A = XB; g.Bt = Bt; g.lda = DM; g.ldb = DM; g.M = M_TOK; g.N = N; g.K = DM;
            pg8::EpiBf16 E; E.O = O; E.ldc = N; E.ssq = ssq; E.silu_pn0 = silu0; E.act = act;
            pg8::StaticOrder S; S.init(M_TOK, N, G, bx);
            pg8::gemm_phase<pg8::EpiBf16, pg8::StaticOrder, true, true>(lds, g, S, E, tid);
        }
        else {
            const bf16* A; const bf16* Bt; int lda, ldb, K; const float* basef; const bf16* baseb; float* outf; bf16* xb; float* sso; bf16* X2 = (bf16*)a->out;
            if (ph == PH_OUT_E)          { A = OE; lda = DM; K = DM; Bt = (const bf16*)(ws + WS_W_OUT_E); ldb = DM; basef = a->in[0]; baseb = nullptr; outf = nullptr; xb = XB; sso = ssq; }
            else if (ph == PH_MLP_OUT0)  { A = HM; lda = DFF; K = DFF; Bt = (const bf16*)(ws + WS_W_MLP_OUT); ldb = DFF; basef = nullptr; baseb = XB; outf = nullptr; xb = XB; sso = ssq; }
            else if (ph == PH_MLP_OUT1)  { A = HM; lda = DFF; K = DFF; Bt = (const bf16*)(ws + WS_W_MLP_OUT) + (size_t)DFF * DM; ldb = DFF; basef = nullptr; baseb = XB; outf = a->out; xb = nullptr; sso = nullptr; }
            else if (ph == PH_OUT_O0)    { A = GB + 2048; lda = 3072; K = 1024; Bt = (const bf16*)(ws + WS_W_OUT_O); ldb = 2048; basef = nullptr; baseb = XB; outf = nullptr; xb = X2; sso = nullptr; }
            else                         { A = GB + 2048; lda = 3072; K = 1024; Bt = (const bf16*)(ws + WS_W_OUT_O) + 1024; ldb = 2048; basef = nullptr; baseb = X2; outf = nullptr; xb = XB; sso = ssq; }
            pg8::Gemm g; g.A = A; g.Bt = Bt; g.lda = lda; g.ldb = ldb; g.M = M_TOK; g.N = DM; g.K = K;
            pg8::EpiResid E; E.basef = basef; E.baseb = baseb; E.outf = outf; E.xb = xb; E.ssq_out = sso; E.ldc = DM;
            E.accscale = (REP_N > 0 && ph == REP_PH && repcnt > 0 && ph != PH_OUT_E && ph != PH_OUT_O0 && ph != PH_MLP_OUT1) ? 0.f : 1.f;
            pg8::StaticOrder S; S.init(M_TOK, DM, G, bx);
            pg8::gemm_phase<pg8::EpiResid, pg8::StaticOrder, false, true>(lds, g, S, E, tid);
        }
        if (ph + 1 == ph_hi && DBG_DUMP) {
            xcd_barrier(bar);
            const bf16* srcb = (DBG_DUMP == 1) ? GB : ST;
            for (size_t i = (size_t)bx * 512 + tid; i < (size_t)M_TOK * DM; i += (size_t)G * 512) a->out[i] = bf_lo((unsigned)srcb[i * DBG_STRIDE]);
        }
        if (ph + 1 < ph_hi) {
            if (ph_lo < 0) {
                asm volatile("s_waitcnt vmcnt(0)" ::: "memory");
                grid.sync();
                __builtin_amdgcn_fence(__ATOMIC_ACQUIRE, "agent");
                asm volatile("s_waitcnt vmcnt(0)" ::: "memory");
                __syncthreads();
            }
            xcd_barrier(bar);
        }
        if (REP_N > 0 && ph == REP_PH && repcnt < REP_N && REP_COND) { ++repcnt; --ph; }
    }
}

extern "C" void kernel_launch(void* const* d_in, const int* in_sizes, int n_in, void* d_out, int out_size, void* d_ws, size_t ws_size, hipStream_t stream) {
    static int grid = 0;
    if (grid == 0) {
        int dev = 0, cus = 0, per_cu = 0;
        (void)hipGetDevice(&dev);
        (void)hipDeviceGetAttribute(&cus, hipDeviceAttributeMultiprocessorCount, dev);
        (void)hipFuncSetAttribute((const void*)mk_fwd, hipFuncAttributeMaxDynamicSharedMemorySize, LDS_BYTES);
        (void)hipOccupancyMaxActiveBlocksPerMultiprocessor(&per_cu, (const void*)mk_fwd, 512, LDS_BYTES);
        grid = (n_in == 19 && per_cu >= 1 && cus == 256 && ws_size >= WS_END && out_size == M_TOK * DM) ? 256 : -1;
        if (grid < 0) fprintf(stderr, "kernel_launch: unsupported configuration (cus %d per_cu %d ws %zu n_in %d)\n", cus, per_cu, ws_size, n_in);
    }
    if (grid < 0) return;
    if (hipMemsetAsync((char*)d_ws + WS_CTL, 0, 65536, stream) != hipSuccess) { fprintf(stderr, "kernel_launch: memset failed\n"); return; }
    Args a{};
    for (int i = 0; i < 19; ++i) a.in[i] = (const float*)d_in[i];
    a.out = (float*)d_out; a.ws = (unsigned char*)d_ws; a.ph_lo = DBG_LO; a.ph_hi = DBG_HI;
    void* args[] = {&a};
    hipError_t e = hipLaunchCooperativeKernel((void*)mk_fwd, dim3(grid), dim3(512), args, LDS_BYTES, stream);
    if (e != hipSuccess) fprintf(stderr, "cooperative launch failed: %s\n", hipGetErrorString(e));
}
```

```cpp
#include <hip/hip_runtime.h>
#include <hip/hip_cooperative_groups.h>
#include <cstdio>
#include <cstdint>
#include <cmath>
namespace cg = cooperative_groups;
#define REP_N 0
#define REP_PH (-1)
namespace pg8 {
#define PG8_LAS __attribute__((address_space(3)))
typedef unsigned short bf16_t;
typedef short bf16x8 __attribute__((ext_vector_type(8)));
typedef float f32x4 __attribute__((ext_vector_type(4)));
typedef float f32x2 __attribute__((ext_vector_type(2)));
typedef unsigned u32x4 __attribute__((ext_vector_type(4)));
typedef unsigned u32x2 __attribute__((ext_vector_type(2)));
constexpr int BM = 256, BK = 64, HALF = 128, HTB = HALF * BK * 2  , STAGE_BYTES = 8 * HTB, NXCD = 8, WGM = 8;

__host__ __device__ __forceinline__ int lds_byte(int r, int c) { const int st = (r >> 4) * 2 + (c >> 5), rr = r & 15, cc = c & 31, ob = rr * 64 + cc * 2; return st * 1024 + (ob ^ (((ob >> 9) & 1) << 5)); }
__host__ __device__ __forceinline__ void stage_rc(int b, int& R, int& C) { const int st = b / 1024, sb = b % 1024, swz = sb ^ (((sb >> 9) & 1) << 5); R = (st >> 1) * 16 + swz / 64; C = (st & 1) * 32 + (swz % 64) / 2; }
__host__ __device__ __forceinline__ int perm32(int rho) { const int n = rho >> 4, i = rho & 15; return 8 * (i >> 2) + 4 * n + (i & 3); }

struct Unit { int pm, pn; };
struct Gemm { const bf16_t* A; const bf16_t* Bt; int lda, ldb, M, N, K; };

struct StaticOrder {
    int nM, nN, nwg, G, c;
    __host__ __device__ void init(int M, int N, int G_, int c_) { nM = M / BM; nN = N / BM; nwg = nM * nN; G = G_; c = c_; }
    __host__ __device__ bool next(int i, Unit& u) const {
        const long L = (long)i * G + c; if (L >= nwg) return false;
        int wgid = (int)L; { const int q = nwg / NXCD, r = nwg % NXCD, xcd = wgid % NXCD, off = wgid / NXCD; wgid = (xcd < r ? xcd * (q + 1) : r * (q + 1) + (xcd - r) * q) + off; }
        const int nig = WGM * nN, gid = wgid / nig, fm = gid * WGM, gsz = (nM - fm) < WGM ? (nM - fm) : WGM;
        u.pm = fm + ((wgid % nig) % gsz); u.pn = (wgid % nig) / gsz; return true;
    }
};

typedef float f32x2_cv __attribute__((ext_vector_type(2))); typedef __bf16 bf16x2_cv __attribute__((ext_vector_type(2)));
__device__ __forceinline__ unsigned cvt_pk_bf16(float lo, float hi) { const f32x2_cv v = {lo, hi}; const bf16x2_cv b = __builtin_convertvector(v, bf16x2_cv); return __builtin_bit_cast(unsigned, b); }


__device__ __forceinline__ float row_rstd(const float* ssq, int row) { const f32x4 p = *(const f32x4*)(ssq + 4 * (size_t)row); return rsqrtf(((p[0] + p[1]) + (p[2] + p[3])) * (1.0f / 1024.0f) + 1e-6f); }

struct EpiBf16 {
    static constexpr bool PERM = true, AFTER_DRAIN = false;
    bf16_t* O; int ldc; const float* ssq; int silu_pn0; int act;
    __device__ __forceinline__ void operator()(const f32x4 (&acc)[2][2][4][2], const Unit& u, int wr, int wc, int fr, int fq) const {
        const int row0 = u.pm * BM + wr * 64 + fr; const int col0 = u.pn * BM + wc * 32 + 8 * fq;
        const bool do_silu = (act == 2) && (u.pn >= silu_pn0);
#pragma unroll
        for (int ai = 0; ai < 2; ++ai)
#pragma unroll
            for (int m = 0; m < 4; ++m) { const int row = row0 + ai * HALF + m * 16; const float rs = row_rstd(ssq, row); bf16_t* rowp = O + (size_t)row * ldc + col0;
#pragma unroll
                for (int bj = 0; bj < 2; ++bj) { f32x4 v0 = acc[ai][bj][m][0] * rs, v1 = acc[ai][bj][m][1] * rs;
                    if (act == 1) {
#pragma unroll
                        for (int e = 0; e < 4; ++e) { const float a = fmaxf(v0[e], 0.f), b = fmaxf(v1[e], 0.f); v0[e] = a * a; v1[e] = b * b; } }
                    if (do_silu) {
#pragma unroll
                        for (int e = 0; e < 4; ++e) { v0[e] = v0[e] / (1.0f + __expf(-v0[e])); v1[e] = v1[e] / (1.0f + __expf(-v1[e])); } }
                    u32x4 w; w.x = cvt_pk_bf16(v0[0], v0[1]); w.y = cvt_pk_bf16(v0[2], v0[3]); w.z = cvt_pk_bf16(v1[0], v1[1]); w.w = cvt_pk_bf16(v1[2], v1[3]);
                    *(u32x4*)(rowp + bj * HALF) = w; } }
    }
};

struct EpiResid {
    static constexpr bool PERM = false, AFTER_DRAIN = true;
    const float* basef; const bf16_t* baseb; float* outf; bf16_t* xb; float* ssq_out; int ldc; float accscale;
    __device__ __forceinline__ void fused(f32x4 (&acc)[2][2][4][2], const Unit& u, int wr, int wc, int fr, int fq, PG8_LAS unsigned char* lds, int wid, int lane) const {
        PG8_LAS float* P = (PG8_LAS float*)lds;
        const int col0 = u.pn * BM + wc * 32 + 4 * fq;
#pragma unroll
        for (int ai = 0; ai < 2; ++ai)
#pragma unroll
            for (int m = 0; m < 4; ++m) { const int r = ai * HALF + wr * 64 + m * 16 + fr; const size_t off = (size_t)(u.pm * BM + r) * ldc + col0; float s = 0.f;
#pragma unroll
                for (int bj = 0; bj < 2; ++bj)
#pragma unroll
                    for (int n = 0; n < 2; ++n) { const size_t o2 = off + bj * HALF + n * 16; f32x4 bs;
                        if (basef) bs = *(const f32x4*)(basef + o2);
                        else { const u32x2 b = *(const u32x2*)(baseb + o2); bs = (f32x4){__uint_as_float(b.x << 16), __uint_as_float(b.x & 0xffff0000u), __uint_as_float(b.y << 16), __uint_as_float(b.y & 0xffff0000u)}; }
                        const f32x4 o = bs + acc[ai][bj][m][n] * accscale;
                        if (outf) *(f32x4*)(outf + o2) = o;
                        if (xb) { u32x2 w; w.x = cvt_pk_bf16(o[0], o[1]); w.y = cvt_pk_bf16(o[2], o[3]); *(u32x2*)(xb + o2) = w; }
                        s += (o[0] * o[0] + o[1] * o[1]) + (o[2] * o[2] + o[3] * o[3]); }
                if (ssq_out) { s += __shfl_xor(s, 16); s += __shfl_xor(s, 32); if (fq == 0) P[r * 4 + wc] = s; }
                if (m & 1) asm volatile("" ::: "memory"); }
        if (ssq_out) {
            __syncthreads();
            const int t = wid * 64 + lane;
            if (t < 256) { const float s = (P[t * 4 + 0] + P[t * 4 + 1]) + (P[t * 4 + 2] + P[t * 4 + 3]); ssq_out[(size_t)(u.pm * BM + t) * 4 + u.pn] = s; }
            __syncthreads();
        }
    }
};

template <class Epi, class Sched, bool ALIGN_EPI = false, bool SP2 = false>
__device__ __forceinline__ void gemm_phase(PG8_LAS unsigned char* lds, const Gemm g, const Sched& S, const Epi& E, const int tid) {
    const int wid = __builtin_amdgcn_readfirstlane(tid >> 6), lane = tid & 63, wr = wid >> 2, wc = wid & 3, fr = lane & 15, fq = lane >> 4;
    const int K = g.K, nt = K / BK;
    unsigned voffA[2], voffB[2];
#pragma unroll
    for (int i = 0; i < 2; ++i) { int R, C; stage_rc(tid * 16 + i * 8192, R, C); const int Rb = Epi::PERM ? ((R & ~31) + perm32(R & 31)) : R;
        voffA[i] = (unsigned)(R * g.lda + C) * 2u; voffB[i] = (unsigned)(Rb * g.ldb + C) * 2u; }
    const size_t kstep = (size_t)(BK * 2);
    const size_t hstepA = (size_t)HALF * g.lda * 2, hstepB = (size_t)HALF * g.ldb * 2;
    const size_t tstepA = 2 * hstepA, tstepB = 2 * hstepB;
    const unsigned ldsw = (unsigned)wid * 1024u;
    const int aoff = lds_byte(wr * 64 + fr, fq * 8), boff = lds_byte(wc * 32 + fr, fq * 8);
#define PG8_SA(b, h) (((b) * 2 + (h)) * HTB)
#define PG8_SB(b, h) ((4 + (b) * 2 + (h)) * HTB)
#define PG8_STAGE(bufoff, gbase, voff) do { _Pragma("unroll") for (int _i = 0; _i < 2; ++_i) \
        __builtin_amdgcn_global_load_lds((const unsigned*)((const char*)(gbase) + (voff)[_i]), (PG8_LAS unsigned*)(lds + (bufoff) + ldsw + _i * 8192), 16, 0, 0); } while (0)
#define PG8_LDA(dst, b, h) do { _Pragma("unroll") for (int m = 0; m < 4; ++m) _Pragma("unroll") for (int k = 0; k < 2; ++k) dst[m][k] = *(const PG8_LAS bf16x8*)(lds + PG8_SA(b, h) + aoff + m * 2048 + k * 1024); } while (0)
#define PG8_LDB(dst, b, h) do { _Pragma("unroll") for (int n = 0; n < 2; ++n) _Pragma("unroll") for (int k = 0; k < 2; ++k) dst[n][k] = *(const PG8_LAS bf16x8*)(lds + PG8_SB(b, h) + boff + n * 2048 + k * 1024); } while (0)
#define PG8_MMA(ai, bj, At, Bt) do { __builtin_amdgcn_s_setprio(1); _Pragma("unroll") for (int m = 0; m < 4; ++m) _Pragma("unroll") for (int n = 0; n < 2; ++n) _Pragma("unroll") for (int k = 0; k < 2; ++k) \
        acc[ai][bj][m][n] = __builtin_amdgcn_mfma_f32_16x16x32_bf16(Bt[n][k], At[m][k], acc[ai][bj][m][n], 0, 0, 0); __builtin_amdgcn_s_setprio(0); } while (0)
#define PG8_WAIT_V(n) asm volatile("s_waitcnt vmcnt(" #n ")" ::: "memory")
#define PG8_WAIT_L(n) asm volatile("s_waitcnt lgkmcnt(" #n ")" ::: "memory")
#define PG8_BAR __builtin_amdgcn_s_barrier()
#define PG8_SCHED __builtin_amdgcn_sched_barrier(0)
    Unit cur, nxt; int ui = 0;
    if (!S.next(0, cur)) return;
    f32x4 acc[2][2][4][2];
#pragma unroll
    for (int a = 0; a < 2; ++a)
#pragma unroll
        for (int b = 0; b < 2; ++b)
#pragma unroll
            for (int m = 0; m < 4; ++m)
#pragma unroll
                for (int n = 0; n < 2; ++n) acc[a][b][m][n] = (f32x4){0.f, 0.f, 0.f, 0.f};
    bf16x8 At[4][2], B0[2][2], B1[2][2];
    const char* cA = (const char*)g.A + (size_t)cur.pm * tstepA; const char* cB = (const char*)g.Bt + (size_t)cur.pn * tstepB;
    if constexpr (SP2) {
        PG8_STAGE(PG8_SB(0, 0), cB, voffB); PG8_STAGE(PG8_SB(0, 1), cB + hstepB, voffB); PG8_STAGE(PG8_SA(0, 0), cA, voffA); PG8_STAGE(PG8_SA(0, 1), cA + hstepA, voffA);
        if (wr == 1) PG8_BAR;
        PG8_WAIT_V(2); PG8_BAR;
        PG8_STAGE(PG8_SB(1, 0), cB + kstep, voffB); PG8_STAGE(PG8_SA(1, 0), cA + kstep, voffA); PG8_STAGE(PG8_SB(1, 1), cB + hstepB + kstep, voffB);
        PG8_WAIT_V(6); PG8_BAR;
    } else {
        PG8_STAGE(PG8_SB(0, 0), cB, voffB); PG8_STAGE(PG8_SA(0, 0), cA, voffA); PG8_STAGE(PG8_SB(0, 1), cB + hstepB, voffB); PG8_STAGE(PG8_SA(0, 1), cA + hstepA, voffA);
        if (wr == 1) PG8_BAR;
        PG8_WAIT_V(4); PG8_BAR;
        PG8_STAGE(PG8_SB(1, 0), cB + kstep, voffB); PG8_STAGE(PG8_SA(1, 0), cA + kstep, voffA); PG8_STAGE(PG8_SB(1, 1), cB + hstepB + kstep, voffB);
        PG8_WAIT_V(6); PG8_BAR;
    }
    for (;;) {
        const bool has_next = S.next(ui + 1, nxt);
        const char* nA = has_next ? (const char*)g.A + (size_t)nxt.pm * tstepA : cA; const char* nB = has_next ? (const char*)g.Bt + (size_t)nxt.pn * tstepB : cB;
        for (int t = 0; t < nt; t += 2) {
            const bool last = (t == nt - 2);
            const char* a1 = cA + (size_t)(t + 1) * kstep;
            const char* a2 = last ? nA : cA + (size_t)(t + 2) * kstep; const char* b2 = last ? nB : cB + (size_t)(t + 2) * kstep;
            const char* a3 = a2 + kstep; const char* b3 = b2 + kstep;
            if constexpr (SP2) {
            PG8_LDB(B0, 0, 0); PG8_LDB(B1, 0, 1); PG8_SCHED; PG8_LDA(At, 0, 0); PG8_STAGE(PG8_SA(1, 1), a1 + hstepA, voffA);
            PG8_WAIT_V(8); PG8_WAIT_L(0); PG8_BAR; PG8_MMA(0, 0, At, B0); PG8_MMA(0, 1, At, B1); PG8_BAR; PG8_SCHED;
            PG8_LDA(At, 0, 1); PG8_STAGE(PG8_SB(0, 0), b2, voffB); PG8_STAGE(PG8_SB(0, 1), b2 + hstepB, voffB); PG8_STAGE(PG8_SA(0, 0), a2, voffA);
            PG8_WAIT_V(8); PG8_WAIT_L(0); PG8_BAR; PG8_MMA(1, 0, At, B0); PG8_MMA(1, 1, At, B1); PG8_BAR; PG8_SCHED;
            PG8_LDB(B0, 1, 0); PG8_LDB(B1, 1, 1); PG8_SCHED; PG8_LDA(At, 1, 0); PG8_STAGE(PG8_SA(0, 1), a2 + hstepA, voffA);
            PG8_WAIT_V(8); PG8_WAIT_L(0); PG8_BAR; PG8_MMA(0, 0, At, B0); PG8_MMA(0, 1, At, B1); PG8_BAR; PG8_SCHED;
            PG8_LDA(At, 1, 1); PG8_STAGE(PG8_SB(1, 0), b3, voffB); PG8_STAGE(PG8_SB(1, 1), b3 + hstepB, voffB); PG8_STAGE(PG8_SA(1, 0), a3, voffA);
            PG8_WAIT_V(8); PG8_WAIT_L(0); PG8_BAR; PG8_MMA(1, 0, At, B0); PG8_MMA(1, 1, At, B1); PG8_BAR; PG8_SCHED;
            } else {
            PG8_LDB(B0, 0, 0); PG8_SCHED; PG8_LDA(At, 0, 0); PG8_STAGE(PG8_SA(1, 1), a1 + hstepA, voffA);
            PG8_WAIT_L(8); PG8_BAR; PG8_WAIT_L(0); PG8_MMA(0, 0, At, B0); PG8_BAR; PG8_SCHED;
            PG8_LDB(B1, 0, 1); PG8_STAGE(PG8_SB(0, 0), b2, voffB);
            PG8_BAR; PG8_WAIT_L(0); PG8_MMA(0, 1, At, B1); PG8_BAR;
            PG8_LDA(At, 0, 1); PG8_STAGE(PG8_SA(0, 0), a2, voffA);
            PG8_BAR; PG8_WAIT_L(0); PG8_MMA(1, 0, At, B0); PG8_BAR; PG8_SCHED;
            PG8_STAGE(PG8_SB(0, 1), b2 + hstepB, voffB);
            PG8_WAIT_V(6); PG8_BAR; PG8_MMA(1, 1, At, B1); PG8_BAR;
            PG8_LDB(B0, 1, 0); PG8_SCHED; PG8_LDA(At, 1, 0); PG8_STAGE(PG8_SA(0, 1), a2 + hstepA, voffA);
            PG8_WAIT_L(8); PG8_BAR; PG8_WAIT_L(0); PG8_MMA(0, 0, At, B0); PG8_BAR; PG8_SCHED;
            PG8_LDB(B1, 1, 1); PG8_STAGE(PG8_SB(1, 0), b3, voffB);
            PG8_BAR; PG8_WAIT_L(0); PG8_MMA(0, 1, At, B1); PG8_BAR;
            PG8_LDA(At, 1, 1); PG8_STAGE(PG8_SA(1, 0), a3, voffA);
            PG8_BAR; PG8_WAIT_L(0); PG8_MMA(1, 0, At, B0); PG8_BAR; PG8_SCHED;
            PG8_STAGE(PG8_SB(1, 1), b3 + hstepB, voffB);
            PG8_WAIT_V(6); PG8_BAR; PG8_MMA(1, 1, At, B1); PG8_BAR;
            }
        }
        if constexpr (ALIGN_EPI) { if (wr == 0) PG8_BAR; }
        if constexpr (!Epi::AFTER_DRAIN) { E(acc, cur, wr, wc, fr, fq); }
        if (!has_next) break;
#pragma unroll
        for (int a = 0; a < 2; ++a)
#pragma unroll
            for (int b = 0; b < 2; ++b)
#pragma unroll
                for (int m = 0; m < 4; ++m)
#pragma unroll
                    for (int n = 0; n < 2; ++n) acc[a][b][m][n] = (f32x4){0.f, 0.f, 0.f, 0.f};
        cur = nxt; cA = nA; cB = nB; ++ui;
        if constexpr (ALIGN_EPI) { if (wr == 1) PG8_BAR; }
    }
    PG8_WAIT_V(0);
    if constexpr (!ALIGN_EPI) { if (wr == 0) PG8_BAR; }
    PG8_BAR;
    if constexpr (Epi::AFTER_DRAIN) { E.fused(acc, cur, wr, wc, fr, fq, lds, wid, lane); }
#undef PG8_SA
#undef PG8_SB
#undef PG8_STAGE
#undef PG8_LDA
#undef PG8_LDB
#undef PG8_MMA
#undef PG8_WAIT_V
#undef PG8_WAIT_L
#undef PG8_BAR
#undef PG8_SCHED
}
}
#define LAS __attribute__((address_space(3)))
typedef unsigned short bf16;
typedef short bf16x8 __attribute__((ext_vector_type(8)));
typedef short s16x4 __attribute__((ext_vector_type(4)));
typedef float f32x4 __attribute__((ext_vector_type(4)));
typedef unsigned u32x4 __attribute__((ext_vector_type(4)));
typedef unsigned u32x2 __attribute__((ext_vector_type(2)));
typedef LAS unsigned char* ldsp;
constexpr float LOG2E = 1.4426950408889634f;

__device__ __forceinline__ float bf_lo(unsigned w) { return __uint_as_float(w << 16); }
__device__ __forceinline__ float bf_hi(unsigned w) { return __uint_as_float(w & 0xffff0000u); }
__device__ __forceinline__ unsigned pk2(float lo, float hi) { return pg8::cvt_pk_bf16(lo, hi); }
__device__ __forceinline__ s16x4 vtr(ldsp p) { typedef short v4i16_t __attribute__((ext_vector_type(4))); return __builtin_bit_cast(s16x4, __builtin_amdgcn_ds_read_tr16_b64_v4i16((LAS v4i16_t*)p)); }
__device__ __forceinline__ bf16x8 cat8(s16x4 lo, s16x4 hi) { return (bf16x8){lo[0], lo[1], lo[2], lo[3], hi[0], hi[1], hi[2], hi[3]}; }
__device__ __forceinline__ f32x4 mfma16(bf16x8 a, bf16x8 b, f32x4 c) { return __builtin_amdgcn_mfma_f32_16x16x32_bf16(a, b, c, 0, 0, 0); }
__device__ __forceinline__ float ex2(float x) { return __builtin_amdgcn_exp2f(x); }

namespace att {
constexpr int SEQ = 16384, LDQ = 2304, LDO = 1024;
constexpr int KPB = 160;
constexpr int COL_QA = 0, COL_KA = 512, COL_VA = 640, COL_QB = 768, COL_KB = 1280, COL_VB = 1792;

template <int NP>
__device__ __forceinline__ void load_rows(u32x4 (&v)[NP], const bf16* src, int tok0, int nvalid, int tid) {
    const int sub = tid & 7;
#pragma unroll
    for (int p = 0; p < NP; ++p) { const int r = (tid >> 3) + 64 * p, tok = tok0 + r; const bool ok = (tok >= 0) && (tok < SEQ) && (r < nvalid);
        v[p] = (u32x4){0u, 0u, 0u, 0u};
        if (ok) v[p] = *(const u32x4*)(src + (size_t)tok * LDQ + sub * 8); }
}
template <int NP, bool NORM>
__device__ __forceinline__ void store_rows(ldsp dst, const u32x4 (&v)[NP], int nrows, const float* gain, int tid) {
    const int sub = tid & 7;
    float gn[8];
    if (NORM) {
#pragma unroll
        for (int j = 0; j < 8; ++j) gn[j] = gain[sub * 8 + j];
    }
#pragma unroll
    for (int p = 0; p < NP; ++p) { const int r = (tid >> 3) + 64 * p;
        if (r < nrows) {
            u32x4 w = v[p];
            if (NORM) {
                float f[8]; f[0] = bf_lo(w.x); f[1] = bf_hi(w.x); f[2] = bf_lo(w.y); f[3] = bf_hi(w.y); f[4] = bf_lo(w.z); f[5] = bf_hi(w.z); f[6] = bf_lo(w.w); f[7] = bf_hi(w.w);
                float ss = 0.f;
#pragma unroll
                for (int j = 0; j < 8; ++j) ss += f[j] * f[j];
                ss += __shfl_xor(ss, 1); ss += __shfl_xor(ss, 2); ss += __shfl_xor(ss, 4);
                const float rs = rsqrtf(ss * (1.0f / 64.0f) + 1e-6f);
#pragma unroll
                for (int j = 0; j < 8; ++j) f[j] = f[j] * rs * gn[j];
                w.x = pk2(f[0], f[1]); w.y = pk2(f[2], f[3]); w.z = pk2(f[4], f[5]); w.w = pk2(f[6], f[7]);
            }
            *(LAS u32x4*)(dst + r * KPB + sub * 16) = w;
        } }
}

__device__ __forceinline__ void load_q(bf16x8 (&qf)[2], const bf16* qrow  , const float* gain, int g) {
    float f[2][8]; float ss = 0.f;
#pragma unroll
    for (int s = 0; s < 2; ++s) { const u32x4 v = *(const u32x4*)(qrow + 32 * s + 8 * g);
        f[s][0] = bf_lo(v.x); f[s][1] = bf_hi(v.x); f[s][2] = bf_lo(v.y); f[s][3] = bf_hi(v.y); f[s][4] = bf_lo(v.z); f[s][5] = bf_hi(v.z); f[s][6] = bf_lo(v.w); f[s][7] = bf_hi(v.w);
#pragma unroll
        for (int j = 0; j < 8; ++j) ss += f[s][j] * f[s][j]; }
    ss += __shfl_xor(ss, 16); ss += __shfl_xor(ss, 32);
    const float rs = rsqrtf(ss * (1.0f / 64.0f) + 1e-6f) * (0.125f * LOG2E);
#pragma unroll
    for (int s = 0; s < 2; ++s) { float o[8];
#pragma unroll
        for (int j = 0; j < 8; ++j) o[j] = f[s][j] * rs * gain[32 * s + 8 * g + j];
        u32x4 w; w.x = pk2(o[0], o[1]); w.y = pk2(o[2], o[3]); w.z = pk2(o[4], o[5]); w.w = pk2(o[6], o[7]);
        qf[s] = __builtin_bit_cast(bf16x8, w); }
}

template <int NT, class RB>
__device__ __forceinline__ void scores(f32x4 (&sc)[NT], ldsp Kb, const bf16x8 (&qf)[2], const RB& rb, int lane) {
    const int fr = lane & 15, g = lane >> 4;
#pragma unroll
    for (int t = 0; t < NT; ++t) { ldsp kp = Kb + (rb(t) + fr) * KPB + g * 16; f32x4 a = (f32x4){0.f, 0.f, 0.f, 0.f};
#pragma unroll
        for (int s = 0; s < 2; ++s) { const bf16x8 kf = *(const LAS bf16x8*)(kp + s * 64); a = mfma16(kf, qf[s], a); }
        sc[t] = a; if ((t & 3) == 3) __builtin_amdgcn_sched_barrier(0); }
}
template <int NT>
__device__ __forceinline__ float softmax_pack(f32x4 (&sc)[NT], bf16x8 (&pf)[NT / 2], float sink2, bool has_sink) {
    float m = -INFINITY;
#pragma unroll
    for (int t = 0; t < NT; ++t)
#pragma unroll
        for (int r = 0; r < 4; ++r) m = fmaxf(m, sc[t][r]);
    m = fmaxf(m, __shfl_xor(m, 16)); m = fmaxf(m, __shfl_xor(m, 32));
    if (has_sink) m = fmaxf(m, sink2);
    float sum = 0.f;
#pragma unroll
    for (int t = 0; t < NT; ++t)
#pragma unroll
        for (int r = 0; r < 4; ++r) { const float p = ex2(sc[t][r] - m); sc[t][r] = p; sum += p; }
    sum += __shfl_xor(sum, 16); sum += __shfl_xor(sum, 32);
    if (has_sink) sum += ex2(sink2 - m);
#pragma unroll
    for (int k = 0; k < NT / 2; ++k) { u32x4 w; w.x = pk2(sc[2 * k][0], sc[2 * k][1]); w.y = pk2(sc[2 * k][2], sc[2 * k][3]); w.z = pk2(sc[2 * k + 1][0], sc[2 * k + 1][1]); w.w = pk2(sc[2 * k + 1][2], sc[2 * k + 1][3]);
        pf[k] = __builtin_bit_cast(bf16x8, w); }
    return sum;
}
template <int NT, class RB>
__device__ __forceinline__ void pv_store(ldsp Vb, const bf16x8 (&pf)[NT / 2], const RB& rb, float sum, bf16* orow  , int lane) {
    const int g = lane >> 4, q4 = (lane & 15) >> 2, p4 = lane & 3;
    f32x4 o[4];
#pragma unroll
    for (int dt = 0; dt < 4; ++dt) o[dt] = (f32x4){0.f, 0.f, 0.f, 0.f};
#pragma unroll
    for (int k = 0; k < NT / 2; ++k) { ldsp v0 = Vb + (rb(2 * k) + 4 * g + q4) * KPB + p4 * 8; ldsp v1 = Vb + (rb(2 * k + 1) + 4 * g + q4) * KPB + p4 * 8;
#pragma unroll
        for (int dt = 0; dt < 4; ++dt) { const bf16x8 vf = cat8(vtr(v0 + dt * 32), vtr(v1 + dt * 32)); o[dt] = mfma16(vf, pf[k], o[dt]); } }
    const float inv = 1.0f / sum;
#pragma unroll
    for (int dt = 0; dt < 4; ++dt) { u32x2 w; w.x = pk2(o[dt][0] * inv, o[dt][1] * inv); w.y = pk2(o[dt][2] * inv, o[dt][3] * inv); *(u32x2*)(orow + dt * 16 + 4 * g) = w; }
}

struct RbWin { int mt; __device__ __forceinline__ int operator()(int t) const { return 16 * (mt + t); } };
struct RbNa { int off, ct0, ct1; __device__ __forceinline__ int operator()(int t) const { return (off + (t >> 1)) * 64 + ((t & 1) ? ct1 : ct0) * 16; } };

struct AttnArgs { const bf16* qkv; bf16* o; const float* qn_a; const float* kn_a; const float* sink_a; const float* qn_b; const float* kn_b; const float* rpb; };

__device__ __forceinline__ void window_compute(ldsp lds, const AttnArgs& A, int unit, int tid) {
    const int n = unit >> 1, kvh = unit & 1, lane = tid & 63, wid = __builtin_amdgcn_readfirstlane(tid >> 6);
    ldsp Kb = lds, Vb = lds + 400 * KPB;
    const int tok0 = (n - 1) * 128;
    const int fr = lane & 15, g = lane >> 4;
    for (int it = 0; it < 4; ++it) {
        const int idx = wid * 4 + it, g4 = idx >> 3, mt = idx & 7, hq = kvh * 4 + g4;
        const int qtok = n * 128 + mt * 16 + fr;
        bf16x8 qf[2]; load_q(qf, A.qkv + (size_t)qtok * LDQ + COL_QA + hq * 64, A.qn_a, g);
        RbWin rb{mt};
        f32x4 sc[18]; scores<18>(sc, Kb, qf, rb, lane);
        const float slope2 = exp2f(-(float)(hq + 1)) * LOG2E;
        const int il = mt * 16 + fr;
#pragma unroll
        for (int t = 0; t < 18; ++t)
#pragma unroll
            for (int r = 0; r < 4; ++r) { const int j = 16 * (mt + t) + 4 * g + r; const int rel = j - 128 - il; const int arel = rel < 0 ? -rel : rel; const int kpos = tok0 + j;
                const bool ok = (arel <= 128) && (kpos >= 0) && (kpos < SEQ);
                sc[t][r] = ok ? sc[t][r] - slope2 * (float)arel : -INFINITY; }
        bf16x8 pf[9]; const float sum = softmax_pack<18>(sc, pf, A.sink_a[hq] * LOG2E, true);
        pv_store<18>(Vb, pf, rb, sum, A.o + (size_t)qtok * LDO + hq * 64, lane);
    }
}

constexpr int NA_ROWS = 704;
constexpr int NA_RPB_OFF = NA_ROWS * KPB;

__device__ __forceinline__ void na_unit(ldsp lds, const AttnArgs& A, int unit, int next_unit, u32x4 (&kreg)[11], int tid) {
    const int rq4 = unit >> 3, h = unit & 7, lane = tid & 63, wid = __builtin_amdgcn_readfirstlane(tid >> 6);
    const int r0 = 4 * rq4; const int base = min(max(r0 - 4, 0), 248);
    const int rq = r0 + (wid >> 1); const int rstart = min(max(rq - 4, 0), 248);
    const int fr = lane & 15, g = lane >> 4;
    store_rows<11, true>(lds, kreg, NA_ROWS, A.kn_b, tid);
    __syncthreads();
    const LAS float* rpl = (const LAS float*)(lds + NA_RPB_OFF);
    bf16x8 pf[2][8]; float sum[2]; int qtok[2];
#pragma unroll
    for (int it = 0; it < 2; ++it) {
        const int mt = 2 * (wid & 1) + it;
        const int qc = (mt < 3) ? 8 + 16 * mt + fr : (fr < 8 ? fr : 48 + fr); qtok[it] = rq * 64 + qc;
        bf16x8 qf[2]; load_q(qf, A.qkv + (size_t)qtok[it] * LDQ + COL_QB + h * 64, A.qn_b, g);
        RbNa rb{rstart - base, (mt < 3) ? mt : 0, (mt < 3) ? mt + 1 : 3};
        f32x4 sc[16]; scores<16>(sc, lds, qf, rb, lane);
        const int cstart = min(max(qc - 8, 0), 48);
#pragma unroll
        for (int t = 0; t < 16; ++t)
#pragma unroll
            for (int r = 0; r < 4; ++r) { const int kr = t >> 1; const int kc = ((t & 1) ? rb.ct1 : rb.ct0) * 16 + 4 * g + r; const bool ok = (kc >= cstart) && (kc < cstart + 16);
                const int ri = rstart + kr - rq + 7; int ci = kc - qc + 15; ci = min(max(ci, 0), 30);
                sc[t][r] = ok ? sc[t][r] + rpl[ri * 31 + ci] : -INFINITY; if (r == 3 && (t & 3) == 3) __builtin_amdgcn_sched_barrier(0); }
        sum[it] = softmax_pack<16>(sc, pf[it], 0.f, false);
    }
    u32x4 vreg[11]; load_rows<11>(vreg, A.qkv + COL_VB + h * 64, base * 64, NA_ROWS, tid);
    __syncthreads();
    store_rows<11, false>(lds, vreg, NA_ROWS, nullptr, tid);
    if (next_unit >= 0) { const int nb = min(max(4 * (next_unit >> 3) - 4, 0), 248); load_rows<11>(kreg, A.qkv + COL_KB + h * 64, nb * 64, NA_ROWS, tid); }
    __syncthreads();
#pragma unroll
    for (int it = 0; it < 2; ++it) { const int mt = 2 * (wid & 1) + it; RbNa rb{rstart - base, (mt < 3) ? mt : 0, (mt < 3) ? mt + 1 : 3};
        pv_store<16>(lds, pf[it], rb, sum[it], A.o + (size_t)qtok[it] * LDO + 512 + h * 64, lane); }
    __syncthreads();
}

__device__ __forceinline__ void attn_phase(ldsp lds, const AttnArgs& A, int vcu, int G, int tid) {
    const int h = vcu & 7;
    u32x4 kreg[11];
#ifndef ATT_REP_WIN
#define ATT_REP_WIN 1
#define ATT_REP_NA 1
#endif
    for (int rw = 0; rw < ATT_REP_WIN; ++rw) {
        const int n = vcu >> 1, kvh = vcu & 1, tok0 = (n - 1) * 128;
        u32x4 kw[7], vw[7];
        load_rows<7>(kw, A.qkv + COL_KA + kvh * 64, tok0, 384, tid);
        load_rows<7>(vw, A.qkv + COL_VA + kvh * 64, tok0, 384, tid);
        store_rows<7, true>(lds, kw, 400, A.kn_a, tid);
        store_rows<7, false>(lds + 400 * KPB, vw, 400, nullptr, tid);
        __syncthreads();
        window_compute(lds, A, vcu, tid);
        __syncthreads();
    }
    for (int rn = 0; rn < ATT_REP_NA; ++rn) {
    { const int b0 = min(max(4 * (vcu >> 3) - 4, 0), 248); load_rows<11>(kreg, A.qkv + COL_KB + h * 64, b0 * 64, NA_ROWS, tid); }
    if (tid < 465) ((LAS float*)(lds + NA_RPB_OFF))[tid] = A.rpb[h * 465 + tid] * LOG2E;
    for (int k = 0; k < 2; ++k) { int t2 = tid; asm volatile("" : "+v"(t2));
        na_unit(lds, A, vcu + 256 * k, (k < 1) ? vcu + 256 * (k + 1) : -1, kreg, t2); }
    }
}
}
namespace ret {
constexpr int SEQ = 16384, LDG = 3072, NCH = 128;
constexpr int COL_Q = 0, COL_K = 512, COL_V = 1024, COL_G = 2048;
constexpr int KPB = 288;
constexpr int VPB = 544;
constexpr int R0 = 0, R1 = 128 * KPB, R2 = 2 * 128 * KPB, RSTAT = R2 + 128 * VPB;
constexpr size_t ST_CHUNK = 128 * 256;

__device__ __forceinline__ unsigned pk2a(float lo, float hi) { unsigned r; asm volatile("v_cvt_pk_bf16_f32 %0, %1, %2" : "=v"(r) : "v"(lo), "v"(hi)); return r; }
struct RetArgs { bf16* G; bf16* ST; const float* l2;   const float* gn; int grp; int dry; bf16* Y; };

template <bool SCALE>
__device__ __forceinline__ void stage128(ldsp dst, const bf16* src, int ld, float a, float b, int tid) {
#pragma unroll
    for (int i = 0; i < 4; ++i) { const int idx = tid + i * 512, row = idx >> 4, ch = idx & 15;
        u32x4 v = *(const u32x4*)(src + (size_t)row * ld + ch * 8);
        if (SCALE) { const float s = ex2(a * (float)row + b);
            v.x = pk2a(bf_lo(v.x) * s, bf_hi(v.x) * s); v.y = pk2a(bf_lo(v.y) * s, bf_hi(v.y) * s); v.z = pk2a(bf_lo(v.z) * s, bf_hi(v.z) * s); v.w = pk2a(bf_lo(v.w) * s, bf_hi(v.w) * s); }
        *(LAS u32x4*)(dst + row * KPB + ch * 16) = v; }
}
__device__ __forceinline__ void stage256(ldsp dst, const bf16* src, int ld, int tid) {
#pragma unroll
    for (int i = 0; i < 8; ++i) { const int idx = tid + i * 512, row = idx >> 5, ch = idx & 31;
        const u32x4 v = *(const u32x4*)(src + (size_t)row * ld + ch * 8);
        *(LAS u32x4*)(dst + row * VPB + ch * 16) = v; }
}
__device__ __forceinline__ bf16x8 trfrag(ldsp X, int pitch, int k0, int n0, int lane) {
    const int g = lane >> 4, q4 = (lane & 15) >> 2, p4 = lane & 3;
    ldsp p = X + (k0 + 8 * g + q4) * pitch + (n0 + 4 * p4) * 2;
    return cat8(vtr(p), vtr(p + 4 * pitch));
}

__device__ __forceinline__ void ld128(u32x4 (&r)[4], const bf16* src, int ld, int tid) {
    const unsigned off0 = (unsigned)(((tid >> 4) * ld + (tid & 15) * 8) * 2);
#pragma unroll
    for (int i = 0; i < 4; ++i) r[i] = *(const u32x4*)((const char*)src + (size_t)i * 32 * ld * 2 + off0);
}
__device__ __forceinline__ void st128(ldsp dst, const u32x4 (&r)[4], int tid) {
    ldsp d0 = dst + (tid >> 4) * KPB + (tid & 15) * 16;
#pragma unroll
    for (int i = 0; i < 4; ++i) *(LAS u32x4*)(d0 + i * 32 * KPB) = r[i];
}
__device__ __forceinline__ void st128s(ldsp dst, const u32x4 (&r)[4], float a, float b, int tid) {
    ldsp d0 = dst + (tid >> 4) * KPB + (tid & 15) * 16;
#pragma unroll
    for (int i = 0; i < 4; ++i) { const int row = (tid >> 4) + 32 * i; const float s = ex2(a * (float)row + b); u32x4 v = r[i];
        v.x = pk2(bf_lo(v.x) * s, bf_hi(v.x) * s); v.y = pk2(bf_lo(v.y) * s, bf_hi(v.y) * s); v.z = pk2(bf_lo(v.z) * s, bf_hi(v.z) * s); v.w = pk2(bf_lo(v.w) * s, bf_hi(v.w) * s);
        *(LAS u32x4*)(d0 + i * 32 * KPB) = v; }
}
__device__ __forceinline__ void ld64(u32x4 (&r)[4], const bf16* src, int ld, int tid) {
    const unsigned off0 = (unsigned)(((tid >> 5) * ld + (tid & 31) * 8) * 2);
#pragma unroll
    for (int i = 0; i < 4; ++i) r[i] = *(const u32x4*)((const char*)src + (size_t)i * 16 * ld * 2 + off0);
}
__device__ __forceinline__ void st64(ldsp dst, const u32x4 (&r)[4], int tid) {
    ldsp d0 = dst + (tid >> 5) * VPB + (tid & 31) * 16;
#pragma unroll
    for (int i = 0; i < 4; ++i) *(LAS u32x4*)(d0 + i * 16 * VPB) = r[i];
}

__device__ __forceinline__ void ret_a_phase(ldsp lds, const RetArgs& A, int vcu, int G, int tid_in) {
    int tid = tid_in;
    const int wid = __builtin_amdgcn_readfirstlane(tid >> 6);
    int u = vcu; if (u >= 512) return;
    u32x4 rk[4], rv0[4], rv1[4];
    { const bf16* rows = A.G + (size_t)(u >> 2) * 128 * LDG; const int hl = u & 3;
      ld128(rk, rows + COL_K + hl * 128, LDG, tid); ld64(rv0, rows + COL_V + hl * 256, LDG, tid); ld64(rv1, rows + (size_t)64 * LDG + COL_V + hl * 256, LDG, tid); }
    for (;;) {
        asm volatile("" : "+v"(tid));
        const int lane = tid & 63, fr = lane & 15, g = lane >> 4;
        const int hl = u & 3, c = u >> 2, h = A.grp * 4 + hl;
        const float l2f = A.l2[h], l2b = A.l2[8 + h];
        st128s(lds + R0, rk, -l2f, 127.0f * l2f, tid);
        st128s(lds + R1, rk, l2b, 0.f, tid);
        st64(lds + R2, rv0, tid); st64(lds + R2 + 64 * VPB, rv1, tid);
        const int un = u + G; const bool has_next = un < 512;
        if (has_next) { const bf16* rows = A.G + (size_t)(un >> 2) * 128 * LDG; const int nhl = un & 3;
            ld128(rk, rows + COL_K + nhl * 128, LDG, tid); ld64(rv0, rows + COL_V + nhl * 256, LDG, tid); ld64(rv1, rows + (size_t)64 * LDG + COL_V + nhl * 256, LDG, tid); }
        __syncthreads();
        for (int dir = 0; dir < 2; ++dir) {
            ldsp Kx = lds + (dir ? R1 : R0);
            f32x4 acc[2][8];
#pragma unroll
            for (int et = 0; et < 2; ++et)
#pragma unroll
                for (int dt = 0; dt < 8; ++dt) acc[et][dt] = (f32x4){0.f, 0.f, 0.f, 0.f};
#pragma unroll
            for (int ks = 0; ks < 4; ++ks) {
                bf16x8 vf[2];
#pragma unroll
                for (int et = 0; et < 2; ++et) vf[et] = trfrag(lds + R2, VPB, 32 * ks, 32 * wid + 16 * et, lane);
#pragma unroll
                for (int dt = 0; dt < 8; ++dt) { const bf16x8 kf = trfrag(Kx, KPB, 32 * ks, 16 * dt, lane);
#pragma unroll
                    for (int et = 0; et < 2; ++et) acc[et][dt] = mfma16(vf[et], kf, acc[et][dt]);
                    if ((dt & 3) == 3) __builtin_amdgcn_sched_barrier(0); }
            }
            bf16* st = A.ST + ((size_t)((dir * 4 + hl) * NCH + c)) * ST_CHUNK; const unsigned soff = (unsigned)((fr * 256 + 32 * wid + 4 * g) * 2);
#pragma unroll
            for (int et = 0; et < 2; ++et)
#pragma unroll
                for (int dt = 0; dt < 8; ++dt) { u32x2 w; w.x = pk2(acc[et][dt][0], acc[et][dt][1]); w.y = pk2(acc[et][dt][2], acc[et][dt][3]);
                    *(u32x2*)((char*)st + (size_t)(16 * dt * 256 + 16 * et) * 2 + soff) = w; }
        }
        __syncthreads();
        if (!has_next) break;
        u = un;
    }
}

__device__ __forceinline__ void ret_b(const RetArgs& A, int vcu, int G, int tid) {
    const int NT = 8 * 16384;
    for (int T = vcu * 512 + tid; T < NT; T += G * 512) {
        const int dh = T >> 14, w = T & 16383, dir = dh >> 2, hl = dh & 3, h = A.grp * 4 + hl;
        const float dec = ex2(128.0f * A.l2[dir * 8 + h]);
        unsigned* p = (unsigned*)(A.ST + (size_t)dh * NCH * ST_CHUNK) + w;
        const ptrdiff_t cs = dir ? -(ptrdiff_t)(ST_CHUNK / 2) : (ptrdiff_t)(ST_CHUNK / 2);
        if (dir) p += (size_t)(NCH - 1) * (ST_CHUNK / 2);
        float s0 = 0.f, s1 = 0.f;
        for (int c = 0; c < NCH; c += 32) {
            unsigned u[32];
#pragma unroll
            for (int k = 0; k < 32; ++k) u[k] = p[(ptrdiff_t)k * cs];
#pragma unroll
            for (int k = 0; k < 32; ++k) { p[(ptrdiff_t)k * cs] = A.dry ? u[k] : pk2(s0, s1); s0 = dec * s0 + bf_lo(u[k]); s1 = dec * s1 + bf_hi(u[k]); }
            p += 32 * cs;
        }
    }
}

constexpr int C_Q = 0, C_KA = 128 * KPB, C_B0 = 2 * 128 * KPB, C_B1 = C_B0 + 64 * VPB, C_STAT = C_B1 + 64 * VPB;
struct CPtrs { const bf16 *q, *k, *v, *sf, *sb; bf16* g; };
__device__ __forceinline__ CPtrs cptrs(const RetArgs& A, int unit) {
    const int hl = unit & 3, c = unit >> 2; bf16* rows = A.G + (size_t)c * 128 * LDG; CPtrs P;
    P.q = rows + COL_Q + hl * 128; P.k = rows + COL_K + hl * 128; P.v = rows + COL_V + hl * 256; P.g = rows + COL_G + hl * 256;
    P.sf = A.ST + ((size_t)((0 * 4 + hl) * NCH + c)) * ST_CHUNK; P.sb = A.ST + ((size_t)((1 * 4 + hl) * NCH + c)) * ST_CHUNK; return P;
}
__device__ __forceinline__ void half_mma(f32x4 (&acc)[2][8], ldsp buf, ldsp Bop, int kofs, int wid, int lane) {
    const int fr = lane & 15, g = lane >> 4;
#pragma unroll
    for (int ks = 0; ks < 2; ++ks) {
        bf16x8 xf[2];
#pragma unroll
        for (int et = 0; et < 2; ++et) xf[et] = trfrag(buf, VPB, 32 * ks, 32 * wid + 16 * et, lane);
#pragma unroll
        for (int it = 0; it < 8; ++it) { const bf16x8 bfrag = *(const LAS bf16x8*)(Bop + (16 * it + fr) * KPB + (kofs + 32 * ks + 8 * g) * 2);
#pragma unroll
            for (int et = 0; et < 2; ++et) acc[et][it] = mfma16(xf[et], bfrag, acc[et][it]);
            if ((it & 3) == 3) __builtin_amdgcn_sched_barrier(0); }
    }
}
__device__ __forceinline__ void ret_c_phase(ldsp lds, const RetArgs& A, int vcu, int G, int tid_in) {
    int tid = tid_in;
    const int wid = __builtin_amdgcn_readfirstlane(tid >> 6);
    int u = vcu; if (u >= 512) return;
    CPtrs P = cptrs(A, u);
    u32x4 r0[4], r1[4], r2[4], r3[4];
    ld128(r0, P.q, LDG, tid); ld128(r1, P.k, LDG, tid); ld64(r2, P.sf, 256, tid); ld64(r3, P.sf + 64 * 256, 256, tid);
    LAS float* stat = (LAS float*)(lds + C_STAT);
    for (;;) {
        asm volatile("" : "+v"(tid));
        const int lane = tid & 63, fr = lane & 15, g = lane >> 4;
        const int un = u + G; const bool has_next = un < 512;
        CPtrs N = P; if (has_next) N = cptrs(A, un);
        const int hl = u & 3, c = u >> 2, h = A.grp * 4 + hl;
        const float l2f = A.l2[h], l2b = A.l2[8 + h];
        st128(lds + C_Q, r0, tid); st128(lds + C_KA, r1, tid);
        ld64(r0, P.sb, 256, tid); ld64(r1, P.sb + 64 * 256, 256, tid);
        __syncthreads();
        f32x4 sa[8];
#pragma unroll
        for (int it = 0; it < 8; ++it) sa[it] = (f32x4){0.f, 0.f, 0.f, 0.f};
#pragma unroll
        for (int ks = 0; ks < 4; ++ks) { const bf16x8 kf = *(const LAS bf16x8*)(lds + C_KA + (16 * wid + fr) * KPB + (32 * ks + 8 * g) * 2);
#pragma unroll
            for (int it = 0; it < 8; ++it) { const bf16x8 qf = *(const LAS bf16x8*)(lds + C_Q + (16 * it + fr) * KPB + (32 * ks + 8 * g) * 2); sa[it] = mfma16(kf, qf, sa[it]); if ((it & 3) == 3) __builtin_amdgcn_sched_barrier(0); } }
        st64(lds + C_B0, r2, tid); ld64(r2, P.v, LDG, tid);
        __syncthreads();
#pragma unroll
        for (int it = 0; it < 8; ++it) { const int i = 16 * it + fr; float v[4];
#pragma unroll
            for (int r = 0; r < 4; ++r) { const int j = 16 * wid + 4 * g + r; const int dl = i - j; const float dm = dl >= 0 ? ex2((float)dl * l2f) : ex2((float)(-dl) * l2b); v[r] = sa[it][r] * dm; }
            u32x2 w; w.x = pk2(v[0], v[1]); w.y = pk2(v[2], v[3]);
            *(LAS u32x2*)(lds + C_KA + i * KPB + (16 * wid + 4 * g) * 2) = w; if (it & 1) __builtin_amdgcn_sched_barrier(0); }
        st64(lds + C_B1, r3, tid); ld64(r3, P.v + (size_t)64 * LDG, LDG, tid);
        f32x4 acc[2][8];
#pragma unroll
        for (int et = 0; et < 2; ++et)
#pragma unroll
            for (int it = 0; it < 8; ++it) acc[et][it] = (f32x4){0.f, 0.f, 0.f, 0.f};
        half_mma(acc, lds + C_B0, lds + C_Q, 0, wid, lane);
        __syncthreads();
        st64(lds + C_B0, r0, tid); if (has_next) ld128(r0, N.q, LDG, tid);
        half_mma(acc, lds + C_B1, lds + C_Q, 64, wid, lane);
        __syncthreads();
#pragma unroll
        for (int it = 0; it < 8; ++it) { const float fi = (float)(16 * it + fr); const float rt = ex2((fi + 1.0f) * l2f - (128.0f - fi) * l2b); acc[0][it] *= rt; acc[1][it] *= rt; }
        st64(lds + C_B1, r1, tid); if (has_next) ld128(r1, N.k, LDG, tid);
        half_mma(acc, lds + C_B0, lds + C_Q, 0, wid, lane);
        __syncthreads();
        st64(lds + C_B0, r2, tid); if (has_next) ld64(r2, N.sf, 256, tid);
        half_mma(acc, lds + C_B1, lds + C_Q, 64, wid, lane);
        __syncthreads();
#pragma unroll
        for (int it = 0; it < 8; ++it) { const float fi = (float)(16 * it + fr); const float sb = ex2((128.0f - fi) * l2b); acc[0][it] *= sb; acc[1][it] *= sb; }
        st64(lds + C_B1, r3, tid); if (has_next) ld64(r3, N.sf + 64 * 256, 256, tid);
        u32x2 gv[8][2]; f32x4 gw[2]; const unsigned goff = (unsigned)((fr * LDG + 32 * wid + 4 * g) * 2);
#pragma unroll
        for (int et = 0; et < 2; ++et) { const int e = 32 * wid + 16 * et + 4 * g; gw[et] = *(const f32x4*)(A.gn + h * 256 + e);
#pragma unroll
            for (int it = 0; it < 8; ++it) gv[it][et] = *(const u32x2*)((const char*)P.g + (size_t)(16 * it * LDG + 16 * et) * 2 + goff); }
        half_mma(acc, lds + C_B0, lds + C_KA, 0, wid, lane);
        __syncthreads();
        half_mma(acc, lds + C_B1, lds + C_KA, 64, wid, lane);
#pragma unroll
        for (int it = 0; it < 8; ++it) { float s1 = 0.f, s2 = 0.f;
#pragma unroll
            for (int et = 0; et < 2; ++et)
#pragma unroll
                for (int r = 0; r < 4; ++r) { const float y = acc[et][it][r]; s1 += y; s2 += y * y; }
            s1 += __shfl_xor(s1, 16); s1 += __shfl_xor(s1, 32); s2 += __shfl_xor(s2, 16); s2 += __shfl_xor(s2, 32);
            if (g == 0) { stat[((16 * it + fr) * 8 + wid) * 2] = s1; stat[((16 * it + fr) * 8 + wid) * 2 + 1] = s2; }
            if (it & 1) __builtin_amdgcn_sched_barrier(0); }
        __syncthreads();
        bf16* yb = A.Y + (size_t)c * 128 * 2048 + h * 256; const unsigned yoff = (unsigned)((fr * 2048 + 32 * wid + 4 * g) * 2);
#pragma unroll
        for (int it = 0; it < 8; ++it) { float s1 = 0.f, s2 = 0.f;
#pragma unroll
            for (int w = 0; w < 8; ++w) { s1 += stat[((16 * it + fr) * 8 + w) * 2]; s2 += stat[((16 * it + fr) * 8 + w) * 2 + 1]; }
            const float mu = s1 * (1.0f / 256.0f); const float var = fmaxf(s2 * (1.0f / 256.0f) - mu * mu, 0.f); const float rs = rsqrtf(var + 1e-5f);
#pragma unroll
            for (int et = 0; et < 2; ++et) { const int e = 32 * wid + 16 * et + 4 * g; const f32x4 y = acc[et][it]; const u32x2 gg = gv[it][et];
                u32x2 w; w.x = pk2(bf_lo(gg.x) * ((y[0] - mu) * rs * gw[et][0]), bf_hi(gg.x) * ((y[1] - mu) * rs * gw[et][1]));
                w.y = pk2(bf_lo(gg.y) * ((y[2] - mu) * rs * gw[et][2]), bf_hi(gg.y) * ((y[3] - mu) * rs * gw[et][3]));
                *(u32x2*)((char*)yb + (size_t)(16 * it * 2048 + 16 * et) * 2 + yoff) = w; }
            __builtin_amdgcn_sched_barrier(0); }
        if (!has_next) break;
        u = un; P = N;
    }
    __syncthreads();
}
}
#define XB_TMO      128
#define XB_XCNT(j)  (256  + 64 * (j))
#define XB_XSUB(j)  (1280 + 64 * (j))
#define XB_XGEN(j)  (2304 + 64 * (j))
#define XB_TOP      3328
#define XB_TOPGEN   3392
#define XCD_BAR_WORDS 3456
#define XB_SPIN_CAP (1u << 18)

__device__ __forceinline__ unsigned xb_ld(unsigned* p)              { return __hip_atomic_load(p, __ATOMIC_RELAXED, __HIP_MEMORY_SCOPE_AGENT); }
__device__ __forceinline__ unsigned xb_add(unsigned* p, unsigned v) { return __hip_atomic_fetch_add(p, v, __ATOMIC_RELAXED, __HIP_MEMORY_SCOPE_AGENT); }
__device__ __forceinline__ unsigned xb_xcc_id() { return (unsigned)__builtin_amdgcn_s_getreg((3 << 11) | 20) & 0xFu; }
#define XB_SPIN(cond, bar) do { unsigned _sp = 0; while (cond) { __builtin_amdgcn_s_sleep(1); \
    if ((++_sp & 255u) == 0u) { if (xb_ld(&(bar)[XB_TMO])) break; if (_sp > XB_SPIN_CAP) { atomicAdd(&(bar)[XB_TMO], 1u); break; } } } } while (0)

struct XcdBarrier {
    unsigned* bar; unsigned x;
    volatile LAS unsigned* st;
};

__device__ __forceinline__ XcdBarrier xcd_barrier_post(unsigned* bar, volatile LAS unsigned* st) {
    XcdBarrier b; b.bar = bar; b.x = xb_xcc_id(); b.st = st;
    if (threadIdx.x == 0) (void)xb_add(&bar[XB_XCNT(b.x)], 1u);
    return b;
}
__device__ __forceinline__ void xcd_barrier_complete(unsigned* bar, unsigned x, unsigned& nloc, unsigned& nx) {
    const unsigned G = gridDim.x * gridDim.y * gridDim.z;
    unsigned sum, cnt, mine, sp = 0u;
    for (;;) {
        sum = 0u; cnt = 0u; mine = 0u;
#pragma unroll
        for (unsigned j = 0; j < 16; ++j) { const unsigned c = xb_ld(&bar[XB_XCNT(j)]); sum += c; cnt += (c > 0u) ? 1u : 0u; mine = (j == x) ? c : mine; }
        if (sum == G) break;
        __builtin_amdgcn_s_sleep(1);
        if ((++sp & 255u) == 0u) { if (xb_ld(&bar[XB_TMO])) break; if (sp > XB_SPIN_CAP) { atomicAdd(&bar[XB_TMO], 1u); break; } }
    }
    nloc = mine > 0u ? mine : 1u; nx = cnt > 0u ? cnt : 1u;
}

__device__ __forceinline__ void xcd_barrier(const XcdBarrier& b) {
    asm volatile("s_waitcnt vmcnt(0)" ::: "memory");
    __syncthreads();
    if (threadIdx.x == 0) {
        unsigned* bar = b.bar;
        __builtin_amdgcn_s_waitcnt(0);
        unsigned nloc = b.st[0], nx = b.st[1];
        if (nloc == 0u) { xcd_barrier_complete(bar, b.x, nloc, nx); b.st[0] = nloc; b.st[1] = nx; }
        const unsigned old = xb_add(&bar[XB_XSUB(b.x)], 1u);
        const unsigned gen = old / nloc;
        if (old + 1u == (gen + 1u) * nloc) {
            __builtin_amdgcn_fence(__ATOMIC_RELEASE, "agent");
            asm volatile("s_waitcnt vmcnt(0)" ::: "memory");
            const unsigned og = xb_add(&bar[XB_TOP], 1u);
            const unsigned tg = og / nx;
            if (og + 1u == (tg + 1u) * nx) xb_add(&bar[XB_TOPGEN], 1u);
            else XB_SPIN(xb_ld(&bar[XB_TOPGEN]) == tg, bar);
            __builtin_amdgcn_fence(__ATOMIC_ACQUIRE, "agent");
            xb_add(&bar[XB_XGEN(b.x)], 1u);
            asm volatile("s_waitcnt vmcnt(0)" ::: "memory");
        } else {
            XB_SPIN(xb_ld(&bar[XB_XGEN(b.x)]) == gen, bar);
            __builtin_amdgcn_fence(__ATOMIC_ACQUIRE, "agent");
            asm volatile("s_waitcnt vmcnt(0)" ::: "memory");
        }
    }
    __syncthreads();
}
constexpr int M_TOK = 16384, DM = 1024, DFF = 4096, N_IN_E = 2304, N_IN_O = 6144;
constexpr size_t MiB = 1u << 20;
constexpr size_t WS_CTL = 0;
constexpr size_t WS_L2 = 4096, WS_SSQ = 512 * 1024;
constexpr int CW_BAR = 4096;
constexpr size_t WS_W_IN_E = 1 * MiB;
constexpr size_t WS_W_OUT_E = WS_W_IN_E + (size_t)N_IN_E * DM * 2;
constexpr size_t WS_W_MLP_IN = WS_W_OUT_E + (size_t)DM * DM * 2;
constexpr size_t WS_W_MLP_OUT = WS_W_MLP_IN + 2 * (size_t)DFF * DM * 2;
constexpr size_t WS_W_IN_O = WS_W_MLP_OUT + 2 * (size_t)DFF * DM * 2;
constexpr size_t WS_W_OUT_O = WS_W_IN_O + (size_t)N_IN_O * DM * 2;
constexpr size_t WS_XB = 56 * MiB;
constexpr size_t WS_BIG = 88 * MiB;
constexpr size_t WS_END = 256 * MiB;
static_assert(WS_W_OUT_O + (size_t)DM * 2048 * 2 <= WS_XB, "weights fit below XB");

constexpr int RING_BYTES = 155648;
constexpr int LDS_BYTES = 159744;

struct Args { const float* in[19]; float* out; unsigned char* ws; int ph_lo, ph_hi; };
typedef const __attribute__((address_space(4))) Args* KArgs;

__device__ __forceinline__ float wave_sum(float v) {
#pragma unroll
    for (int o = 1; o < 64; o <<= 1) v += __shfl_xor(v, o);
    return v;
}
struct WItem { const float* W; int N; bf16* WT; int ldo; int k0, n0, orow0; const float* gain; float nscale; };
constexpr int WI_C0 = 1152, WI_C1 = WI_C0 + 512, WI_C2 = WI_C1 + 2048, WI_C3 = WI_C2 + 2048, WI_C4 = WI_C3 + 2048, WI_C5 = WI_C4 + 2048, WI_C6 = WI_C5 + 3072, WI_C7 = WI_C6 + 1024;
__device__ __forceinline__ void witem_decode(KArgs a, unsigned char* ws, int gi, WItem& d) {
    int item, K, mode = 0; d.gain = nullptr; d.nscale = 1.0f;
    if (gi < WI_C0)      { item = gi;         d.W = a->in[2];  K = DM;  d.N = N_IN_E; d.WT = (bf16*)(ws + WS_W_IN_E); d.gain = a->in[1]; }
    else if (gi < WI_C1) { item = gi - WI_C0; d.W = a->in[9];  K = DM;  d.N = DM;     d.WT = (bf16*)(ws + WS_W_OUT_E); }
    else if (gi < WI_C2) { item = gi - WI_C1; d.W = a->in[17]; K = DM;  d.N = DFF;    d.WT = (bf16*)(ws + WS_W_MLP_IN); d.gain = a->in[16]; }
    else if (gi < WI_C3) { item = gi - WI_C2; d.W = a->in[17] + (size_t)DM * DFF; K = DM; d.N = DFF; d.WT = (bf16*)(ws + WS_W_MLP_IN) + (size_t)DFF * DM; d.gain = a->in[16] + DM; }
    else if (gi < WI_C4) { item = gi - WI_C3; d.W = a->in[18]; K = DFF; d.N = DM;     d.WT = (bf16*)(ws + WS_W_MLP_OUT); }
    else if (gi < WI_C5) { item = gi - WI_C4; d.W = a->in[18] + (size_t)DFF * DM; K = DFF; d.N = DM; d.WT = (bf16*)(ws + WS_W_MLP_OUT) + (size_t)DFF * DM; }
    else if (gi < WI_C6) { item = gi - WI_C5; d.W = a->in[11]; K = DM;  d.N = N_IN_O; d.WT = (bf16*)(ws + WS_W_IN_O); d.gain = a->in[10]; mode = 1; }
    else                 { item = gi - WI_C6; d.W = a->in[15]; K = 2048; d.N = DM;    d.WT = (bf16*)(ws + WS_W_OUT_O); }
    const int nblk = d.N / 32, kb = item / nblk, nb = item % nblk; d.k0 = 64 * kb; d.n0 = 32 * nb; d.orow0 = d.n0; d.ldo = K;
    if (mode == 1) {
        const int n0 = d.n0;
        if (n0 < 1024) { d.orow0 = (n0 >> 9) * 3072 + (n0 & 511); }
        else if (n0 < 2048) { const int nk = n0 - 1024; d.orow0 = (nk >> 9) * 3072 + 512 + (nk & 511); d.nscale = 0.08838834764831845f; }
        else if (n0 < 4096) { const int nv = n0 - 2048; d.orow0 = (nv >> 10) * 3072 + 1024 + (nv & 1023); }
        else { const int ng = n0 - 4096; d.orow0 = (ng >> 10) * 3072 + 2048 + (ng & 1023); }
    }
}
__device__ __forceinline__ void witem_load(const WItem& d, float (&v)[32], int lane) {
#pragma unroll
    for (int i = 0; i < 32; ++i) { const int kk = 2 * i + (lane >> 5); v[i] = d.W[(size_t)(d.k0 + kk) * d.N + d.n0 + (lane & 31)]; }
}
__device__ __forceinline__ void witem_finish(const WItem& d, const float (&v)[32], LAS float* scr, int lane) {
#pragma unroll
    for (int i = 0; i < 32; ++i) { const int kk = 2 * i + (lane >> 5); const float gsc = d.gain ? d.gain[d.k0 + kk] * d.nscale : d.nscale; scr[kk * 33 + (lane & 31)] = v[i] * gsc; }
    asm volatile("s_waitcnt lgkmcnt(0)" ::: "memory");
    const int c = lane & 7;
#pragma unroll
    for (int j = 0; j < 4; ++j) { const int n = (lane >> 3) + 8 * j; const LAS float* s = scr + (8 * c) * 33 + n;
        u32x4 o; o.x = pk2(s[0 * 33], s[1 * 33]); o.y = pk2(s[2 * 33], s[3 * 33]); o.z = pk2(s[4 * 33], s[5 * 33]); o.w = pk2(s[6 * 33], s[7 * 33]);
        *(u32x4*)(d.WT + (size_t)(d.orow0 + n) * d.ldo + d.k0 + 8 * c) = o; }
    asm volatile("s_waitcnt lgkmcnt(0)" ::: "memory");
}
__device__ __forceinline__ void prologue(KArgs a, ldsp lds, int vcu, int G, int tid) {
    const int lane = tid & 63, wave = __builtin_amdgcn_readfirstlane(tid >> 6);
    unsigned char* ws = a->ws;
    LAS float* scr = (LAS float*)(lds + wave * 16384);
    const int gw = vcu * 8 + wave, NGW = G * 8;
    {
        WItem cur, nxt; float va[32], vb[32];
        int gi = gw;
        if (gi < WI_C7) { witem_decode(a, ws, gi, cur); witem_load(cur, va, lane); }
        while (gi < WI_C7) {
            const int g1 = gi + NGW, g2 = gi + 2 * NGW;
            if (g1 < WI_C7) { witem_decode(a, ws, g1, nxt); witem_load(nxt, vb, lane); }
            witem_finish(cur, va, scr, lane);
            if (g1 >= WI_C7) break;
            if (g2 < WI_C7) { witem_decode(a, ws, g2, cur); witem_load(cur, va, lane); }
            witem_finish(nxt, vb, scr, lane);
            gi = g2;
        }
    }
    const float* x = a->in[0]; bf16* XB = (bf16*)(ws + WS_XB); float* ssq = (float*)(ws + WS_SSQ);
    for (int m = gw; m < M_TOK; m += 2 * NGW) {
        const int m2 = m + NGW;
        const f32x4* xr0 = (const f32x4*)(x + (size_t)m * DM) + lane; const f32x4* xr1 = (const f32x4*)(x + (size_t)m2 * DM) + lane;
        f32x4 v0[4], v1[4];
#pragma unroll
        for (int j = 0; j < 4; ++j) { v0[j] = xr0[64 * j]; v1[j] = xr1[64 * j]; }
        unsigned long long* o0 = (unsigned long long*)(XB + (size_t)m * DM) + lane; unsigned long long* o1 = (unsigned long long*)(XB + (size_t)m2 * DM) + lane;
        float s0 = 0.f, s1 = 0.f;
#pragma unroll
        for (int j = 0; j < 4; ++j) { s0 += (v0[j][0] * v0[j][0] + v0[j][1] * v0[j][1]) + (v0[j][2] * v0[j][2] + v0[j][3] * v0[j][3]);
            s1 += (v1[j][0] * v1[j][0] + v1[j][1] * v1[j][1]) + (v1[j][2] * v1[j][2] + v1[j][3] * v1[j][3]);
            o0[64 * j] = (unsigned long long)pk2(v0[j][0], v0[j][1]) | ((unsigned long long)pk2(v0[j][2], v0[j][3]) << 32);
            o1[64 * j] = (unsigned long long)pk2(v1[j][0], v1[j][1]) | ((unsigned long long)pk2(v1[j][2], v1[j][3]) << 32); }
        s0 = wave_sum(s0); s1 = wave_sum(s1);
        if (lane == 0) { *(f32x4*)(ssq + 4 * (size_t)m) = (f32x4){s0, 0.f, 0.f, 0.f}; *(f32x4*)(ssq + 4 * (size_t)m2) = (f32x4){s1, 0.f, 0.f, 0.f}; }
    }
    if (vcu == 0 && tid < 16) { const float d = (tid < 8 ? a->in[12] : a->in[13])[tid & 7]; const float e = __expf(-d);
        const float l1p = (e < 0.0625f) ? e * (1.0f - e * (0.5f - e * ((1.0f / 3.0f) - e * (0.25f - e * 0.2f)))) : __logf(1.0f + e);
        ((float*)(ws + WS_L2))[tid] = -l1p * LOG2E; }
}

#ifndef DBG_DUMP
#define DBG_DUMP 0
#endif
#ifndef REP_PH
#define REP_PH (-1)
#define REP_N 0
#endif
#ifndef REP_COND
#define REP_COND true
#endif
#ifndef DBG_STRIDE
#define DBG_STRIDE 1
#endif
#ifndef DBG_HI
#define DBG_HI PH_COUNT
#endif
#ifndef DBG_LO
#define DBG_LO 0
#endif
#ifndef DBG_AOFF
#define DBG_AOFF 2048
#endif
#ifndef DBG_LDA
#define DBG_LDA 3072
#endif
#ifndef DBG_LDB
#define DBG_LDB 2048
#endif
#ifndef DBG_K
#define DBG_K 1024
#endif
enum { PH_PRO = 0, PH_IN_E, PH_ATTN, PH_OUT_E, PH_MLP_IN0, PH_MLP_OUT0, PH_IN_O0, PH_RA0, PH_RB0, PH_RC0, PH_IN_O1, PH_RA1, PH_RB1, PH_RC1, PH_OUT_O, PH_MLP_IN1, PH_MLP_OUT1, PH_COUNT };

__global__ void __launch_bounds__(512, 2) mk_fwd(Args a_unused) {
    extern __shared__ __attribute__((aligned(16))) unsigned char lds_raw[];
    cg::grid_group grid = cg::this_grid();
    const ldsp lds = (ldsp)lds_raw;
    volatile LAS unsigned* MISC = (volatile LAS unsigned*)(lds + RING_BYTES);
    if (threadIdx.x < 32) MISC[threadIdx.x] = 0u;
    __syncthreads();
    const XcdBarrier bar = xcd_barrier_post((unsigned*)(((KArgs)__builtin_amdgcn_kernarg_segment_ptr())->ws + WS_CTL) + CW_BAR, MISC + 8);
    const int G = gridDim.x;
    int repcnt = 0;
    const int ph_lo = ((KArgs)__builtin_amdgcn_kernarg_segment_ptr())->ph_lo, ph_hi = ((KArgs)__builtin_amdgcn_kernarg_segment_ptr())->ph_hi;
    for (int ph = ph_lo; ph < ph_hi; ++ph) {
        const __attribute__((address_space(4))) char* kp = (const __attribute__((address_space(4))) char*)__builtin_amdgcn_kernarg_segment_ptr();
        asm volatile("" : "+s"(kp));
        KArgs a = (KArgs)kp;
        unsigned char* ws = a->ws;
        bf16* XB = (bf16*)(ws + WS_XB); float* ssq = (float*)(ws + WS_SSQ);
        bf16* BIG = (bf16*)(ws + WS_BIG);
        bf16* QKV = BIG; bf16* OE = BIG + (size_t)M_TOK * N_IN_E; bf16* HM = BIG; bf16* GB = BIG; bf16* ST = BIG + (size_t)M_TOK * 3072;
        int tid = threadIdx.x, bx = blockIdx.x;
        asm volatile("" : "+v"(tid)); asm volatile("" : "+s"(bx));
        const int vcu = (G % 8 == 0) ? (bx % 8) * (G / 8) + bx / 8 : bx;
        if (ph == PH_PRO) { prologue(a, lds, vcu, G, tid); }
        else if (ph == PH_ATTN) {
            att::AttnArgs A{QKV, OE, a->in[3], a->in[4], a->in[5], a->in[6], a->in[7], a->in[8]};
            att::attn_phase(lds, A, vcu, G, tid);
        }
        else if (ph == PH_RA0 || ph == PH_RA1 || ph == PH_RB0 || ph == PH_RB1 || ph == PH_RC0 || ph == PH_RC1) {
            ret::RetArgs R{GB, ST, (const float*)(ws + WS_L2), a->in[14], (ph >= PH_IN_O1) ? 1 : 0, (REP_N > 0 && ph == REP_PH && repcnt > 0) ? 1 : 0, (bf16*)a->out};
            if (ph == PH_RA0 || ph == PH_RA1) { ret::ret_a_phase(lds, R, vcu, G, tid); }
            else if (ph == PH_RB0 || ph == PH_RB1) { ret::ret_b(R, vcu, G, tid); }
            else { ret::ret_c_phase(lds, R, vcu, G, tid); }
        }
        else if (ph == PH_IN_E || ph == PH_MLP_IN0 || ph == PH_MLP_IN1 || ph == PH_IN_O0 || ph == PH_IN_O1) {
            const bf16* Bt; int N, act, silu0; bf16* O;
            if (ph == PH_IN_E)           { Bt = (const bf16*)(ws + WS_W_IN_E); N = N_IN_E; O = QKV; act = 0; silu0 = 1 << 30; }
            else if (ph == PH_MLP_IN0)   { Bt = (const bf16*)(ws + WS_W_MLP_IN); N = DFF; O = HM; act = 1; silu0 = 1 << 30; }
            else if (ph == PH_MLP_IN1)   { Bt = (const bf16*)(ws + WS_W_MLP_IN) + (size_t)DFF * DM; N = DFF; O = HM; act = 1; silu0 = 1 << 30; }
            else if (ph == PH_IN_O0)     { Bt = (const bf16*)(ws + WS_W_IN_O); N = 3072; O = GB; act = 2; silu0 = 8; }
            else                         { Bt = (const bf16*)(ws + WS_W_IN_O) + (size_t)3072 * DM; N = 3072; O = GB; act = 2; silu0 = 8; }
            pg8::Gemm g; g.A = XB; g.Bt = Bt; g.lda = DM; g.ldb = DM; g.M = M_TOK; g.N = N; g.K = DM;
            pg8::EpiBf16 E; E.O = O; E.ldc = N; E.ssq = ssq; E.silu_pn0 = silu0; E.act = act;
            pg8::StaticOrder S; S.init(M_TOK, N, G, bx);
            pg8::gemm_phase<pg8::EpiBf16, pg8::StaticOrder, true, true>(lds, g, S, E, tid);
        }
        else {
            const bf16* A; const bf16* Bt; int lda, ldb, K; const float* basef; const bf16* baseb; float* outf; bf16* xb; float* sso;
            if (ph == PH_OUT_E)          { A = OE; lda = DM; K = DM; Bt = (const bf16*)(ws + WS_W_OUT_E); ldb = DM; basef = a->in[0]; baseb = nullptr; outf = nullptr; xb = XB; sso = ssq; }
            else if (ph == PH_MLP_OUT0)  { A = HM; lda = DFF; K = DFF; Bt = (const bf16*)(ws + WS_W_MLP_OUT); ldb = DFF; basef = nullptr; baseb = XB; outf = nullptr; xb = XB; sso = ssq; }
            else if (ph == PH_MLP_OUT1)  { A = HM; lda = DFF; K = DFF; Bt = (const bf16*)(ws + WS_W_MLP_OUT) + (size_t)DFF * DM; ldb = DFF; basef = nullptr; baseb = XB; outf = a->out; xb = nullptr; sso = nullptr; }
            else                         { A = (const bf16*)a->out; lda = 2048; K = 2048; Bt = (const bf16*)(ws + WS_W_OUT_O); ldb = 2048; basef = nullptr; baseb = XB; outf = nullptr; xb = XB; sso = ssq; }
            pg8::Gemm g; g.A = A; g.Bt = Bt; g.lda = lda; g.ldb = ldb; g.M = M_TOK; g.N = DM; g.K = K;
            pg8::EpiResid E; E.basef = basef; E.baseb = baseb; E.outf = outf; E.xb = xb; E.ssq_out = sso; E.ldc = DM;
            E.accscale = (REP_N > 0 && ph == REP_PH && repcnt > 0 && ph != PH_OUT_E && ph != PH_MLP_OUT1) ? 0.f : 1.f;
            pg8::StaticOrder S; S.init(M_TOK, DM, G, bx);
            pg8::gemm_phase<pg8::EpiResid, pg8::StaticOrder, false, true>(lds, g, S, E, tid);
        }
        if (ph + 1 == ph_hi && DBG_DUMP) {
            xcd_barrier(bar);
            const bf16* srcb = (DBG_DUMP == 1) ? GB : ST;
            for (size_t i = (size_t)bx * 512 + tid; i < (size_t)M_TOK * DM; i += (size_t)G * 512) a->out[i] = bf_lo((unsigned)srcb[i * DBG_STRIDE]);
        }
        if (ph + 1 < ph_hi) {
            if (ph_lo < 0) {
                asm volatile("s_waitcnt vmcnt(0)" ::: "memory");
                grid.sync();
                __builtin_amdgcn_fence(__ATOMIC_ACQUIRE, "agent");
                asm volatile("s_waitcnt vmcnt(0)" ::: "memory");
                __syncthreads();
            }
            xcd_barrier(bar);
        }
        if (REP_N > 0 && ph == REP_PH && repcnt < REP_N && REP_COND) { ++repcnt; --ph; }
    }
}

extern "C" void kernel_launch(void* const* d_in, const int* in_sizes, int n_in, void* d_out, int out_size, void* d_ws, size_t ws_size, hipStream_t stream) {
    static int grid = 0;
    if (grid == 0) {
        int dev = 0, cus = 0, per_cu = 0;
        (void)hipGetDevice(&dev);
        (void)hipDeviceGetAttribute(&cus, hipDeviceAttributeMultiprocessorCount, dev);
        (void)hipFuncSetAttribute((const void*)mk_fwd, hipFuncAttributeMaxDynamicSharedMemorySize, LDS_BYTES);
        (void)hipOccupancyMaxActiveBlocksPerMultiprocessor(&per_cu, (const void*)mk_fwd, 512, LDS_BYTES);
        grid = (n_in == 19 && per_cu >= 1 && cus == 256 && ws_size >= WS_END && out_size == M_TOK * DM) ? 256 : -1;
        if (grid < 0) fprintf(stderr, "kernel_launch: unsupported configuration (cus %d per_cu %d ws %zu n_in %d)\n", cus, per_cu, ws_size, n_in);
    }
    if (grid < 0) return;
    if (hipMemsetAsync((char*)d_ws + WS_CTL, 0, 65536, stream) != hipSuccess) { fprintf(stderr, "kernel_launch: memset failed\n"); return; }
    Args a{};
    for (int i = 0; i < 19; ++i) a.in[i] = (const float*)d_in[i];
    a.out = (float*)d_out; a.ws = (unsigned char*)d_ws; a.ph_lo = DBG_LO; a.ph_hi = DBG_HI;
    void* args[] = {&a};
#ifdef PLAIN_LAUNCH
    hipError_t e = hipLaunchKernel((void*)mk_fwd, dim3(grid), dim3(512), args, LDS_BYTES, stream);
#else
    hipError_t e = hipLaunchCooperativeKernel((void*)mk_fwd, dim3(grid), dim3(512), args, LDS_BYTES, stream);
#endif
    if (e != hipSuccess) fprintf(stderr, "cooperative launch failed: %s\n", hipGetErrorString(e));
}
```

```cpp
#include <hip/hip_runtime.h>
#include <hip/hip_cooperative_groups.h>
#include <cstdio>
#include <cstdint>
#include <cmath>
namespace cg = cooperative_groups;
#define REP_N 0
#define REP_PH (-1)
namespace pg8 {
#define PG8_LAS __attribute__((address_space(3)))
typedef unsigned short bf16_t;
typedef short bf16x8 __attribute__((ext_vector_type(8)));
typedef float f32x4 __attribute__((ext_vector_type(4)));
typedef float f32x2 __attribute__((ext_vector_type(2)));
typedef unsigned u32x4 __attribute__((ext_vector_type(4)));
typedef unsigned u32x2 __attribute__((ext_vector_type(2)));
constexpr int BM = 256, BK = 64, HALF = 128, HTB = HALF * BK * 2  , STAGE_BYTES = 8 * HTB, NXCD = 8, WGM = 8;

__host__ __device__ __forceinline__ int lds_byte(int r, int c) { const int st = (r >> 4) * 2 + (c >> 5), rr = r & 15, cc = c & 31, ob = rr * 64 + cc * 2; return st * 1024 + (ob ^ (((ob >> 9) & 1) << 5)); }
__host__ __device__ __forceinline__ void stage_rc(int b, int& R, int& C) { const int st = b / 1024, sb = b % 1024, swz = sb ^ (((sb >> 9) & 1) << 5); R = (st >> 1) * 16 + swz / 64; C = (st & 1) * 32 + (swz % 64) / 2; }
__host__ __device__ __forceinline__ int perm32(int rho) { const int n = rho >> 4, i = rho & 15; return 8 * (i >> 2) + 4 * n + (i & 3); }

struct Unit { int pm, pn; };
struct Gemm { const bf16_t* A; const bf16_t* Bt; int lda, ldb, M, N, K; };

struct StaticOrder {
    int nM, nN, nwg, G, c;
    __host__ __device__ void init(int M, int N, int G_, int c_) { nM = M / BM; nN = N / BM; nwg = nM * nN; G = G_; c = c_; }
    __host__ __device__ bool next(int i, Unit& u) const {
        const long L = (long)i * G + c; if (L >= nwg) return false;
        int wgid = (int)L; { const int q = nwg / NXCD, r = nwg % NXCD, xcd = wgid % NXCD, off = wgid / NXCD; wgid = (xcd < r ? xcd * (q + 1) : r * (q + 1) + (xcd - r) * q) + off; }
        const int nig = WGM * nN, gid = wgid / nig, fm = gid * WGM, gsz = (nM - fm) < WGM ? (nM - fm) : WGM;
        u.pm = fm + ((wgid % nig) % gsz); u.pn = (wgid % nig) / gsz; return true;
    }
};

typedef float f32x2_cv __attribute__((ext_vector_type(2))); typedef __bf16 bf16x2_cv __attribute__((ext_vector_type(2)));
__device__ __forceinline__ unsigned cvt_pk_bf16(float lo, float hi) { const f32x2_cv v = {lo, hi}; const bf16x2_cv b = __builtin_convertvector(v, bf16x2_cv); return __builtin_bit_cast(unsigned, b); }


__device__ __forceinline__ float row_rstd(const float* ssq, int row) { const f32x4 p = *(const f32x4*)(ssq + 4 * (size_t)row); return rsqrtf(((p[0] + p[1]) + (p[2] + p[3])) * (1.0f / 1024.0f) + 1e-6f); }

struct EpiBf16 {
    static constexpr bool PERM = true, AFTER_DRAIN = false;
    bf16_t* O; int ldc; const float* ssq; int silu_pn0; int act;
    __device__ __forceinline__ void operator()(const f32x4 (&acc)[2][2][4][2], const Unit& u, int wr, int wc, int fr, int fq) const {
        const int row0 = u.pm * BM + wr * 64 + fr; const int col0 = u.pn * BM + wc * 32 + 8 * fq;
        const bool do_silu = (act == 2) && (u.pn >= silu_pn0);
#if 1
        const __amdgpu_buffer_rsrc_t rsrc = __builtin_amdgcn_make_buffer_rsrc((void*)O, 0, 0x7fffffff, 0x00020000);
#endif
#pragma unroll
        for (int ai = 0; ai < 2; ++ai)
#pragma unroll
            for (int m = 0; m < 4; ++m) { const int row = row0 + ai * HALF + m * 16; const float rs = row_rstd(ssq, row); bf16_t* rowp = O + (size_t)row * ldc + col0;
#pragma unroll
                for (int bj = 0; bj < 2; ++bj) { f32x4 v0 = acc[ai][bj][m][0] * rs, v1 = acc[ai][bj][m][1] * rs;
                    if (act == 1) {
#pragma unroll
                        for (int e = 0; e < 4; ++e) { const float a = fmaxf(v0[e], 0.f), b = fmaxf(v1[e], 0.f); v0[e] = a * a; v1[e] = b * b; } }
                    if (do_silu) {
#pragma unroll
                        for (int e = 0; e < 4; ++e) { v0[e] = v0[e] / (1.0f + __expf(-v0[e])); v1[e] = v1[e] / (1.0f + __expf(-v1[e])); } }
                    u32x4 w; w.x = cvt_pk_bf16(v0[0], v0[1]); w.y = cvt_pk_bf16(v0[2], v0[3]); w.z = cvt_pk_bf16(v1[0], v1[1]); w.w = cvt_pk_bf16(v1[2], v1[3]);
#if 1
                    __builtin_amdgcn_raw_buffer_store_b128(w, rsrc, (unsigned)(((size_t)row * ldc + col0 + bj * HALF) * 2), 0, 16);
#else
                    *(u32x4*)(rowp + bj * HALF) = w;
#endif
                    } }
    }
};

struct EpiResid {
    static constexpr bool PERM = false, AFTER_DRAIN = true;
    const float* basef; const bf16_t* baseb; float* outf; bf16_t* xb; float* ssq_out; int ldc; float accscale;
    __device__ __forceinline__ void fused(f32x4 (&acc)[2][2][4][2], const Unit& u, int wr, int wc, int fr, int fq, PG8_LAS unsigned char* lds, int wid, int lane) const {
        PG8_LAS float* P = (PG8_LAS float*)lds;
        const int col0 = u.pn * BM + wc * 32 + 4 * fq;
#pragma unroll
        for (int ai = 0; ai < 2; ++ai)
#pragma unroll
            for (int m = 0; m < 4; ++m) { const int r = ai * HALF + wr * 64 + m * 16 + fr; const size_t off = (size_t)(u.pm * BM + r) * ldc + col0; float s = 0.f;
#pragma unroll
                for (int bj = 0; bj < 2; ++bj)
#pragma unroll
                    for (int n = 0; n < 2; ++n) { const size_t o2 = off + bj * HALF + n * 16; f32x4 bs;
                        if (basef) bs = *(const f32x4*)(basef + o2);
                        else { const u32x2 b = *(const u32x2*)(baseb + o2); bs = (f32x4){__uint_as_float(b.x << 16), __uint_as_float(b.x & 0xffff0000u), __uint_as_float(b.y << 16), __uint_as_float(b.y & 0xffff0000u)}; }
                        const f32x4 o = bs + acc[ai][bj][m][n] * accscale;
                        if (outf) *(f32x4*)(outf + o2) = o;
                        if (xb) { u32x2 w; w.x = cvt_pk_bf16(o[0], o[1]); w.y = cvt_pk_bf16(o[2], o[3]); *(u32x2*)(xb + o2) = w; }
                        s += (o[0] * o[0] + o[1] * o[1]) + (o[2] * o[2] + o[3] * o[3]); }
                if (ssq_out) { s += __shfl_xor(s, 16); s += __shfl_xor(s, 32); if (fq == 0) P[r * 4 + wc] = s; }
                if (m & 1) asm volatile("" ::: "memory"); }
        if (ssq_out) {
            __syncthreads();
            const int t = wid * 64 + lane;
            if (t < 256) { const float s = (P[t * 4 + 0] + P[t * 4 + 1]) + (P[t * 4 + 2] + P[t * 4 + 3]); ssq_out[(size_t)(u.pm * BM + t) * 4 + u.pn] = s; }
            __syncthreads();
        }
    }
};

template <class Epi, class Sched, bool ALIGN_EPI = false, bool SP2 = false>
__device__ __forceinline__ void gemm_phase(PG8_LAS unsigned char* lds, const Gemm g, const Sched& S, const Epi& E, const int tid) {
    const int wid = __builtin_amdgcn_readfirstlane(tid >> 6), lane = tid & 63, wr = wid >> 2, wc = wid & 3, fr = lane & 15, fq = lane >> 4;
    const int K = g.K, nt = K / BK;
    unsigned voffA[2], voffB[2];
#pragma unroll
    for (int i = 0; i < 2; ++i) { int R, C; stage_rc(tid * 16 + i * 8192, R, C); const int Rb = Epi::PERM ? ((R & ~31) + perm32(R & 31)) : R;
        voffA[i] = (unsigned)(R * g.lda + C) * 2u; voffB[i] = (unsigned)(Rb * g.ldb + C) * 2u; }
    const size_t kstep = (size_t)(BK * 2);
    const size_t hstepA = (size_t)HALF * g.lda * 2, hstepB = (size_t)HALF * g.ldb * 2;
    const size_t tstepA = 2 * hstepA, tstepB = 2 * hstepB;
    const unsigned ldsw = (unsigned)wid * 1024u;
    const int aoff = lds_byte(wr * 64 + fr, fq * 8), boff = lds_byte(wc * 32 + fr, fq * 8);
#define PG8_SA(b, h) (((b) * 2 + (h)) * HTB)
#define PG8_SB(b, h) ((4 + (b) * 2 + (h)) * HTB)
#define PG8_STAGE(bufoff, gbase, voff) do { _Pragma("unroll") for (int _i = 0; _i < 2; ++_i) \
        __builtin_amdgcn_global_load_lds((const unsigned*)((const char*)(gbase) + (voff)[_i]), (PG8_LAS unsigned*)(lds + (bufoff) + ldsw + _i * 8192), 16, 0, 0); } while (0)
#define PG8_LDA(dst, b, h) do { _Pragma("unroll") for (int m = 0; m < 4; ++m) _Pragma("unroll") for (int k = 0; k < 2; ++k) dst[m][k] = *(const PG8_LAS bf16x8*)(lds + PG8_SA(b, h) + aoff + m * 2048 + k * 1024); } while (0)
#define PG8_LDB(dst, b, h) do { _Pragma("unroll") for (int n = 0; n < 2; ++n) _Pragma("unroll") for (int k = 0; k < 2; ++k) dst[n][k] = *(const PG8_LAS bf16x8*)(lds + PG8_SB(b, h) + boff + n * 2048 + k * 1024); } while (0)
#define PG8_MMA(ai, bj, At, Bt) do { __builtin_amdgcn_s_setprio(1); _Pragma("unroll") for (int m = 0; m < 4; ++m) _Pragma("unroll") for (int n = 0; n < 2; ++n) _Pragma("unroll") for (int k = 0; k < 2; ++k) \
        acc[ai][bj][m][n] = __builtin_amdgcn_mfma_f32_16x16x32_bf16(Bt[n][k], At[m][k], acc[ai][bj][m][n], 0, 0, 0); __builtin_amdgcn_s_setprio(0); } while (0)
#define PG8_WAIT_V(n) asm volatile("s_waitcnt vmcnt(" #n ")" ::: "memory")
#define PG8_WAIT_L(n) asm volatile("s_waitcnt lgkmcnt(" #n ")" ::: "memory")
#define PG8_BAR __builtin_amdgcn_s_barrier()
#define PG8_SCHED __builtin_amdgcn_sched_barrier(0)
    Unit cur, nxt; int ui = 0;
    if (!S.next(0, cur)) return;
    f32x4 acc[2][2][4][2];
#pragma unroll
    for (int a = 0; a < 2; ++a)
#pragma unroll
        for (int b = 0; b < 2; ++b)
#pragma unroll
            for (int m = 0; m < 4; ++m)
#pragma unroll
                for (int n = 0; n < 2; ++n) acc[a][b][m][n] = (f32x4){0.f, 0.f, 0.f, 0.f};
    bf16x8 At[4][2], B0[2][2], B1[2][2];
    const char* cA = (const char*)g.A + (size_t)cur.pm * tstepA; const char* cB = (const char*)g.Bt + (size_t)cur.pn * tstepB;
    if constexpr (SP2) {
        PG8_STAGE(PG8_SB(0, 0), cB, voffB); PG8_STAGE(PG8_SB(0, 1), cB + hstepB, voffB); PG8_STAGE(PG8_SA(0, 0), cA, voffA); PG8_STAGE(PG8_SA(0, 1), cA + hstepA, voffA);
        if (wr == 1) PG8_BAR;
        PG8_WAIT_V(2); PG8_BAR;
        PG8_STAGE(PG8_SB(1, 0), cB + kstep, voffB); PG8_STAGE(PG8_SA(1, 0), cA + kstep, voffA); PG8_STAGE(PG8_SB(1, 1), cB + hstepB + kstep, voffB);
        PG8_WAIT_V(6); PG8_BAR;
    } else {
        PG8_STAGE(PG8_SB(0, 0), cB, voffB); PG8_STAGE(PG8_SA(0, 0), cA, voffA); PG8_STAGE(PG8_SB(0, 1), cB + hstepB, voffB); PG8_STAGE(PG8_SA(0, 1), cA + hstepA, voffA);
        if (wr == 1) PG8_BAR;
        PG8_WAIT_V(4); PG8_BAR;
        PG8_STAGE(PG8_SB(1, 0), cB + kstep, voffB); PG8_STAGE(PG8_SA(1, 0), cA + kstep, voffA); PG8_STAGE(PG8_SB(1, 1), cB + hstepB + kstep, voffB);
        PG8_WAIT_V(6); PG8_BAR;
    }
    for (;;) {
        const bool has_next = S.next(ui + 1, nxt);
        const char* nA = has_next ? (const char*)g.A + (size_t)nxt.pm * tstepA : cA; const char* nB = has_next ? (const char*)g.Bt + (size_t)nxt.pn * tstepB : cB;
        for (int t = 0; t < nt; t += 2) {
            const bool last = (t == nt - 2);
            const char* a1 = cA + (size_t)(t + 1) * kstep;
            const char* a2 = last ? nA : cA + (size_t)(t + 2) * kstep; const char* b2 = last ? nB : cB + (size_t)(t + 2) * kstep;
            const char* a3 = a2 + kstep; const char* b3 = b2 + kstep;
            if constexpr (SP2) {
            PG8_LDB(B0, 0, 0); PG8_LDB(B1, 0, 1); PG8_SCHED; PG8_LDA(At, 0, 0); PG8_STAGE(PG8_SA(1, 1), a1 + hstepA, voffA);
            PG8_WAIT_V(8); PG8_WAIT_L(0); PG8_BAR; PG8_MMA(0, 0, At, B0); PG8_MMA(0, 1, At, B1); PG8_BAR; PG8_SCHED;
            PG8_LDA(At, 0, 1); PG8_STAGE(PG8_SB(0, 0), b2, voffB); PG8_STAGE(PG8_SB(0, 1), b2 + hstepB, voffB); PG8_STAGE(PG8_SA(0, 0), a2, voffA);
            PG8_WAIT_V(8); PG8_WAIT_L(0); PG8_BAR; PG8_MMA(1, 0, At, B0); PG8_MMA(1, 1, At, B1); PG8_BAR; PG8_SCHED;
            PG8_LDB(B0, 1, 0); PG8_LDB(B1, 1, 1); PG8_SCHED; PG8_LDA(At, 1, 0); PG8_STAGE(PG8_SA(0, 1), a2 + hstepA, voffA);
            PG8_WAIT_V(8); PG8_WAIT_L(0); PG8_BAR; PG8_MMA(0, 0, At, B0); PG8_MMA(0, 1, At, B1); PG8_BAR; PG8_SCHED;
            PG8_LDA(At, 1, 1); PG8_STAGE(PG8_SB(1, 0), b3, voffB); PG8_STAGE(PG8_SB(1, 1), b3 + hstepB, voffB); PG8_STAGE(PG8_SA(1, 0), a3, voffA);
            PG8_WAIT_V(8); PG8_WAIT_L(0); PG8_BAR; PG8_MMA(1, 0, At, B0); PG8_MMA(1, 1, At, B1); PG8_BAR; PG8_SCHED;
            } else {
            PG8_LDB(B0, 0, 0); PG8_SCHED; PG8_LDA(At, 0, 0); PG8_STAGE(PG8_SA(1, 1), a1 + hstepA, voffA);
            PG8_WAIT_L(8); PG8_BAR; PG8_WAIT_L(0); PG8_MMA(0, 0, At, B0); PG8_BAR; PG8_SCHED;
            PG8_LDB(B1, 0, 1); PG8_STAGE(PG8_SB(0, 0), b2, voffB);
            PG8_BAR; PG8_WAIT_L(0); PG8_MMA(0, 1, At, B1); PG8_BAR;
            PG8_LDA(At, 0, 1); PG8_STAGE(PG8_SA(0, 0), a2, voffA);
            PG8_BAR; PG8_WAIT_L(0); PG8_MMA(1, 0, At, B0); PG8_BAR; PG8_SCHED;
            PG8_STAGE(PG8_SB(0, 1), b2 + hstepB, voffB);
            PG8_WAIT_V(6); PG8_BAR; PG8_MMA(1, 1, At, B1); PG8_BAR;
            PG8_LDB(B0, 1, 0); PG8_SCHED; PG8_LDA(At, 1, 0); PG8_STAGE(PG8_SA(0, 1), a2 + hstepA, voffA);
            PG8_WAIT_L(8); PG8_BAR; PG8_WAIT_L(0); PG8_MMA(0, 0, At, B0); PG8_BAR; PG8_SCHED;
            PG8_LDB(B1, 1, 1); PG8_STAGE(PG8_SB(1, 0), b3, voffB);
            PG8_BAR; PG8_WAIT_L(0); PG8_MMA(0, 1, At, B1); PG8_BAR;
            PG8_LDA(At, 1, 1); PG8_STAGE(PG8_SA(1, 0), a3, voffA);
            PG8_BAR; PG8_WAIT_L(0); PG8_MMA(1, 0, At, B0); PG8_BAR; PG8_SCHED;
            PG8_STAGE(PG8_SB(1, 1), b3 + hstepB, voffB);
            PG8_WAIT_V(6); PG8_BAR; PG8_MMA(1, 1, At, B1); PG8_BAR;
            }
        }
        if constexpr (ALIGN_EPI) { if (wr == 0) PG8_BAR; }
        if constexpr (!Epi::AFTER_DRAIN) { E(acc, cur, wr, wc, fr, fq); }
        if (!has_next) break;
#pragma unroll
        for (int a = 0; a < 2; ++a)
#pragma unroll
            for (int b = 0; b < 2; ++b)
#pragma unroll
                for (int m = 0; m < 4; ++m)
#pragma unroll
                    for (int n = 0; n < 2; ++n) acc[a][b][m][n] = (f32x4){0.f, 0.f, 0.f, 0.f};
        cur = nxt; cA = nA; cB = nB; ++ui;
        if constexpr (ALIGN_EPI) { if (wr == 1) PG8_BAR; }
    }
    PG8_WAIT_V(0);
    if constexpr (!ALIGN_EPI) { if (wr == 0) PG8_BAR; }
    PG8_BAR;
    if constexpr (Epi::AFTER_DRAIN) { E.fused(acc, cur, wr, wc, fr, fq, lds, wid, lane); }
#undef PG8_SA
#undef PG8_SB
#undef PG8_STAGE
#undef PG8_LDA
#undef PG8_LDB
#undef PG8_MMA
#undef PG8_WAIT_V
#undef PG8_WAIT_L
#undef PG8_BAR
#undef PG8_SCHED
}
}
#define LAS __attribute__((address_space(3)))
typedef unsigned short bf16;
typedef short bf16x8 __attribute__((ext_vector_type(8)));
typedef short s16x4 __attribute__((ext_vector_type(4)));
typedef float f32x4 __attribute__((ext_vector_type(4)));
typedef unsigned u32x4 __attribute__((ext_vector_type(4)));
typedef unsigned u32x2 __attribute__((ext_vector_type(2)));
typedef LAS unsigned char* ldsp;
constexpr float LOG2E = 1.4426950408889634f;

__device__ __forceinline__ float bf_lo(unsigned w) { return __uint_as_float(w << 16); }
__device__ __forceinline__ float bf_hi(unsigned w) { return __uint_as_float(w & 0xffff0000u); }
__device__ __forceinline__ unsigned pk2(float lo, float hi) { return pg8::cvt_pk_bf16(lo, hi); }
__device__ __forceinline__ s16x4 vtr(ldsp p) { typedef short v4i16_t __attribute__((ext_vector_type(4))); return __builtin_bit_cast(s16x4, __builtin_amdgcn_ds_read_tr16_b64_v4i16((LAS v4i16_t*)p)); }
__device__ __forceinline__ bf16x8 cat8(s16x4 lo, s16x4 hi) { return (bf16x8){lo[0], lo[1], lo[2], lo[3], hi[0], hi[1], hi[2], hi[3]}; }
__device__ __forceinline__ f32x4 mfma16(bf16x8 a, bf16x8 b, f32x4 c) { return __builtin_amdgcn_mfma_f32_16x16x32_bf16(a, b, c, 0, 0, 0); }
__device__ __forceinline__ float ex2(float x) { return __builtin_amdgcn_exp2f(x); }

namespace att {
constexpr int SEQ = 16384, LDQ = 2304, LDO = 1024;
constexpr int KPB = 160;
constexpr int COL_QA = 0, COL_KA = 512, COL_VA = 640, COL_QB = 768, COL_KB = 1280, COL_VB = 1792;

template <int NP>
__device__ __forceinline__ void load_rows(u32x4 (&v)[NP], const bf16* src, int tok0, int nvalid, int tid) {
    const int sub = tid & 7;
#pragma unroll
    for (int p = 0; p < NP; ++p) { const int r = (tid >> 3) + 64 * p, tok = tok0 + r; const bool ok = (tok >= 0) && (tok < SEQ) && (r < nvalid);
        v[p] = (u32x4){0u, 0u, 0u, 0u};
        if (ok) v[p] = *(const u32x4*)(src + (size_t)tok * LDQ + sub * 8); }
}
template <int NP, bool NORM>
__device__ __forceinline__ void store_rows(ldsp dst, const u32x4 (&v)[NP], int nrows, const float* gain, int tid) {
    const int sub = tid & 7;
    float gn[8];
    if (NORM) {
#pragma unroll
        for (int j = 0; j < 8; ++j) gn[j] = gain[sub * 8 + j];
    }
#pragma unroll
    for (int p = 0; p < NP; ++p) { const int r = (tid >> 3) + 64 * p;
        if (r < nrows) {
            u32x4 w = v[p];
            if (NORM) {
                float f[8]; f[0] = bf_lo(w.x); f[1] = bf_hi(w.x); f[2] = bf_lo(w.y); f[3] = bf_hi(w.y); f[4] = bf_lo(w.z); f[5] = bf_hi(w.z); f[6] = bf_lo(w.w); f[7] = bf_hi(w.w);
                float ss = 0.f;
#pragma unroll
                for (int j = 0; j < 8; ++j) ss += f[j] * f[j];
                ss += __shfl_xor(ss, 1); ss += __shfl_xor(ss, 2); ss += __shfl_xor(ss, 4);
                const float rs = rsqrtf(ss * (1.0f / 64.0f) + 1e-6f);
#pragma unroll
                for (int j = 0; j < 8; ++j) f[j] = f[j] * rs * gn[j];
                w.x = pk2(f[0], f[1]); w.y = pk2(f[2], f[3]); w.z = pk2(f[4], f[5]); w.w = pk2(f[6], f[7]);
            }
            *(LAS u32x4*)(dst + r * KPB + sub * 16) = w;
        } }
}

__device__ __forceinline__ void load_q_raw(u32x4 (&raw)[2], const bf16* qrow  , int g) {
#pragma unroll
    for (int s = 0; s < 2; ++s) raw[s] = *(const u32x4*)(qrow + 32 * s + 8 * g);
}
__device__ __forceinline__ void finish_q(bf16x8 (&qf)[2], const u32x4 (&raw)[2], const float* gain, int g) {
    float f[2][8]; float ss = 0.f;
#pragma unroll
    for (int s = 0; s < 2; ++s) { const u32x4 v = raw[s];
        f[s][0] = bf_lo(v.x); f[s][1] = bf_hi(v.x); f[s][2] = bf_lo(v.y); f[s][3] = bf_hi(v.y); f[s][4] = bf_lo(v.z); f[s][5] = bf_hi(v.z); f[s][6] = bf_lo(v.w); f[s][7] = bf_hi(v.w);
#pragma unroll
        for (int j = 0; j < 8; ++j) ss += f[s][j] * f[s][j]; }
    ss += __shfl_xor(ss, 16); ss += __shfl_xor(ss, 32);
    const float rs = rsqrtf(ss * (1.0f / 64.0f) + 1e-6f) * (0.125f * LOG2E);
#pragma unroll
    for (int s = 0; s < 2; ++s) { float o[8];
#pragma unroll
        for (int j = 0; j < 8; ++j) o[j] = f[s][j] * rs * gain[32 * s + 8 * g + j];
        u32x4 w; w.x = pk2(o[0], o[1]); w.y = pk2(o[2], o[3]); w.z = pk2(o[4], o[5]); w.w = pk2(o[6], o[7]);
        qf[s] = __builtin_bit_cast(bf16x8, w); }
}

template <int NT, class RB>
__device__ __forceinline__ void scores(f32x4 (&sc)[NT], ldsp Kb, const bf16x8 (&qf)[2], const RB& rb, int lane) {
    const int fr = lane & 15, g = lane >> 4;
#pragma unroll
    for (int t = 0; t < NT; ++t) { ldsp kp = Kb + (rb(t) + fr) * KPB + g * 16; f32x4 a = (f32x4){0.f, 0.f, 0.f, 0.f};
#pragma unroll
        for (int s = 0; s < 2; ++s) { const bf16x8 kf = *(const LAS bf16x8*)(kp + s * 64); a = mfma16(kf, qf[s], a); }
        sc[t] = a; if ((t & 3) == 3) __builtin_amdgcn_sched_barrier(0); }
}
template <int NT>
__device__ __forceinline__ float softmax_pack(f32x4 (&sc)[NT], bf16x8 (&pf)[NT / 2], float sink2, bool has_sink) {
    float m = -INFINITY;
#pragma unroll
    for (int t = 0; t < NT; ++t)
#pragma unroll
        for (int r = 0; r < 4; ++r) m = fmaxf(m, sc[t][r]);
    m = fmaxf(m, __shfl_xor(m, 16)); m = fmaxf(m, __shfl_xor(m, 32));
    if (has_sink) m = fmaxf(m, sink2);
    float sum = 0.f;
#pragma unroll
    for (int t = 0; t < NT; ++t)
#pragma unroll
        for (int r = 0; r < 4; ++r) { const float p = ex2(sc[t][r] - m); sc[t][r] = p; sum += p; }
    sum += __shfl_xor(sum, 16); sum += __shfl_xor(sum, 32);
    if (has_sink) sum += ex2(sink2 - m);
#pragma unroll
    for (int k = 0; k < NT / 2; ++k) { u32x4 w; w.x = pk2(sc[2 * k][0], sc[2 * k][1]); w.y = pk2(sc[2 * k][2], sc[2 * k][3]); w.z = pk2(sc[2 * k + 1][0], sc[2 * k + 1][1]); w.w = pk2(sc[2 * k + 1][2], sc[2 * k + 1][3]);
        pf[k] = __builtin_bit_cast(bf16x8, w); }
    return sum;
}
template <int NT, class RB>
__device__ __forceinline__ void pv_store(ldsp Vb, const bf16x8 (&pf)[NT / 2], const RB& rb, float sum, bf16* orow  , int lane) {
    const int g = lane >> 4, q4 = (lane & 15) >> 2, p4 = lane & 3;
    f32x4 o[4];
#pragma unroll
    for (int dt = 0; dt < 4; ++dt) o[dt] = (f32x4){0.f, 0.f, 0.f, 0.f};
#pragma unroll
    for (int k = 0; k < NT / 2; ++k) { ldsp v0 = Vb + (rb(2 * k) + 4 * g + q4) * KPB + p4 * 8; ldsp v1 = Vb + (rb(2 * k + 1) + 4 * g + q4) * KPB + p4 * 8;
#pragma unroll
        for (int dt = 0; dt < 4; ++dt) { const bf16x8 vf = cat8(vtr(v0 + dt * 32), vtr(v1 + dt * 32)); o[dt] = mfma16(vf, pf[k], o[dt]); } }
    const float inv = 1.0f / sum;
#pragma unroll
    for (int dt = 0; dt < 4; ++dt) { u32x2 w; w.x = pk2(o[dt][0] * inv, o[dt][1] * inv); w.y = pk2(o[dt][2] * inv, o[dt][3] * inv); *(u32x2*)(orow + dt * 16 + 4 * g) = w; }
}

struct RbWin { int mt; __device__ __forceinline__ int operator()(int t) const { return 16 * (mt + t); } };
struct RbNa { int off, ct0, ct1; __device__ __forceinline__ int operator()(int t) const { return (off + (t >> 1)) * 64 + ((t & 1) ? ct1 : ct0) * 16; } };

struct AttnArgs { const bf16* qkv; bf16* o; const float* qn_a; const float* kn_a; const float* sink_a; const float* qn_b; const float* kn_b; const float* rpb; };

__device__ __forceinline__ void window_tile(ldsp Kb, ldsp Vb, const AttnArgs& A, int n, int kvh, int idx, const u32x4 (&qraw)[2], int lane) {
    const int fr = lane & 15, g = lane >> 4;
    const int g4 = idx >> 3, mt = idx & 7, hq = kvh * 4 + g4;
    const int qtok = n * 128 + mt * 16 + fr;
    bf16x8 qf[2]; finish_q(qf, qraw, A.qn_a, g);
    RbWin rb{mt};
    f32x4 sc[18]; scores<18>(sc, Kb, qf, rb, lane);
    const float slope2 = exp2f(-(float)(hq + 1)) * LOG2E;
    {
        const float cl = (float)(4 * g - 128 - fr);
        const float lo = (float)max(-128, -qtok), hi = (float)min(128, SEQ - 1 - qtok);
#pragma unroll
        for (int t = 0; t < 18; ++t)
#pragma unroll
            for (int r = 0; r < 4; ++r) { const float rel = cl + (float)(16 * t + r); sc[t][r] = (rel >= lo && rel <= hi) ? fmaf(-slope2, fabsf(rel), sc[t][r]) : -INFINITY; }
    }
    bf16x8 pf[9]; const float sum = softmax_pack<18>(sc, pf, A.sink_a[hq] * LOG2E, true);
    pv_store<18>(Vb, pf, rb, sum, A.o + (size_t)qtok * LDO + hq * 64, lane);
}
__device__ __forceinline__ void window_compute(ldsp lds, const AttnArgs& A, int unit, int tid) {
    const int n = unit >> 1, kvh = unit & 1, lane = tid & 63, wid = __builtin_amdgcn_readfirstlane(tid >> 6);
    ldsp Kb = lds, Vb = lds + 400 * KPB;
    const int tok0 = (n - 1) * 128;
    const int fr = lane & 15, g = lane >> 4;
    u32x4 qa[2], qb[2];
    const bf16* qbase = A.qkv + (size_t)(n * 128 + fr) * LDQ + COL_QA + kvh * 256;
    auto qptr = [&](int it) { const int idx = wid * 4 + it; return qbase + (size_t)((idx & 7) * 16) * LDQ + (idx >> 3) * 64; };
    load_q_raw(qa, qptr(0), g);
    for (int it = 0; it < 4; it += 2) {
        load_q_raw(qb, qptr(it + 1), g);
        window_tile(Kb, Vb, A, n, kvh, wid * 4 + it, qa, lane);
        if (it + 2 < 4) load_q_raw(qa, qptr(it + 2), g);
        window_tile(Kb, Vb, A, n, kvh, wid * 4 + it + 1, qb, lane);
    }
}

constexpr int NA_ROWS = 704;
constexpr int NA_RPB_OFF = NA_ROWS * KPB;

__device__ __forceinline__ void na_unit(ldsp lds, const AttnArgs& A, int unit, int next_unit, u32x4 (&kreg)[11], int tid) {
    const int rq4 = unit >> 3, h = unit & 7, lane = tid & 63, wid = __builtin_amdgcn_readfirstlane(tid >> 6);
    const int r0 = 4 * rq4; const int base = min(max(r0 - 4, 0), 248);
    const int rq = r0 + (wid >> 1); const int rstart = min(max(rq - 4, 0), 248);
    const int fr = lane & 15, g = lane >> 4;
    store_rows<11, true>(lds, kreg, NA_ROWS, A.kn_b, tid);
    __syncthreads();
    const LAS float* rpl = (const LAS float*)(lds + NA_RPB_OFF);
    bf16x8 pf[2][8]; float sum[2]; int qtok[2]; int qcs[2]; u32x4 qraw[2][2];
#pragma unroll
    for (int it = 0; it < 2; ++it) { const int mt = 2 * (wid & 1) + it; qcs[it] = (mt < 3) ? 8 + 16 * mt + fr : (fr < 8 ? fr : 48 + fr); qtok[it] = rq * 64 + qcs[it];
        load_q_raw(qraw[it], A.qkv + (size_t)qtok[it] * LDQ + COL_QB + h * 64, g); }
#pragma unroll
    for (int it = 0; it < 2; ++it) {
        const int mt = 2 * (wid & 1) + it; const int qc = qcs[it];
        bf16x8 qf[2]; finish_q(qf, qraw[it], A.qn_b, g);
        RbNa rb{rstart - base, (mt < 3) ? mt : 0, (mt < 3) ? mt + 1 : 3};
        f32x4 sc[16]; scores<16>(sc, lds, qf, rb, lane);
        const int cstart = min(max(qc - 8, 0), 48);
        const int d0 = 4 * g - cstart;
        const LAS float* rpl0 = rpl + (rstart - rq + 7) * 128 + (4 * g - qc + 64);
#pragma unroll
        for (int t = 0; t < 16; ++t) { const int ct = (t & 1) ? rb.ct1 : rb.ct0; const LAS float* rp = rpl0 + (t >> 1) * 128 + 16 * ct; const int kb = 16 * ct + d0;
#pragma unroll
            for (int r = 0; r < 4; ++r) sc[t][r] = ((unsigned)(kb + r) < 16u) ? sc[t][r] + rp[r] : -INFINITY;
            if ((t & 3) == 3) __builtin_amdgcn_sched_barrier(0); }
        sum[it] = softmax_pack<16>(sc, pf[it], 0.f, false);
        __builtin_amdgcn_sched_barrier(0);
    }
    u32x4 vreg[11]; load_rows<11>(vreg, A.qkv + COL_VB + h * 64, base * 64, NA_ROWS, tid);
    __syncthreads();
    store_rows<11, false>(lds, vreg, NA_ROWS, nullptr, tid);
    if (next_unit >= 0) { const int nb = min(max(4 * (next_unit >> 3) - 4, 0), 248); load_rows<11>(kreg, A.qkv + COL_KB + h * 64, nb * 64, NA_ROWS, tid); }
    __syncthreads();
#pragma unroll
    for (int it = 0; it < 2; ++it) { const int mt = 2 * (wid & 1) + it; RbNa rb{rstart - base, (mt < 3) ? mt : 0, (mt < 3) ? mt + 1 : 3};
        pv_store<16>(lds, pf[it], rb, sum[it], A.o + (size_t)qtok[it] * LDO + 512 + h * 64, lane); __builtin_amdgcn_sched_barrier(0); }
    __syncthreads();
}

__device__ __forceinline__ void attn_phase(ldsp lds, const AttnArgs& A, int vcu, int G, int tid) {
    const int h = vcu & 7;
    u32x4 kreg[11];
#ifndef ATT_REP_WIN
#define ATT_REP_WIN 1
#define ATT_REP_NA 1
#endif
    for (int rw = 0; rw < ATT_REP_WIN; ++rw) {
        const int n = vcu >> 1, kvh = vcu & 1, tok0 = (n - 1) * 128;
        u32x4 kw[7], vw[7];
        load_rows<7>(kw, A.qkv + COL_KA + kvh * 64, tok0, 384, tid);
        load_rows<7>(vw, A.qkv + COL_VA + kvh * 64, tok0, 384, tid);
        store_rows<7, true>(lds, kw, 400, A.kn_a, tid);
        store_rows<7, false>(lds + 400 * KPB, vw, 400, nullptr, tid);
        __syncthreads();
        window_compute(lds, A, vcu, tid);
        __syncthreads();
    }
    for (int rn = 0; rn < ATT_REP_NA; ++rn) {
    { const int b0 = min(max(4 * (vcu >> 3) - 4, 0), 248); load_rows<11>(kreg, A.qkv + COL_KB + h * 64, b0 * 64, NA_ROWS, tid); }
    for (int i = tid; i < 15 * 128; i += 512) { const int ri = i >> 7, dc = i & 127; const int ci = min(max(dc - 49, 0), 30); ((LAS float*)(lds + NA_RPB_OFF))[i] = A.rpb[h * 465 + ri * 31 + ci] * LOG2E; }
    for (int k = 0; k < 2; ++k) { int t2 = tid; asm volatile("" : "+v"(t2));
        na_unit(lds, A, vcu + 256 * k, (k < 1) ? vcu + 256 * (k + 1) : -1, kreg, t2); }
    }
}
}
namespace ret {
constexpr int SEQ = 16384, LDG = 3072, NCH = 128;
constexpr int COL_Q = 0, COL_K = 512, COL_V = 1024, COL_G = 2048;
constexpr int KPB = 288;
constexpr int VPB = 544;
constexpr int R0 = 0, R1 = 128 * KPB, R2 = 2 * 128 * KPB, RSTAT = R2 + 128 * VPB;
constexpr size_t ST_CHUNK = 128 * 256;

__device__ __forceinline__ unsigned pk2a(float lo, float hi) { unsigned r; asm volatile("v_cvt_pk_bf16_f32 %0, %1, %2" : "=v"(r) : "v"(lo), "v"(hi)); return r; }
struct RetArgs { bf16* G; bf16* ST; const float* l2;   const float* gn; int grp; int dry; bf16* Y; };

template <bool SCALE>
__device__ __forceinline__ void stage128(ldsp dst, const bf16* src, int ld, float a, float b, int tid) {
#pragma unroll
    for (int i = 0; i < 4; ++i) { const int idx = tid + i * 512, row = idx >> 4, ch = idx & 15;
        u32x4 v = *(const u32x4*)(src + (size_t)row * ld + ch * 8);
        if (SCALE) { const float s = ex2(a * (float)row + b);
            v.x = pk2a(bf_lo(v.x) * s, bf_hi(v.x) * s); v.y = pk2a(bf_lo(v.y) * s, bf_hi(v.y) * s); v.z = pk2a(bf_lo(v.z) * s, bf_hi(v.z) * s); v.w = pk2a(bf_lo(v.w) * s, bf_hi(v.w) * s); }
        *(LAS u32x4*)(dst + row * KPB + ch * 16) = v; }
}
__device__ __forceinline__ void stage256(ldsp dst, const bf16* src, int ld, int tid) {
#pragma unroll
    for (int i = 0; i < 8; ++i) { const int idx = tid + i * 512, row = idx >> 5, ch = idx & 31;
        const u32x4 v = *(const u32x4*)(src + (size_t)row * ld + ch * 8);
        *(LAS u32x4*)(dst + row * VPB + ch * 16) = v; }
}
__device__ __forceinline__ bf16x8 trfrag(ldsp X, int pitch, int k0, int n0, int lane) {
    const int g = lane >> 4, q4 = (lane & 15) >> 2, p4 = lane & 3;
    ldsp p = X + (k0 + 8 * g + q4) * pitch + (n0 + 4 * p4) * 2;
    return cat8(vtr(p), vtr(p + 4 * pitch));
}

__device__ __forceinline__ void ld128(u32x4 (&r)[4], const bf16* src, int ld, int tid) {
    const unsigned off0 = (unsigned)(((tid >> 4) * ld + (tid & 15) * 8) * 2);
#pragma unroll
    for (int i = 0; i < 4; ++i) r[i] = *(const u32x4*)((const char*)src + (size_t)i * 32 * ld * 2 + off0);
}
__device__ __forceinline__ void st128(ldsp dst, const u32x4 (&r)[4], int tid) {
    ldsp d0 = dst + (tid >> 4) * KPB + (tid & 15) * 16;
#pragma unroll
    for (int i = 0; i < 4; ++i) *(LAS u32x4*)(d0 + i * 32 * KPB) = r[i];
}
__device__ __forceinline__ void st128s(ldsp dst, const u32x4 (&r)[4], float a, float b, int tid) {
    ldsp d0 = dst + (tid >> 4) * KPB + (tid & 15) * 16;
#pragma unroll
    for (int i = 0; i < 4; ++i) { const int row = (tid >> 4) + 32 * i; const float s = ex2(a * (float)row + b); u32x4 v = r[i];
        v.x = pk2(bf_lo(v.x) * s, bf_hi(v.x) * s); v.y = pk2(bf_lo(v.y) * s, bf_hi(v.y) * s); v.z = pk2(bf_lo(v.z) * s, bf_hi(v.z) * s); v.w = pk2(bf_lo(v.w) * s, bf_hi(v.w) * s);
        *(LAS u32x4*)(d0 + i * 32 * KPB) = v; }
}
__device__ __forceinline__ void ld64(u32x4 (&r)[4], const bf16* src, int ld, int tid) {
    const unsigned off0 = (unsigned)(((tid >> 5) * ld + (tid & 31) * 8) * 2);
#pragma unroll
    for (int i = 0; i < 4; ++i) r[i] = *(const u32x4*)((const char*)src + (size_t)i * 16 * ld * 2 + off0);
}
__device__ __forceinline__ void st64(ldsp dst, const u32x4 (&r)[4], int tid) {
    ldsp d0 = dst + (tid >> 5) * VPB + (tid & 31) * 16;
#pragma unroll
    for (int i = 0; i < 4; ++i) *(LAS u32x4*)(d0 + i * 16 * VPB) = r[i];
}

__device__ __forceinline__ void ret_a_phase(ldsp lds, const RetArgs& A, int vcu, int G, int tid_in) {
    int tid = tid_in;
    const int wid = __builtin_amdgcn_readfirstlane(tid >> 6);
    int u = vcu; if (u >= 512) return;
    u32x4 rk[4], rv0[4], rv1[4];
    { const bf16* rows = A.G + (size_t)(u >> 2) * 128 * LDG; const int hl = u & 3;
      ld128(rk, rows + COL_K + hl * 128, LDG, tid); ld64(rv0, rows + COL_V + hl * 256, LDG, tid); ld64(rv1, rows + (size_t)64 * LDG + COL_V + hl * 256, LDG, tid); }
    for (;;) {
        asm volatile("" : "+v"(tid));
        const int lane = tid & 63, fr = lane & 15, g = lane >> 4;
        const int hl = u & 3, c = u >> 2, h = A.grp * 4 + hl;
        const float l2f = A.l2[h], l2b = A.l2[8 + h];
        st128s(lds + R0, rk, -l2f, 127.0f * l2f, tid);
        st128s(lds + R1, rk, l2b, 0.f, tid);
        st64(lds + R2, rv0, tid); st64(lds + R2 + 64 * VPB, rv1, tid);
        const int un = u + G; const bool has_next = un < 512;
        if (has_next) { const bf16* rows = A.G + (size_t)(un >> 2) * 128 * LDG; const int nhl = un & 3;
            ld128(rk, rows + COL_K + nhl * 128, LDG, tid); ld64(rv0, rows + COL_V + nhl * 256, LDG, tid); ld64(rv1, rows + (size_t)64 * LDG + COL_V + nhl * 256, LDG, tid); }
        __syncthreads();
        for (int dir = 0; dir < 2; ++dir) {
            ldsp Kx = lds + (dir ? R1 : R0);
            f32x4 acc[2][8];
#pragma unroll
            for (int et = 0; et < 2; ++et)
#pragma unroll
                for (int dt = 0; dt < 8; ++dt) acc[et][dt] = (f32x4){0.f, 0.f, 0.f, 0.f};
#pragma unroll
            for (int ks = 0; ks < 4; ++ks) {
                bf16x8 vf[2];
#pragma unroll
                for (int et = 0; et < 2; ++et) vf[et] = trfrag(lds + R2, VPB, 32 * ks, 32 * wid + 16 * et, lane);
#pragma unroll
                for (int dt = 0; dt < 8; ++dt) { const bf16x8 kf = trfrag(Kx, KPB, 32 * ks, 16 * dt, lane);
#pragma unroll
                    for (int et = 0; et < 2; ++et) acc[et][dt] = mfma16(vf[et], kf, acc[et][dt]);
                    if ((dt & 3) == 3) __builtin_amdgcn_sched_barrier(0); }
            }
            bf16* st = A.ST + ((size_t)((dir * 4 + hl) * NCH + c)) * ST_CHUNK; const unsigned soff = (unsigned)((fr * 256 + 32 * wid + 4 * g) * 2);
#pragma unroll
            for (int et = 0; et < 2; ++et)
#pragma unroll
                for (int dt = 0; dt < 8; ++dt) { u32x2 w; w.x = pk2(acc[et][dt][0], acc[et][dt][1]); w.y = pk2(acc[et][dt][2], acc[et][dt][3]);
                    *(u32x2*)((char*)st + (size_t)(16 * dt * 256 + 16 * et) * 2 + soff) = w; }
        }
        __syncthreads();
        if (!has_next) break;
        u = un;
    }
}

__device__ __forceinline__ void ret_b(const RetArgs& A, int vcu, int G, int tid) {
    const int NT = 8 * 16384;
    for (int T = vcu * 512 + tid; T < NT; T += G * 512) {
        const int dh = T >> 14, w = T & 16383, dir = dh >> 2, hl = dh & 3, h = A.grp * 4 + hl;
        const float dec = ex2(128.0f * A.l2[dir * 8 + h]);
        unsigned* p = (unsigned*)(A.ST + (size_t)dh * NCH * ST_CHUNK) + w;
        const ptrdiff_t cs = dir ? -(ptrdiff_t)(ST_CHUNK / 2) : (ptrdiff_t)(ST_CHUNK / 2);
        if (dir) p += (size_t)(NCH - 1) * (ST_CHUNK / 2);
        float s0 = 0.f, s1 = 0.f;
        for (int c = 0; c < NCH; c += 32) {
            unsigned u[32];
#pragma unroll
            for (int k = 0; k < 32; ++k) u[k] = p[(ptrdiff_t)k * cs];
#pragma unroll
            for (int k = 0; k < 32; ++k) { p[(ptrdiff_t)k * cs] = A.dry ? u[k] : pk2(s0, s1); s0 = dec * s0 + bf_lo(u[k]); s1 = dec * s1 + bf_hi(u[k]); }
            p += 32 * cs;
        }
    }
}

constexpr int C_Q = 0, C_KA = 128 * KPB, C_B0 = 2 * 128 * KPB, C_B1 = C_B0 + 64 * VPB, C_STAT = C_B1 + 64 * VPB;
struct CPtrs { const bf16 *q, *k, *v, *sf, *sb; bf16* g; };
__device__ __forceinline__ CPtrs cptrs(const RetArgs& A, int unit) {
    const int hl = unit & 3, c = unit >> 2; bf16* rows = A.G + (size_t)c * 128 * LDG; CPtrs P;
    P.q = rows + COL_Q + hl * 128; P.k = rows + COL_K + hl * 128; P.v = rows + COL_V + hl * 256; P.g = rows + COL_G + hl * 256;
    P.sf = A.ST + ((size_t)((0 * 4 + hl) * NCH + c)) * ST_CHUNK; P.sb = A.ST + ((size_t)((1 * 4 + hl) * NCH + c)) * ST_CHUNK; return P;
}
__device__ __forceinline__ void half_mma(f32x4 (&acc)[2][8], ldsp buf, ldsp Bop, int kofs, int wid, int lane) {
    const int fr = lane & 15, g = lane >> 4;
#pragma unroll
    for (int ks = 0; ks < 2; ++ks) {
        bf16x8 xf[2];
#pragma unroll
        for (int et = 0; et < 2; ++et) xf[et] = trfrag(buf, VPB, 32 * ks, 32 * wid + 16 * et, lane);
#pragma unroll
        for (int it = 0; it < 8; ++it) { const bf16x8 bfrag = *(const LAS bf16x8*)(Bop + (16 * it + fr) * KPB + (kofs + 32 * ks + 8 * g) * 2);
#pragma unroll
            for (int et = 0; et < 2; ++et) acc[et][it] = mfma16(xf[et], bfrag, acc[et][it]);
            if ((it & 3) == 3) __builtin_amdgcn_sched_barrier(0); }
    }
}
__device__ __forceinline__ void ret_c_phase(ldsp lds, const RetArgs& A, int vcu, int G, int tid_in) {
    int tid = tid_in;
    const int wid = __builtin_amdgcn_readfirstlane(tid >> 6);
    int u = vcu; if (u >= 512) return;
    CPtrs P = cptrs(A, u);
    u32x4 r0[4], r1[4], r2[4], r3[4];
    ld128(r0, P.q, LDG, tid); ld128(r1, P.k, LDG, tid); ld64(r2, P.sf, 256, tid); ld64(r3, P.sf + 64 * 256, 256, tid);
    LAS float* stat = (LAS float*)(lds + C_STAT);
    for (;;) {
        asm volatile("" : "+v"(tid));
        const int lane = tid & 63, fr = lane & 15, g = lane >> 4;
        const int un = u + G; const bool has_next = un < 512;
        CPtrs N = P; if (has_next) N = cptrs(A, un);
        const int hl = u & 3, c = u >> 2, h = A.grp * 4 + hl;
        const float l2f = A.l2[h], l2b = A.l2[8 + h];
        st128(lds + C_Q, r0, tid); st128(lds + C_KA, r1, tid);
        ld64(r0, P.sb, 256, tid); ld64(r1, P.sb + 64 * 256, 256, tid);
        __syncthreads();
        f32x4 sa[8];
#pragma unroll
        for (int it = 0; it < 8; ++it) sa[it] = (f32x4){0.f, 0.f, 0.f, 0.f};
#pragma unroll
        for (int ks = 0; ks < 4; ++ks) { const bf16x8 kf = *(const LAS bf16x8*)(lds + C_KA + (16 * wid + fr) * KPB + (32 * ks + 8 * g) * 2);
#pragma unroll
            for (int it = 0; it < 8; ++it) { const bf16x8 qf = *(const LAS bf16x8*)(lds + C_Q + (16 * it + fr) * KPB + (32 * ks + 8 * g) * 2); sa[it] = mfma16(kf, qf, sa[it]); if ((it & 3) == 3) __builtin_amdgcn_sched_barrier(0); } }
        st64(lds + C_B0, r2, tid); ld64(r2, P.v, LDG, tid);
        __syncthreads();
#pragma unroll
        for (int it = 0; it < 8; ++it) { const int i = 16 * it + fr; float v[4];
#pragma unroll
            for (int r = 0; r < 4; ++r) { const int j = 16 * wid + 4 * g + r; const int dl = i - j; const float dm = dl >= 0 ? ex2((float)dl * l2f) : ex2((float)(-dl) * l2b); v[r] = sa[it][r] * dm; }
            u32x2 w; w.x = pk2(v[0], v[1]); w.y = pk2(v[2], v[3]);
            *(LAS u32x2*)(lds + C_KA + i * KPB + (16 * wid + 4 * g) * 2) = w; if (it & 1) __builtin_amdgcn_sched_barrier(0); }
        st64(lds + C_B1, r3, tid); ld64(r3, P.v + (size_t)64 * LDG, LDG, tid);
        f32x4 acc[2][8];
#pragma unroll
        for (int et = 0; et < 2; ++et)
#pragma unroll
            for (int it = 0; it < 8; ++it) acc[et][it] = (f32x4){0.f, 0.f, 0.f, 0.f};
        half_mma(acc, lds + C_B0, lds + C_Q, 0, wid, lane);
        __syncthreads();
        st64(lds + C_B0, r0, tid); if (has_next) ld128(r0, N.q, LDG, tid);
        half_mma(acc, lds + C_B1, lds + C_Q, 64, wid, lane);
        __syncthreads();
#pragma unroll
        for (int it = 0; it < 8; ++it) { const float fi = (float)(16 * it + fr); const float rt = ex2((fi + 1.0f) * l2f - (128.0f - fi) * l2b); acc[0][it] *= rt; acc[1][it] *= rt; }
        st64(lds + C_B1, r1, tid); if (has_next) ld128(r1, N.k, LDG, tid);
        half_mma(acc, lds + C_B0, lds + C_Q, 0, wid, lane);
        __syncthreads();
        st64(lds + C_B0, r2, tid); if (has_next) ld64(r2, N.sf, 256, tid);
        half_mma(acc, lds + C_B1, lds + C_Q, 64, wid, lane);
        __syncthreads();
#pragma unroll
        for (int it = 0; it < 8; ++it) { const float fi = (float)(16 * it + fr); const float sb = ex2((128.0f - fi) * l2b); acc[0][it] *= sb; acc[1][it] *= sb; }
        st64(lds + C_B1, r3, tid); if (has_next) ld64(r3, N.sf + 64 * 256, 256, tid);
        u32x2 gv[8][2]; f32x4 gw[2]; const unsigned goff = (unsigned)((fr * LDG + 32 * wid + 4 * g) * 2);
#pragma unroll
        for (int et = 0; et < 2; ++et) { const int e = 32 * wid + 16 * et + 4 * g; gw[et] = *(const f32x4*)(A.gn + h * 256 + e);
#pragma unroll
            for (int it = 0; it < 8; ++it) gv[it][et] = *(const u32x2*)((const char*)P.g + (size_t)(16 * it * LDG + 16 * et) * 2 + goff); }
        half_mma(acc, lds + C_B0, lds + C_KA, 0, wid, lane);
        __syncthreads();
        half_mma(acc, lds + C_B1, lds + C_KA, 64, wid, lane);
#pragma unroll
        for (int it = 0; it < 8; ++it) { float s1 = 0.f, s2 = 0.f;
#pragma unroll
            for (int et = 0; et < 2; ++et)
#pragma unroll
                for (int r = 0; r < 4; ++r) { const float y = acc[et][it][r]; s1 += y; s2 += y * y; }
            s1 += __shfl_xor(s1, 16); s1 += __shfl_xor(s1, 32); s2 += __shfl_xor(s2, 16); s2 += __shfl_xor(s2, 32);
            if (g == 0) { stat[((16 * it + fr) * 8 + wid) * 2] = s1; stat[((16 * it + fr) * 8 + wid) * 2 + 1] = s2; }
            if (it & 1) __builtin_amdgcn_sched_barrier(0); }
        __syncthreads();
        bf16* yb = A.Y + (size_t)c * 128 * 2048 + h * 256; const unsigned yoff = (unsigned)((fr * 2048 + 32 * wid + 4 * g) * 2);
#pragma unroll
        for (int it = 0; it < 8; ++it) { float s1 = 0.f, s2 = 0.f;
#pragma unroll
            for (int w = 0; w < 8; ++w) { s1 += stat[((16 * it + fr) * 8 + w) * 2]; s2 += stat[((16 * it + fr) * 8 + w) * 2 + 1]; }
            const float mu = s1 * (1.0f / 256.0f); const float var = fmaxf(s2 * (1.0f / 256.0f) - mu * mu, 0.f); const float rs = rsqrtf(var + 1e-5f);
#pragma unroll
            for (int et = 0; et < 2; ++et) { const int e = 32 * wid + 16 * et + 4 * g; const f32x4 y = acc[et][it]; const u32x2 gg = gv[it][et];
                u32x2 w; w.x = pk2(bf_lo(gg.x) * ((y[0] - mu) * rs * gw[et][0]), bf_hi(gg.x) * ((y[1] - mu) * rs * gw[et][1]));
                w.y = pk2(bf_lo(gg.y) * ((y[2] - mu) * rs * gw[et][2]), bf_hi(gg.y) * ((y[3] - mu) * rs * gw[et][3]));
                *(u32x2*)((char*)yb + (size_t)(16 * it * 2048 + 16 * et) * 2 + yoff) = w; }
            __builtin_amdgcn_sched_barrier(0); }
        if (!has_next) break;
        u = un; P = N;
    }
    __syncthreads();
}
}
#define XB_TMO      128
#define XB_XCNT(j)  (256  + 64 * (j))
#define XB_XSUB(j)  (1280 + 64 * (j))
#define XB_XGEN(j)  (2304 + 64 * (j))
#define XB_TOP      3328
#define XB_TOPGEN   3392
#define XCD_BAR_WORDS 3456
#define XB_SPIN_CAP (1u << 18)

__device__ __forceinline__ unsigned xb_ld(unsigned* p)              { return __hip_atomic_load(p, __ATOMIC_RELAXED, __HIP_MEMORY_SCOPE_AGENT); }
__device__ __forceinline__ unsigned xb_add(unsigned* p, unsigned v) { return __hip_atomic_fetch_add(p, v, __ATOMIC_RELAXED, __HIP_MEMORY_SCOPE_AGENT); }
__device__ __forceinline__ unsigned xb_xcc_id() { return (unsigned)__builtin_amdgcn_s_getreg((3 << 11) | 20) & 0xFu; }
#define XB_SPIN(cond, bar) do { unsigned _sp = 0; while (cond) { __builtin_amdgcn_s_sleep(1); \
    if ((++_sp & 255u) == 0u) { if (xb_ld(&(bar)[XB_TMO])) break; if (_sp > XB_SPIN_CAP) { atomicAdd(&(bar)[XB_TMO], 1u); break; } } } } while (0)

struct XcdBarrier {
    unsigned* bar; unsigned x;
    volatile LAS unsigned* st;
};

__device__ __forceinline__ XcdBarrier xcd_barrier_post(unsigned* bar, volatile LAS unsigned* st) {
    XcdBarrier b; b.bar = bar; b.x = xb_xcc_id(); b.st = st;
    if (threadIdx.x == 0) (void)xb_add(&bar[XB_XCNT(b.x)], 1u);
    return b;
}
__device__ __forceinline__ void xcd_barrier_complete(unsigned* bar, unsigned x, unsigned& nloc, unsigned& nx) {
    const unsigned G = gridDim.x * gridDim.y * gridDim.z;
    unsigned sum, cnt, mine, sp = 0u;
    for (;;) {
        sum = 0u; cnt = 0u; mine = 0u;
#pragma unroll
        for (unsigned j = 0; j < 16; ++j) { const unsigned c = xb_ld(&bar[XB_XCNT(j)]); sum += c; cnt += (c > 0u) ? 1u : 0u; mine = (j == x) ? c : mine; }
        if (sum == G) break;
        __builtin_amdgcn_s_sleep(1);
        if ((++sp & 255u) == 0u) { if (xb_ld(&bar[XB_TMO])) break; if (sp > XB_SPIN_CAP) { atomicAdd(&bar[XB_TMO], 1u); break; } }
    }
    nloc = mine > 0u ? mine : 1u; nx = cnt > 0u ? cnt : 1u;
}

__device__ __forceinline__ void xcd_barrier(const XcdBarrier& b) {
    asm volatile("s_waitcnt vmcnt(0)" ::: "memory");
    __syncthreads();
    if (threadIdx.x == 0) {
        unsigned* bar = b.bar;
        __builtin_amdgcn_s_waitcnt(0);
        unsigned nloc = b.st[0], nx = b.st[1];
        if (nloc == 0u) { xcd_barrier_complete(bar, b.x, nloc, nx); b.st[0] = nloc; b.st[1] = nx; }
        const unsigned old = xb_add(&bar[XB_XSUB(b.x)], 1u);
        const unsigned gen = old / nloc;
        if (old + 1u == (gen + 1u) * nloc) {
            __builtin_amdgcn_fence(__ATOMIC_RELEASE, "agent");
            asm volatile("s_waitcnt vmcnt(0)" ::: "memory");
            const unsigned og = xb_add(&bar[XB_TOP], 1u);
            const unsigned tg = og / nx;
            if (og + 1u == (tg + 1u) * nx) xb_add(&bar[XB_TOPGEN], 1u);
            else XB_SPIN(xb_ld(&bar[XB_TOPGEN]) == tg, bar);
            __builtin_amdgcn_fence(__ATOMIC_ACQUIRE, "agent");
            xb_add(&bar[XB_XGEN(b.x)], 1u);
            asm volatile("s_waitcnt vmcnt(0)" ::: "memory");
        } else {
            XB_SPIN(xb_ld(&bar[XB_XGEN(b.x)]) == gen, bar);
            __builtin_amdgcn_fence(__ATOMIC_ACQUIRE, "agent");
            asm volatile("s_waitcnt vmcnt(0)" ::: "memory");
        }
    }
    __syncthreads();
}
constexpr int M_TOK = 16384, DM = 1024, DFF = 4096, N_IN_E = 2304, N_IN_O = 6144;
constexpr size_t MiB = 1u << 20;
constexpr size_t WS_CTL = 0;
constexpr size_t WS_L2 = 4096, WS_SSQ = 512 * 1024;
constexpr int CW_BAR = 4096;
constexpr size_t WS_W_IN_E = 1 * MiB;
constexpr size_t WS_W_OUT_E = WS_W_IN_E + (size_t)N_IN_E * DM * 2;
constexpr size_t WS_W_MLP_IN = WS_W_OUT_E + (size_t)DM * DM * 2;
constexpr size_t WS_W_MLP_OUT = WS_W_MLP_IN + 2 * (size_t)DFF * DM * 2;
constexpr size_t WS_W_IN_O = WS_W_MLP_OUT + 2 * (size_t)DFF * DM * 2;
constexpr size_t WS_W_OUT_O = WS_W_IN_O + (size_t)N_IN_O * DM * 2;
constexpr size_t WS_XB = 56 * MiB;
constexpr size_t WS_BIG = 88 * MiB;
constexpr size_t WS_END = 256 * MiB;
static_assert(WS_W_OUT_O + (size_t)DM * 2048 * 2 <= WS_XB, "weights fit below XB");

constexpr int RING_BYTES = 155648;
constexpr int LDS_BYTES = 159744;

struct Args { const float* in[19]; float* out; unsigned char* ws; int ph_lo, ph_hi; };
typedef const __attribute__((address_space(4))) Args* KArgs;

__device__ __forceinline__ float wave_sum(float v) {
#pragma unroll
    for (int o = 1; o < 64; o <<= 1) v += __shfl_xor(v, o);
    return v;
}
struct WItem { const float* W; int N; bf16* WT; int ldo; int k0, n0, orow0; const float* gain; float nscale; };
constexpr int WI_C0 = 1152, WI_C1 = WI_C0 + 512, WI_C2 = WI_C1 + 2048, WI_C3 = WI_C2 + 2048, WI_C4 = WI_C3 + 2048, WI_C5 = WI_C4 + 2048, WI_C6 = WI_C5 + 3072, WI_C7 = WI_C6 + 1024;
constexpr int WI_EARLY = WI_C3;
__device__ __forceinline__ void witem_decode(KArgs a, unsigned char* ws, int gi, WItem& d) {
    int item, K, mode = 0; d.gain = nullptr; d.nscale = 1.0f;
    if (gi < WI_C0)      { item = gi;         d.W = a->in[2];  K = DM;  d.N = N_IN_E; d.WT = (bf16*)(ws + WS_W_IN_E); d.gain = a->in[1]; }
    else if (gi < WI_C1) { item = gi - WI_C0; d.W = a->in[9];  K = DM;  d.N = DM;     d.WT = (bf16*)(ws + WS_W_OUT_E); }
    else if (gi < WI_C2) { item = gi - WI_C1; d.W = a->in[17]; K = DM;  d.N = DFF;    d.WT = (bf16*)(ws + WS_W_MLP_IN); d.gain = a->in[16]; }
    else if (gi < WI_C3) { item = gi - WI_C2; d.W = a->in[18]; K = DFF; d.N = DM;     d.WT = (bf16*)(ws + WS_W_MLP_OUT); }
    else if (gi < WI_C4) { item = gi - WI_C3; d.W = a->in[17] + (size_t)DM * DFF; K = DM; d.N = DFF; d.WT = (bf16*)(ws + WS_W_MLP_IN) + (size_t)DFF * DM; d.gain = a->in[16] + DM; }
    else if (gi < WI_C5) { item = gi - WI_C4; d.W = a->in[18] + (size_t)DFF * DM; K = DFF; d.N = DM; d.WT = (bf16*)(ws + WS_W_MLP_OUT) + (size_t)DFF * DM; }
    else if (gi < WI_C6) { item = gi - WI_C5; d.W = a->in[11]; K = DM;  d.N = N_IN_O; d.WT = (bf16*)(ws + WS_W_IN_O); d.gain = a->in[10]; mode = 1; }
    else                 { item = gi - WI_C6; d.W = a->in[15]; K = 2048; d.N = DM;    d.WT = (bf16*)(ws + WS_W_OUT_O); }
    const int nblk = d.N / 32, kb = item / nblk, nb = item % nblk; d.k0 = 64 * kb; d.n0 = 32 * nb; d.orow0 = d.n0; d.ldo = K;
    if (mode == 1) {
        const int n0 = d.n0;
        if (n0 < 1024) { d.orow0 = (n0 >> 9) * 3072 + (n0 & 511); }
        else if (n0 < 2048) { const int nk = n0 - 1024; d.orow0 = (nk >> 9) * 3072 + 512 + (nk & 511); d.nscale = 0.08838834764831845f; }
        else if (n0 < 4096) { const int nv = n0 - 2048; d.orow0 = (nv >> 10) * 3072 + 1024 + (nv & 1023); }
        else { const int ng = n0 - 4096; d.orow0 = (ng >> 10) * 3072 + 2048 + (ng & 1023); }
    }
}
__device__ __forceinline__ void witem_load(const WItem& d, float (&v)[32], int lane) {
#pragma unroll
    for (int i = 0; i < 32; ++i) { const int kk = 2 * i + (lane >> 5); v[i] = d.W[(size_t)(d.k0 + kk) * d.N + d.n0 + (lane & 31)]; }
}
__device__ __forceinline__ void witem_finish(const WItem& d, const float (&v)[32], LAS float* scr, int lane) {
#pragma unroll
    for (int i = 0; i < 32; ++i) { const int kk = 2 * i + (lane >> 5); const float gsc = d.gain ? d.gain[d.k0 + kk] * d.nscale : d.nscale; scr[kk * 33 + (lane & 31)] = v[i] * gsc; }
    asm volatile("s_waitcnt lgkmcnt(0)" ::: "memory");
    const int c = lane & 7;
#pragma unroll
    for (int j = 0; j < 4; ++j) { const int n = (lane >> 3) + 8 * j; const LAS float* s = scr + (8 * c) * 33 + n;
        u32x4 o; o.x = pk2(s[0 * 33], s[1 * 33]); o.y = pk2(s[2 * 33], s[3 * 33]); o.z = pk2(s[4 * 33], s[5 * 33]); o.w = pk2(s[6 * 33], s[7 * 33]);
        *(u32x4*)(d.WT + (size_t)(d.orow0 + n) * d.ldo + d.k0 + 8 * c) = o; }
    asm volatile("s_waitcnt lgkmcnt(0)" ::: "memory");
}
__device__ __forceinline__ void convert_items(KArgs a, ldsp lds, int gbeg, int gend, int wv, int nw, int tid) {
    const int lane = tid & 63, wave = __builtin_amdgcn_readfirstlane(tid >> 6);
    unsigned char* ws = a->ws;
    LAS float* scr = (LAS float*)(lds + wave * 16384);
    WItem cur, nxt; float va[32], vb[32];
    int gi = gbeg + wv;
    if (gi < gend) { witem_decode(a, ws, gi, cur); witem_load(cur, va, lane); }
    while (gi < gend) {
        const int g1 = gi + nw, g2 = gi + 2 * nw;
        if (g1 < gend) { witem_decode(a, ws, g1, nxt); witem_load(nxt, vb, lane); }
        witem_finish(cur, va, scr, lane);
        if (g1 >= gend) break;
        if (g2 < gend) { witem_decode(a, ws, g2, cur); witem_load(cur, va, lane); }
        witem_finish(nxt, vb, scr, lane);
        gi = g2;
    }
}
__device__ __forceinline__ void prologue(KArgs a, ldsp lds, int vcu, int G, int tid) {
    const int lane = tid & 63, wave = __builtin_amdgcn_readfirstlane(tid >> 6);
    unsigned char* ws = a->ws;
    const int gw = vcu * 8 + wave, NGW = G * 8;
    convert_items(a, lds, 0, WI_EARLY, gw, NGW, tid);
    const float* x = a->in[0]; bf16* XB = (bf16*)(ws + WS_XB); float* ssq = (float*)(ws + WS_SSQ);
    for (int m = gw; m < M_TOK; m += 2 * NGW) {
        const int m2 = m + NGW;
        const f32x4* xr0 = (const f32x4*)(x + (size_t)m * DM) + lane; const f32x4* xr1 = (const f32x4*)(x + (size_t)m2 * DM) + lane;
        f32x4 v0[4], v1[4];
#pragma unroll
        for (int j = 0; j < 4; ++j) { v0[j] = xr0[64 * j]; v1[j] = xr1[64 * j]; }
        unsigned long long* o0 = (unsigned long long*)(XB + (size_t)m * DM) + lane; unsigned long long* o1 = (unsigned long long*)(XB + (size_t)m2 * DM) + lane;
        float s0 = 0.f, s1 = 0.f;
#pragma unroll
        for (int j = 0; j < 4; ++j) { s0 += (v0[j][0] * v0[j][0] + v0[j][1] * v0[j][1]) + (v0[j][2] * v0[j][2] + v0[j][3] * v0[j][3]);
            s1 += (v1[j][0] * v1[j][0] + v1[j][1] * v1[j][1]) + (v1[j][2] * v1[j][2] + v1[j][3] * v1[j][3]);
            o0[64 * j] = (unsigned long long)pk2(v0[j][0], v0[j][1]) | ((unsigned long long)pk2(v0[j][2], v0[j][3]) << 32);
            o1[64 * j] = (unsigned long long)pk2(v1[j][0], v1[j][1]) | ((unsigned long long)pk2(v1[j][2], v1[j][3]) << 32); }
        s0 = wave_sum(s0); s1 = wave_sum(s1);
        if (lane == 0) { *(f32x4*)(ssq + 4 * (size_t)m) = (f32x4){s0, 0.f, 0.f, 0.f}; *(f32x4*)(ssq + 4 * (size_t)m2) = (f32x4){s1, 0.f, 0.f, 0.f}; }
    }
    if (vcu == 0 && tid < 16) { const float d = (tid < 8 ? a->in[12] : a->in[13])[tid & 7]; const float e = __expf(-d);
        const float l1p = (e < 0.0625f) ? e * (1.0f - e * (0.5f - e * ((1.0f / 3.0f) - e * (0.25f - e * 0.2f)))) : __logf(1.0f + e);
        ((float*)(ws + WS_L2))[tid] = -l1p * LOG2E; }
}

#ifndef DBG_DUMP
#define DBG_DUMP 0
#endif
#ifndef REP_PH
#define REP_PH (-1)
#define REP_N 0
#endif
#ifndef REP_COND
#define REP_COND true
#endif
#ifndef DBG_STRIDE
#define DBG_STRIDE 1
#endif
#ifndef DBG_HI
#define DBG_HI PH_COUNT
#endif
#ifndef DBG_LO
#define DBG_LO 0
#endif
#ifndef DBG_AOFF
#define DBG_AOFF 2048
#endif
#ifndef DBG_LDA
#define DBG_LDA 3072
#endif
#ifndef DBG_LDB
#define DBG_LDB 2048
#endif
#ifndef DBG_K
#define DBG_K 1024
#endif
enum { PH_PRO = 0, PH_IN_E, PH_ATTN, PH_OUT_E, PH_MLP_IN0, PH_MLP_OUT0, PH_IN_O0, PH_RA0, PH_RB0, PH_RC0, PH_IN_O1, PH_RA1, PH_RB1, PH_RC1, PH_OUT_O, PH_MLP_IN1, PH_MLP_OUT1, PH_COUNT };

__global__ void __launch_bounds__(512, 2) mk_fwd(Args a_unused) {
    extern __shared__ __attribute__((aligned(16))) unsigned char lds_raw[];
    cg::grid_group grid = cg::this_grid();
    const ldsp lds = (ldsp)lds_raw;
    volatile LAS unsigned* MISC = (volatile LAS unsigned*)(lds + RING_BYTES);
    if (threadIdx.x < 32) MISC[threadIdx.x] = 0u;
    __syncthreads();
    const XcdBarrier bar = xcd_barrier_post((unsigned*)(((KArgs)__builtin_amdgcn_kernarg_segment_ptr())->ws + WS_CTL) + CW_BAR, MISC + 8);
    const int G = gridDim.x;
    int repcnt = 0;
    const int ph_lo = ((KArgs)__builtin_amdgcn_kernarg_segment_ptr())->ph_lo, ph_hi = ((KArgs)__builtin_amdgcn_kernarg_segment_ptr())->ph_hi;
    for (int ph = ph_lo; ph < ph_hi; ++ph) {
        const __attribute__((address_space(4))) char* kp = (const __attribute__((address_space(4))) char*)__builtin_amdgcn_kernarg_segment_ptr();
        asm volatile("" : "+s"(kp));
        KArgs a = (KArgs)kp;
        unsigned char* ws = a->ws;
        bf16* XB = (bf16*)(ws + WS_XB); float* ssq = (float*)(ws + WS_SSQ);
        bf16* BIG = (bf16*)(ws + WS_BIG);
        bf16* QKV = BIG; bf16* OE = BIG + (size_t)M_TOK * N_IN_E; bf16* HM = BIG; bf16* GB = BIG; bf16* ST = BIG + (size_t)M_TOK * 3072;
        int tid = threadIdx.x, bx = blockIdx.x;
        asm volatile("" : "+v"(tid)); asm volatile("" : "+s"(bx));
        const int vcu = (G % 8 == 0) ? (bx % 8) * (G / 8) + bx / 8 : bx;
        if (ph == PH_PRO) { prologue(a, lds, vcu, G, tid); }
        else if (ph == PH_ATTN) {
            att::AttnArgs A{QKV, OE, a->in[3], a->in[4], a->in[5], a->in[6], a->in[7], a->in[8]};
            att::attn_phase(lds, A, vcu, G, tid);
        }
        else if (ph == PH_RA0 || ph == PH_RA1 || ph == PH_RB0 || ph == PH_RB1 || ph == PH_RC0 || ph == PH_RC1) {
            ret::RetArgs R{GB, ST, (const float*)(ws + WS_L2), a->in[14], (ph >= PH_IN_O1) ? 1 : 0, (REP_N > 0 && ph == REP_PH && repcnt > 0) ? 1 : 0, (bf16*)a->out};
            if (ph == PH_RA0 || ph == PH_RA1) { ret::ret_a_phase(lds, R, vcu, G, tid); }
            else if (ph == PH_RB0 || ph == PH_RB1) { ret::ret_b(R, vcu, G, tid); }
            else { ret::ret_c_phase(lds, R, vcu, G, tid); }
        }
        else if (ph == PH_IN_E || ph == PH_MLP_IN0 || ph == PH_MLP_IN1 || ph == PH_IN_O0 || ph == PH_IN_O1) {
            const bf16* Bt; int N, act, silu0; bf16* O;
            if (ph == PH_IN_E)           { Bt = (const bf16*)(ws + WS_W_IN_E); N = N_IN_E; O = QKV; act = 0; silu0 = 1 << 30; }
            else if (ph == PH_MLP_IN0)   { Bt = (const bf16*)(ws + WS_W_MLP_IN); N = DFF; O = HM; act = 1; silu0 = 1 << 30; }
            else if (ph == PH_MLP_IN1)   { Bt = (const bf16*)(ws + WS_W_MLP_IN) + (size_t)DFF * DM; N = DFF; O = HM; act = 1; silu0 = 1 << 30; }
            else if (ph == PH_IN_O0)     { Bt = (const bf16*)(ws + WS_W_IN_O); N = 3072; O = GB; act = 2; silu0 = 8; }
            else                         { Bt = (const bf16*)(ws + WS_W_IN_O) + (size_t)3072 * DM; N = 3072; O = GB; act = 2; silu0 = 8; }
            pg8::Gemm g; g.A = XB; g.Bt = Bt; g.lda = DM; g.ldb = DM; g.M = M_TOK; g.N = N; g.K = DM;
            pg8::EpiBf16 E; E.O = O; E.ldc = N; E.ssq = ssq; E.silu_pn0 = silu0; E.act = act;
            pg8::StaticOrder S; S.init(M_TOK, N, G, bx);
            pg8::gemm_phase<pg8::EpiBf16, pg8::StaticOrder, true, true>(lds, g, S, E, tid);
            if (ph == PH_IN_E && bx >= 64) convert_items(a, lds, WI_EARLY, WI_C7, (bx - 64) * 8 + __builtin_amdgcn_readfirstlane(tid >> 6), (G - 64) * 8, tid);
        }
        else {
            const bf16* A; const bf16* Bt; int lda, ldb, K; const float* basef; const bf16* baseb; float* outf; bf16* xb; float* sso;
            if (ph == PH_OUT_E)          { A = OE; lda = DM; K = DM; Bt = (const bf16*)(ws + WS_W_OUT_E); ldb = DM; basef = a->in[0]; baseb = nullptr; outf = nullptr; xb = XB; sso = ssq; }
            else if (ph == PH_MLP_OUT0)  { A = HM; lda = DFF; K = DFF; Bt = (const bf16*)(ws + WS_W_MLP_OUT); ldb = DFF; basef = nullptr; baseb = XB; outf = nullptr; xb = XB; sso = ssq; }
            else if (ph == PH_MLP_OUT1)  { A = HM; lda = DFF; K = DFF; Bt = (const bf16*)(ws + WS_W_MLP_OUT) + (size_t)DFF * DM; ldb = DFF; basef = nullptr; baseb = XB; outf = a->out; xb = nullptr; sso = nullptr; }
            else                         { A = (const bf16*)a->out; lda = 2048; K = 2048; Bt = (const bf16*)(ws + WS_W_OUT_O); ldb = 2048; basef = nullptr; baseb = XB; outf = nullptr; xb = XB; sso = ssq; }
            pg8::Gemm g; g.A = A; g.Bt = Bt; g.lda = lda; g.ldb = ldb; g.M = M_TOK; g.N = DM; g.K = K;
            pg8::EpiResid E; E.basef = basef; E.baseb = baseb; E.outf = outf; E.xb = xb; E.ssq_out = sso; E.ldc = DM;
            E.accscale = (REP_N > 0 && ph == REP_PH && repcnt > 0 && ph != PH_OUT_E && ph != PH_MLP_OUT1) ? 0.f : 1.f;
            pg8::StaticOrder S; S.init(M_TOK, DM, G, bx);
            pg8::gemm_phase<pg8::EpiResid, pg8::StaticOrder, false, true>(lds, g, S, E, tid);
        }
        if (ph + 1 == ph_hi && DBG_DUMP) {
            xcd_barrier(bar);
            const bf16* srcb = (DBG_DUMP == 1) ? GB : ST;
            for (size_t i = (size_t)bx * 512 + tid; i < (size_t)M_TOK * DM; i += (size_t)G * 512) a->out[i] = bf_lo((unsigned)srcb[i * DBG_STRIDE]);
        }
#ifdef NOP_REPS
        if (ph == NOP_AT) { for (int q = 0; q < NOP_REPS; ++q) xcd_barrier(bar); }
#endif
        if (ph + 1 < ph_hi) {
            if (ph_lo < 0) {
                asm volatile("s_waitcnt vmcnt(0)" ::: "memory");
                grid.sync();
                __builtin_amdgcn_fence(__ATOMIC_ACQUIRE, "agent");
                asm volatile("s_waitcnt vmcnt(0)" ::: "memory");
                __syncthreads();
            }
            xcd_barrier(bar);
        }
        if (REP_N > 0 && ph == REP_PH && repcnt < REP_N && REP_COND) { ++repcnt; --ph; }
    }
}

extern "C" void kernel_launch(void* const* d_in, const int* in_sizes, int n_in, void* d_out, int out_size, void* d_ws, size_t ws_size, hipStream_t stream) {
    static int grid = 0;
    if (grid == 0) {
        int dev = 0, cus = 0, per_cu = 0;
        (void)hipGetDevice(&dev);
        (void)hipDeviceGetAttribute(&cus, hipDeviceAttributeMultiprocessorCount, dev);
        (void)hipFuncSetAttribute((const void*)mk_fwd, hipFuncAttributeMaxDynamicSharedMemorySize, LDS_BYTES);
        (void)hipOccupancyMaxActiveBlocksPerMultiprocessor(&per_cu, (const void*)mk_fwd, 512, LDS_BYTES);
        grid = (n_in == 19 && per_cu >= 1 && cus == 256 && ws_size >= WS_END && out_size == M_TOK * DM) ? 256 : -1;
        if (grid < 0) fprintf(stderr, "kernel_launch: unsupported configuration (cus %d per_cu %d ws %zu n_in %d)\n", cus, per_cu, ws_size, n_in);
    }
    if (grid < 0) return;
    if (hipMemsetAsync((char*)d_ws + WS_CTL, 0, 65536, stream) != hipSuccess) { fprintf(stderr, "kernel_launch: memset failed\n"); return; }
    Args a{};
    for (int i = 0; i < 19; ++i) a.in[i] = (const float*)d_in[i];
    a.out = (float*)d_out; a.ws = (unsigned char*)d_ws; a.ph_lo = DBG_LO; a.ph_hi = DBG_HI;
    void* args[] = {&a};
#ifdef PLAIN_LAUNCH
    hipError_t e = hipLaunchKernel((void*)mk_fwd, dim3(grid), dim3(512), args, LDS_BYTES, stream);
#else
    hipError_t e = hipLaunchCooperativeKernel((void*)mk_fwd, dim3(grid), dim3(512), args, LDS_BYTES, stream);
#endif
    if (e != hipSuccess) fprintf(stderr, "cooperative launch failed: %s\n", hipGetErrorString(e));
}
```

```cpp
#include <hip/hip_runtime.h>
#include <hip/hip_cooperative_groups.h>
#include <cstdio>
#include <cstdint>
#include <cmath>
namespace cg = cooperative_groups;
#define REP_N 0
#define REP_PH (-1)
namespace pg8 {
#define PG8_LAS __attribute__((address_space(3)))
typedef unsigned short bf16_t;
typedef short bf16x8 __attribute__((ext_vector_type(8)));
typedef float f32x4 __attribute__((ext_vector_type(4)));
typedef float f32x2 __attribute__((ext_vector_type(2)));
typedef unsigned u32x4 __attribute__((ext_vector_type(4)));
typedef unsigned u32x2 __attribute__((ext_vector_type(2)));
constexpr int BM = 256, BK = 64, HALF = 128, HTB = HALF * BK * 2  , STAGE_BYTES = 8 * HTB, NXCD = 8, WGM = 8;

__host__ __device__ __forceinline__ int lds_byte(int r, int c) { const int st = (r >> 4) * 2 + (c >> 5), rr = r & 15, cc = c & 31, ob = rr * 64 + cc * 2; return st * 1024 + (ob ^ (((ob >> 9) & 1) << 5)); }
__host__ __device__ __forceinline__ void stage_rc(int b, int& R, int& C) { const int st = b / 1024, sb = b % 1024, swz = sb ^ (((sb >> 9) & 1) << 5); R = (st >> 1) * 16 + swz / 64; C = (st & 1) * 32 + (swz % 64) / 2; }
__host__ __device__ __forceinline__ int perm32(int rho) { const int n = rho >> 4, i = rho & 15; return 8 * (i >> 2) + 4 * n + (i & 3); }

struct Unit { int pm, pn; };
struct Gemm { const bf16_t* A; const bf16_t* Bt; int lda, ldb, M, N, K; };

struct StaticOrder {
    int nM, nN, nwg, G, c;
    __host__ __device__ void init(int M, int N, int G_, int c_) { nM = M / BM; nN = N / BM; nwg = nM * nN; G = G_; c = c_; }
    __host__ __device__ bool next(int i, Unit& u) const {
        const long L = (long)i * G + c; if (L >= nwg) return false;
        int wgid = (int)L; { const int q = nwg / NXCD, r = nwg % NXCD, xcd = wgid % NXCD, off = wgid / NXCD; wgid = (xcd < r ? xcd * (q + 1) : r * (q + 1) + (xcd - r) * q) + off; }
        const int nig = WGM * nN, gid = wgid / nig, fm = gid * WGM, gsz = (nM - fm) < WGM ? (nM - fm) : WGM;
        u.pm = fm + ((wgid % nig) % gsz); u.pn = (wgid % nig) / gsz; return true;
    }
};

typedef float f32x2_cv __attribute__((ext_vector_type(2))); typedef __bf16 bf16x2_cv __attribute__((ext_vector_type(2)));
__device__ __forceinline__ unsigned cvt_pk_bf16(float lo, float hi) { const f32x2_cv v = {lo, hi}; const bf16x2_cv b = __builtin_convertvector(v, bf16x2_cv); return __builtin_bit_cast(unsigned, b); }


__device__ __forceinline__ float row_rstd(const float* ssq, int row) { const f32x4 p = *(const f32x4*)(ssq + 4 * (size_t)row); return rsqrtf(((p[0] + p[1]) + (p[2] + p[3])) * (1.0f / 1024.0f) + 1e-6f); }

struct EpiBf16 {
    static constexpr bool PERM = true, AFTER_DRAIN = false;
    bf16_t* O; int ldc; const float* ssq; int silu_pn0; int act;
    __device__ __forceinline__ void operator()(const f32x4 (&acc)[2][2][4][2], const Unit& u, int wr, int wc, int fr, int fq) const {
        const int row0 = u.pm * BM + wr * 64 + fr; const int col0 = u.pn * BM + wc * 32 + 8 * fq;
        const bool do_silu = (act == 2) && (u.pn >= silu_pn0);
#if 1
        const __amdgpu_buffer_rsrc_t rsrc = __builtin_amdgcn_make_buffer_rsrc((void*)O, 0, 0x7fffffff, 0x00020000);
#endif
#pragma unroll
        for (int ai = 0; ai < 2; ++ai)
#pragma unroll
            for (int m = 0; m < 4; ++m) { const int row = row0 + ai * HALF + m * 16; const float rs = row_rstd(ssq, row); bf16_t* rowp = O + (size_t)row * ldc + col0;
#pragma unroll
                for (int bj = 0; bj < 2; ++bj) { f32x4 v0 = acc[ai][bj][m][0] * rs, v1 = acc[ai][bj][m][1] * rs;
                    if (act == 1) {
#pragma unroll
                        for (int e = 0; e < 4; ++e) { const float a = fmaxf(v0[e], 0.f), b = fmaxf(v1[e], 0.f); v0[e] = a * a; v1[e] = b * b; } }
                    if (do_silu) {
#pragma unroll
                        for (int e = 0; e < 4; ++e) { v0[e] = v0[e] / (1.0f + __expf(-v0[e])); v1[e] = v1[e] / (1.0f + __expf(-v1[e])); } }
                    u32x4 w; w.x = cvt_pk_bf16(v0[0], v0[1]); w.y = cvt_pk_bf16(v0[2], v0[3]); w.z = cvt_pk_bf16(v1[0], v1[1]); w.w = cvt_pk_bf16(v1[2], v1[3]);
#if 1
                    __builtin_amdgcn_raw_buffer_store_b128(w, rsrc, (unsigned)(((size_t)row * ldc + col0 + bj * HALF) * 2), 0, 16);
#else
                    *(u32x4*)(rowp + bj * HALF) = w;
#endif
                    } }
    }
};

struct EpiResid {
    static constexpr bool PERM = true, AFTER_DRAIN = true;
    const float* basef; const bf16_t* baseb; float* outf; bf16_t* xb; float* ssq_out; int ldc; float accscale;
    __device__ __forceinline__ void fused(f32x4 (&acc)[2][2][4][2], const Unit& u, int wr, int wc, int fr, int fq, PG8_LAS unsigned char* lds, int wid, int lane) const {
        PG8_LAS float* P = (PG8_LAS float*)lds;
        const int col0 = u.pn * BM + wc * 32 + 8 * fq;
#pragma unroll
        for (int ai = 0; ai < 2; ++ai)
#pragma unroll
            for (int m = 0; m < 4; ++m) { const int r = ai * HALF + wr * 64 + m * 16 + fr; const size_t off = (size_t)(u.pm * BM + r) * ldc + col0; float s = 0.f;
#pragma unroll
                for (int bj = 0; bj < 2; ++bj) { const size_t o2 = off + bj * HALF; f32x4 b0, b1;
                    if (basef) { b0 = *(const f32x4*)(basef + o2); b1 = *(const f32x4*)(basef + o2 + 4); }
                    else { const u32x4 b = *(const u32x4*)(baseb + o2);
                        b0 = (f32x4){__uint_as_float(b.x << 16), __uint_as_float(b.x & 0xffff0000u), __uint_as_float(b.y << 16), __uint_as_float(b.y & 0xffff0000u)};
                        b1 = (f32x4){__uint_as_float(b.z << 16), __uint_as_float(b.z & 0xffff0000u), __uint_as_float(b.w << 16), __uint_as_float(b.w & 0xffff0000u)}; }
                    const f32x4 o0 = b0 + acc[ai][bj][m][0] * accscale, o1 = b1 + acc[ai][bj][m][1] * accscale;
                    if (outf) { *(f32x4*)(outf + o2) = o0; *(f32x4*)(outf + o2 + 4) = o1; }
                    if (xb) { u32x4 w; w.x = cvt_pk_bf16(o0[0], o0[1]); w.y = cvt_pk_bf16(o0[2], o0[3]); w.z = cvt_pk_bf16(o1[0], o1[1]); w.w = cvt_pk_bf16(o1[2], o1[3]); *(u32x4*)(xb + o2) = w; }
                    s += ((o0[0] * o0[0] + o0[1] * o0[1]) + (o0[2] * o0[2] + o0[3] * o0[3])) + ((o1[0] * o1[0] + o1[1] * o1[1]) + (o1[2] * o1[2] + o1[3] * o1[3])); }
                if (ssq_out) { s += __shfl_xor(s, 16); s += __shfl_xor(s, 32); if (fq == 0) P[r * 4 + wc] = s; }
                if (m & 1) asm volatile("" ::: "memory"); }
        if (ssq_out) {
            __syncthreads();
            const int t = wid * 64 + lane;
            if (t < 256) { const float s = (P[t * 4 + 0] + P[t * 4 + 1]) + (P[t * 4 + 2] + P[t * 4 + 3]); ssq_out[(size_t)(u.pm * BM + t) * 4 + u.pn] = s; }
            __syncthreads();
        }
    }
};

template <class Epi, class Sched, bool ALIGN_EPI = false, bool SP2 = false>
__device__ __forceinline__ void gemm_phase(PG8_LAS unsigned char* lds, const Gemm g, const Sched& S, const Epi& E, const int tid) {
    const int wid = __builtin_amdgcn_readfirstlane(tid >> 6), lane = tid & 63, wr = wid >> 2, wc = wid & 3, fr = lane & 15, fq = lane >> 4;
    const int K = g.K, nt = K / BK;
    unsigned voffA[2], voffB[2];
#pragma unroll
    for (int i = 0; i < 2; ++i) { int R, C; stage_rc(tid * 16 + i * 8192, R, C); const int Rb = Epi::PERM ? ((R & ~31) + perm32(R & 31)) : R;
        voffA[i] = (unsigned)(R * g.lda + C) * 2u; voffB[i] = (unsigned)(Rb * g.ldb + C) * 2u; }
    const size_t kstep = (size_t)(BK * 2);
    const size_t hstepA = (size_t)HALF * g.lda * 2, hstepB = (size_t)HALF * g.ldb * 2;
    const size_t tstepA = 2 * hstepA, tstepB = 2 * hstepB;
    const unsigned ldsw = (unsigned)wid * 1024u;
    const int aoff = lds_byte(wr * 64 + fr, fq * 8), boff = lds_byte(wc * 32 + fr, fq * 8);
#define PG8_SA(b, h) (((b) * 2 + (h)) * HTB)
#define PG8_SB(b, h) ((4 + (b) * 2 + (h)) * HTB)
#define PG8_STAGE(bufoff, gbase, voff) do { _Pragma("unroll") for (int _i = 0; _i < 2; ++_i) \
        __builtin_amdgcn_global_load_lds((const unsigned*)((const char*)(gbase) + (voff)[_i]), (PG8_LAS unsigned*)(lds + (bufoff) + ldsw + _i * 8192), 16, 0, 0); } while (0)
#define PG8_LDA(dst, b, h) do { _Pragma("unroll") for (int m = 0; m < 4; ++m) _Pragma("unroll") for (int k = 0; k < 2; ++k) dst[m][k] = *(const PG8_LAS bf16x8*)(lds + PG8_SA(b, h) + aoff + m * 2048 + k * 1024); } while (0)
#define PG8_LDB(dst, b, h) do { _Pragma("unroll") for (int n = 0; n < 2; ++n) _Pragma("unroll") for (int k = 0; k < 2; ++k) dst[n][k] = *(const PG8_LAS bf16x8*)(lds + PG8_SB(b, h) + boff + n * 2048 + k * 1024); } while (0)
#define PG8_MMA(ai, bj, At, Bt) do { __builtin_amdgcn_s_setprio(1); _Pragma("unroll") for (int m = 0; m < 4; ++m) _Pragma("unroll") for (int n = 0; n < 2; ++n) _Pragma("unroll") for (int k = 0; k < 2; ++k) \
        acc[ai][bj][m][n] = __builtin_amdgcn_mfma_f32_16x16x32_bf16(Bt[n][k], At[m][k], acc[ai][bj][m][n], 0, 0, 0); __builtin_amdgcn_s_setprio(0); } while (0)
#define PG8_WAIT_V(n) asm volatile("s_waitcnt vmcnt(" #n ")" ::: "memory")
#define PG8_WAIT_L(n) asm volatile("s_waitcnt lgkmcnt(" #n ")" ::: "memory")
#define PG8_BAR __builtin_amdgcn_s_barrier()
#define PG8_SCHED __builtin_amdgcn_sched_barrier(0)
    Unit cur, nxt; int ui = 0;
    if (!S.next(0, cur)) return;
    f32x4 acc[2][2][4][2];
#pragma unroll
    for (int a = 0; a < 2; ++a)
#pragma unroll
        for (int b = 0; b < 2; ++b)
#pragma unroll
            for (int m = 0; m < 4; ++m)
#pragma unroll
                for (int n = 0; n < 2; ++n) acc[a][b][m][n] = (f32x4){0.f, 0.f, 0.f, 0.f};
    bf16x8 At[4][2], B0[2][2], B1[2][2];
    const char* cA = (const char*)g.A + (size_t)cur.pm * tstepA; const char* cB = (const char*)g.Bt + (size_t)cur.pn * tstepB;
    if constexpr (SP2) {
        PG8_STAGE(PG8_SB(0, 0), cB, voffB); PG8_STAGE(PG8_SB(0, 1), cB + hstepB, voffB); PG8_STAGE(PG8_SA(0, 0), cA, voffA); PG8_STAGE(PG8_SA(0, 1), cA + hstepA, voffA);
        if (wr == 1) PG8_BAR;
        PG8_WAIT_V(2); PG8_BAR;
        PG8_STAGE(PG8_SB(1, 0), cB + kstep, voffB); PG8_STAGE(PG8_SA(1, 0), cA + kstep, voffA); PG8_STAGE(PG8_SB(1, 1), cB + hstepB + kstep, voffB);
        PG8_WAIT_V(6); PG8_BAR;
    } else {
        PG8_STAGE(PG8_SB(0, 0), cB, voffB); PG8_STAGE(PG8_SA(0, 0), cA, voffA); PG8_STAGE(PG8_SB(0, 1), cB + hstepB, voffB); PG8_STAGE(PG8_SA(0, 1), cA + hstepA, voffA);
        if (wr == 1) PG8_BAR;
        PG8_WAIT_V(4); PG8_BAR;
        PG8_STAGE(PG8_SB(1, 0), cB + kstep, voffB); PG8_STAGE(PG8_SA(1, 0), cA + kstep, voffA); PG8_STAGE(PG8_SB(1, 1), cB + hstepB + kstep, voffB);
        PG8_WAIT_V(6); PG8_BAR;
    }
    for (;;) {
        const bool has_next = S.next(ui + 1, nxt);
        const char* nA = has_next ? (const char*)g.A + (size_t)nxt.pm * tstepA : cA; const char* nB = has_next ? (const char*)g.Bt + (size_t)nxt.pn * tstepB : cB;
        for (int t = 0; t < nt; t += 2) {
            const bool last = (t == nt - 2);
            const char* a1 = cA + (size_t)(t + 1) * kstep;
            const char* a2 = last ? nA : cA + (size_t)(t + 2) * kstep; const char* b2 = last ? nB : cB + (size_t)(t + 2) * kstep;
            const char* a3 = a2 + kstep; const char* b3 = b2 + kstep;
            if constexpr (SP2) {
            PG8_LDB(B0, 0, 0); PG8_LDB(B1, 0, 1); PG8_SCHED; PG8_LDA(At, 0, 0); PG8_STAGE(PG8_SA(1, 1), a1 + hstepA, voffA);
            PG8_WAIT_V(8); PG8_WAIT_L(0); PG8_BAR; PG8_MMA(0, 0, At, B0); PG8_MMA(0, 1, At, B1); PG8_BAR; PG8_SCHED;
            PG8_LDA(At, 0, 1); PG8_STAGE(PG8_SB(0, 0), b2, voffB); PG8_STAGE(PG8_SB(0, 1), b2 + hstepB, voffB); PG8_STAGE(PG8_SA(0, 0), a2, voffA);
            PG8_WAIT_V(8); PG8_WAIT_L(0); PG8_BAR; PG8_MMA(1, 0, At, B0); PG8_MMA(1, 1, At, B1); PG8_BAR; PG8_SCHED;
            PG8_LDB(B0, 1, 0); PG8_LDB(B1, 1, 1); PG8_SCHED; PG8_LDA(At, 1, 0); PG8_STAGE(PG8_SA(0, 1), a2 + hstepA, voffA);
            PG8_WAIT_V(8); PG8_WAIT_L(0); PG8_BAR; PG8_MMA(0, 0, At, B0); PG8_MMA(0, 1, At, B1); PG8_BAR; PG8_SCHED;
            PG8_LDA(At, 1, 1); PG8_STAGE(PG8_SB(1, 0), b3, voffB); PG8_STAGE(PG8_SB(1, 1), b3 + hstepB, voffB); PG8_STAGE(PG8_SA(1, 0), a3, voffA);
            PG8_WAIT_V(8); PG8_WAIT_L(0); PG8_BAR; PG8_MMA(1, 0, At, B0); PG8_MMA(1, 1, At, B1); PG8_BAR; PG8_SCHED;
            } else {
            PG8_LDB(B0, 0, 0); PG8_SCHED; PG8_LDA(At, 0, 0); PG8_STAGE(PG8_SA(1, 1), a1 + hstepA, voffA);
            PG8_WAIT_L(8); PG8_BAR; PG8_WAIT_L(0); PG8_MMA(0, 0, At, B0); PG8_BAR; PG8_SCHED;
            PG8_LDB(B1, 0, 1); PG8_STAGE(PG8_SB(0, 0), b2, voffB);
            PG8_BAR; PG8_WAIT_L(0); PG8_MMA(0, 1, At, B1); PG8_BAR;
            PG8_LDA(At, 0, 1); PG8_STAGE(PG8_SA(0, 0), a2, voffA);
            PG8_BAR; PG8_WAIT_L(0); PG8_MMA(1, 0, At, B0); PG8_BAR; PG8_SCHED;
            PG8_STAGE(PG8_SB(0, 1), b2 + hstepB, voffB);
            PG8_WAIT_V(6); PG8_BAR; PG8_MMA(1, 1, At, B1); PG8_BAR;
            PG8_LDB(B0, 1, 0); PG8_SCHED; PG8_LDA(At, 1, 0); PG8_STAGE(PG8_SA(0, 1), a2 + hstepA, voffA);
            PG8_WAIT_L(8); PG8_BAR; PG8_WAIT_L(0); PG8_MMA(0, 0, At, B0); PG8_BAR; PG8_SCHED;
            PG8_LDB(B1, 1, 1); PG8_STAGE(PG8_SB(1, 0), b3, voffB);
            PG8_BAR; PG8_WAIT_L(0); PG8_MMA(0, 1, At, B1); PG8_BAR;
            PG8_LDA(At, 1, 1); PG8_STAGE(PG8_SA(1, 0), a3, voffA);
            PG8_BAR; PG8_WAIT_L(0); PG8_MMA(1, 0, At, B0); PG8_BAR; PG8_SCHED;
            PG8_STAGE(PG8_SB(1, 1), b3 + hstepB, voffB);
            PG8_WAIT_V(6); PG8_BAR; PG8_MMA(1, 1, At, B1); PG8_BAR;
            }
        }
        if constexpr (ALIGN_EPI) { if (wr == 0) PG8_BAR; }
        if constexpr (!Epi::AFTER_DRAIN) { E(acc, cur, wr, wc, fr, fq); }
        if (!has_next) break;
#pragma unroll
        for (int a = 0; a < 2; ++a)
#pragma unroll
            for (int b = 0; b < 2; ++b)
#pragma unroll
                for (int m = 0; m < 4; ++m)
#pragma unroll
                    for (int n = 0; n < 2; ++n) acc[a][b][m][n] = (f32x4){0.f, 0.f, 0.f, 0.f};
        cur = nxt; cA = nA; cB = nB; ++ui;
        if constexpr (ALIGN_EPI) { if (wr == 1) PG8_BAR; }
    }
    PG8_WAIT_V(0);
    if constexpr (!ALIGN_EPI) { if (wr == 0) PG8_BAR; }
    PG8_BAR;
    if constexpr (Epi::AFTER_DRAIN) { E.fused(acc, cur, wr, wc, fr, fq, lds, wid, lane); }
#undef PG8_SA
#undef PG8_SB
#undef PG8_STAGE
#undef PG8_LDA
#undef PG8_LDB
#undef PG8_MMA
#undef PG8_WAIT_V
#undef PG8_WAIT_L
#undef PG8_BAR
#undef PG8_SCHED
}
}
#define LAS __attribute__((address_space(3)))
typedef unsigned short bf16;
typedef short bf16x8 __attribute__((ext_vector_type(8)));
typedef short s16x4 __attribute__((ext_vector_type(4)));
typedef float f32x4 __attribute__((ext_vector_type(4)));
typedef unsigned u32x4 __attribute__((ext_vector_type(4)));
typedef unsigned u32x2 __attribute__((ext_vector_type(2)));
typedef LAS unsigned char* ldsp;
constexpr float LOG2E = 1.4426950408889634f;

__device__ __forceinline__ float bf_lo(unsigned w) { return __uint_as_float(w << 16); }
__device__ __forceinline__ float bf_hi(unsigned w) { return __uint_as_float(w & 0xffff0000u); }
__device__ __forceinline__ unsigned pk2(float lo, float hi) { return pg8::cvt_pk_bf16(lo, hi); }
__device__ __forceinline__ s16x4 vtr(ldsp p) { typedef short v4i16_t __attribute__((ext_vector_type(4))); return __builtin_bit_cast(s16x4, __builtin_amdgcn_ds_read_tr16_b64_v4i16((LAS v4i16_t*)p)); }
__device__ __forceinline__ bf16x8 cat8(s16x4 lo, s16x4 hi) { return (bf16x8){lo[0], lo[1], lo[2], lo[3], hi[0], hi[1], hi[2], hi[3]}; }
__device__ __forceinline__ f32x4 mfma16(bf16x8 a, bf16x8 b, f32x4 c) { return __builtin_amdgcn_mfma_f32_16x16x32_bf16(a, b, c, 0, 0, 0); }
__device__ __forceinline__ float ex2(float x) { return __builtin_amdgcn_exp2f(x); }

namespace att {
constexpr int SEQ = 16384, LDQ = 2304, LDO = 1024;
constexpr int KPB = 160;
constexpr int COL_QA = 0, COL_KA = 512, COL_VA = 640, COL_QB = 768, COL_KB = 1280, COL_VB = 1792;

template <int NP>
__device__ __forceinline__ void load_rows(u32x4 (&v)[NP], const bf16* src, int tok0, int nvalid, int tid) {
    const int sub = tid & 7;
#pragma unroll
    for (int p = 0; p < NP; ++p) { const int r = (tid >> 3) + 64 * p, tok = tok0 + r; const bool ok = (tok >= 0) && (tok < SEQ) && (r < nvalid);
        v[p] = (u32x4){0u, 0u, 0u, 0u};
        if (ok) v[p] = *(const u32x4*)(src + (size_t)tok * LDQ + sub * 8); }
}
template <int NP, bool NORM>
__device__ __forceinline__ void store_rows(ldsp dst, const u32x4 (&v)[NP], int nrows, const float* gain, int tid) {
    const int sub = tid & 7;
    float gn[8];
    if (NORM) {
#pragma unroll
        for (int j = 0; j < 8; ++j) gn[j] = gain[sub * 8 + j];
    }
#pragma unroll
    for (int p = 0; p < NP; ++p) { const int r = (tid >> 3) + 64 * p;
        if (r < nrows) {
            u32x4 w = v[p];
            if (NORM) {
                float f[8]; f[0] = bf_lo(w.x); f[1] = bf_hi(w.x); f[2] = bf_lo(w.y); f[3] = bf_hi(w.y); f[4] = bf_lo(w.z); f[5] = bf_hi(w.z); f[6] = bf_lo(w.w); f[7] = bf_hi(w.w);
                float ss = 0.f;
#pragma unroll
                for (int j = 0; j < 8; ++j) ss += f[j] * f[j];
                ss += __shfl_xor(ss, 1); ss += __shfl_xor(ss, 2); ss += __shfl_xor(ss, 4);
                const float rs = rsqrtf(ss * (1.0f / 64.0f) + 1e-6f);
#pragma unroll
                for (int j = 0; j < 8; ++j) f[j] = f[j] * rs * gn[j];
                w.x = pk2(f[0], f[1]); w.y = pk2(f[2], f[3]); w.z = pk2(f[4], f[5]); w.w = pk2(f[6], f[7]);
            }
            *(LAS u32x4*)(dst + r * KPB + sub * 16) = w;
        } }
}

__device__ __forceinline__ void load_q_raw(u32x4 (&raw)[2], const bf16* qrow  , int g) {
#pragma unroll
    for (int s = 0; s < 2; ++s) raw[s] = *(const u32x4*)(qrow + 32 * s + 8 * g);
}
__device__ __forceinline__ void finish_q(bf16x8 (&qf)[2], const u32x4 (&raw)[2], const float* gain, int g) {
    float f[2][8]; float ss = 0.f;
#pragma unroll
    for (int s = 0; s < 2; ++s) { const u32x4 v = raw[s];
        f[s][0] = bf_lo(v.x); f[s][1] = bf_hi(v.x); f[s][2] = bf_lo(v.y); f[s][3] = bf_hi(v.y); f[s][4] = bf_lo(v.z); f[s][5] = bf_hi(v.z); f[s][6] = bf_lo(v.w); f[s][7] = bf_hi(v.w);
#pragma unroll
        for (int j = 0; j < 8; ++j) ss += f[s][j] * f[s][j]; }
    ss += __shfl_xor(ss, 16); ss += __shfl_xor(ss, 32);
    const float rs = rsqrtf(ss * (1.0f / 64.0f) + 1e-6f) * (0.125f * LOG2E);
#pragma unroll
    for (int s = 0; s < 2; ++s) { float o[8];
#pragma unroll
        for (int j = 0; j < 8; ++j) o[j] = f[s][j] * rs * gain[32 * s + 8 * g + j];
        u32x4 w; w.x = pk2(o[0], o[1]); w.y = pk2(o[2], o[3]); w.z = pk2(o[4], o[5]); w.w = pk2(o[6], o[7]);
        qf[s] = __builtin_bit_cast(bf16x8, w); }
}

template <int NT, class RB>
__device__ __forceinline__ void scores(f32x4 (&sc)[NT], ldsp Kb, const bf16x8 (&qf)[2], const RB& rb, int lane) {
    const int fr = lane & 15, g = lane >> 4;
#pragma unroll
    for (int t = 0; t < NT; ++t) { ldsp kp = Kb + (rb(t) + fr) * KPB + g * 16; f32x4 a = (f32x4){0.f, 0.f, 0.f, 0.f};
#pragma unroll
        for (int s = 0; s < 2; ++s) { const bf16x8 kf = *(const LAS bf16x8*)(kp + s * 64); a = mfma16(kf, qf[s], a); }
        sc[t] = a; if ((t & 3) == 3) __builtin_amdgcn_sched_barrier(0); }
}
template <int NT>
__device__ __forceinline__ float softmax_pack(f32x4 (&sc)[NT], bf16x8 (&pf)[NT / 2], float sink2, bool has_sink) {
    float m = -INFINITY;
#pragma unroll
    for (int t = 0; t < NT; ++t)
#pragma unroll
        for (int r = 0; r < 4; ++r) m = fmaxf(m, sc[t][r]);
    m = fmaxf(m, __shfl_xor(m, 16)); m = fmaxf(m, __shfl_xor(m, 32));
    if (has_sink) m = fmaxf(m, sink2);
    float sum = 0.f;
#pragma unroll
    for (int t = 0; t < NT; ++t)
#pragma unroll
        for (int r = 0; r < 4; ++r) { const float p = ex2(sc[t][r] - m); sc[t][r] = p; sum += p; }
    sum += __shfl_xor(sum, 16); sum += __shfl_xor(sum, 32);
    if (has_sink) sum += ex2(sink2 - m);
#pragma unroll
    for (int k = 0; k < NT / 2; ++k) { u32x4 w; w.x = pk2(sc[2 * k][0], sc[2 * k][1]); w.y = pk2(sc[2 * k][2], sc[2 * k][3]); w.z = pk2(sc[2 * k + 1][0], sc[2 * k + 1][1]); w.w = pk2(sc[2 * k + 1][2], sc[2 * k + 1][3]);
        pf[k] = __builtin_bit_cast(bf16x8, w); }
    return sum;
}
template <int NT, class RB>
__device__ __forceinline__ void pv_store(ldsp Vb, const bf16x8 (&pf)[NT / 2], const RB& rb, float sum, bf16* orow  , int lane) {
    const int g = lane >> 4, q4 = (lane & 15) >> 2, p4 = lane & 3;
    f32x4 o[4];
#pragma unroll
    for (int dt = 0; dt < 4; ++dt) o[dt] = (f32x4){0.f, 0.f, 0.f, 0.f};
#pragma unroll
    for (int k = 0; k < NT / 2; ++k) { ldsp v0 = Vb + (rb(2 * k) + 4 * g + q4) * KPB + p4 * 8; ldsp v1 = Vb + (rb(2 * k + 1) + 4 * g + q4) * KPB + p4 * 8;
#pragma unroll
        for (int dt = 0; dt < 4; ++dt) { const bf16x8 vf = cat8(vtr(v0 + dt * 32), vtr(v1 + dt * 32)); o[dt] = mfma16(vf, pf[k], o[dt]); } }
    const float inv = 1.0f / sum;
#pragma unroll
    for (int dt = 0; dt < 4; ++dt) { u32x2 w; w.x = pk2(o[dt][0] * inv, o[dt][1] * inv); w.y = pk2(o[dt][2] * inv, o[dt][3] * inv); *(u32x2*)(orow + dt * 16 + 4 * g) = w; }
}

struct RbWin { int mt; __device__ __forceinline__ int operator()(int t) const { return 16 * (mt + t); } };
struct RbNa { int off, ct0, ct1; __device__ __forceinline__ int operator()(int t) const { return (off + (t >> 1)) * 64 + ((t & 1) ? ct1 : ct0) * 16; } };

struct AttnArgs { const bf16* qkv; bf16* o; const float* qn_a; const float* kn_a; const float* sink_a; const float* qn_b; const float* kn_b; const float* rpb; };

__device__ __forceinline__ void window_tile(ldsp Kb, ldsp Vb, const AttnArgs& A, int n, int kvh, int idx, const u32x4 (&qraw)[2], int lane) {
    const int fr = lane & 15, g = lane >> 4;
    const int g4 = idx >> 3, mt = idx & 7, hq = kvh * 4 + g4;
    const int qtok = n * 128 + mt * 16 + fr;
    bf16x8 qf[2]; finish_q(qf, qraw, A.qn_a, g);
    RbWin rb{mt};
    f32x4 sc[18]; scores<18>(sc, Kb, qf, rb, lane);
    const float slope2 = exp2f(-(float)(hq + 1)) * LOG2E;
    {
        const float cl = (float)(4 * g - 128 - fr);
        const float lo = (float)max(-128, -qtok), hi = (float)min(128, SEQ - 1 - qtok);
#pragma unroll
        for (int t = 0; t < 18; ++t)
#pragma unroll
            for (int r = 0; r < 4; ++r) { const float rel = cl + (float)(16 * t + r); sc[t][r] = (rel >= lo && rel <= hi) ? fmaf(-slope2, fabsf(rel), sc[t][r]) : -INFINITY; }
    }
    bf16x8 pf[9]; const float sum = softmax_pack<18>(sc, pf, A.sink_a[hq] * LOG2E, true);
    pv_store<18>(Vb, pf, rb, sum, A.o + (size_t)qtok * LDO + hq * 64, lane);
}
__device__ __forceinline__ void window_compute(ldsp lds, const AttnArgs& A, int unit, int tid) {
    const int n = unit >> 1, kvh = unit & 1, lane = tid & 63, wid = __builtin_amdgcn_readfirstlane(tid >> 6);
    ldsp Kb = lds, Vb = lds + 400 * KPB;
    const int tok0 = (n - 1) * 128;
    const int fr = lane & 15, g = lane >> 4;
    u32x4 qa[2], qb[2];
    const bf16* qbase = A.qkv + (size_t)(n * 128 + fr) * LDQ + COL_QA + kvh * 256;
    auto qptr = [&](int it) { const int idx = wid * 4 + it; return qbase + (size_t)((idx & 7) * 16) * LDQ + (idx >> 3) * 64; };
    load_q_raw(qa, qptr(0), g);
    for (int it = 0; it < 4; it += 2) {
        load_q_raw(qb, qptr(it + 1), g);
        window_tile(Kb, Vb, A, n, kvh, wid * 4 + it, qa, lane);
        if (it + 2 < 4) load_q_raw(qa, qptr(it + 2), g);
        window_tile(Kb, Vb, A, n, kvh, wid * 4 + it + 1, qb, lane);
    }
}

constexpr int NA_ROWS = 704;
constexpr int NA_RPB_OFF = NA_ROWS * KPB;

__device__ __forceinline__ void na_unit(ldsp lds, const AttnArgs& A, int unit, int next_unit, u32x4 (&kreg)[11], int tid) {
    const int rq4 = unit >> 3, h = unit & 7, lane = tid & 63, wid = __builtin_amdgcn_readfirstlane(tid >> 6);
    const int r0 = 4 * rq4; const int base = min(max(r0 - 4, 0), 248);
    const int rq = r0 + (wid >> 1); const int rstart = min(max(rq - 4, 0), 248);
    const int fr = lane & 15, g = lane >> 4;
    store_rows<11, true>(lds, kreg, NA_ROWS, A.kn_b, tid);
    __syncthreads();
    const LAS float* rpl = (const LAS float*)(lds + NA_RPB_OFF);
    bf16x8 pf[2][8]; float sum[2]; int qtok[2]; int qcs[2]; u32x4 qraw[2][2];
#pragma unroll
    for (int it = 0; it < 2; ++it) { const int mt = 2 * (wid & 1) + it; qcs[it] = (mt < 3) ? 8 + 16 * mt + fr : (fr < 8 ? fr : 48 + fr); qtok[it] = rq * 64 + qcs[it];
        load_q_raw(qraw[it], A.qkv + (size_t)qtok[it] * LDQ + COL_QB + h * 64, g); }
#pragma unroll
    for (int it = 0; it < 2; ++it) {
        const int mt = 2 * (wid & 1) + it; const int qc = qcs[it];
        bf16x8 qf[2]; finish_q(qf, qraw[it], A.qn_b, g);
        RbNa rb{rstart - base, (mt < 3) ? mt : 0, (mt < 3) ? mt + 1 : 3};
        f32x4 sc[16]; scores<16>(sc, lds, qf, rb, lane);
        const int cstart = min(max(qc - 8, 0), 48);
        const int d0 = 4 * g - cstart;
        const LAS float* rpl0 = rpl + (rstart - rq + 7) * 128 + (4 * g - qc + 64);
#pragma unroll
        for (int t = 0; t < 16; ++t) { const int ct = (t & 1) ? rb.ct1 : rb.ct0; const LAS float* rp = rpl0 + (t >> 1) * 128 + 16 * ct; const int kb = 16 * ct + d0;
#pragma unroll
            for (int r = 0; r < 4; ++r) sc[t][r] = ((unsigned)(kb + r) < 16u) ? sc[t][r] + rp[r] : -INFINITY;
            if ((t & 3) == 3) __builtin_amdgcn_sched_barrier(0); }
        sum[it] = softmax_pack<16>(sc, pf[it], 0.f, false);
        __builtin_amdgcn_sched_barrier(0);
    }
    u32x4 vreg[11]; load_rows<11>(vreg, A.qkv + COL_VB + h * 64, base * 64, NA_ROWS, tid);
    __syncthreads();
    store_rows<11, false>(lds, vreg, NA_ROWS, nullptr, tid);
    if (next_unit >= 0) { const int nb = min(max(4 * (next_unit >> 3) - 4, 0), 248); load_rows<11>(kreg, A.qkv + COL_KB + h * 64, nb * 64, NA_ROWS, tid); }
    __syncthreads();
#pragma unroll
    for (int it = 0; it < 2; ++it) { const int mt = 2 * (wid & 1) + it; RbNa rb{rstart - base, (mt < 3) ? mt : 0, (mt < 3) ? mt + 1 : 3};
        pv_store<16>(lds, pf[it], rb, sum[it], A.o + (size_t)qtok[it] * LDO + 512 + h * 64, lane); __builtin_amdgcn_sched_barrier(0); }
    __syncthreads();
}

__device__ __forceinline__ void attn_phase(ldsp lds, const AttnArgs& A, int vcu, int G, int tid) {
    const int h = vcu & 7;
    u32x4 kreg[11];
#ifndef ATT_REP_WIN
#define ATT_REP_WIN 1
#define ATT_REP_NA 1
#endif
    for (int rw = 0; rw < ATT_REP_WIN; ++rw) {
        const int n = vcu >> 1, kvh = vcu & 1, tok0 = (n - 1) * 128;
        u32x4 kw[7], vw[7];
        load_rows<7>(kw, A.qkv + COL_KA + kvh * 64, tok0, 384, tid);
        load_rows<7>(vw, A.qkv + COL_VA + kvh * 64, tok0, 384, tid);
        store_rows<7, true>(lds, kw, 400, A.kn_a, tid);
        store_rows<7, false>(lds + 400 * KPB, vw, 400, nullptr, tid);
        __syncthreads();
        window_compute(lds, A, vcu, tid);
        __syncthreads();
    }
    for (int rn = 0; rn < ATT_REP_NA; ++rn) {
    { const int b0 = min(max(4 * (vcu >> 3) - 4, 0), 248); load_rows<11>(kreg, A.qkv + COL_KB + h * 64, b0 * 64, NA_ROWS, tid); }
    for (int i = tid; i < 15 * 128; i += 512) { const int ri = i >> 7, dc = i & 127; const int ci = min(max(dc - 49, 0), 30); ((LAS float*)(lds + NA_RPB_OFF))[i] = A.rpb[h * 465 + ri * 31 + ci] * LOG2E; }
    for (int k = 0; k < 2; ++k) { int t2 = tid; asm volatile("" : "+v"(t2));
        na_unit(lds, A, vcu + 256 * k, (k < 1) ? vcu + 256 * (k + 1) : -1, kreg, t2); }
    }
}
}
namespace ret {
constexpr int SEQ = 16384, LDG = 3072, NCH = 128;
constexpr int COL_Q = 0, COL_K = 512, COL_V = 1024, COL_G = 2048;
constexpr int KPB = 288;
constexpr int VPB = 544;
constexpr int UPB = 528;
constexpr int R0 = 0, R1 = 128 * KPB, R2 = 2 * 128 * KPB, RSTAT = R2 + 128 * VPB;
constexpr size_t ST_CHUNK = 128 * 256;

__device__ __forceinline__ unsigned pk2a(float lo, float hi) { unsigned r; asm volatile("v_cvt_pk_bf16_f32 %0, %1, %2" : "=v"(r) : "v"(lo), "v"(hi)); return r; }
struct RetArgs { bf16* G; bf16* ST; const float* l2;   const float* gn; int grp; int dry; bf16* Y; };

template <bool SCALE>
__device__ __forceinline__ void stage128(ldsp dst, const bf16* src, int ld, float a, float b, int tid) {
#pragma unroll
    for (int i = 0; i < 4; ++i) { const int idx = tid + i * 512, row = idx >> 4, ch = idx & 15;
        u32x4 v = *(const u32x4*)(src + (size_t)row * ld + ch * 8);
        if (SCALE) { const float s = ex2(a * (float)row + b);
            v.x = pk2a(bf_lo(v.x) * s, bf_hi(v.x) * s); v.y = pk2a(bf_lo(v.y) * s, bf_hi(v.y) * s); v.z = pk2a(bf_lo(v.z) * s, bf_hi(v.z) * s); v.w = pk2a(bf_lo(v.w) * s, bf_hi(v.w) * s); }
        *(LAS u32x4*)(dst + row * KPB + ch * 16) = v; }
}
__device__ __forceinline__ void stage256(ldsp dst, const bf16* src, int ld, int tid) {
#pragma unroll
    for (int i = 0; i < 8; ++i) { const int idx = tid + i * 512, row = idx >> 5, ch = idx & 31;
        const u32x4 v = *(const u32x4*)(src + (size_t)row * ld + ch * 8);
        *(LAS u32x4*)(dst + row * VPB + ch * 16) = v; }
}
__device__ __forceinline__ bf16x8 trfrag(ldsp X, int pitch, int k0, int n0, int lane) {
    const int g = lane >> 4, q4 = (lane & 15) >> 2, p4 = lane & 3;
    ldsp p = X + (k0 + 8 * g + q4) * pitch + (n0 + 4 * p4) * 2;
    return cat8(vtr(p), vtr(p + 4 * pitch));
}

__device__ __forceinline__ void ld128(u32x4 (&r)[4], const bf16* src, int ld, int tid) {
    const unsigned off0 = (unsigned)(((tid >> 4) * ld + (tid & 15) * 8) * 2);
#pragma unroll
    for (int i = 0; i < 4; ++i) r[i] = *(const u32x4*)((const char*)src + (size_t)i * 32 * ld * 2 + off0);
}
__device__ __forceinline__ void st128(ldsp dst, const u32x4 (&r)[4], int tid) {
    ldsp d0 = dst + (tid >> 4) * KPB + (tid & 15) * 16;
#pragma unroll
    for (int i = 0; i < 4; ++i) *(LAS u32x4*)(d0 + i * 32 * KPB) = r[i];
}
__device__ __forceinline__ void st128s(ldsp dst, const u32x4 (&r)[4], float a, float b, int tid) {
    ldsp d0 = dst + (tid >> 4) * KPB + (tid & 15) * 16;
#pragma unroll
    for (int i = 0; i < 4; ++i) { const int row = (tid >> 4) + 32 * i; const float s = ex2(a * (float)row + b); u32x4 v = r[i];
        v.x = pk2(bf_lo(v.x) * s, bf_hi(v.x) * s); v.y = pk2(bf_lo(v.y) * s, bf_hi(v.y) * s); v.z = pk2(bf_lo(v.z) * s, bf_hi(v.z) * s); v.w = pk2(bf_lo(v.w) * s, bf_hi(v.w) * s);
        *(LAS u32x4*)(d0 + i * 32 * KPB) = v; }
}
__device__ __forceinline__ void ld64(u32x4 (&r)[4], const bf16* src, int ld, int tid) {
    const unsigned off0 = (unsigned)(((tid >> 5) * ld + (tid & 31) * 8) * 2);
#pragma unroll
    for (int i = 0; i < 4; ++i) r[i] = *(const u32x4*)((const char*)src + (size_t)i * 16 * ld * 2 + off0);
}
__device__ __forceinline__ void st64(ldsp dst, const u32x4 (&r)[4], int tid) {
    ldsp d0 = dst + (tid >> 5) * VPB + (tid & 31) * 16;
#pragma unroll
    for (int i = 0; i < 4; ++i) *(LAS u32x4*)(d0 + i * 16 * VPB) = r[i];
}

__device__ __forceinline__ void ret_a_phase(ldsp lds, const RetArgs& A, int vcu, int G, int tid_in) {
    int tid = tid_in;
    const int wid = __builtin_amdgcn_readfirstlane(tid >> 6);
    int u = vcu; if (u >= 512) return;
    u32x4 rk[4], rv0[4], rv1[4];
    { const bf16* rows = A.G + (size_t)(u >> 2) * 128 * LDG; const int hl = u & 3;
      ld128(rk, rows + COL_K + hl * 128, LDG, tid); ld64(rv0, rows + COL_V + hl * 256, LDG, tid); ld64(rv1, rows + (size_t)64 * LDG + COL_V + hl * 256, LDG, tid); }
    for (;;) {
        asm volatile("" : "+v"(tid));
        const int lane = tid & 63, fr = lane & 15, g = lane >> 4;
        const int hl = u & 3, c = u >> 2, h = A.grp * 4 + hl;
        const float l2f = A.l2[h], l2b = A.l2[8 + h];
        st128s(lds + R0, rk, -l2f, 127.0f * l2f, tid);
        st128s(lds + R1, rk, l2b, 0.f, tid);
        st64(lds + R2, rv0, tid); st64(lds + R2 + 64 * VPB, rv1, tid);
        const int un = u + G; const bool has_next = un < 512;
        if (has_next) { const bf16* rows = A.G + (size_t)(un >> 2) * 128 * LDG; const int nhl = un & 3;
            ld128(rk, rows + COL_K + nhl * 128, LDG, tid); ld64(rv0, rows + COL_V + nhl * 256, LDG, tid); ld64(rv1, rows + (size_t)64 * LDG + COL_V + nhl * 256, LDG, tid); }
        __syncthreads();
        f32x4 acc[2][2][8];
#pragma unroll
        for (int dir = 0; dir < 2; ++dir) {
            ldsp Kx = lds + (dir ? R1 : R0);
#pragma unroll
            for (int et = 0; et < 2; ++et)
#pragma unroll
                for (int dt = 0; dt < 8; ++dt) acc[dir][et][dt] = (f32x4){0.f, 0.f, 0.f, 0.f};
#pragma unroll
            for (int ks = 0; ks < 4; ++ks) {
                bf16x8 vf[2];
#pragma unroll
                for (int et = 0; et < 2; ++et) vf[et] = trfrag(lds + R2, VPB, 32 * ks, 32 * wid + 16 * et, lane);
#pragma unroll
                for (int dt = 0; dt < 8; ++dt) { const bf16x8 kf = trfrag(Kx, KPB, 32 * ks, 16 * dt, lane);
#pragma unroll
                    for (int et = 0; et < 2; ++et) acc[dir][et][dt] = mfma16(vf[et], kf, acc[dir][et][dt]);
                    if ((dt & 3) == 3) __builtin_amdgcn_sched_barrier(0); }
            }
        }
        __syncthreads();
#pragma unroll
        for (int dir = 0; dir < 2; ++dir)
#pragma unroll
            for (int et = 0; et < 2; ++et)
#pragma unroll
                for (int dt = 0; dt < 8; ++dt) { u32x2 w; w.x = pk2(acc[dir][et][dt][0], acc[dir][et][dt][1]); w.y = pk2(acc[dir][et][dt][2], acc[dir][et][dt][3]);
                    *(LAS u32x2*)(lds + dir * (128 * UPB) + (16 * dt + fr) * UPB + (32 * wid + 16 * et + 4 * g) * 2) = w; }
        __syncthreads();
#pragma unroll
        for (int dir = 0; dir < 2; ++dir) { char* st = (char*)(A.ST + ((size_t)((dir * 4 + hl) * NCH + c)) * ST_CHUNK); const unsigned soff = (unsigned)((tid >> 5) * 512 + (tid & 31) * 16);
            ldsp s0 = lds + dir * (128 * UPB) + (tid >> 5) * UPB + (tid & 31) * 16;
#pragma unroll
            for (int i = 0; i < 8; ++i) *(u32x4*)(st + (size_t)i * 16 * 512 + soff) = *(const LAS u32x4*)(s0 + i * 16 * UPB); }
        __syncthreads();
        if (!has_next) break;
        u = un;
    }
}

__device__ __forceinline__ void ret_b(const RetArgs& A, int vcu, int G, int tid) {
    const int NT = 8 * 16384;
    for (int T = vcu * 512 + tid; T < NT; T += G * 512) {
        const int dh = T >> 14, w = T & 16383, dir = dh >> 2, hl = dh & 3, h = A.grp * 4 + hl;
        const float dec = ex2(128.0f * A.l2[dir * 8 + h]);
        unsigned* p = (unsigned*)(A.ST + (size_t)dh * NCH * ST_CHUNK) + w;
        const ptrdiff_t cs = dir ? -(ptrdiff_t)(ST_CHUNK / 2) : (ptrdiff_t)(ST_CHUNK / 2);
        if (dir) p += (size_t)(NCH - 1) * (ST_CHUNK / 2);
        float s0 = 0.f, s1 = 0.f;
        for (int c = 0; c < NCH; c += 32) {
            unsigned u[32];
#pragma unroll
            for (int k = 0; k < 32; ++k) u[k] = p[(ptrdiff_t)k * cs];
#pragma unroll
            for (int k = 0; k < 32; ++k) { p[(ptrdiff_t)k * cs] = A.dry ? u[k] : pk2(s0, s1); s0 = dec * s0 + bf_lo(u[k]); s1 = dec * s1 + bf_hi(u[k]); }
            p += 32 * cs;
        }
    }
}

constexpr int C_Q = 0, C_KA = 128 * KPB, C_B0 = 2 * 128 * KPB, C_B1 = C_B0 + 64 * VPB, C_STAT = C_B1 + 64 * VPB;
struct CPtrs { const bf16 *q, *k, *v, *sf, *sb; bf16* g; };
__device__ __forceinline__ CPtrs cptrs(const RetArgs& A, int unit) {
    const int hl = unit & 3, c = unit >> 2; bf16* rows = A.G + (size_t)c * 128 * LDG; CPtrs P;
    P.q = rows + COL_Q + hl * 128; P.k = rows + COL_K + hl * 128; P.v = rows + COL_V + hl * 256; P.g = rows + COL_G + hl * 256;
    P.sf = A.ST + ((size_t)((0 * 4 + hl) * NCH + c)) * ST_CHUNK; P.sb = A.ST + ((size_t)((1 * 4 + hl) * NCH + c)) * ST_CHUNK; return P;
}
__device__ __forceinline__ void half_mma(f32x4 (&acc)[2][8], ldsp buf, ldsp Bop, int kofs, int wid, int lane) {
    const int fr = lane & 15, g = lane >> 4;
#pragma unroll
    for (int ks = 0; ks < 2; ++ks) {
        bf16x8 xf[2];
#pragma unroll
        for (int et = 0; et < 2; ++et) xf[et] = trfrag(buf, VPB, 32 * ks, 32 * wid + 16 * et, lane);
#pragma unroll
        for (int it = 0; it < 8; ++it) { const bf16x8 bfrag = *(const LAS bf16x8*)(Bop + (16 * it + fr) * KPB + (kofs + 32 * ks + 8 * g) * 2);
#pragma unroll
            for (int et = 0; et < 2; ++et) acc[et][it] = mfma16(xf[et], bfrag, acc[et][it]);
            if ((it & 3) == 3) __builtin_amdgcn_sched_barrier(0); }
    }
}
__device__ __forceinline__ void ret_c_phase(ldsp lds, const RetArgs& A, int vcu, int G, int tid_in) {
    int tid = tid_in;
    const int wid = __builtin_amdgcn_readfirstlane(tid >> 6);
    int u = vcu; if (u >= 512) return;
    CPtrs P = cptrs(A, u);
    u32x4 r0[4], r1[4], r2[4], r3[4];
    ld128(r0, P.q, LDG, tid); ld128(r1, P.k, LDG, tid); ld64(r2, P.sf, 256, tid); ld64(r3, P.sf + 64 * 256, 256, tid);
    LAS float* stat = (LAS float*)(lds + C_STAT);
    for (;;) {
        asm volatile("" : "+v"(tid));
        const int lane = tid & 63, fr = lane & 15, g = lane >> 4;
        const int un = u + G; const bool has_next = un < 512;
        CPtrs N = P; if (has_next) N = cptrs(A, un);
        const int hl = u & 3, c = u >> 2, h = A.grp * 4 + hl;
        const float l2f = A.l2[h], l2b = A.l2[8 + h];
        st128(lds + C_Q, r0, tid); st128(lds + C_KA, r1, tid);
        ld64(r0, P.sb, 256, tid); ld64(r1, P.sb + 64 * 256, 256, tid);
        __syncthreads();
        f32x4 sa[8];
#pragma unroll
        for (int it = 0; it < 8; ++it) sa[it] = (f32x4){0.f, 0.f, 0.f, 0.f};
#pragma unroll
        for (int ks = 0; ks < 4; ++ks) { const bf16x8 kf = *(const LAS bf16x8*)(lds + C_KA + (16 * wid + fr) * KPB + (32 * ks + 8 * g) * 2);
#pragma unroll
            for (int it = 0; it < 8; ++it) { const bf16x8 qf = *(const LAS bf16x8*)(lds + C_Q + (16 * it + fr) * KPB + (32 * ks + 8 * g) * 2); sa[it] = mfma16(kf, qf, sa[it]); if ((it & 3) == 3) __builtin_amdgcn_sched_barrier(0); } }
        st64(lds + C_B0, r2, tid); ld64(r2, P.v, LDG, tid);
        __syncthreads();
#pragma unroll
        for (int it = 0; it < 8; ++it) { const int i = 16 * it + fr; float v[4];
#pragma unroll
            for (int r = 0; r < 4; ++r) { const int j = 16 * wid + 4 * g + r; const int dl = i - j; const float dm = dl >= 0 ? ex2((float)dl * l2f) : ex2((float)(-dl) * l2b); v[r] = sa[it][r] * dm; }
            u32x2 w; w.x = pk2(v[0], v[1]); w.y = pk2(v[2], v[3]);
            *(LAS u32x2*)(lds + C_KA + i * KPB + (16 * wid + 4 * g) * 2) = w; if (it & 1) __builtin_amdgcn_sched_barrier(0); }
        st64(lds + C_B1, r3, tid); ld64(r3, P.v + (size_t)64 * LDG, LDG, tid);
        f32x4 acc[2][8];
#pragma unroll
        for (int et = 0; et < 2; ++et)
#pragma unroll
            for (int it = 0; it < 8; ++it) acc[et][it] = (f32x4){0.f, 0.f, 0.f, 0.f};
        half_mma(acc, lds + C_B0, lds + C_Q, 0, wid, lane);
        __syncthreads();
        st64(lds + C_B0, r0, tid); if (has_next) ld128(r0, N.q, LDG, tid);
        half_mma(acc, lds + C_B1, lds + C_Q, 64, wid, lane);
        __syncthreads();
#pragma unroll
        for (int it = 0; it < 8; ++it) { const float fi = (float)(16 * it + fr); const float rt = ex2((fi + 1.0f) * l2f - (128.0f - fi) * l2b); acc[0][it] *= rt; acc[1][it] *= rt; }
        st64(lds + C_B1, r1, tid); if (has_next) ld128(r1, N.k, LDG, tid);
        half_mma(acc, lds + C_B0, lds + C_Q, 0, wid, lane);
        __syncthreads();
        st64(lds + C_B0, r2, tid); if (has_next) ld64(r2, N.sf, 256, tid);
        half_mma(acc, lds + C_B1, lds + C_Q, 64, wid, lane);
        __syncthreads();
#pragma unroll
        for (int it = 0; it < 8; ++it) { const float fi = (float)(16 * it + fr); const float sb = ex2((128.0f - fi) * l2b); acc[0][it] *= sb; acc[1][it] *= sb; }
        st64(lds + C_B1, r3, tid); if (has_next) ld64(r3, N.sf + 64 * 256, 256, tid);
        u32x2 gv[8][2]; f32x4 gw[2]; const unsigned goff = (unsigned)((fr * LDG + 32 * wid + 4 * g) * 2);
#pragma unroll
        for (int et = 0; et < 2; ++et) { const int e = 32 * wid + 16 * et + 4 * g; gw[et] = *(const f32x4*)(A.gn + h * 256 + e);
#pragma unroll
            for (int it = 0; it < 8; ++it) gv[it][et] = *(const u32x2*)((const char*)P.g + (size_t)(16 * it * LDG + 16 * et) * 2 + goff); }
        half_mma(acc, lds + C_B0, lds + C_KA, 0, wid, lane);
        __syncthreads();
        half_mma(acc, lds + C_B1, lds + C_KA, 64, wid, lane);
#pragma unroll
        for (int it = 0; it < 8; ++it) { float s1 = 0.f, s2 = 0.f;
#pragma unroll
            for (int et = 0; et < 2; ++et)
#pragma unroll
                for (int r = 0; r < 4; ++r) { const float y = acc[et][it][r]; s1 += y; s2 += y * y; }
            s1 += __shfl_xor(s1, 16); s1 += __shfl_xor(s1, 32); s2 += __shfl_xor(s2, 16); s2 += __shfl_xor(s2, 32);
            if (g == 0) { stat[((16 * it + fr) * 8 + wid) * 2] = s1; stat[((16 * it + fr) * 8 + wid) * 2 + 1] = s2; }
            if (it & 1) __builtin_amdgcn_sched_barrier(0); }
        __syncthreads();
#pragma unroll
        for (int it = 0; it < 8; ++it) { float s1 = 0.f, s2 = 0.f;
#pragma unroll
            for (int w = 0; w < 8; ++w) { s1 += stat[((16 * it + fr) * 8 + w) * 2]; s2 += stat[((16 * it + fr) * 8 + w) * 2 + 1]; }
            const float mu = s1 * (1.0f / 256.0f); const float var = fmaxf(s2 * (1.0f / 256.0f) - mu * mu, 0.f); const float rs = rsqrtf(var + 1e-5f);
#pragma unroll
            for (int et = 0; et < 2; ++et) { const int e = 32 * wid + 16 * et + 4 * g; const f32x4 y = acc[et][it]; const u32x2 gg = gv[it][et];
                u32x2 w; w.x = pk2(bf_lo(gg.x) * ((y[0] - mu) * rs * gw[et][0]), bf_hi(gg.x) * ((y[1] - mu) * rs * gw[et][1]));
                w.y = pk2(bf_lo(gg.y) * ((y[2] - mu) * rs * gw[et][2]), bf_hi(gg.y) * ((y[3] - mu) * rs * gw[et][3]));
                *(LAS u32x2*)(lds + C_B0 + (16 * it + fr) * UPB + e * 2) = w; }
            __builtin_amdgcn_sched_barrier(0); }
        __syncthreads();
        { char* yb = (char*)(A.Y + (size_t)c * 128 * 2048 + h * 256); const unsigned yoff = (unsigned)((tid >> 5) * 4096 + (tid & 31) * 16);
          ldsp s0 = lds + C_B0 + (tid >> 5) * UPB + (tid & 31) * 16;
#pragma unroll
          for (int i = 0; i < 8; ++i) *(u32x4*)(yb + (size_t)i * 16 * 4096 + yoff) = *(const LAS u32x4*)(s0 + i * 16 * UPB); }
        if (!has_next) break;
        u = un; P = N;
    }
    __syncthreads();
}
}
#define XB_TMO      128
#define XB_XCNT(j)  (256  + 64 * (j))
#define XB_XSUB(j)  (1280 + 64 * (j))
#define XB_XGEN(j)  (2304 + 64 * (j))
#define XB_TOP      3328
#define XB_TOPGEN   3392
#define XCD_BAR_WORDS 3456
#define XB_SPIN_CAP (1u << 18)

__device__ __forceinline__ unsigned xb_ld(unsigned* p)              { return __hip_atomic_load(p, __ATOMIC_RELAXED, __HIP_MEMORY_SCOPE_AGENT); }
__device__ __forceinline__ unsigned xb_add(unsigned* p, unsigned v) { return __hip_atomic_fetch_add(p, v, __ATOMIC_RELAXED, __HIP_MEMORY_SCOPE_AGENT); }
__device__ __forceinline__ unsigned xb_xcc_id() { return (unsigned)__builtin_amdgcn_s_getreg((3 << 11) | 20) & 0xFu; }
#define XB_SPIN(cond, bar) do { unsigned _sp = 0; while (cond) { __builtin_amdgcn_s_sleep(1); \
    if ((++_sp & 255u) == 0u) { if (xb_ld(&(bar)[XB_TMO])) break; if (_sp > XB_SPIN_CAP) { atomicAdd(&(bar)[XB_TMO], 1u); break; } } } } while (0)

struct XcdBarrier {
    unsigned* bar; unsigned x;
    volatile LAS unsigned* st;
};

__device__ __forceinline__ XcdBarrier xcd_barrier_post(unsigned* bar, volatile LAS unsigned* st) {
    XcdBarrier b; b.bar = bar; b.x = xb_xcc_id(); b.st = st;
    if (threadIdx.x == 0) (void)xb_add(&bar[XB_XCNT(b.x)], 1u);
    return b;
}
__device__ __forceinline__ void xcd_barrier_complete(unsigned* bar, unsigned x, unsigned& nloc, unsigned& nx) {
    const unsigned G = gridDim.x * gridDim.y * gridDim.z;
    unsigned sum, cnt, mine, sp = 0u;
    for (;;) {
        sum = 0u; cnt = 0u; mine = 0u;
#pragma unroll
        for (unsigned j = 0; j < 16; ++j) { const unsigned c = xb_ld(&bar[XB_XCNT(j)]); sum += c; cnt += (c > 0u) ? 1u : 0u; mine = (j == x) ? c : mine; }
        if (sum == G) break;
        __builtin_amdgcn_s_sleep(1);
        if ((++sp & 255u) == 0u) { if (xb_ld(&bar[XB_TMO])) break; if (sp > XB_SPIN_CAP) { atomicAdd(&bar[XB_TMO], 1u); break; } }
    }
    nloc = mine > 0u ? mine : 1u; nx = cnt > 0u ? cnt : 1u;
}

__device__ __forceinline__ void xcd_barrier(const XcdBarrier& b) {
    asm volatile("s_waitcnt vmcnt(0)" ::: "memory");
    __syncthreads();
    if (threadIdx.x == 0) {
        unsigned* bar = b.bar;
        __builtin_amdgcn_s_waitcnt(0);
        unsigned nloc = b.st[0], nx = b.st[1];
        if (nloc == 0u) { xcd_barrier_complete(bar, b.x, nloc, nx); b.st[0] = nloc; b.st[1] = nx; }
        const unsigned old = xb_add(&bar[XB_XSUB(b.x)], 1u);
        const unsigned gen = old / nloc;
        if (old + 1u == (gen + 1u) * nloc) {
            __builtin_amdgcn_fence(__ATOMIC_RELEASE, "agent");
            asm volatile("s_waitcnt vmcnt(0)" ::: "memory");
            const unsigned og = xb_add(&bar[XB_TOP], 1u);
            const unsigned tg = og / nx;
            if (og + 1u == (tg + 1u) * nx) xb_add(&bar[XB_TOPGEN], 1u);
            else XB_SPIN(xb_ld(&bar[XB_TOPGEN]) == tg, bar);
            __builtin_amdgcn_fence(__ATOMIC_ACQUIRE, "agent");
            xb_add(&bar[XB_XGEN(b.x)], 1u);
            asm volatile("s_waitcnt vmcnt(0)" ::: "memory");
        } else {
            XB_SPIN(xb_ld(&bar[XB_XGEN(b.x)]) == gen, bar);
            __builtin_amdgcn_fence(__ATOMIC_ACQUIRE, "agent");
            asm volatile("s_waitcnt vmcnt(0)" ::: "memory");
        }
    }
    __syncthreads();
}
constexpr int M_TOK = 16384, DM = 1024, DFF = 4096, N_IN_E = 2304, N_IN_O = 6144;
constexpr size_t MiB = 1u << 20;
constexpr size_t WS_CTL = 0;
constexpr size_t WS_L2 = 4096, WS_SSQ = 512 * 1024;
constexpr int CW_BAR = 4096;
constexpr size_t WS_W_IN_E = 1 * MiB;
constexpr size_t WS_W_OUT_E = WS_W_IN_E + (size_t)N_IN_E * DM * 2;
constexpr size_t WS_W_MLP_IN = WS_W_OUT_E + (size_t)DM * DM * 2;
constexpr size_t WS_W_MLP_OUT = WS_W_MLP_IN + 2 * (size_t)DFF * DM * 2;
constexpr size_t WS_W_IN_O = WS_W_MLP_OUT + 2 * (size_t)DFF * DM * 2;
constexpr size_t WS_W_OUT_O = WS_W_IN_O + (size_t)N_IN_O * DM * 2;
constexpr size_t WS_XB = 56 * MiB;
constexpr size_t WS_BIG = 88 * MiB;
constexpr size_t WS_END = 256 * MiB;
static_assert(WS_W_OUT_O + (size_t)DM * 2048 * 2 <= WS_XB, "weights fit below XB");

constexpr int RING_BYTES = 155648;
constexpr int LDS_BYTES = 159744;

struct Args { const float* in[19]; float* out; unsigned char* ws; int ph_lo, ph_hi; };
typedef const __attribute__((address_space(4))) Args* KArgs;

__device__ __forceinline__ float wave_sum(float v) {
#pragma unroll
    for (int o = 1; o < 64; o <<= 1) v += __shfl_xor(v, o);
    return v;
}
struct WItem { const float* W; int N; bf16* WT; int ldo; int k0, n0, orow0; const float* gain; float nscale; };
constexpr int WI_C0 = 1152, WI_C1 = WI_C0 + 512, WI_C2 = WI_C1 + 2048, WI_C3 = WI_C2 + 2048, WI_C4 = WI_C3 + 2048, WI_C5 = WI_C4 + 2048, WI_C6 = WI_C5 + 3072, WI_C7 = WI_C6 + 1024;
constexpr int WI_EARLY = WI_C3;
__device__ __forceinline__ void witem_decode(KArgs a, unsigned char* ws, int gi, WItem& d) {
    int item, K, mode = 0; d.gain = nullptr; d.nscale = 1.0f;
    if (gi < WI_C0)      { item = gi;         d.W = a->in[2];  K = DM;  d.N = N_IN_E; d.WT = (bf16*)(ws + WS_W_IN_E); d.gain = a->in[1]; }
    else if (gi < WI_C1) { item = gi - WI_C0; d.W = a->in[9];  K = DM;  d.N = DM;     d.WT = (bf16*)(ws + WS_W_OUT_E); }
    else if (gi < WI_C2) { item = gi - WI_C1; d.W = a->in[17]; K = DM;  d.N = DFF;    d.WT = (bf16*)(ws + WS_W_MLP_IN); d.gain = a->in[16]; }
    else if (gi < WI_C3) { item = gi - WI_C2; d.W = a->in[18]; K = DFF; d.N = DM;     d.WT = (bf16*)(ws + WS_W_MLP_OUT); }
    else if (gi < WI_C4) { item = gi - WI_C3; d.W = a->in[17] + (size_t)DM * DFF; K = DM; d.N = DFF; d.WT = (bf16*)(ws + WS_W_MLP_IN) + (size_t)DFF * DM; d.gain = a->in[16] + DM; }
    else if (gi < WI_C5) { item = gi - WI_C4; d.W = a->in[18] + (size_t)DFF * DM; K = DFF; d.N = DM; d.WT = (bf16*)(ws + WS_W_MLP_OUT) + (size_t)DFF * DM; }
    else if (gi < WI_C6) { item = gi - WI_C5; d.W = a->in[11]; K = DM;  d.N = N_IN_O; d.WT = (bf16*)(ws + WS_W_IN_O); d.gain = a->in[10]; mode = 1; }
    else                 { item = gi - WI_C6; d.W = a->in[15]; K = 2048; d.N = DM;    d.WT = (bf16*)(ws + WS_W_OUT_O); }
    const int nblk = d.N / 32, kb = item / nblk, nb = item % nblk; d.k0 = 64 * kb; d.n0 = 32 * nb; d.orow0 = d.n0; d.ldo = K;
    if (mode == 1) {
        const int n0 = d.n0;
        if (n0 < 1024) { d.orow0 = (n0 >> 9) * 3072 + (n0 & 511); }
        else if (n0 < 2048) { const int nk = n0 - 1024; d.orow0 = (nk >> 9) * 3072 + 512 + (nk & 511); d.nscale = 0.08838834764831845f; }
        else if (n0 < 4096) { const int nv = n0 - 2048; d.orow0 = (nv >> 10) * 3072 + 1024 + (nv & 1023); }
        else { const int ng = n0 - 4096; d.orow0 = (ng >> 10) * 3072 + 2048 + (ng & 1023); }
    }
}
__device__ __forceinline__ void witem_load(const WItem& d, float (&v)[32], int lane) {
#pragma unroll
    for (int i = 0; i < 32; ++i) { const int kk = 2 * i + (lane >> 5); v[i] = d.W[(size_t)(d.k0 + kk) * d.N + d.n0 + (lane & 31)]; }
}
__device__ __forceinline__ void witem_finish(const WItem& d, const float (&v)[32], LAS float* scr, int lane) {
#pragma unroll
    for (int i = 0; i < 32; ++i) { const int kk = 2 * i + (lane >> 5); const float gsc = d.gain ? d.gain[d.k0 + kk] * d.nscale : d.nscale; scr[kk * 33 + (lane & 31)] = v[i] * gsc; }
    asm volatile("s_waitcnt lgkmcnt(0)" ::: "memory");
    const int c = lane & 7;
#pragma unroll
    for (int j = 0; j < 4; ++j) { const int n = (lane >> 3) + 8 * j; const LAS float* s = scr + (8 * c) * 33 + n;
        u32x4 o; o.x = pk2(s[0 * 33], s[1 * 33]); o.y = pk2(s[2 * 33], s[3 * 33]); o.z = pk2(s[4 * 33], s[5 * 33]); o.w = pk2(s[6 * 33], s[7 * 33]);
        *(u32x4*)(d.WT + (size_t)(d.orow0 + n) * d.ldo + d.k0 + 8 * c) = o; }
    asm volatile("s_waitcnt lgkmcnt(0)" ::: "memory");
}
__device__ __forceinline__ void convert_items(KArgs a, ldsp lds, int gbeg, int gend, int wv, int nw, int tid) {
    const int lane = tid & 63, wave = __builtin_amdgcn_readfirstlane(tid >> 6);
    unsigned char* ws = a->ws;
    LAS float* scr = (LAS float*)(lds + wave * 16384);
    WItem cur, nxt; float va[32], vb[32];
    int gi = gbeg + wv;
    if (gi < gend) { witem_decode(a, ws, gi, cur); witem_load(cur, va, lane); }
    while (gi < gend) {
        const int g1 = gi + nw, g2 = gi + 2 * nw;
        if (g1 < gend) { witem_decode(a, ws, g1, nxt); witem_load(nxt, vb, lane); }
        witem_finish(cur, va, scr, lane);
        if (g1 >= gend) break;
        if (g2 < gend) { witem_decode(a, ws, g2, cur); witem_load(cur, va, lane); }
        witem_finish(nxt, vb, scr, lane);
        gi = g2;
    }
}
__device__ __forceinline__ void prologue(KArgs a, ldsp lds, int vcu, int G, int tid) {
    const int lane = tid & 63, wave = __builtin_amdgcn_readfirstlane(tid >> 6);
    unsigned char* ws = a->ws;
    const int gw = vcu * 8 + wave, NGW = G * 8;
    convert_items(a, lds, 0, WI_EARLY, gw, NGW, tid);
    const float* x = a->in[0]; bf16* XB = (bf16*)(ws + WS_XB); float* ssq = (float*)(ws + WS_SSQ);
    for (int m = gw; m < M_TOK; m += 2 * NGW) {
        const int m2 = m + NGW;
        const f32x4* xr0 = (const f32x4*)(x + (size_t)m * DM) + lane; const f32x4* xr1 = (const f32x4*)(x + (size_t)m2 * DM) + lane;
        f32x4 v0[4], v1[4];
#pragma unroll
        for (int j = 0; j < 4; ++j) { v0[j] = xr0[64 * j]; v1[j] = xr1[64 * j]; }
        unsigned long long* o0 = (unsigned long long*)(XB + (size_t)m * DM) + lane; unsigned long long* o1 = (unsigned long long*)(XB + (size_t)m2 * DM) + lane;
        float s0 = 0.f, s1 = 0.f;
#pragma unroll
        for (int j = 0; j < 4; ++j) { s0 += (v0[j][0] * v0[j][0] + v0[j][1] * v0[j][1]) + (v0[j][2] * v0[j][2] + v0[j][3] * v0[j][3]);
            s1 += (v1[j][0] * v1[j][0] + v1[j][1] * v1[j][1]) + (v1[j][2] * v1[j][2] + v1[j][3] * v1[j][3]);
            o0[64 * j] = (unsigned long long)pk2(v0[j][0], v0[j][1]) | ((unsigned long long)pk2(v0[j][2], v0[j][3]) << 32);
            o1[64 * j] = (unsigned long long)pk2(v1[j][0], v1[j][1]) | ((unsigned long long)pk2(v1[j][2], v1[j][3]) << 32); }
        s0 = wave_sum(s0); s1 = wave_sum(s1);
        if (lane == 0) { *(f32x4*)(ssq + 4 * (size_t)m) = (f32x4){s0, 0.f, 0.f, 0.f}; *(f32x4*)(ssq + 4 * (size_t)m2) = (f32x4){s1, 0.f, 0.f, 0.f}; }
    }
    if (vcu == 0 && tid < 16) { const float d = (tid < 8 ? a->in[12] : a->in[13])[tid & 7]; const float e = __expf(-d);
        const float l1p = (e < 0.0625f) ? e * (1.0f - e * (0.5f - e * ((1.0f / 3.0f) - e * (0.25f - e * 0.2f)))) : __logf(1.0f + e);
        ((float*)(ws + WS_L2))[tid] = -l1p * LOG2E; }
}

#ifndef DBG_DUMP
#define DBG_DUMP 0
#endif
#ifndef REP_PH
#define REP_PH (-1)
#define REP_N 0
#endif
#ifndef REP_COND
#define REP_COND true
#endif
#ifndef DBG_STRIDE
#define DBG_STRIDE 1
#endif
#ifndef DBG_HI
#define DBG_HI PH_COUNT
#endif
#ifndef DBG_LO
#define DBG_LO 0
#endif
#ifndef DBG_AOFF
#define DBG_AOFF 2048
#endif
#ifndef DBG_LDA
#define DBG_LDA 3072
#endif
#ifndef DBG_LDB
#define DBG_LDB 2048
#endif
#ifndef DBG_K
#define DBG_K 1024
#endif
enum { PH_PRO = 0, PH_IN_E, PH_ATTN, PH_OUT_E, PH_MLP_IN0, PH_MLP_OUT0, PH_IN_O0, PH_RA0, PH_RB0, PH_RC0, PH_IN_O1, PH_RA1, PH_RB1, PH_RC1, PH_OUT_O, PH_MLP_IN1, PH_MLP_OUT1, PH_COUNT };

__global__ void __launch_bounds__(512, 2) mk_fwd(Args a_unused) {
    extern __shared__ __attribute__((aligned(16))) unsigned char lds_raw[];
    cg::grid_group grid = cg::this_grid();
    const ldsp lds = (ldsp)lds_raw;
    volatile LAS unsigned* MISC = (volatile LAS unsigned*)(lds + RING_BYTES);
    if (threadIdx.x < 32) MISC[threadIdx.x] = 0u;
    __syncthreads();
    const XcdBarrier bar = xcd_barrier_post((unsigned*)(((KArgs)__builtin_amdgcn_kernarg_segment_ptr())->ws + WS_CTL) + CW_BAR, MISC + 8);
    const int G = gridDim.x;
    int repcnt = 0;
    const int ph_lo = ((KArgs)__builtin_amdgcn_kernarg_segment_ptr())->ph_lo, ph_hi = ((KArgs)__builtin_amdgcn_kernarg_segment_ptr())->ph_hi;
    for (int ph = ph_lo; ph < ph_hi; ++ph) {
        const __attribute__((address_space(4))) char* kp = (const __attribute__((address_space(4))) char*)__builtin_amdgcn_kernarg_segment_ptr();
        asm volatile("" : "+s"(kp));
        KArgs a = (KArgs)kp;
        unsigned char* ws = a->ws;
        bf16* XB = (bf16*)(ws + WS_XB); float* ssq = (float*)(ws + WS_SSQ);
        bf16* BIG = (bf16*)(ws + WS_BIG);
        bf16* QKV = BIG; bf16* OE = BIG + (size_t)M_TOK * N_IN_E; bf16* HM = BIG; bf16* GB = BIG; bf16* ST = BIG + (size_t)M_TOK * 3072;
        int tid = threadIdx.x, bx = blockIdx.x;
        asm volatile("" : "+v"(tid)); asm volatile("" : "+s"(bx));
        const int vcu = (G % 8 == 0) ? (bx % 8) * (G / 8) + bx / 8 : bx;
        if (ph == PH_PRO) { prologue(a, lds, vcu, G, tid); }
        else if (ph == PH_ATTN) {
            att::AttnArgs A{QKV, OE, a->in[3], a->in[4], a->in[5], a->in[6], a->in[7], a->in[8]};
            att::attn_phase(lds, A, vcu, G, tid);
        }
        else if (ph == PH_RA0 || ph == PH_RA1 || ph == PH_RB0 || ph == PH_RB1 || ph == PH_RC0 || ph == PH_RC1) {
            ret::RetArgs R{GB, ST, (const float*)(ws + WS_L2), a->in[14], (ph >= PH_IN_O1) ? 1 : 0, (REP_N > 0 && ph == REP_PH && repcnt > 0) ? 1 : 0, (bf16*)a->out};
            if (ph == PH_RA0 || ph == PH_RA1) { ret::ret_a_phase(lds, R, vcu, G, tid); }
            else if (ph == PH_RB0 || ph == PH_RB1) { ret::ret_b(R, vcu, G, tid); }
            else { ret::ret_c_phase(lds, R, vcu, G, tid); }
        }
        else if (ph == PH_IN_E || ph == PH_MLP_IN0 || ph == PH_MLP_IN1 || ph == PH_IN_O0 || ph == PH_IN_O1) {
            const bf16* Bt; int N, act, silu0; bf16* O;
            if (ph == PH_IN_E)           { Bt = (const bf16*)(ws + WS_W_IN_E); N = N_IN_E; O = QKV; act = 0; silu0 = 1 << 30; }
            else if (ph == PH_MLP_IN0)   { Bt = (const bf16*)(ws + WS_W_MLP_IN); N = DFF; O = HM; act = 1; silu0 = 1 << 30; }
            else if (ph == PH_MLP_IN1)   { Bt = (const bf16*)(ws + WS_W_MLP_IN) + (size_t)DFF * DM; N = DFF; O = HM; act = 1; silu0 = 1 << 30; }
            else if (ph == PH_IN_O0)     { Bt = (const bf16*)(ws + WS_W_IN_O); N = 3072; O = GB; act = 2; silu0 = 8; }
            else                         { Bt = (const bf16*)(ws + WS_W_IN_O) + (size_t)3072 * DM; N = 3072; O = GB; act = 2; silu0 = 8; }
            pg8::Gemm g; g.A = XB; g.Bt = Bt; g.lda = DM; g.ldb = DM; g.M = M_TOK; g.N = N; g.K = DM;
            pg8::EpiBf16 E; E.O = O; E.ldc = N; E.ssq = ssq; E.silu_pn0 = silu0; E.act = act;
            pg8::StaticOrder S; S.init(M_TOK, N, G, bx);
            pg8::gemm_phase<pg8::EpiBf16, pg8::StaticOrder, true, true>(lds, g, S, E, tid);
            if (ph == PH_IN_E && bx >= 64) convert_items(a, lds, WI_EARLY, WI_C7, (bx - 64) * 8 + __builtin_amdgcn_readfirstlane(tid >> 6), (G - 64) * 8, tid);
        }
        else {
            const bf16* A; const bf16* Bt; int lda, ldb, K; const float* basef; const bf16* baseb; float* outf; bf16* xb; float* sso;
            if (ph == PH_OUT_E)          { A = OE; lda = DM; K = DM; Bt = (const bf16*)(ws + WS_W_OUT_E); ldb = DM; basef = nullptr; baseb = XB; outf = nullptr; xb = XB; sso = ssq; }
            else if (ph == PH_MLP_OUT0)  { A = HM; lda = DFF; K = DFF; Bt = (const bf16*)(ws + WS_W_MLP_OUT); ldb = DFF; basef = nullptr; baseb = XB; outf = nullptr; xb = XB; sso = ssq; }
            else if (ph == PH_MLP_OUT1)  { A = HM; lda = DFF; K = DFF; Bt = (const bf16*)(ws + WS_W_MLP_OUT) + (size_t)DFF * DM; ldb = DFF; basef = nullptr; baseb = XB; outf = a->out; xb = nullptr; sso = nullptr; }
            else                         { A = (const bf16*)a->out; lda = 2048; K = 2048; Bt = (const bf16*)(ws + WS_W_OUT_O); ldb = 2048; basef = nullptr; baseb = XB; outf = nullptr; xb = XB; sso = ssq; }
            pg8::Gemm g; g.A = A; g.Bt = Bt; g.lda = lda; g.ldb = ldb; g.M = M_TOK; g.N = DM; g.K = K;
            pg8::EpiResid E; E.basef = basef; E.baseb = baseb; E.outf = outf; E.xb = xb; E.ssq_out = sso; E.ldc = DM;
            E.accscale = (REP_N > 0 && ph == REP_PH && repcnt > 0 && ph != PH_OUT_E && ph != PH_MLP_OUT1) ? 0.f : 1.f;
            pg8::StaticOrder S; S.init(M_TOK, DM, G, bx);
            pg8::gemm_phase<pg8::EpiResid, pg8::StaticOrder, false, true>(lds, g, S, E, tid);
        }
        if (ph + 1 == ph_hi && DBG_DUMP) {
            xcd_barrier(bar);
            const bf16* srcb = (DBG_DUMP == 1) ? GB : ST;
            for (size_t i = (size_t)bx * 512 + tid; i < (size_t)M_TOK * DM; i += (size_t)G * 512) a->out[i] = bf_lo((unsigned)srcb[i * DBG_STRIDE]);
        }
#ifdef NOP_REPS
        if (ph == NOP_AT) { for (int q = 0; q < NOP_REPS; ++q) xcd_barrier(bar); }
#endif
        if (ph + 1 < ph_hi) {
            if (ph_lo < 0) {
                asm volatile("s_waitcnt vmcnt(0)" ::: "memory");
                grid.sync();
                __builtin_amdgcn_fence(__ATOMIC_ACQUIRE, "agent");
                asm volatile("s_waitcnt vmcnt(0)" ::: "memory");
                __syncthreads();
            }
            xcd_barrier(bar);
        }
        if (REP_N > 0 && ph == REP_PH && repcnt < REP_N && REP_COND) { ++repcnt; --ph; }
    }
}

extern "C" void kernel_launch(void* const* d_in, const int* in_sizes, int n_in, void* d_out, int out_size, void* d_ws, size_t ws_size, hipStream_t stream) {
    static int grid = 0;
    if (grid == 0) {
        int dev = 0, cus = 0, per_cu = 0;
        (void)hipGetDevice(&dev);
        (void)hipDeviceGetAttribute(&cus, hipDeviceAttributeMultiprocessorCount, dev);
        (void)hipFuncSetAttribute((const void*)mk_fwd, hipFuncAttributeMaxDynamicSharedMemorySize, LDS_BYTES);
        (void)hipOccupancyMaxActiveBlocksPerMultiprocessor(&per_cu, (const void*)mk_fwd, 512, LDS_BYTES);
        grid = (n_in == 19 && per_cu >= 1 && cus == 256 && ws_size >= WS_END && out_size == M_TOK * DM) ? 256 : -1;
        if (grid < 0) fprintf(stderr, "kernel_launch: unsupported configuration (cus %d per_cu %d ws %zu n_in %d)\n", cus, per_cu, ws_size, n_in);
    }
    if (grid < 0) return;
    if (hipMemsetAsync((char*)d_ws + WS_CTL, 0, 65536, stream) != hipSuccess) { fprintf(stderr, "kernel_launch: memset failed\n"); return; }
    Args a{};
    for (int i = 0; i < 19; ++i) a.in[i] = (const float*)d_in[i];
    a.out = (float*)d_out; a.ws = (unsigned char*)d_ws; a.ph_lo = DBG_LO; a.ph_hi = DBG_HI;
    void* args[] = {&a};
#ifdef PLAIN_LAUNCH
    hipError_t e = hipLaunchKernel((void*)mk_fwd, dim3(grid), dim3(512), args, LDS_BYTES, stream);
#else
    hipError_t e = hipLaunchCooperativeKernel((void*)mk_fwd, dim3(grid), dim3(512), args, LDS_BYTES, stream);
#endif
    if (e != hipSuccess) fprintf(stderr, "cooperative launch failed: %s\n", hipGetErrorString(e));
}
```

```cpp
#include <hip/hip_runtime.h>
#include <hip/hip_cooperative_groups.h>
#include <cstdio>
#include <cstdint>
#include <cmath>
namespace cg = cooperative_groups;
namespace pg8 {
#define PG8_LAS __attribute__((address_space(3)))
typedef unsigned short bf16_t;
typedef short bf16x8 __attribute__((ext_vector_type(8)));
typedef float f32x4 __attribute__((ext_vector_type(4)));
typedef float f32x2 __attribute__((ext_vector_type(2)));
typedef unsigned u32x4 __attribute__((ext_vector_type(4)));
typedef unsigned u32x2 __attribute__((ext_vector_type(2)));
constexpr int BM = 256, BK = 64, HALF = 128, HTB = HALF * BK * 2  , STAGE_BYTES = 8 * HTB, NXCD = 8, WGM = 8;

__host__ __device__ __forceinline__ int lds_byte(int r, int c) { const int st = (r >> 4) * 2 + (c >> 5), rr = r & 15, cc = c & 31, ob = rr * 64 + cc * 2; return st * 1024 + (ob ^ (((ob >> 9) & 1) << 5)); }
__host__ __device__ __forceinline__ void stage_rc(int b, int& R, int& C) { const int st = b / 1024, sb = b % 1024, swz = sb ^ (((sb >> 9) & 1) << 5); R = (st >> 1) * 16 + swz / 64; C = (st & 1) * 32 + (swz % 64) / 2; }
__host__ __device__ __forceinline__ int perm32(int rho) { const int n = rho >> 4, i = rho & 15; return 8 * (i >> 2) + 4 * n + (i & 3); }

struct Unit { int pm, pn; };
struct Gemm { const bf16_t* A; const bf16_t* Bt; int lda, ldb, M, N, K; };

struct StaticOrder {
    int nM, nN, nwg, G, c;
    __host__ __device__ void init(int M, int N, int G_, int c_) { nM = M / BM; nN = N / BM; nwg = nM * nN; G = G_; c = c_; }
    __host__ __device__ bool next(int i, Unit& u) const {
        const long L = (long)i * G + c; if (L >= nwg) return false;
        int wgid = (int)L; { const int q = nwg / NXCD, r = nwg % NXCD, xcd = wgid % NXCD, off = wgid / NXCD; wgid = (xcd < r ? xcd * (q + 1) : r * (q + 1) + (xcd - r) * q) + off; }
        const int nig = WGM * nN, gid = wgid / nig, fm = gid * WGM, gsz = (nM - fm) < WGM ? (nM - fm) : WGM;
        u.pm = fm + ((wgid % nig) % gsz); u.pn = (wgid % nig) / gsz; return true;
    }
};

typedef float f32x2_cv __attribute__((ext_vector_type(2))); typedef __bf16 bf16x2_cv __attribute__((ext_vector_type(2)));
__device__ __forceinline__ unsigned cvt_pk_bf16(float lo, float hi) { const f32x2_cv v = {lo, hi}; const bf16x2_cv b = __builtin_convertvector(v, bf16x2_cv); return __builtin_bit_cast(unsigned, b); }


__device__ __forceinline__ float row_rstd(const float* ssq, int row) { const f32x4 p = *(const f32x4*)(ssq + 4 * (size_t)row); return rsqrtf(((p[0] + p[1]) + (p[2] + p[3])) * (1.0f / 1024.0f) + 1e-6f); }

struct EpiBf16 {
    static constexpr bool PERM = true, AFTER_DRAIN = false;
    bf16_t* O; int ldc; const float* ssq; int silu_pn0; int act;
    __device__ __forceinline__ void preload(float (&rsv)[8], int pm, int wr, int fr) const {
        const int row0 = pm * BM + wr * 64 + fr;
#pragma unroll
        for (int ai = 0; ai < 2; ++ai)
#pragma unroll
            for (int m = 0; m < 4; ++m) rsv[ai * 4 + m] = row_rstd(ssq, row0 + ai * HALF + m * 16);
    }
    __device__ __forceinline__ void operator()(const f32x4 (&acc)[2][2][4][2], const Unit& u, int wr, int wc, int fr, int fq, float (&rsv)[8], int& rs_pm) const {
        if (rs_pm != u.pm) { preload(rsv, u.pm, wr, fr); rs_pm = u.pm; }
        const int row0 = u.pm * BM + wr * 64 + fr; const int col0 = u.pn * BM + wc * 32 + 8 * fq;
        const bool do_silu = (act == 2) && (u.pn >= silu_pn0);
#if 1
        const __amdgpu_buffer_rsrc_t rsrc = __builtin_amdgcn_make_buffer_rsrc((void*)O, 0, 0x7fffffff, 0x00020000);
#endif
#pragma unroll
        for (int ai = 0; ai < 2; ++ai)
#pragma unroll
            for (int m = 0; m < 4; ++m) { const int row = row0 + ai * HALF + m * 16; const float rs = rsv[ai * 4 + m]; bf16_t* rowp = O + (size_t)row * ldc + col0;
#pragma unroll
                for (int bj = 0; bj < 2; ++bj) { f32x4 v0 = acc[ai][bj][m][0] * rs, v1 = acc[ai][bj][m][1] * rs;
                    if (act == 1) {
#pragma unroll
                        for (int e = 0; e < 4; ++e) { const float a = fmaxf(v0[e], 0.f), b = fmaxf(v1[e], 0.f); v0[e] = a * a; v1[e] = b * b; } }
                    if (do_silu) {
#pragma unroll
                        for (int e = 0; e < 4; ++e) { v0[e] = v0[e] / (1.0f + __expf(-v0[e])); v1[e] = v1[e] / (1.0f + __expf(-v1[e])); } }
                    u32x4 w; w.x = cvt_pk_bf16(v0[0], v0[1]); w.y = cvt_pk_bf16(v0[2], v0[3]); w.z = cvt_pk_bf16(v1[0], v1[1]); w.w = cvt_pk_bf16(v1[2], v1[3]);
#if 1
                    __builtin_amdgcn_raw_buffer_store_b128(w, rsrc, (unsigned)(((size_t)row * ldc + col0 + bj * HALF) * 2), 0, 16);
#else
                    *(u32x4*)(rowp + bj * HALF) = w;
#endif
                    } }
    }
};

struct EpiResid {
    static constexpr bool PERM = true, AFTER_DRAIN = true;
    const float* basef; const bf16_t* baseb; float* outf; bf16_t* xb; float* ssq_out; int ldc; float accscale;
    __device__ __forceinline__ void fused(f32x4 (&acc)[2][2][4][2], const Unit& u, int wr, int wc, int fr, int fq, PG8_LAS unsigned char* lds, int wid, int lane) const {
        PG8_LAS float* P = (PG8_LAS float*)lds;
        const int col0 = u.pn * BM + wc * 32 + 8 * fq;
#pragma unroll
        for (int ai = 0; ai < 2; ++ai)
#pragma unroll
            for (int m = 0; m < 4; ++m) { const int r = ai * HALF + wr * 64 + m * 16 + fr; const size_t off = (size_t)(u.pm * BM + r) * ldc + col0; float s = 0.f;
#pragma unroll
                for (int bj = 0; bj < 2; ++bj) { const size_t o2 = off + bj * HALF; f32x4 b0, b1;
                    if (basef) { b0 = *(const f32x4*)(basef + o2); b1 = *(const f32x4*)(basef + o2 + 4); }
                    else { const u32x4 b = *(const u32x4*)(baseb + o2);
                        b0 = (f32x4){__uint_as_float(b.x << 16), __uint_as_float(b.x & 0xffff0000u), __uint_as_float(b.y << 16), __uint_as_float(b.y & 0xffff0000u)};
                        b1 = (f32x4){__uint_as_float(b.z << 16), __uint_as_float(b.z & 0xffff0000u), __uint_as_float(b.w << 16), __uint_as_float(b.w & 0xffff0000u)}; }
                    const f32x4 o0 = b0 + acc[ai][bj][m][0] * accscale, o1 = b1 + acc[ai][bj][m][1] * accscale;
                    if (outf) { *(f32x4*)(outf + o2) = o0; *(f32x4*)(outf + o2 + 4) = o1; }
                    if (xb) { u32x4 w; w.x = cvt_pk_bf16(o0[0], o0[1]); w.y = cvt_pk_bf16(o0[2], o0[3]); w.z = cvt_pk_bf16(o1[0], o1[1]); w.w = cvt_pk_bf16(o1[2], o1[3]); *(u32x4*)(xb + o2) = w; }
                    s += ((o0[0] * o0[0] + o0[1] * o0[1]) + (o0[2] * o0[2] + o0[3] * o0[3])) + ((o1[0] * o1[0] + o1[1] * o1[1]) + (o1[2] * o1[2] + o1[3] * o1[3])); }
                if (ssq_out) { s += __shfl_xor(s, 16); s += __shfl_xor(s, 32); if (fq == 0) P[r * 4 + wc] = s; }
                if (m & 1) asm volatile("" ::: "memory"); }
        if (ssq_out) {
            __syncthreads();
            const int t = wid * 64 + lane;
            if (t < 256) { const float s = (P[t * 4 + 0] + P[t * 4 + 1]) + (P[t * 4 + 2] + P[t * 4 + 3]); ssq_out[(size_t)(u.pm * BM + t) * 4 + u.pn] = s; }
            __syncthreads();
        }
    }
};

template <class Epi, class Sched, bool ALIGN_EPI = false, bool SP2 = false>
__device__ __forceinline__ void gemm_phase(PG8_LAS unsigned char* lds, const Gemm g, const Sched& S, const Epi& E, const int tid) {
    const int wid = __builtin_amdgcn_readfirstlane(tid >> 6), lane = tid & 63, wr = wid >> 2, wc = wid & 3, fr = lane & 15, fq = lane >> 4;
    const int K = g.K, nt = K / BK;
    unsigned voffA[2], voffB[2];
#pragma unroll
    for (int i = 0; i < 2; ++i) { int R, C; stage_rc(tid * 16 + i * 8192, R, C); const int Rb = Epi::PERM ? ((R & ~31) + perm32(R & 31)) : R;
        voffA[i] = (unsigned)(R * g.lda + C) * 2u; voffB[i] = (unsigned)(Rb * g.ldb + C) * 2u; }
    const size_t kstep = (size_t)(BK * 2);
    const size_t hstepA = (size_t)HALF * g.lda * 2, hstepB = (size_t)HALF * g.ldb * 2;
    const size_t tstepA = 2 * hstepA, tstepB = 2 * hstepB;
    const unsigned ldsw = (unsigned)wid * 1024u;
    const int aoff = lds_byte(wr * 64 + fr, fq * 8), boff = lds_byte(wc * 32 + fr, fq * 8);
#define PG8_SA(b, h) (((b) * 2 + (h)) * HTB)
#define PG8_SB(b, h) ((4 + (b) * 2 + (h)) * HTB)
#define PG8_STAGE(bufoff, gbase, voff) do { _Pragma("unroll") for (int _i = 0; _i < 2; ++_i) \
        __builtin_amdgcn_global_load_lds((const unsigned*)((const char*)(gbase) + (voff)[_i]), (PG8_LAS unsigned*)(lds + (bufoff) + ldsw + _i * 8192), 16, 0, 0); } while (0)
#define PG8_LDA(dst, b, h) do { _Pragma("unroll") for (int m = 0; m < 4; ++m) _Pragma("unroll") for (int k = 0; k < 2; ++k) dst[m][k] = *(const PG8_LAS bf16x8*)(lds + PG8_SA(b, h) + aoff + m * 2048 + k * 1024); } while (0)
#define PG8_LDB(dst, b, h) do { _Pragma("unroll") for (int n = 0; n < 2; ++n) _Pragma("unroll") for (int k = 0; k < 2; ++k) dst[n][k] = *(const PG8_LAS bf16x8*)(lds + PG8_SB(b, h) + boff + n * 2048 + k * 1024); } while (0)
#define PG8_MMA(ai, bj, At, Bt) do { __builtin_amdgcn_s_setprio(1); _Pragma("unroll") for (int m = 0; m < 4; ++m) _Pragma("unroll") for (int n = 0; n < 2; ++n) _Pragma("unroll") for (int k = 0; k < 2; ++k) \
        acc[ai][bj][m][n] = __builtin_amdgcn_mfma_f32_16x16x32_bf16(Bt[n][k], At[m][k], acc[ai][bj][m][n], 0, 0, 0); __builtin_amdgcn_s_setprio(0); } while (0)
#define PG8_WAIT_V(n) asm volatile("s_waitcnt vmcnt(" #n ")" ::: "memory")
#define PG8_WAIT_L(n) asm volatile("s_waitcnt lgkmcnt(" #n ")" ::: "memory")
#define PG8_BAR __builtin_amdgcn_s_barrier()
#define PG8_SCHED __builtin_amdgcn_sched_barrier(0)
    Unit cur, nxt; int ui = 0;
    if (!S.next(0, cur)) return;
    f32x4 acc[2][2][4][2];
#pragma unroll
    for (int a = 0; a < 2; ++a)
#pragma unroll
        for (int b = 0; b < 2; ++b)
#pragma unroll
            for (int m = 0; m < 4; ++m)
#pragma unroll
                for (int n = 0; n < 2; ++n) acc[a][b][m][n] = (f32x4){0.f, 0.f, 0.f, 0.f};
    bf16x8 At[4][2], B0[2][2], B1[2][2];
    const char* cA = (const char*)g.A + (size_t)cur.pm * tstepA; const char* cB = (const char*)g.Bt + (size_t)cur.pn * tstepB;
    float rsv[8]; int rs_pm = -1;
    if constexpr (!Epi::AFTER_DRAIN) { E.preload(rsv, cur.pm, wr, fr); rs_pm = cur.pm; }
    if constexpr (SP2) {
        PG8_STAGE(PG8_SB(0, 0), cB, voffB); PG8_STAGE(PG8_SB(0, 1), cB + hstepB, voffB); PG8_STAGE(PG8_SA(0, 0), cA, voffA); PG8_STAGE(PG8_SA(0, 1), cA + hstepA, voffA);
        if (wr == 1) PG8_BAR;
        PG8_WAIT_V(2); PG8_BAR;
        PG8_STAGE(PG8_SB(1, 0), cB + kstep, voffB); PG8_STAGE(PG8_SA(1, 0), cA + kstep, voffA); PG8_STAGE(PG8_SB(1, 1), cB + hstepB + kstep, voffB);
        PG8_WAIT_V(6); PG8_BAR;
    } else {
        PG8_STAGE(PG8_SB(0, 0), cB, voffB); PG8_STAGE(PG8_SA(0, 0), cA, voffA); PG8_STAGE(PG8_SB(0, 1), cB + hstepB, voffB); PG8_STAGE(PG8_SA(0, 1), cA + hstepA, voffA);
        if (wr == 1) PG8_BAR;
        PG8_WAIT_V(4); PG8_BAR;
        PG8_STAGE(PG8_SB(1, 0), cB + kstep, voffB); PG8_STAGE(PG8_SA(1, 0), cA + kstep, voffA); PG8_STAGE(PG8_SB(1, 1), cB + hstepB + kstep, voffB);
        PG8_WAIT_V(6); PG8_BAR;
    }
    for (;;) {
        const bool has_next = S.next(ui + 1, nxt);
        const char* nA = has_next ? (const char*)g.A + (size_t)nxt.pm * tstepA : cA; const char* nB = has_next ? (const char*)g.Bt + (size_t)nxt.pn * tstepB : cB;
        for (int t = 0; t < nt; t += 2) {
            const bool last = (t == nt - 2);
            const char* a1 = cA + (size_t)(t + 1) * kstep;
            const char* a2 = last ? nA : cA + (size_t)(t + 2) * kstep; const char* b2 = last ? nB : cB + (size_t)(t + 2) * kstep;
            const char* a3 = a2 + kstep; const char* b3 = b2 + kstep;
            if constexpr (SP2) {
            PG8_LDB(B0, 0, 0); PG8_LDB(B1, 0, 1); PG8_SCHED; PG8_LDA(At, 0, 0); PG8_STAGE(PG8_SA(1, 1), a1 + hstepA, voffA);
            PG8_WAIT_V(8); PG8_WAIT_L(0); PG8_BAR; PG8_MMA(0, 0, At, B0); PG8_MMA(0, 1, At, B1); PG8_BAR; PG8_SCHED;
            PG8_LDA(At, 0, 1); PG8_STAGE(PG8_SB(0, 0), b2, voffB); PG8_STAGE(PG8_SB(0, 1), b2 + hstepB, voffB); PG8_STAGE(PG8_SA(0, 0), a2, voffA);
            PG8_WAIT_V(8); PG8_WAIT_L(0); PG8_BAR; PG8_MMA(1, 0, At, B0); PG8_MMA(1, 1, At, B1); PG8_BAR; PG8_SCHED;
            PG8_LDB(B0, 1, 0); PG8_LDB(B1, 1, 1); PG8_SCHED; PG8_LDA(At, 1, 0); PG8_STAGE(PG8_SA(0, 1), a2 + hstepA, voffA);
            PG8_WAIT_V(8); PG8_WAIT_L(0); PG8_BAR; PG8_MMA(0, 0, At, B0); PG8_MMA(0, 1, At, B1); PG8_BAR; PG8_SCHED;
            PG8_LDA(At, 1, 1); PG8_STAGE(PG8_SB(1, 0), b3, voffB); PG8_STAGE(PG8_SB(1, 1), b3 + hstepB, voffB); PG8_STAGE(PG8_SA(1, 0), a3, voffA);
            PG8_WAIT_V(8); PG8_WAIT_L(0); PG8_BAR; PG8_MMA(1, 0, At, B0); PG8_MMA(1, 1, At, B1); PG8_BAR; PG8_SCHED;
            } else {
            PG8_LDB(B0, 0, 0); PG8_SCHED; PG8_LDA(At, 0, 0); PG8_STAGE(PG8_SA(1, 1), a1 + hstepA, voffA);
            PG8_WAIT_L(8); PG8_BAR; PG8_WAIT_L(0); PG8_MMA(0, 0, At, B0); PG8_BAR; PG8_SCHED;
            PG8_LDB(B1, 0, 1); PG8_STAGE(PG8_SB(0, 0), b2, voffB);
            PG8_BAR; PG8_WAIT_L(0); PG8_MMA(0, 1, At, B1); PG8_BAR;
            PG8_LDA(At, 0, 1); PG8_STAGE(PG8_SA(0, 0), a2, voffA);
            PG8_BAR; PG8_WAIT_L(0); PG8_MMA(1, 0, At, B0); PG8_BAR; PG8_SCHED;
            PG8_STAGE(PG8_SB(0, 1), b2 + hstepB, voffB);
            PG8_WAIT_V(6); PG8_BAR; PG8_MMA(1, 1, At, B1); PG8_BAR;
            PG8_LDB(B0, 1, 0); PG8_SCHED; PG8_LDA(At, 1, 0); PG8_STAGE(PG8_SA(0, 1), a2 + hstepA, voffA);
            PG8_WAIT_L(8); PG8_BAR; PG8_WAIT_L(0); PG8_MMA(0, 0, At, B0); PG8_BAR; PG8_SCHED;
            PG8_LDB(B1, 1, 1); PG8_STAGE(PG8_SB(1, 0), b3, voffB);
            PG8_BAR; PG8_WAIT_L(0); PG8_MMA(0, 1, At, B1); PG8_BAR;
            PG8_LDA(At, 1, 1); PG8_STAGE(PG8_SA(1, 0), a3, voffA);
            PG8_BAR; PG8_WAIT_L(0); PG8_MMA(1, 0, At, B0); PG8_BAR; PG8_SCHED;
            PG8_STAGE(PG8_SB(1, 1), b3 + hstepB, voffB);
            PG8_WAIT_V(6); PG8_BAR; PG8_MMA(1, 1, At, B1); PG8_BAR;
            }
        }
        if constexpr (ALIGN_EPI) { if (wr == 0) PG8_BAR; }
        if constexpr (!Epi::AFTER_DRAIN) { E(acc, cur, wr, wc, fr, fq, rsv, rs_pm); }
        if (!has_next) break;
#pragma unroll
        for (int a = 0; a < 2; ++a)
#pragma unroll
            for (int b = 0; b < 2; ++b)
#pragma unroll
                for (int m = 0; m < 4; ++m)
#pragma unroll
                    for (int n = 0; n < 2; ++n) acc[a][b][m][n] = (f32x4){0.f, 0.f, 0.f, 0.f};
        cur = nxt; cA = nA; cB = nB; ++ui;
        if constexpr (ALIGN_EPI) { if (wr == 1) PG8_BAR; }
    }
    PG8_WAIT_V(0);
    if constexpr (!ALIGN_EPI) { if (wr == 0) PG8_BAR; }
    PG8_BAR;
    if constexpr (Epi::AFTER_DRAIN) { E.fused(acc, cur, wr, wc, fr, fq, lds, wid, lane); }
#undef PG8_SA
#undef PG8_SB
#undef PG8_STAGE
#undef PG8_LDA
#undef PG8_LDB
#undef PG8_MMA
#undef PG8_WAIT_V
#undef PG8_WAIT_L
#undef PG8_BAR
#undef PG8_SCHED
}
}
#define LAS __attribute__((address_space(3)))
typedef unsigned short bf16;
typedef short bf16x8 __attribute__((ext_vector_type(8)));
typedef short s16x4 __attribute__((ext_vector_type(4)));
typedef float f32x4 __attribute__((ext_vector_type(4)));
typedef unsigned u32x4 __attribute__((ext_vector_type(4)));
typedef unsigned u32x2 __attribute__((ext_vector_type(2)));
typedef LAS unsigned char* ldsp;
constexpr float LOG2E = 1.4426950408889634f;

__device__ __forceinline__ float bf_lo(unsigned w) { return __uint_as_float(w << 16); }
__device__ __forceinline__ float bf_hi(unsigned w) { return __uint_as_float(w & 0xffff0000u); }
__device__ __forceinline__ unsigned pk2(float lo, float hi) { return pg8::cvt_pk_bf16(lo, hi); }
__device__ __forceinline__ s16x4 vtr(ldsp p) { typedef short v4i16_t __attribute__((ext_vector_type(4))); return __builtin_bit_cast(s16x4, __builtin_amdgcn_ds_read_tr16_b64_v4i16((LAS v4i16_t*)p)); }
__device__ __forceinline__ bf16x8 cat8(s16x4 lo, s16x4 hi) { return (bf16x8){lo[0], lo[1], lo[2], lo[3], hi[0], hi[1], hi[2], hi[3]}; }
__device__ __forceinline__ f32x4 mfma16(bf16x8 a, bf16x8 b, f32x4 c) { return __builtin_amdgcn_mfma_f32_16x16x32_bf16(a, b, c, 0, 0, 0); }
__device__ __forceinline__ float ex2(float x) { return __builtin_amdgcn_exp2f(x); }

namespace att {
constexpr int SEQ = 16384, LDQ = 2304, LDO = 1024;
constexpr int KPB = 160;
constexpr int COL_QA = 0, COL_KA = 512, COL_VA = 640, COL_QB = 768, COL_KB = 1280, COL_VB = 1792;

template <int NP>
__device__ __forceinline__ void load_rows(u32x4 (&v)[NP], const bf16* src, int tok0, int nvalid, int tid) {
    const int sub = tid & 7;
#pragma unroll
    for (int p = 0; p < NP; ++p) { const int r = (tid >> 3) + 64 * p, tok = tok0 + r; const bool ok = (tok >= 0) && (tok < SEQ) && (r < nvalid);
        v[p] = (u32x4){0u, 0u, 0u, 0u};
        if (ok) v[p] = *(const u32x4*)(src + (size_t)tok * LDQ + sub * 8); }
}
template <int NP, bool NORM>
__device__ __forceinline__ void store_rows(ldsp dst, const u32x4 (&v)[NP], int nrows, const float* gain, int tid) {
    const int sub = tid & 7;
    float gn[8];
    if (NORM) {
#pragma unroll
        for (int j = 0; j < 8; ++j) gn[j] = gain[sub * 8 + j];
    }
#pragma unroll
    for (int p = 0; p < NP; ++p) { const int r = (tid >> 3) + 64 * p;
        if (r < nrows) {
            u32x4 w = v[p];
            if (NORM) {
                float f[8]; f[0] = bf_lo(w.x); f[1] = bf_hi(w.x); f[2] = bf_lo(w.y); f[3] = bf_hi(w.y); f[4] = bf_lo(w.z); f[5] = bf_hi(w.z); f[6] = bf_lo(w.w); f[7] = bf_hi(w.w);
                float ss = 0.f;
#pragma unroll
                for (int j = 0; j < 8; ++j) ss += f[j] * f[j];
                ss += __shfl_xor(ss, 1); ss += __shfl_xor(ss, 2); ss += __shfl_xor(ss, 4);
                const float rs = rsqrtf(ss * (1.0f / 64.0f) + 1e-6f);
#pragma unroll
                for (int j = 0; j < 8; ++j) f[j] = f[j] * rs * gn[j];
                w.x = pk2(f[0], f[1]); w.y = pk2(f[2], f[3]); w.z = pk2(f[4], f[5]); w.w = pk2(f[6], f[7]);
            }
            *(LAS u32x4*)(dst + r * KPB + sub * 16) = w;
        } }
}

__device__ __forceinline__ void load_q_raw(u32x4 (&raw)[2], const bf16* qrow  , int g) {
#pragma unroll
    for (int s = 0; s < 2; ++s) raw[s] = *(const u32x4*)(qrow + 32 * s + 8 * g);
}
__device__ __forceinline__ void finish_q(bf16x8 (&qf)[2], const u32x4 (&raw)[2], const float* gain, int g) {
    float f[2][8]; float ss = 0.f;
#pragma unroll
    for (int s = 0; s < 2; ++s) { const u32x4 v = raw[s];
        f[s][0] = bf_lo(v.x); f[s][1] = bf_hi(v.x); f[s][2] = bf_lo(v.y); f[s][3] = bf_hi(v.y); f[s][4] = bf_lo(v.z); f[s][5] = bf_hi(v.z); f[s][6] = bf_lo(v.w); f[s][7] = bf_hi(v.w);
#pragma unroll
        for (int j = 0; j < 8; ++j) ss += f[s][j] * f[s][j]; }
    ss += __shfl_xor(ss, 16); ss += __shfl_xor(ss, 32);
    const float rs = rsqrtf(ss * (1.0f / 64.0f) + 1e-6f) * (0.125f * LOG2E);
#pragma unroll
    for (int s = 0; s < 2; ++s) { float o[8];
#pragma unroll
        for (int j = 0; j < 8; ++j) o[j] = f[s][j] * rs * gain[32 * s + 8 * g + j];
        u32x4 w; w.x = pk2(o[0], o[1]); w.y = pk2(o[2], o[3]); w.z = pk2(o[4], o[5]); w.w = pk2(o[6], o[7]);
        qf[s] = __builtin_bit_cast(bf16x8, w); }
}

template <int NT, class RB>
__device__ __forceinline__ void scores(f32x4 (&sc)[NT], ldsp Kb, const bf16x8 (&qf)[2], const RB& rb, int lane) {
    const int fr = lane & 15, g = lane >> 4;
#pragma unroll
    for (int t = 0; t < NT; ++t) { ldsp kp = Kb + (rb(t) + fr) * KPB + g * 16; f32x4 a = (f32x4){0.f, 0.f, 0.f, 0.f};
#pragma unroll
        for (int s = 0; s < 2; ++s) { const bf16x8 kf = *(const LAS bf16x8*)(kp + s * 64); a = mfma16(kf, qf[s], a); }
        sc[t] = a; if ((t & 3) == 3) __builtin_amdgcn_sched_barrier(0); }
}
template <int NT>
__device__ __forceinline__ float softmax_pack(f32x4 (&sc)[NT], bf16x8 (&pf)[NT / 2], float sink2, bool has_sink) {
    float m = -INFINITY;
#pragma unroll
    for (int t = 0; t < NT; ++t)
#pragma unroll
        for (int r = 0; r < 4; ++r) m = fmaxf(m, sc[t][r]);
    m = fmaxf(m, __shfl_xor(m, 16)); m = fmaxf(m, __shfl_xor(m, 32));
    if (has_sink) m = fmaxf(m, sink2);
    float sum = 0.f;
#pragma unroll
    for (int t = 0; t < NT; ++t)
#pragma unroll
        for (int r = 0; r < 4; ++r) { const float p = ex2(sc[t][r] - m); sc[t][r] = p; sum += p; }
    sum += __shfl_xor(sum, 16); sum += __shfl_xor(sum, 32);
    if (has_sink) sum += ex2(sink2 - m);
#pragma unroll
    for (int k = 0; k < NT / 2; ++k) { u32x4 w; w.x = pk2(sc[2 * k][0], sc[2 * k][1]); w.y = pk2(sc[2 * k][2], sc[2 * k][3]); w.z = pk2(sc[2 * k + 1][0], sc[2 * k + 1][1]); w.w = pk2(sc[2 * k + 1][2], sc[2 * k + 1][3]);
        pf[k] = __builtin_bit_cast(bf16x8, w); }
    return sum;
}
template <int NT, class RB>
__device__ __forceinline__ void pv_store(ldsp Vb, const bf16x8 (&pf)[NT / 2], const RB& rb, float sum, bf16* orow  , int lane) {
    const int g = lane >> 4, q4 = (lane & 15) >> 2, p4 = lane & 3;
    f32x4 o[4];
#pragma unroll
    for (int dt = 0; dt < 4; ++dt) o[dt] = (f32x4){0.f, 0.f, 0.f, 0.f};
#pragma unroll
    for (int k = 0; k < NT / 2; ++k) { ldsp v0 = Vb + (rb(2 * k) + 4 * g + q4) * KPB + p4 * 8; ldsp v1 = Vb + (rb(2 * k + 1) + 4 * g + q4) * KPB + p4 * 8;
#pragma unroll
        for (int dt = 0; dt < 4; ++dt) { const bf16x8 vf = cat8(vtr(v0 + dt * 32), vtr(v1 + dt * 32)); o[dt] = mfma16(vf, pf[k], o[dt]); } }
    const float inv = 1.0f / sum;
#pragma unroll
    for (int dt = 0; dt < 4; ++dt) { u32x2 w; w.x = pk2(o[dt][0] * inv, o[dt][1] * inv); w.y = pk2(o[dt][2] * inv, o[dt][3] * inv); *(u32x2*)(orow + dt * 16 + 4 * g) = w; }
}

struct RbWin { int mt; __device__ __forceinline__ int operator()(int t) const { return 16 * (mt + t); } };
struct RbNa { int off, ct0, ct1; __device__ __forceinline__ int operator()(int t) const { return (off + (t >> 1)) * 64 + ((t & 1) ? ct1 : ct0) * 16; } };

struct AttnArgs { const bf16* qkv; bf16* o; const float* qn_a; const float* kn_a; const float* sink_a; const float* qn_b; const float* kn_b; const float* rpb; };

__device__ __forceinline__ void window_tile(ldsp Kb, ldsp Vb, const AttnArgs& A, int n, int kvh, int idx, const u32x4 (&qraw)[2], int lane) {
    const int fr = lane & 15, g = lane >> 4;
    const int g4 = idx >> 3, mt = idx & 7, hq = kvh * 4 + g4;
    const int qtok = n * 128 + mt * 16 + fr;
    bf16x8 qf[2]; finish_q(qf, qraw, A.qn_a, g);
    RbWin rb{mt};
    f32x4 sc[18]; scores<18>(sc, Kb, qf, rb, lane);
    const float slope2 = exp2f(-(float)(hq + 1)) * LOG2E;
    {
        const float cl = (float)(4 * g - 128 - fr);
        const float lo = (float)max(-128, -qtok), hi = (float)min(128, SEQ - 1 - qtok);
#pragma unroll
        for (int t = 0; t < 18; ++t)
#pragma unroll
            for (int r = 0; r < 4; ++r) { const float rel = cl + (float)(16 * t + r); sc[t][r] = (rel >= lo && rel <= hi) ? fmaf(-slope2, fabsf(rel), sc[t][r]) : -INFINITY; }
    }
    bf16x8 pf[9]; const float sum = softmax_pack<18>(sc, pf, A.sink_a[hq] * LOG2E, true);
    pv_store<18>(Vb, pf, rb, sum, A.o + (size_t)qtok * LDO + hq * 64, lane);
}
__device__ __forceinline__ void window_compute(ldsp lds, const AttnArgs& A, int unit, int tid) {
    const int n = unit >> 1, kvh = unit & 1, lane = tid & 63, wid = __builtin_amdgcn_readfirstlane(tid >> 6);
    ldsp Kb = lds, Vb = lds + 400 * KPB;
    const int tok0 = (n - 1) * 128;
    const int fr = lane & 15, g = lane >> 4;
    u32x4 qa[2], qb[2];
    const bf16* qbase = A.qkv + (size_t)(n * 128 + fr) * LDQ + COL_QA + kvh * 256;
    auto qptr = [&](int it) { const int idx = wid * 4 + it; return qbase + (size_t)((idx & 7) * 16) * LDQ + (idx >> 3) * 64; };
    load_q_raw(qa, qptr(0), g);
    for (int it = 0; it < 4; it += 2) {
        load_q_raw(qb, qptr(it + 1), g);
        window_tile(Kb, Vb, A, n, kvh, wid * 4 + it, qa, lane);
        if (it + 2 < 4) load_q_raw(qa, qptr(it + 2), g);
        window_tile(Kb, Vb, A, n, kvh, wid * 4 + it + 1, qb, lane);
    }
}

constexpr int NA_ROWS = 704;
constexpr int NA_RPB_OFF = NA_ROWS * KPB;

__device__ __forceinline__ void na_unit(ldsp lds, const AttnArgs& A, int unit, int next_unit, u32x4 (&kreg)[11], int tid) {
    const int rq4 = unit >> 3, h = unit & 7, lane = tid & 63, wid = __builtin_amdgcn_readfirstlane(tid >> 6);
    const int r0 = 4 * rq4; const int base = min(max(r0 - 4, 0), 248);
    const int rq = r0 + (wid >> 1); const int rstart = min(max(rq - 4, 0), 248);
    const int fr = lane & 15, g = lane >> 4;
    store_rows<11, true>(lds, kreg, NA_ROWS, A.kn_b, tid);
    __syncthreads();
    const LAS float* rpl = (const LAS float*)(lds + NA_RPB_OFF);
    bf16x8 pf[2][8]; float sum[2]; int qtok[2]; int qcs[2]; u32x4 qraw[2][2];
#pragma unroll
    for (int it = 0; it < 2; ++it) { const int mt = 2 * (wid & 1) + it; qcs[it] = (mt < 3) ? 8 + 16 * mt + fr : (fr < 8 ? fr : 48 + fr); qtok[it] = rq * 64 + qcs[it];
        load_q_raw(qraw[it], A.qkv + (size_t)qtok[it] * LDQ + COL_QB + h * 64, g); }
#pragma unroll
    for (int it = 0; it < 2; ++it) {
        const int mt = 2 * (wid & 1) + it; const int qc = qcs[it];
        bf16x8 qf[2]; finish_q(qf, qraw[it], A.qn_b, g);
        RbNa rb{rstart - base, (mt < 3) ? mt : 0, (mt < 3) ? mt + 1 : 3};
        f32x4 sc[16]; scores<16>(sc, lds, qf, rb, lane);
        const int cstart = min(max(qc - 8, 0), 48);
        const int d0 = 4 * g - cstart;
        const LAS float* rpl0 = rpl + (rstart - rq + 7) * 128 + (4 * g - qc + 64);
#pragma unroll
        for (int t = 0; t < 16; ++t) { const int ct = (t & 1) ? rb.ct1 : rb.ct0; const LAS float* rp = rpl0 + (t >> 1) * 128 + 16 * ct; const int kb = 16 * ct + d0;
#pragma unroll
            for (int r = 0; r < 4; ++r) sc[t][r] = ((unsigned)(kb + r) < 16u) ? sc[t][r] + rp[r] : -INFINITY;
            if ((t & 3) == 3) __builtin_amdgcn_sched_barrier(0); }
        sum[it] = softmax_pack<16>(sc, pf[it], 0.f, false);
        __builtin_amdgcn_sched_barrier(0);
    }
    u32x4 vreg[11]; load_rows<11>(vreg, A.qkv + COL_VB + h * 64, base * 64, NA_ROWS, tid);
    __syncthreads();
    store_rows<11, false>(lds, vreg, NA_ROWS, nullptr, tid);
    if (next_unit >= 0) { const int nb = min(max(4 * (next_unit >> 3) - 4, 0), 248); load_rows<11>(kreg, A.qkv + COL_KB + h * 64, nb * 64, NA_ROWS, tid); }
    __syncthreads();
#pragma unroll
    for (int it = 0; it < 2; ++it) { const int mt = 2 * (wid & 1) + it; RbNa rb{rstart - base, (mt < 3) ? mt : 0, (mt < 3) ? mt + 1 : 3};
        pv_store<16>(lds, pf[it], rb, sum[it], A.o + (size_t)qtok[it] * LDO + 512 + h * 64, lane); __builtin_amdgcn_sched_barrier(0); }
    __syncthreads();
}

__device__ __forceinline__ void attn_phase(ldsp lds, const AttnArgs& A, int vcu, int G, int tid) {
    const int h = vcu & 7;
    u32x4 kreg[11];
#ifndef ATT_REP_WIN
#define ATT_REP_WIN 1
#define ATT_REP_NA 1
#endif
    for (int rw = 0; rw < ATT_REP_WIN; ++rw) {
        const int n = vcu >> 1, kvh = vcu & 1, tok0 = (n - 1) * 128;
        u32x4 kw[7], vw[7];
        load_rows<7>(kw, A.qkv + COL_KA + kvh * 64, tok0, 384, tid);
        load_rows<7>(vw, A.qkv + COL_VA + kvh * 64, tok0, 384, tid);
        store_rows<7, true>(lds, kw, 400, A.kn_a, tid);
        store_rows<7, false>(lds + 400 * KPB, vw, 400, nullptr, tid);
        __syncthreads();
        window_compute(lds, A, vcu, tid);
        __syncthreads();
    }
    for (int rn = 0; rn < ATT_REP_NA; ++rn) {
    { const int b0 = min(max(4 * (vcu >> 3) - 4, 0), 248); load_rows<11>(kreg, A.qkv + COL_KB + h * 64, b0 * 64, NA_ROWS, tid); }
    for (int i = tid; i < 15 * 128; i += 512) { const int ri = i >> 7, dc = i & 127; const int ci = min(max(dc - 49, 0), 30); ((LAS float*)(lds + NA_RPB_OFF))[i] = A.rpb[h * 465 + ri * 31 + ci] * LOG2E; }
    for (int k = 0; k < 2; ++k) { int t2 = tid; asm volatile("" : "+v"(t2));
        na_unit(lds, A, vcu + 256 * k, (k < 1) ? vcu + 256 * (k + 1) : -1, kreg, t2); }
    }
}
}
namespace ret {
constexpr int SEQ = 16384, LDG = 3072, NCH = 128;
constexpr int COL_Q = 0, COL_K = 512, COL_V = 1024, COL_G = 2048;
constexpr int KPB = 288;
constexpr int VPB = 544;
constexpr int UPB = 528;
constexpr int R0 = 0, R1 = 128 * KPB, R2 = 2 * 128 * KPB, RSTAT = R2 + 128 * VPB;
constexpr size_t ST_CHUNK = 128 * 256;

__device__ __forceinline__ unsigned pk2a(float lo, float hi) { unsigned r; asm volatile("v_cvt_pk_bf16_f32 %0, %1, %2" : "=v"(r) : "v"(lo), "v"(hi)); return r; }
struct RetArgs { bf16* G; bf16* ST; const float* l2;   const float* gn; int grp; int dry; bf16* Y; };

template <bool SCALE>
__device__ __forceinline__ void stage128(ldsp dst, const bf16* src, int ld, float a, float b, int tid) {
#pragma unroll
    for (int i = 0; i < 4; ++i) { const int idx = tid + i * 512, row = idx >> 4, ch = idx & 15;
        u32x4 v = *(const u32x4*)(src + (size_t)row * ld + ch * 8);
        if (SCALE) { const float s = ex2(a * (float)row + b);
            v.x = pk2a(bf_lo(v.x) * s, bf_hi(v.x) * s); v.y = pk2a(bf_lo(v.y) * s, bf_hi(v.y) * s); v.z = pk2a(bf_lo(v.z) * s, bf_hi(v.z) * s); v.w = pk2a(bf_lo(v.w) * s, bf_hi(v.w) * s); }
        *(LAS u32x4*)(dst + row * KPB + ch * 16) = v; }
}
__device__ __forceinline__ void stage256(ldsp dst, const bf16* src, int ld, int tid) {
#pragma unroll
    for (int i = 0; i < 8; ++i) { const int idx = tid + i * 512, row = idx >> 5, ch = idx & 31;
        const u32x4 v = *(const u32x4*)(src + (size_t)row * ld + ch * 8);
        *(LAS u32x4*)(dst + row * VPB + ch * 16) = v; }
}
__device__ __forceinline__ bf16x8 trfrag(ldsp X, int pitch, int k0, int n0, int lane) {
    const int g = lane >> 4, q4 = (lane & 15) >> 2, p4 = lane & 3;
    ldsp p = X + (k0 + 8 * g + q4) * pitch + (n0 + 4 * p4) * 2;
    return cat8(vtr(p), vtr(p + 4 * pitch));
}

__device__ __forceinline__ void ld128(u32x4 (&r)[4], const bf16* src, int ld, int tid) {
    const unsigned off0 = (unsigned)(((tid >> 4) * ld + (tid & 15) * 8) * 2);
#pragma unroll
    for (int i = 0; i < 4; ++i) r[i] = *(const u32x4*)((const char*)src + (size_t)i * 32 * ld * 2 + off0);
}
__device__ __forceinline__ void st128(ldsp dst, const u32x4 (&r)[4], int tid) {
    ldsp d0 = dst + (tid >> 4) * KPB + (tid & 15) * 16;
#pragma unroll
    for (int i = 0; i < 4; ++i) *(LAS u32x4*)(d0 + i * 32 * KPB) = r[i];
}
__device__ __forceinline__ void st128s(ldsp dst, const u32x4 (&r)[4], float a, float b, int tid) {
    ldsp d0 = dst + (tid >> 4) * KPB + (tid & 15) * 16;
#pragma unroll
    for (int i = 0; i < 4; ++i) { const int row = (tid >> 4) + 32 * i; const float s = ex2(a * (float)row + b); u32x4 v = r[i];
        v.x = pk2(bf_lo(v.x) * s, bf_hi(v.x) * s); v.y = pk2(bf_lo(v.y) * s, bf_hi(v.y) * s); v.z = pk2(bf_lo(v.z) * s, bf_hi(v.z) * s); v.w = pk2(bf_lo(v.w) * s, bf_hi(v.w) * s);
        *(LAS u32x4*)(d0 + i * 32 * KPB) = v; }
}
__device__ __forceinline__ void ld64(u32x4 (&r)[4], const bf16* src, int ld, int tid) {
    const unsigned off0 = (unsigned)(((tid >> 5) * ld + (tid & 31) * 8) * 2);
#pragma unroll
    for (int i = 0; i < 4; ++i) r[i] = *(const u32x4*)((const char*)src + (size_t)i * 16 * ld * 2 + off0);
}
__device__ __forceinline__ void st64(ldsp dst, const u32x4 (&r)[4], int tid) {
    ldsp d0 = dst + (tid >> 5) * VPB + (tid & 31) * 16;
#pragma unroll
    for (int i = 0; i < 4; ++i) *(LAS u32x4*)(d0 + i * 16 * VPB) = r[i];
}

__device__ __forceinline__ void ret_a_phase(ldsp lds, const RetArgs& A, int vcu, int G, int tid_in) {
    int tid = tid_in;
    const int wid = __builtin_amdgcn_readfirstlane(tid >> 6);
    int u = vcu; if (u >= 512) return;
    u32x4 rk[4], rv0[4], rv1[4];
    { const bf16* rows = A.G + (size_t)(u >> 2) * 128 * LDG; const int hl = u & 3;
      ld128(rk, rows + COL_K + hl * 128, LDG, tid); ld64(rv0, rows + COL_V + hl * 256, LDG, tid); ld64(rv1, rows + (size_t)64 * LDG + COL_V + hl * 256, LDG, tid); }
    for (;;) {
        asm volatile("" : "+v"(tid));
        const int lane = tid & 63, fr = lane & 15, g = lane >> 4;
        const int hl = u & 3, c = u >> 2, h = A.grp * 4 + hl;
        const float l2f = A.l2[h], l2b = A.l2[8 + h];
        st128s(lds + R0, rk, -l2f, 127.0f * l2f, tid);
        st128s(lds + R1, rk, l2b, 0.f, tid);
        st64(lds + R2, rv0, tid); st64(lds + R2 + 64 * VPB, rv1, tid);
        const int un = u + G; const bool has_next = un < 512;
        if (has_next) { const bf16* rows = A.G + (size_t)(un >> 2) * 128 * LDG; const int nhl = un & 3;
            ld128(rk, rows + COL_K + nhl * 128, LDG, tid); ld64(rv0, rows + COL_V + nhl * 256, LDG, tid); ld64(rv1, rows + (size_t)64 * LDG + COL_V + nhl * 256, LDG, tid); }
        __syncthreads();
        f32x4 acc[2][2][8];
#pragma unroll
        for (int dir = 0; dir < 2; ++dir) {
            ldsp Kx = lds + (dir ? R1 : R0);
#pragma unroll
            for (int et = 0; et < 2; ++et)
#pragma unroll
                for (int dt = 0; dt < 8; ++dt) acc[dir][et][dt] = (f32x4){0.f, 0.f, 0.f, 0.f};
#pragma unroll
            for (int ks = 0; ks < 4; ++ks) {
                bf16x8 vf[2];
#pragma unroll
                for (int et = 0; et < 2; ++et) vf[et] = trfrag(lds + R2, VPB, 32 * ks, 32 * wid + 16 * et, lane);
#pragma unroll
                for (int dt = 0; dt < 8; ++dt) { const bf16x8 kf = trfrag(Kx, KPB, 32 * ks, 16 * dt, lane);
#pragma unroll
                    for (int et = 0; et < 2; ++et) acc[dir][et][dt] = mfma16(vf[et], kf, acc[dir][et][dt]);
                    if ((dt & 3) == 3) __builtin_amdgcn_sched_barrier(0); }
            }
        }
        __syncthreads();
#pragma unroll
        for (int dir = 0; dir < 2; ++dir)
#pragma unroll
            for (int et = 0; et < 2; ++et)
#pragma unroll
                for (int dt = 0; dt < 8; ++dt) { u32x2 w; w.x = pk2(acc[dir][et][dt][0], acc[dir][et][dt][1]); w.y = pk2(acc[dir][et][dt][2], acc[dir][et][dt][3]);
                    *(LAS u32x2*)(lds + dir * (128 * UPB) + (16 * dt + fr) * UPB + (32 * wid + 16 * et + 4 * g) * 2) = w; }
        __syncthreads();
#pragma unroll
        for (int dir = 0; dir < 2; ++dir) { char* st = (char*)(A.ST + ((size_t)((dir * 4 + hl) * NCH + c)) * ST_CHUNK); const unsigned soff = (unsigned)((tid >> 5) * 512 + (tid & 31) * 16);
            ldsp s0 = lds + dir * (128 * UPB) + (tid >> 5) * UPB + (tid & 31) * 16;
#pragma unroll
            for (int i = 0; i < 8; ++i) *(u32x4*)(st + (size_t)i * 16 * 512 + soff) = *(const LAS u32x4*)(s0 + i * 16 * UPB); }
        __syncthreads();
        if (!has_next) break;
        u = un;
    }
}

__device__ __forceinline__ void ret_b(const RetArgs& A, int vcu, int G, int tid) {
    const int NT = 8 * 16384;
    for (int T = vcu * 512 + tid; T < NT; T += G * 512) {
        const int dh = T >> 14, w = T & 16383, dir = dh >> 2, hl = dh & 3, h = A.grp * 4 + hl;
        const float dec = ex2(128.0f * A.l2[dir * 8 + h]);
        unsigned* p = (unsigned*)(A.ST + (size_t)dh * NCH * ST_CHUNK) + w;
        const ptrdiff_t cs = dir ? -(ptrdiff_t)(ST_CHUNK / 2) : (ptrdiff_t)(ST_CHUNK / 2);
        if (dir) p += (size_t)(NCH - 1) * (ST_CHUNK / 2);
        float s0 = 0.f, s1 = 0.f;
        for (int c = 0; c < NCH; c += 32) {
            unsigned u[32];
#pragma unroll
            for (int k = 0; k < 32; ++k) u[k] = p[(ptrdiff_t)k * cs];
#pragma unroll
            for (int k = 0; k < 32; ++k) { p[(ptrdiff_t)k * cs] = A.dry ? u[k] : pk2(s0, s1); s0 = dec * s0 + bf_lo(u[k]); s1 = dec * s1 + bf_hi(u[k]); }
            p += 32 * cs;
        }
    }
}

constexpr int C_Q = 0, C_KA = 128 * KPB, C_B0 = 2 * 128 * KPB, C_B1 = C_B0 + 64 * VPB, C_STAT = C_B1 + 64 * VPB;
struct CPtrs { const bf16 *q, *k, *v, *sf, *sb; bf16* g; };
__device__ __forceinline__ CPtrs cptrs(const RetArgs& A, int unit) {
    const int hl = unit & 3, c = unit >> 2; bf16* rows = A.G + (size_t)c * 128 * LDG; CPtrs P;
    P.q = rows + COL_Q + hl * 128; P.k = rows + COL_K + hl * 128; P.v = rows + COL_V + hl * 256; P.g = rows + COL_G + hl * 256;
    P.sf = A.ST + ((size_t)((0 * 4 + hl) * NCH + c)) * ST_CHUNK; P.sb = A.ST + ((size_t)((1 * 4 + hl) * NCH + c)) * ST_CHUNK; return P;
}
__device__ __forceinline__ void half_mma(f32x4 (&acc)[2][8], ldsp buf, ldsp Bop, int kofs, int wid, int lane) {
    const int fr = lane & 15, g = lane >> 4;
#pragma unroll
    for (int ks = 0; ks < 2; ++ks) {
        bf16x8 xf[2];
#pragma unroll
        for (int et = 0; et < 2; ++et) xf[et] = trfrag(buf, VPB, 32 * ks, 32 * wid + 16 * et, lane);
#pragma unroll
        for (int it = 0; it < 8; ++it) { const bf16x8 bfrag = *(const LAS bf16x8*)(Bop + (16 * it + fr) * KPB + (kofs + 32 * ks + 8 * g) * 2);
#pragma unroll
            for (int et = 0; et < 2; ++et) acc[et][it] = mfma16(xf[et], bfrag, acc[et][it]);
            if ((it & 3) == 3) __builtin_amdgcn_sched_barrier(0); }
    }
}
__device__ __forceinline__ void ret_c_phase(ldsp lds, const RetArgs& A, int vcu, int G, int tid_in) {
    int tid = tid_in;
    const int wid = __builtin_amdgcn_readfirstlane(tid >> 6);
    int u = vcu; if (u >= 512) return;
    CPtrs P = cptrs(A, u);
    u32x4 r0[4], r1[4], r2[4], r3[4];
    ld128(r0, P.q, LDG, tid); ld128(r1, P.k, LDG, tid); ld64(r2, P.sf, 256, tid); ld64(r3, P.sf + 64 * 256, 256, tid);
    LAS float* stat = (LAS float*)(lds + C_STAT);
    for (;;) {
        asm volatile("" : "+v"(tid));
        const int lane = tid & 63, fr = lane & 15, g = lane >> 4;
        const int un = u + G; const bool has_next = un < 512;
        CPtrs N = P; if (has_next) N = cptrs(A, un);
        const int hl = u & 3, c = u >> 2, h = A.grp * 4 + hl;
        const float l2f = A.l2[h], l2b = A.l2[8 + h];
        st128(lds + C_Q, r0, tid); st128(lds + C_KA, r1, tid);
        ld64(r0, P.sb, 256, tid); ld64(r1, P.sb + 64 * 256, 256, tid);
        __syncthreads();
        f32x4 sa[8];
#pragma unroll
        for (int it = 0; it < 8; ++it) sa[it] = (f32x4){0.f, 0.f, 0.f, 0.f};
#pragma unroll
        for (int ks = 0; ks < 4; ++ks) { const bf16x8 kf = *(const LAS bf16x8*)(lds + C_KA + (16 * wid + fr) * KPB + (32 * ks + 8 * g) * 2);
#pragma unroll
            for (int it = 0; it < 8; ++it) { const bf16x8 qf = *(const LAS bf16x8*)(lds + C_Q + (16 * it + fr) * KPB + (32 * ks + 8 * g) * 2); sa[it] = mfma16(kf, qf, sa[it]); if ((it & 3) == 3) __builtin_amdgcn_sched_barrier(0); } }
        st64(lds + C_B0, r2, tid); ld64(r2, P.v, LDG, tid);
        __syncthreads();
#pragma unroll
        for (int it = 0; it < 8; ++it) { const int i = 16 * it + fr; float v[4];
#pragma unroll
            for (int r = 0; r < 4; ++r) { const int j = 16 * wid + 4 * g + r; const int dl = i - j; const float dm = dl >= 0 ? ex2((float)dl * l2f) : ex2((float)(-dl) * l2b); v[r] = sa[it][r] * dm; }
            u32x2 w; w.x = pk2(v[0], v[1]); w.y = pk2(v[2], v[3]);
            *(LAS u32x2*)(lds + C_KA + i * KPB + (16 * wid + 4 * g) * 2) = w; if (it & 1) __builtin_amdgcn_sched_barrier(0); }
        st64(lds + C_B1, r3, tid); ld64(r3, P.v + (size_t)64 * LDG, LDG, tid);
        f32x4 acc[2][8];
#pragma unroll
        for (int et = 0; et < 2; ++et)
#pragma unroll
            for (int it = 0; it < 8; ++it) acc[et][it] = (f32x4){0.f, 0.f, 0.f, 0.f};
        half_mma(acc, lds + C_B0, lds + C_Q, 0, wid, lane);
        __syncthreads();
        st64(lds + C_B0, r0, tid); if (has_next) ld128(r0, N.q, LDG, tid);
        half_mma(acc, lds + C_B1, lds + C_Q, 64, wid, lane);
        __syncthreads();
#pragma unroll
        for (int it = 0; it < 8; ++it) { const float fi = (float)(16 * it + fr); const float rt = ex2((fi + 1.0f) * l2f - (128.0f - fi) * l2b); acc[0][it] *= rt; acc[1][it] *= rt; }
        st64(lds + C_B1, r1, tid); if (has_next) ld128(r1, N.k, LDG, tid);
        half_mma(acc, lds + C_B0, lds + C_Q, 0, wid, lane);
        __syncthreads();
        st64(lds + C_B0, r2, tid); if (has_next) ld64(r2, N.sf, 256, tid);
        half_mma(acc, lds + C_B1, lds + C_Q, 64, wid, lane);
        __syncthreads();
#pragma unroll
        for (int it = 0; it < 8; ++it) { const float fi = (float)(16 * it + fr); const float sb = ex2((128.0f - fi) * l2b); acc[0][it] *= sb; acc[1][it] *= sb; }
        st64(lds + C_B1, r3, tid); if (has_next) ld64(r3, N.sf + 64 * 256, 256, tid);
        u32x2 gv[8][2]; f32x4 gw[2]; const unsigned goff = (unsigned)((fr * LDG + 32 * wid + 4 * g) * 2);
#pragma unroll
        for (int et = 0; et < 2; ++et) { const int e = 32 * wid + 16 * et + 4 * g; gw[et] = *(const f32x4*)(A.gn + h * 256 + e);
#pragma unroll
            for (int it = 0; it < 8; ++it) gv[it][et] = *(const u32x2*)((const char*)P.g + (size_t)(16 * it * LDG + 16 * et) * 2 + goff); }
        half_mma(acc, lds + C_B0, lds + C_KA, 0, wid, lane);
        __syncthreads();
        half_mma(acc, lds + C_B1, lds + C_KA, 64, wid, lane);
#pragma unroll
        for (int it = 0; it < 8; ++it) { float s1 = 0.f, s2 = 0.f;
#pragma unroll
            for (int et = 0; et < 2; ++et)
#pragma unroll
                for (int r = 0; r < 4; ++r) { const float y = acc[et][it][r]; s1 += y; s2 += y * y; }
            s1 += __shfl_xor(s1, 16); s1 += __shfl_xor(s1, 32); s2 += __shfl_xor(s2, 16); s2 += __shfl_xor(s2, 32);
            if (g == 0) { stat[((16 * it + fr) * 8 + wid) * 2] = s1; stat[((16 * it + fr) * 8 + wid) * 2 + 1] = s2; }
            if (it & 1) __builtin_amdgcn_sched_barrier(0); }
        __syncthreads();
#pragma unroll
        for (int it = 0; it < 8; ++it) { float s1 = 0.f, s2 = 0.f;
#pragma unroll
            for (int w = 0; w < 8; ++w) { s1 += stat[((16 * it + fr) * 8 + w) * 2]; s2 += stat[((16 * it + fr) * 8 + w) * 2 + 1]; }
            const float mu = s1 * (1.0f / 256.0f); const float var = fmaxf(s2 * (1.0f / 256.0f) - mu * mu, 0.f); const float rs = rsqrtf(var + 1e-5f);
#pragma unroll
            for (int et = 0; et < 2; ++et) { const int e = 32 * wid + 16 * et + 4 * g; const f32x4 y = acc[et][it]; const u32x2 gg = gv[it][et];
                u32x2 w; w.x = pk2(bf_lo(gg.x) * ((y[0] - mu) * rs * gw[et][0]), bf_hi(gg.x) * ((y[1] - mu) * rs * gw[et][1]));
                w.y = pk2(bf_lo(gg.y) * ((y[2] - mu) * rs * gw[et][2]), bf_hi(gg.y) * ((y[3] - mu) * rs * gw[et][3]));
                *(LAS u32x2*)(lds + C_B0 + (16 * it + fr) * UPB + e * 2) = w; }
            __builtin_amdgcn_sched_barrier(0); }
        __syncthreads();
        { char* yb = (char*)(A.Y + (size_t)c * 128 * 2048 + h * 256); const unsigned yoff = (unsigned)((tid >> 5) * 4096 + (tid & 31) * 16);
          ldsp s0 = lds + C_B0 + (tid >> 5) * UPB + (tid & 31) * 16;
#pragma unroll
          for (int i = 0; i < 8; ++i) *(u32x4*)(yb + (size_t)i * 16 * 4096 + yoff) = *(const LAS u32x4*)(s0 + i * 16 * UPB); }
        if (!has_next) break;
        u = un; P = N;
    }
    __syncthreads();
}
}
#define XB_TMO      128
#define XB_XCNT(j)  (256  + 64 * (j))
#define XB_XSUB(j)  (1280 + 64 * (j))
#define XB_XGEN(j)  (2304 + 64 * (j))
#define XB_TOP      3328
#define XB_TOPGEN   3392
#define XCD_BAR_WORDS 3456
#define XB_SPIN_CAP (1u << 18)

__device__ __forceinline__ unsigned xb_ld(unsigned* p)              { return __hip_atomic_load(p, __ATOMIC_RELAXED, __HIP_MEMORY_SCOPE_AGENT); }
__device__ __forceinline__ unsigned xb_add(unsigned* p, unsigned v) { return __hip_atomic_fetch_add(p, v, __ATOMIC_RELAXED, __HIP_MEMORY_SCOPE_AGENT); }
__device__ __forceinline__ unsigned xb_xcc_id() { return (unsigned)__builtin_amdgcn_s_getreg((3 << 11) | 20) & 0xFu; }
#define XB_SPIN(cond, bar) do { unsigned _sp = 0; while (cond) { __builtin_amdgcn_s_sleep(1); \
    if ((++_sp & 255u) == 0u) { if (xb_ld(&(bar)[XB_TMO])) break; if (_sp > XB_SPIN_CAP) { atomicAdd(&(bar)[XB_TMO], 1u); break; } } } } while (0)

struct XcdBarrier {
    unsigned* bar; unsigned x;
    volatile LAS unsigned* st;
};

__device__ __forceinline__ XcdBarrier xcd_barrier_post(unsigned* bar, volatile LAS unsigned* st) {
    XcdBarrier b; b.bar = bar; b.x = xb_xcc_id(); b.st = st;
    if (threadIdx.x == 0) (void)xb_add(&bar[XB_XCNT(b.x)], 1u);
    return b;
}
__device__ __forceinline__ void xcd_barrier_complete(unsigned* bar, unsigned x, unsigned& nloc, unsigned& nx) {
    const unsigned G = gridDim.x * gridDim.y * gridDim.z;
    unsigned sum, cnt, mine, sp = 0u;
    for (;;) {
        sum = 0u; cnt = 0u; mine = 0u;
#pragma unroll
        for (unsigned j = 0; j < 16; ++j) { const unsigned c = xb_ld(&bar[XB_XCNT(j)]); sum += c; cnt += (c > 0u) ? 1u : 0u; mine = (j == x) ? c : mine; }
        if (sum == G) break;
        __builtin_amdgcn_s_sleep(1);
        if ((++sp & 255u) == 0u) { if (xb_ld(&bar[XB_TMO])) break; if (sp > XB_SPIN_CAP) { atomicAdd(&bar[XB_TMO], 1u); break; } }
    }
    nloc = mine > 0u ? mine : 1u; nx = cnt > 0u ? cnt : 1u;
}

__device__ __forceinline__ void xcd_barrier(const XcdBarrier& b) {
    asm volatile("s_waitcnt vmcnt(0)" ::: "memory");
    __syncthreads();
    if (threadIdx.x == 0) {
        unsigned* bar = b.bar;
        __builtin_amdgcn_s_waitcnt(0);
        unsigned nloc = b.st[0], nx = b.st[1];
        if (nloc == 0u) { xcd_barrier_complete(bar, b.x, nloc, nx); b.st[0] = nloc; b.st[1] = nx; }
        const unsigned old = xb_add(&bar[XB_XSUB(b.x)], 1u);
        const unsigned gen = old / nloc;
        if (old + 1u == (gen + 1u) * nloc) {
            __builtin_amdgcn_fence(__ATOMIC_RELEASE, "agent");
            asm volatile("s_waitcnt vmcnt(0)" ::: "memory");
            const unsigned og = xb_add(&bar[XB_TOP], 1u);
            const unsigned tg = og / nx;
            if (og + 1u == (tg + 1u) * nx) xb_add(&bar[XB_TOPGEN], 1u);
            else XB_SPIN(xb_ld(&bar[XB_TOPGEN]) == tg, bar);
            __builtin_amdgcn_fence(__ATOMIC_ACQUIRE, "agent");
            xb_add(&bar[XB_XGEN(b.x)], 1u);
            asm volatile("s_waitcnt vmcnt(0)" ::: "memory");
        } else {
            XB_SPIN(xb_ld(&bar[XB_XGEN(b.x)]) == gen, bar);
            __builtin_amdgcn_fence(__ATOMIC_ACQUIRE, "agent");
            asm volatile("s_waitcnt vmcnt(0)" ::: "memory");
        }
    }
    __syncthreads();
}
constexpr int M_TOK = 16384, DM = 1024, DFF = 4096, N_IN_E = 2304, N_IN_O = 6144;
constexpr size_t MiB = 1u << 20;
constexpr size_t WS_CTL = 0;
constexpr size_t WS_L2 = 4096, WS_SSQ = 512 * 1024;
constexpr int CW_BAR = 4096;
constexpr size_t WS_W_IN_E = 1 * MiB;
constexpr size_t WS_W_OUT_E = WS_W_IN_E + (size_t)N_IN_E * DM * 2;
constexpr size_t WS_W_MLP_IN = WS_W_OUT_E + (size_t)DM * DM * 2;
constexpr size_t WS_W_MLP_OUT = WS_W_MLP_IN + 2 * (size_t)DFF * DM * 2;
constexpr size_t WS_W_IN_O = WS_W_MLP_OUT + 2 * (size_t)DFF * DM * 2;
constexpr size_t WS_W_OUT_O = WS_W_IN_O + (size_t)N_IN_O * DM * 2;
constexpr size_t WS_XB = 56 * MiB;
constexpr size_t WS_BIG = 88 * MiB;
constexpr size_t WS_END = 256 * MiB;
static_assert(WS_W_OUT_O + (size_t)DM * 2048 * 2 <= WS_XB, "weights fit below XB");

constexpr int RING_BYTES = 155648;
constexpr int LDS_BYTES = 159744;

struct Args { const float* in[19]; float* out; unsigned char* ws; int ph_lo, ph_hi; };
typedef const __attribute__((address_space(4))) Args* KArgs;

__device__ __forceinline__ float wave_sum(float v) {
#pragma unroll
    for (int o = 1; o < 64; o <<= 1) v += __shfl_xor(v, o);
    return v;
}
struct WItem { const float* W; int N; bf16* WT; int ldo; int k0, n0, orow0; const float* gain; float nscale; };
constexpr int WI_C0 = 1152, WI_C1 = WI_C0 + 512, WI_C2 = WI_C1 + 2048, WI_C3 = WI_C2 + 2048, WI_C4 = WI_C3 + 2048, WI_C5 = WI_C4 + 2048, WI_C6 = WI_C5 + 3072, WI_C7 = WI_C6 + 1024;
constexpr int WI_EARLY = WI_C3;
__device__ __forceinline__ void witem_decode(KArgs a, unsigned char* ws, int gi, WItem& d) {
    int item, K, mode = 0; d.gain = nullptr; d.nscale = 1.0f;
    if (gi < WI_C0)      { item = gi;         d.W = a->in[2];  K = DM;  d.N = N_IN_E; d.WT = (bf16*)(ws + WS_W_IN_E); d.gain = a->in[1]; }
    else if (gi < WI_C1) { item = gi - WI_C0; d.W = a->in[9];  K = DM;  d.N = DM;     d.WT = (bf16*)(ws + WS_W_OUT_E); }
    else if (gi < WI_C2) { item = gi - WI_C1; d.W = a->in[17]; K = DM;  d.N = DFF;    d.WT = (bf16*)(ws + WS_W_MLP_IN); d.gain = a->in[16]; }
    else if (gi < WI_C3) { item = gi - WI_C2; d.W = a->in[18]; K = DFF; d.N = DM;     d.WT = (bf16*)(ws + WS_W_MLP_OUT); }
    else if (gi < WI_C4) { item = gi - WI_C3; d.W = a->in[17] + (size_t)DM * DFF; K = DM; d.N = DFF; d.WT = (bf16*)(ws + WS_W_MLP_IN) + (size_t)DFF * DM; d.gain = a->in[16] + DM; }
    else if (gi < WI_C5) { item = gi - WI_C4; d.W = a->in[18] + (size_t)DFF * DM; K = DFF; d.N = DM; d.WT = (bf16*)(ws + WS_W_MLP_OUT) + (size_t)DFF * DM; }
    else if (gi < WI_C6) { item = gi - WI_C5; d.W = a->in[11]; K = DM;  d.N = N_IN_O; d.WT = (bf16*)(ws + WS_W_IN_O); d.gain = a->in[10]; mode = 1; }
    else                 { item = gi - WI_C6; d.W = a->in[15]; K = 2048; d.N = DM;    d.WT = (bf16*)(ws + WS_W_OUT_O); }
    const int nblk = d.N / 32, kb = item / nblk, nb = item % nblk; d.k0 = 64 * kb; d.n0 = 32 * nb; d.orow0 = d.n0; d.ldo = K;
    if (mode == 1) {
        const int n0 = d.n0;
        if (n0 < 1024) { d.orow0 = (n0 >> 9) * 3072 + (n0 & 511); }
        else if (n0 < 2048) { const int nk = n0 - 1024; d.orow0 = (nk >> 9) * 3072 + 512 + (nk & 511); d.nscale = 0.08838834764831845f; }
        else if (n0 < 4096) { const int nv = n0 - 2048; d.orow0 = (nv >> 10) * 3072 + 1024 + (nv & 1023); }
        else { const int ng = n0 - 4096; d.orow0 = (ng >> 10) * 3072 + 2048 + (ng & 1023); }
    }
}
__device__ __forceinline__ void witem_load(const WItem& d, float (&v)[32], int lane) {
#pragma unroll
    for (int i = 0; i < 32; ++i) { const int kk = 2 * i + (lane >> 5); v[i] = d.W[(size_t)(d.k0 + kk) * d.N + d.n0 + (lane & 31)]; }
}
__device__ __forceinline__ void witem_finish(const WItem& d, const float (&v)[32], LAS float* scr, int lane) {
#pragma unroll
    for (int i = 0; i < 32; ++i) { const int kk = 2 * i + (lane >> 5); const float gsc = d.gain ? d.gain[d.k0 + kk] * d.nscale : d.nscale; scr[kk * 33 + (lane & 31)] = v[i] * gsc; }
    asm volatile("s_waitcnt lgkmcnt(0)" ::: "memory");
    const int c = lane & 7;
#pragma unroll
    for (int j = 0; j < 4; ++j) { const int n = (lane >> 3) + 8 * j; const LAS float* s = scr + (8 * c) * 33 + n;
        u32x4 o; o.x = pk2(s[0 * 33], s[1 * 33]); o.y = pk2(s[2 * 33], s[3 * 33]); o.z = pk2(s[4 * 33], s[5 * 33]); o.w = pk2(s[6 * 33], s[7 * 33]);
        *(u32x4*)(d.WT + (size_t)(d.orow0 + n) * d.ldo + d.k0 + 8 * c) = o; }
    asm volatile("s_waitcnt lgkmcnt(0)" ::: "memory");
}
__device__ __forceinline__ void convert_items(KArgs a, ldsp lds, int gbeg, int gend, int wv, int nw, int tid) {
    const int lane = tid & 63, wave = __builtin_amdgcn_readfirstlane(tid >> 6);
    unsigned char* ws = a->ws;
    LAS float* scr = (LAS float*)(lds + wave * 16384);
    WItem cur, nxt; float va[32], vb[32];
    int gi = gbeg + wv;
    if (gi < gend) { witem_decode(a, ws, gi, cur); witem_load(cur, va, lane); }
    while (gi < gend) {
        const int g1 = gi + nw, g2 = gi + 2 * nw;
        if (g1 < gend) { witem_decode(a, ws, g1, nxt); witem_load(nxt, vb, lane); }
        witem_finish(cur, va, scr, lane);
        if (g1 >= gend) break;
        if (g2 < gend) { witem_decode(a, ws, g2, cur); witem_load(cur, va, lane); }
        witem_finish(nxt, vb, scr, lane);
        gi = g2;
    }
}
__device__ __forceinline__ void prologue(KArgs a, ldsp lds, int vcu, int G, int tid) {
    const int lane = tid & 63, wave = __builtin_amdgcn_readfirstlane(tid >> 6);
    unsigned char* ws = a->ws;
    const int gw = vcu * 8 + wave, NGW = G * 8;
    convert_items(a, lds, 0, WI_EARLY, gw, NGW, tid);
    const float* x = a->in[0]; bf16* XB = (bf16*)(ws + WS_XB); float* ssq = (float*)(ws + WS_SSQ);
    for (int m = gw; m < M_TOK; m += 2 * NGW) {
        const int m2 = m + NGW;
        const f32x4* xr0 = (const f32x4*)(x + (size_t)m * DM) + lane; const f32x4* xr1 = (const f32x4*)(x + (size_t)m2 * DM) + lane;
        f32x4 v0[4], v1[4];
#pragma unroll
        for (int j = 0; j < 4; ++j) { v0[j] = xr0[64 * j]; v1[j] = xr1[64 * j]; }
        unsigned long long* o0 = (unsigned long long*)(XB + (size_t)m * DM) + lane; unsigned long long* o1 = (unsigned long long*)(XB + (size_t)m2 * DM) + lane;
        float s0 = 0.f, s1 = 0.f;
#pragma unroll
        for (int j = 0; j < 4; ++j) { s0 += (v0[j][0] * v0[j][0] + v0[j][1] * v0[j][1]) + (v0[j][2] * v0[j][2] + v0[j][3] * v0[j][3]);
            s1 += (v1[j][0] * v1[j][0] + v1[j][1] * v1[j][1]) + (v1[j][2] * v1[j][2] + v1[j][3] * v1[j][3]);
            o0[64 * j] = (unsigned long long)pk2(v0[j][0], v0[j][1]) | ((unsigned long long)pk2(v0[j][2], v0[j][3]) << 32);
            o1[64 * j] = (unsigned long long)pk2(v1[j][0], v1[j][1]) | ((unsigned long long)pk2(v1[j][2], v1[j][3]) << 32); }
        s0 = wave_sum(s0); s1 = wave_sum(s1);
        if (lane == 0) { *(f32x4*)(ssq + 4 * (size_t)m) = (f32x4){s0, 0.f, 0.f, 0.f}; *(f32x4*)(ssq + 4 * (size_t)m2) = (f32x4){s1, 0.f, 0.f, 0.f}; }
    }
    if (vcu == 0 && tid < 16) { const float d = (tid < 8 ? a->in[12] : a->in[13])[tid & 7]; const float e = __expf(-d);
        const float l1p = (e < 0.0625f) ? e * (1.0f - e * (0.5f - e * ((1.0f / 3.0f) - e * (0.25f - e * 0.2f)))) : __logf(1.0f + e);
        ((float*)(ws + WS_L2))[tid] = -l1p * LOG2E; }
}

#ifndef DBG_DUMP
#define DBG_DUMP 0
#endif
#ifndef GEMM_ALIGN
#define GEMM_ALIGN true
#endif
#ifndef REP_PH
#define REP_PH (-1)
#define REP_N 0
#endif
#ifndef REP_COND
#define REP_COND true
#endif
#ifndef DBG_STRIDE
#define DBG_STRIDE 1
#endif
#ifndef DBG_HI
#define DBG_HI PH_COUNT
#endif
#ifndef DBG_LO
#define DBG_LO 0
#endif
#ifndef DBG_AOFF
#define DBG_AOFF 2048
#endif
#ifndef DBG_LDA
#define DBG_LDA 3072
#endif
#ifndef DBG_LDB
#define DBG_LDB 2048
#endif
#ifndef DBG_K
#define DBG_K 1024
#endif
enum { PH_PRO = 0, PH_IN_E, PH_ATTN, PH_OUT_E, PH_MLP_IN0, PH_MLP_OUT0, PH_IN_O0, PH_RA0, PH_RB0, PH_RC0, PH_IN_O1, PH_RA1, PH_RB1, PH_RC1, PH_OUT_O, PH_MLP_IN1, PH_MLP_OUT1, PH_COUNT };

__global__ void __launch_bounds__(512, 2) mk_fwd(Args a_unused) {
    extern __shared__ __attribute__((aligned(16))) unsigned char lds_raw[];
    cg::grid_group grid = cg::this_grid();
    const ldsp lds = (ldsp)lds_raw;
    volatile LAS unsigned* MISC = (volatile LAS unsigned*)(lds + RING_BYTES);
    if (threadIdx.x < 32) MISC[threadIdx.x] = 0u;
    __syncthreads();
    const XcdBarrier bar = xcd_barrier_post((unsigned*)(((KArgs)__builtin_amdgcn_kernarg_segment_ptr())->ws + WS_CTL) + CW_BAR, MISC + 8);
    const int G = gridDim.x;
    int repcnt = 0;
    const int ph_lo = ((KArgs)__builtin_amdgcn_kernarg_segment_ptr())->ph_lo, ph_hi = ((KArgs)__builtin_amdgcn_kernarg_segment_ptr())->ph_hi;
    for (int ph = ph_lo; ph < ph_hi; ++ph) {
        const __attribute__((address_space(4))) char* kp = (const __attribute__((address_space(4))) char*)__builtin_amdgcn_kernarg_segment_ptr();
        asm volatile("" : "+s"(kp));
        KArgs a = (KArgs)kp;
        unsigned char* ws = a->ws;
        bf16* XB = (bf16*)(ws + WS_XB); float* ssq = (float*)(ws + WS_SSQ);
        bf16* BIG = (bf16*)(ws + WS_BIG);
        bf16* QKV = BIG; bf16* OE = BIG + (size_t)M_TOK * N_IN_E; bf16* HM = BIG; bf16* GB = BIG; bf16* ST = BIG + (size_t)M_TOK * 3072;
        int tid = threadIdx.x, bx = blockIdx.x;
        asm volatile("" : "+v"(tid)); asm volatile("" : "+s"(bx));
        const int vcu = (G % 8 == 0) ? (bx % 8) * (G / 8) + bx / 8 : bx;
        if (ph == PH_PRO) { prologue(a, lds, vcu, G, tid); }
        else if (ph == PH_ATTN) {
            att::AttnArgs A{QKV, OE, a->in[3], a->in[4], a->in[5], a->in[6], a->in[7], a->in[8]};
            att::attn_phase(lds, A, vcu, G, tid);
        }
        else if (ph == PH_RA0 || ph == PH_RA1 || ph == PH_RB0 || ph == PH_RB1 || ph == PH_RC0 || ph == PH_RC1) {
            ret::RetArgs R{GB, ST, (const float*)(ws + WS_L2), a->in[14], (ph >= PH_IN_O1) ? 1 : 0, (REP_N > 0 && ph == REP_PH && repcnt > 0) ? 1 : 0, (bf16*)a->out};
            if (ph == PH_RA0 || ph == PH_RA1) { ret::ret_a_phase(lds, R, vcu, G, tid); }
            else if (ph == PH_RB0 || ph == PH_RB1) { ret::ret_b(R, vcu, G, tid); }
            else { ret::ret_c_phase(lds, R, vcu, G, tid); }
        }
        else if (ph == PH_IN_E || ph == PH_MLP_IN0 || ph == PH_MLP_IN1 || ph == PH_IN_O0 || ph == PH_IN_O1) {
            const bf16* Bt; int N, act, silu0; bf16* O;
            if (ph == PH_IN_E)           { Bt = (const bf16*)(ws + WS_W_IN_E); N = N_IN_E; O = QKV; act = 0; silu0 = 1 << 30; }
            else if (ph == PH_MLP_IN0)   { Bt = (const bf16*)(ws + WS_W_MLP_IN); N = DFF; O = HM; act = 1; silu0 = 1 << 30; }
            else if (ph == PH_MLP_IN1)   { Bt = (const bf16*)(ws + WS_W_MLP_IN) + (size_t)DFF * DM; N = DFF; O = HM; act = 1; silu0 = 1 << 30; }
            else if (ph == PH_IN_O0)     { Bt = (const bf16*)(ws + WS_W_IN_O); N = 3072; O = GB; act = 2; silu0 = 8; }
            else                         { Bt = (const bf16*)(ws + WS_W_IN_O) + (size_t)3072 * DM; N = 3072; O = GB; act = 2; silu0 = 8; }
            pg8::Gemm g; g.A = XB; g.Bt = Bt; g.lda = DM; g.ldb = DM; g.M = M_TOK; g.N = N; g.K = DM;
            pg8::EpiBf16 E; E.O = O; E.ldc = N; E.ssq = ssq; E.silu_pn0 = silu0; E.act = act;
            pg8::StaticOrder S; S.init(M_TOK, N, G, bx);
            pg8::gemm_phase<pg8::EpiBf16, pg8::StaticOrder, GEMM_ALIGN, true>(lds, g, S, E, tid);
            if (ph == PH_IN_E && bx >= 64) convert_items(a, lds, WI_EARLY, WI_C7, (bx - 64) * 8 + __builtin_amdgcn_readfirstlane(tid >> 6), (G - 64) * 8, tid);
        }
        else {
            const bf16* A; const bf16* Bt; int lda, ldb, K; const float* basef; const bf16* baseb; float* outf; bf16* xb; float* sso;
            if (ph == PH_OUT_E)          { A = OE; lda = DM; K = DM; Bt = (const bf16*)(ws + WS_W_OUT_E); ldb = DM; basef = nullptr; baseb = XB; outf = nullptr; xb = XB; sso = ssq; }
            else if (ph == PH_MLP_OUT0)  { A = HM; lda = DFF; K = DFF; Bt = (const bf16*)(ws + WS_W_MLP_OUT); ldb = DFF; basef = nullptr; baseb = XB; outf = nullptr; xb = XB; sso = ssq; }
            else if (ph == PH_MLP_OUT1)  { A = HM; lda = DFF; K = DFF; Bt = (const bf16*)(ws + WS_W_MLP_OUT) + (size_t)DFF * DM; ldb = DFF; basef = nullptr; baseb = XB; outf = a->out; xb = nullptr; sso = nullptr; }
            else                         { A = (const bf16*)a->out; lda = 2048; K = 2048; Bt = (const bf16*)(ws + WS_W_OUT_O); ldb = 2048; basef = nullptr; baseb = XB; outf = nullptr; xb = XB; sso = ssq; }
            pg8::Gemm g; g.A = A; g.Bt = Bt; g.lda = lda; g.ldb = ldb; g.M = M_TOK; g.N = DM; g.K = K;
            pg8::EpiResid E; E.basef = basef; E.baseb = baseb; E.outf = outf; E.xb = xb; E.ssq_out = sso; E.ldc = DM;
            E.accscale = (REP_N > 0 && ph == REP_PH && repcnt > 0 && ph != PH_OUT_E && ph != PH_MLP_OUT1) ? 0.f : 1.f;
            pg8::StaticOrder S; S.init(M_TOK, DM, G, bx);
            pg8::gemm_phase<pg8::EpiResid, pg8::StaticOrder, false, true>(lds, g, S, E, tid);
        }
        if (ph + 1 == ph_hi && DBG_DUMP) {
            xcd_barrier(bar);
            const bf16* srcb = (DBG_DUMP == 1) ? GB : ST;
            for (size_t i = (size_t)bx * 512 + tid; i < (size_t)M_TOK * DM; i += (size_t)G * 512) a->out[i] = bf_lo((unsigned)srcb[i * DBG_STRIDE]);
        }
#ifdef NOP_REPS
        if (ph == NOP_AT) { for (int q = 0; q < NOP_REPS; ++q) xcd_barrier(bar); }
#endif
        if (ph + 1 < ph_hi) {
            if (ph_lo < 0) {
                asm volatile("s_waitcnt vmcnt(0)" ::: "memory");
                grid.sync();
                __builtin_amdgcn_fence(__ATOMIC_ACQUIRE, "agent");
                asm volatile("s_waitcnt vmcnt(0)" ::: "memory");
                __syncthreads();
            }
            xcd_barrier(bar);
        }
        if (REP_N > 0 && ph == REP_PH && repcnt < REP_N && REP_COND) { ++repcnt; --ph; }
    }
}

extern "C" void kernel_launch(void* const* d_in, const int* in_sizes, int n_in, void* d_out, int out_size, void* d_ws, size_t ws_size, hipStream_t stream) {
    static int grid = 0;
    if (grid == 0) {
        int dev = 0, cus = 0, per_cu = 0;
        (void)hipGetDevice(&dev);
        (void)hipDeviceGetAttribute(&cus, hipDeviceAttributeMultiprocessorCount, dev);
        (void)hipFuncSetAttribute((const void*)mk_fwd, hipFuncAttributeMaxDynamicSharedMemorySize, LDS_BYTES);
        (void)hipOccupancyMaxActiveBlocksPerMultiprocessor(&per_cu, (const void*)mk_fwd, 512, LDS_BYTES);
        grid = (n_in == 19 && per_cu >= 1 && cus == 256 && ws_size >= WS_END && out_size == M_TOK * DM) ? 256 : -1;
        if (grid < 0) fprintf(stderr, "kernel_launch: unsupported configuration (cus %d per_cu %d ws %zu n_in %d)\n", cus, per_cu, ws_size, n_in);
    }
    if (grid < 0) return;
    if (hipMemsetAsync((char*)d_ws + WS_CTL, 0, 65536, stream) != hipSuccess) { fprintf(stderr, "kernel_launch: memset failed\n"); return; }
    Args a{};
    for (int i = 0; i < 19; ++i) a.in[i] = (const float*)d_in[i];
    a.out = (float*)d_out; a.ws = (unsigned char*)d_ws; a.ph_lo = DBG_LO; a.ph_hi = DBG_HI;
    void* args[] = {&a};
#ifdef PLAIN_LAUNCH
    hipError_t e = hipLaunchKernel((void*)mk_fwd, dim3(grid), dim3(512), args, LDS_BYTES, stream);
#else
    hipError_t e = hipLaunchCooperativeKernel((void*)mk_fwd, dim3(grid), dim3(512), args, LDS_BYTES, stream);
#endif
    if (e != hipSuccess) fprintf(stderr, "cooperative launch failed: %s\n", hipGetErrorString(e));
}
```

```cpp
#include <hip/hip_runtime.h>
#include <hip/hip_cooperative_groups.h>
#include <cstdio>
#include <cstdint>
#include <cmath>
namespace cg = cooperative_groups;
#define REP_N 0
#define REP_PH (-1)
namespace pg8 {
#define PG8_LAS __attribute__((address_space(3)))
typedef unsigned short bf16_t;
typedef short bf16x8 __attribute__((ext_vector_type(8)));
typedef float f32x4 __attribute__((ext_vector_type(4)));
typedef float f32x2 __attribute__((ext_vector_type(2)));
typedef unsigned u32x4 __attribute__((ext_vector_type(4)));
typedef unsigned u32x2 __attribute__((ext_vector_type(2)));
constexpr int BM = 256, BK = 64, HALF = 128, HTB = HALF * BK * 2  , STAGE_BYTES = 8 * HTB, NXCD = 8, WGM = 8;

__host__ __device__ __forceinline__ int lds_byte(int r, int c) { const int st = (r >> 4) * 2 + (c >> 5), rr = r & 15, cc = c & 31, ob = rr * 64 + cc * 2; return st * 1024 + (ob ^ (((ob >> 9) & 1) << 5)); }
__host__ __device__ __forceinline__ void stage_rc(int b, int& R, int& C) { const int st = b / 1024, sb = b % 1024, swz = sb ^ (((sb >> 9) & 1) << 5); R = (st >> 1) * 16 + swz / 64; C = (st & 1) * 32 + (swz % 64) / 2; }
__host__ __device__ __forceinline__ int perm32(int rho) { const int n = rho >> 4, i = rho & 15; return 8 * (i >> 2) + 4 * n + (i & 3); }

struct Unit { int pm, pn; };
struct Gemm { const bf16_t* A; const bf16_t* Bt; int lda, ldb, M, N, K; };

struct StaticOrder {
    int nM, nN, nwg, G, c;
    __host__ __device__ void init(int M, int N, int G_, int c_) { nM = M / BM; nN = N / BM; nwg = nM * nN; G = G_; c = c_; }
    __host__ __device__ bool next(int i, Unit& u) const {
        const long L = (long)i * G + c; if (L >= nwg) return false;
        int wgid = (int)L; { const int q = nwg / NXCD, r = nwg % NXCD, xcd = wgid % NXCD, off = wgid / NXCD; wgid = (xcd < r ? xcd * (q + 1) : r * (q + 1) + (xcd - r) * q) + off; }
        const int nig = WGM * nN, gid = wgid / nig, fm = gid * WGM, gsz = (nM - fm) < WGM ? (nM - fm) : WGM;
        u.pm = fm + ((wgid % nig) % gsz); u.pn = (wgid % nig) / gsz; return true;
    }
};

typedef float f32x2_cv __attribute__((ext_vector_type(2))); typedef __bf16 bf16x2_cv __attribute__((ext_vector_type(2)));
__device__ __forceinline__ unsigned cvt_pk_bf16(float lo, float hi) { const f32x2_cv v = {lo, hi}; const bf16x2_cv b = __builtin_convertvector(v, bf16x2_cv); return __builtin_bit_cast(unsigned, b); }


__device__ __forceinline__ float row_rstd(const float* ssq, int row) { const f32x4 p = *(const f32x4*)(ssq + 4 * (size_t)row); return rsqrtf(((p[0] + p[1]) + (p[2] + p[3])) * (1.0f / 1024.0f) + 1e-6f); }

struct EpiBf16 {
    static constexpr bool PERM = true, AFTER_DRAIN = false;
    bf16_t* O; int ldc; const float* ssq; int silu_pn0; int act;
    __device__ __forceinline__ void preload(float (&rsv)[8], int pm, int wr, int fr) const {
        const int row0 = pm * BM + wr * 64 + fr;
#pragma unroll
        for (int ai = 0; ai < 2; ++ai)
#pragma unroll
            for (int m = 0; m < 4; ++m) rsv[ai * 4 + m] = row_rstd(ssq, row0 + ai * HALF + m * 16);
    }
    __device__ __forceinline__ void operator()(const f32x4 (&acc)[2][2][4][2], const Unit& u, int wr, int wc, int fr, int fq, float (&rsv)[8], int& rs_pm) const {
        if (rs_pm != u.pm) { preload(rsv, u.pm, wr, fr); rs_pm = u.pm; }
        const int row0 = u.pm * BM + wr * 64 + fr; const int col0 = u.pn * BM + wc * 32 + 8 * fq;
        const bool do_silu = (act == 2) && (u.pn >= silu_pn0);
#if 1
        const __amdgpu_buffer_rsrc_t rsrc = __builtin_amdgcn_make_buffer_rsrc((void*)O, 0, 0x7fffffff, 0x00020000);
#endif
#pragma unroll
        for (int ai = 0; ai < 2; ++ai)
#pragma unroll
            for (int m = 0; m < 4; ++m) { const int row = row0 + ai * HALF + m * 16; const float rs = rsv[ai * 4 + m]; bf16_t* rowp = O + (size_t)row * ldc + col0;
#pragma unroll
                for (int bj = 0; bj < 2; ++bj) { f32x4 v0 = acc[ai][bj][m][0] * rs, v1 = acc[ai][bj][m][1] * rs;
                    if (act == 1) {
#pragma unroll
                        for (int e = 0; e < 4; ++e) { const float a = fmaxf(v0[e], 0.f), b = fmaxf(v1[e], 0.f); v0[e] = a * a; v1[e] = b * b; } }
                    if (do_silu) {
#pragma unroll
                        for (int e = 0; e < 4; ++e) { v0[e] = v0[e] * __builtin_amdgcn_rcpf(1.0f + __builtin_amdgcn_exp2f(-1.4426950408889634f * v0[e])); v1[e] = v1[e] * __builtin_amdgcn_rcpf(1.0f + __builtin_amdgcn_exp2f(-1.4426950408889634f * v1[e])); } }
                    u32x4 w; w.x = cvt_pk_bf16(v0[0], v0[1]); w.y = cvt_pk_bf16(v0[2], v0[3]); w.z = cvt_pk_bf16(v1[0], v1[1]); w.w = cvt_pk_bf16(v1[2], v1[3]);
#if 1
                    __builtin_amdgcn_raw_buffer_store_b128(w, rsrc, (unsigned)(((size_t)row * ldc + col0 + bj * HALF) * 2), 0, 16);
#else
                    *(u32x4*)(rowp + bj * HALF) = w;
#endif
                    } }
    }
};

struct EpiResid {
    static constexpr bool PERM = true, AFTER_DRAIN = true;
    const float* basef; const bf16_t* baseb; float* outf; bf16_t* xb; float* ssq_out; int ldc; float accscale;
    __device__ __forceinline__ void fused(f32x4 (&acc)[2][2][4][2], const Unit& u, int wr, int wc, int fr, int fq, PG8_LAS unsigned char* lds, int wid, int lane) const {
        PG8_LAS float* P = (PG8_LAS float*)lds;
        const int col0 = u.pn * BM + wc * 32 + 8 * fq;
#pragma unroll
        for (int ai = 0; ai < 2; ++ai)
#pragma unroll
            for (int m = 0; m < 4; ++m) { const int r = ai * HALF + wr * 64 + m * 16 + fr; const size_t off = (size_t)(u.pm * BM + r) * ldc + col0; float s = 0.f;
#pragma unroll
                for (int bj = 0; bj < 2; ++bj) { const size_t o2 = off + bj * HALF; f32x4 b0, b1;
                    if (basef) { b0 = *(const f32x4*)(basef + o2); b1 = *(const f32x4*)(basef + o2 + 4); }
                    else { const u32x4 b = *(const u32x4*)(baseb + o2);
                        b0 = (f32x4){__uint_as_float(b.x << 16), __uint_as_float(b.x & 0xffff0000u), __uint_as_float(b.y << 16), __uint_as_float(b.y & 0xffff0000u)};
                        b1 = (f32x4){__uint_as_float(b.z << 16), __uint_as_float(b.z & 0xffff0000u), __uint_as_float(b.w << 16), __uint_as_float(b.w & 0xffff0000u)}; }
                    const f32x4 o0 = b0 + acc[ai][bj][m][0] * accscale, o1 = b1 + acc[ai][bj][m][1] * accscale;
                    if (outf) { *(f32x4*)(outf + o2) = o0; *(f32x4*)(outf + o2 + 4) = o1; }
                    if (xb) { u32x4 w; w.x = cvt_pk_bf16(o0[0], o0[1]); w.y = cvt_pk_bf16(o0[2], o0[3]); w.z = cvt_pk_bf16(o1[0], o1[1]); w.w = cvt_pk_bf16(o1[2], o1[3]); *(u32x4*)(xb + o2) = w; }
                    s += ((o0[0] * o0[0] + o0[1] * o0[1]) + (o0[2] * o0[2] + o0[3] * o0[3])) + ((o1[0] * o1[0] + o1[1] * o1[1]) + (o1[2] * o1[2] + o1[3] * o1[3])); }
                if (ssq_out) { s += __shfl_xor(s, 16); s += __shfl_xor(s, 32); if (fq == 0) P[r * 4 + wc] = s; }
                if (m & 1) asm volatile("" ::: "memory"); }
        if (ssq_out) {
            __syncthreads();
            const int t = wid * 64 + lane;
            if (t < 256) { const float s = (P[t * 4 + 0] + P[t * 4 + 1]) + (P[t * 4 + 2] + P[t * 4 + 3]); ssq_out[(size_t)(u.pm * BM + t) * 4 + u.pn] = s; }
            __syncthreads();
        }
    }
};

template <class Epi, class Sched, bool ALIGN_EPI = false, bool SP2 = false>
__device__ __forceinline__ void gemm_phase(PG8_LAS unsigned char* lds, const Gemm g, const Sched& S, const Epi& E, const int tid) {
    const int wid = __builtin_amdgcn_readfirstlane(tid >> 6), lane = tid & 63, wr = wid >> 2, wc = wid & 3, fr = lane & 15, fq = lane >> 4;
    const int K = g.K, nt = K / BK;
    unsigned voffA[2], voffB[2];
#pragma unroll
    for (int i = 0; i < 2; ++i) { int R, C; stage_rc(tid * 16 + i * 8192, R, C); const int Rb = Epi::PERM ? ((R & ~31) + perm32(R & 31)) : R;
        voffA[i] = (unsigned)(R * g.lda + C) * 2u; voffB[i] = (unsigned)(Rb * g.ldb + C) * 2u; }
    const size_t kstep = (size_t)(BK * 2);
    const size_t hstepA = (size_t)HALF * g.lda * 2, hstepB = (size_t)HALF * g.ldb * 2;
    const size_t tstepA = 2 * hstepA, tstepB = 2 * hstepB;
    const unsigned ldsw = (unsigned)wid * 1024u;
    const int aoff = lds_byte(wr * 64 + fr, fq * 8), boff = lds_byte(wc * 32 + fr, fq * 8);
#define PG8_SA(b, h) (((b) * 2 + (h)) * HTB)
#define PG8_SB(b, h) ((4 + (b) * 2 + (h)) * HTB)
#define PG8_STAGE(bufoff, gbase, voff) do { _Pragma("unroll") for (int _i = 0; _i < 2; ++_i) \
        __builtin_amdgcn_global_load_lds((const unsigned*)((const char*)(gbase) + (voff)[_i]), (PG8_LAS unsigned*)(lds + (bufoff) + ldsw + _i * 8192), 16, 0, 0); } while (0)
#define PG8_LDA(dst, b, h) do { _Pragma("unroll") for (int m = 0; m < 4; ++m) _Pragma("unroll") for (int k = 0; k < 2; ++k) dst[m][k] = *(const PG8_LAS bf16x8*)(lds + PG8_SA(b, h) + aoff + m * 2048 + k * 1024); } while (0)
#define PG8_LDB(dst, b, h) do { _Pragma("unroll") for (int n = 0; n < 2; ++n) _Pragma("unroll") for (int k = 0; k < 2; ++k) dst[n][k] = *(const PG8_LAS bf16x8*)(lds + PG8_SB(b, h) + boff + n * 2048 + k * 1024); } while (0)
#define PG8_MMA(ai, bj, At, Bt) do { __builtin_amdgcn_s_setprio(1); _Pragma("unroll") for (int m = 0; m < 4; ++m) _Pragma("unroll") for (int n = 0; n < 2; ++n) _Pragma("unroll") for (int k = 0; k < 2; ++k) \
        acc[ai][bj][m][n] = __builtin_amdgcn_mfma_f32_16x16x32_bf16(Bt[n][k], At[m][k], acc[ai][bj][m][n], 0, 0, 0); __builtin_amdgcn_s_setprio(0); } while (0)
#define PG8_WAIT_V(n) asm volatile("s_waitcnt vmcnt(" #n ")" ::: "memory")
#define PG8_WAIT_L(n) asm volatile("s_waitcnt lgkmcnt(" #n ")" ::: "memory")
#define PG8_BAR __builtin_amdgcn_s_barrier()
#define PG8_SCHED __builtin_amdgcn_sched_barrier(0)
    Unit cur, nxt; int ui = 0;
    if (!S.next(0, cur)) return;
    f32x4 acc[2][2][4][2];
#pragma unroll
    for (int a = 0; a < 2; ++a)
#pragma unroll
        for (int b = 0; b < 2; ++b)
#pragma unroll
            for (int m = 0; m < 4; ++m)
#pragma unroll
                for (int n = 0; n < 2; ++n) acc[a][b][m][n] = (f32x4){0.f, 0.f, 0.f, 0.f};
    bf16x8 At[4][2], B0[2][2], B1[2][2];
    const char* cA = (const char*)g.A + (size_t)cur.pm * tstepA; const char* cB = (const char*)g.Bt + (size_t)cur.pn * tstepB;
    float rsv[8]; int rs_pm = -1;
    if constexpr (!Epi::AFTER_DRAIN) { E.preload(rsv, cur.pm, wr, fr); rs_pm = cur.pm; }
    if constexpr (SP2) {
        PG8_STAGE(PG8_SB(0, 0), cB, voffB); PG8_STAGE(PG8_SB(0, 1), cB + hstepB, voffB); PG8_STAGE(PG8_SA(0, 0), cA, voffA); PG8_STAGE(PG8_SA(0, 1), cA + hstepA, voffA);
        if (wr == 1) PG8_BAR;
        PG8_WAIT_V(2); PG8_BAR;
        PG8_STAGE(PG8_SB(1, 0), cB + kstep, voffB); PG8_STAGE(PG8_SA(1, 0), cA + kstep, voffA); PG8_STAGE(PG8_SB(1, 1), cB + hstepB + kstep, voffB);
        PG8_WAIT_V(6); PG8_BAR;
    } else {
        PG8_STAGE(PG8_SB(0, 0), cB, voffB); PG8_STAGE(PG8_SA(0, 0), cA, voffA); PG8_STAGE(PG8_SB(0, 1), cB + hstepB, voffB); PG8_STAGE(PG8_SA(0, 1), cA + hstepA, voffA);
        if (wr == 1) PG8_BAR;
        PG8_WAIT_V(4); PG8_BAR;
        PG8_STAGE(PG8_SB(1, 0), cB + kstep, voffB); PG8_STAGE(PG8_SA(1, 0), cA + kstep, voffA); PG8_STAGE(PG8_SB(1, 1), cB + hstepB + kstep, voffB);
        PG8_WAIT_V(6); PG8_BAR;
    }
    for (;;) {
        const bool has_next = S.next(ui + 1, nxt);
        const char* nA = has_next ? (const char*)g.A + (size_t)nxt.pm * tstepA : cA; const char* nB = has_next ? (const char*)g.Bt + (size_t)nxt.pn * tstepB : cB;
        for (int t = 0; t < nt; t += 2) {
            const bool last = (t == nt - 2);
            const char* a1 = cA + (size_t)(t + 1) * kstep;
            const char* a2 = last ? nA : cA + (size_t)(t + 2) * kstep; const char* b2 = last ? nB : cB + (size_t)(t + 2) * kstep;
            const char* a3 = a2 + kstep; const char* b3 = b2 + kstep;
            if constexpr (SP2) {
            PG8_LDB(B0, 0, 0); PG8_LDB(B1, 0, 1); PG8_SCHED; PG8_LDA(At, 0, 0); PG8_STAGE(PG8_SA(1, 1), a1 + hstepA, voffA);
            PG8_WAIT_V(8); PG8_WAIT_L(0); PG8_BAR; PG8_MMA(0, 0, At, B0); PG8_MMA(0, 1, At, B1); PG8_BAR; PG8_SCHED;
            PG8_LDA(At, 0, 1); PG8_STAGE(PG8_SB(0, 0), b2, voffB); PG8_STAGE(PG8_SB(0, 1), b2 + hstepB, voffB); PG8_STAGE(PG8_SA(0, 0), a2, voffA);
            PG8_WAIT_V(8); PG8_WAIT_L(0); PG8_BAR; PG8_MMA(1, 0, At, B0); PG8_MMA(1, 1, At, B1); PG8_BAR; PG8_SCHED;
            PG8_LDB(B0, 1, 0); PG8_LDB(B1, 1, 1); PG8_SCHED; PG8_LDA(At, 1, 0); PG8_STAGE(PG8_SA(0, 1), a2 + hstepA, voffA);
            PG8_WAIT_V(8); PG8_WAIT_L(0); PG8_BAR; PG8_MMA(0, 0, At, B0); PG8_MMA(0, 1, At, B1); PG8_BAR; PG8_SCHED;
            PG8_LDA(At, 1, 1); PG8_STAGE(PG8_SB(1, 0), b3, voffB); PG8_STAGE(PG8_SB(1, 1), b3 + hstepB, voffB); PG8_STAGE(PG8_SA(1, 0), a3, voffA);
            PG8_WAIT_V(8); PG8_WAIT_L(0); PG8_BAR; PG8_MMA(1, 0, At, B0); PG8_MMA(1, 1, At, B1); PG8_BAR; PG8_SCHED;
            } else {
            PG8_LDB(B0, 0, 0); PG8_SCHED; PG8_LDA(At, 0, 0); PG8_STAGE(PG8_SA(1, 1), a1 + hstepA, voffA);
            PG8_WAIT_L(8); PG8_BAR; PG8_WAIT_L(0); PG8_MMA(0, 0, At, B0); PG8_BAR; PG8_SCHED;
            PG8_LDB(B1, 0, 1); PG8_STAGE(PG8_SB(0, 0), b2, voffB);
            PG8_BAR; PG8_WAIT_L(0); PG8_MMA(0, 1, At, B1); PG8_BAR;
            PG8_LDA(At, 0, 1); PG8_STAGE(PG8_SA(0, 0), a2, voffA);
            PG8_BAR; PG8_WAIT_L(0); PG8_MMA(1, 0, At, B0); PG8_BAR; PG8_SCHED;
            PG8_STAGE(PG8_SB(0, 1), b2 + hstepB, voffB);
            PG8_WAIT_V(6); PG8_BAR; PG8_MMA(1, 1, At, B1); PG8_BAR;
            PG8_LDB(B0, 1, 0); PG8_SCHED; PG8_LDA(At, 1, 0); PG8_STAGE(PG8_SA(0, 1), a2 + hstepA, voffA);
            PG8_WAIT_L(8); PG8_BAR; PG8_WAIT_L(0); PG8_MMA(0, 0, At, B0); PG8_BAR; PG8_SCHED;
            PG8_LDB(B1, 1, 1); PG8_STAGE(PG8_SB(1, 0), b3, voffB);
            PG8_BAR; PG8_WAIT_L(0); PG8_MMA(0, 1, At, B1); PG8_BAR;
            PG8_LDA(At, 1, 1); PG8_STAGE(PG8_SA(1, 0), a3, voffA);
            PG8_BAR; PG8_WAIT_L(0); PG8_MMA(1, 0, At, B0); PG8_BAR; PG8_SCHED;
            PG8_STAGE(PG8_SB(1, 1), b3 + hstepB, voffB);
            PG8_WAIT_V(6); PG8_BAR; PG8_MMA(1, 1, At, B1); PG8_BAR;
            }
        }
        if constexpr (ALIGN_EPI) { if (wr == 0) PG8_BAR; }
        if constexpr (!Epi::AFTER_DRAIN) { E(acc, cur, wr, wc, fr, fq, rsv, rs_pm); }
        if (!has_next) break;
#pragma unroll
        for (int a = 0; a < 2; ++a)
#pragma unroll
            for (int b = 0; b < 2; ++b)
#pragma unroll
                for (int m = 0; m < 4; ++m)
#pragma unroll
                    for (int n = 0; n < 2; ++n) acc[a][b][m][n] = (f32x4){0.f, 0.f, 0.f, 0.f};
        cur = nxt; cA = nA; cB = nB; ++ui;
        if constexpr (ALIGN_EPI) { if (wr == 1) PG8_BAR; }
    }
    PG8_WAIT_V(0);
    if constexpr (!ALIGN_EPI) { if (wr == 0) PG8_BAR; }
    PG8_BAR;
    if constexpr (Epi::AFTER_DRAIN) { E.fused(acc, cur, wr, wc, fr, fq, lds, wid, lane); }
#undef PG8_SA
#undef PG8_SB
#undef PG8_STAGE
#undef PG8_LDA
#undef PG8_LDB
#undef PG8_MMA
#undef PG8_WAIT_V
#undef PG8_WAIT_L
#undef PG8_BAR
#undef PG8_SCHED
}
}
#define LAS __attribute__((address_space(3)))
typedef unsigned short bf16;
typedef short bf16x8 __attribute__((ext_vector_type(8)));
typedef short s16x4 __attribute__((ext_vector_type(4)));
typedef float f32x4 __attribute__((ext_vector_type(4)));
typedef unsigned u32x4 __attribute__((ext_vector_type(4)));
typedef unsigned u32x2 __attribute__((ext_vector_type(2)));
typedef LAS unsigned char* ldsp;
constexpr float LOG2E = 1.4426950408889634f;

__device__ __forceinline__ float bf_lo(unsigned w) { return __uint_as_float(w << 16); }
__device__ __forceinline__ float bf_hi(unsigned w) { return __uint_as_float(w & 0xffff0000u); }
__device__ __forceinline__ unsigned pk2(float lo, float hi) { return pg8::cvt_pk_bf16(lo, hi); }
__device__ __forceinline__ s16x4 vtr(ldsp p) { typedef short v4i16_t __attribute__((ext_vector_type(4))); return __builtin_bit_cast(s16x4, __builtin_amdgcn_ds_read_tr16_b64_v4i16((LAS v4i16_t*)p)); }
__device__ __forceinline__ bf16x8 cat8(s16x4 lo, s16x4 hi) { return (bf16x8){lo[0], lo[1], lo[2], lo[3], hi[0], hi[1], hi[2], hi[3]}; }
__device__ __forceinline__ f32x4 mfma16(bf16x8 a, bf16x8 b, f32x4 c) { return __builtin_amdgcn_mfma_f32_16x16x32_bf16(a, b, c, 0, 0, 0); }
__device__ __forceinline__ float ex2(float x) { return __builtin_amdgcn_exp2f(x); }

namespace att {
constexpr int SEQ = 16384, LDQ = 2304, LDO = 1024;
constexpr int KPB = 160;
constexpr int COL_QA = 0, COL_KA = 512, COL_VA = 640, COL_QB = 768, COL_KB = 1280, COL_VB = 1792;

template <int NP>
__device__ __forceinline__ void load_rows(u32x4 (&v)[NP], const bf16* src, int tok0, int nvalid, int tid) {
    const int sub = tid & 7;
#pragma unroll
    for (int p = 0; p < NP; ++p) { const int r = (tid >> 3) + 64 * p, tok = tok0 + r; const bool ok = (tok >= 0) && (tok < SEQ) && (r < nvalid);
        v[p] = (u32x4){0u, 0u, 0u, 0u};
        if (ok) v[p] = *(const u32x4*)(src + (size_t)tok * LDQ + sub * 8); }
}
template <int NP, bool NORM>
__device__ __forceinline__ void store_rows(ldsp dst, const u32x4 (&v)[NP], int nrows, const float* gain, int tid) {
    const int sub = tid & 7;
    float gn[8];
    if (NORM) {
#pragma unroll
        for (int j = 0; j < 8; ++j) gn[j] = gain[sub * 8 + j];
    }
#pragma unroll
    for (int p = 0; p < NP; ++p) { const int r = (tid >> 3) + 64 * p;
        if (r < nrows) {
            u32x4 w = v[p];
            if (NORM) {
                float f[8]; f[0] = bf_lo(w.x); f[1] = bf_hi(w.x); f[2] = bf_lo(w.y); f[3] = bf_hi(w.y); f[4] = bf_lo(w.z); f[5] = bf_hi(w.z); f[6] = bf_lo(w.w); f[7] = bf_hi(w.w);
                float ss = 0.f;
#pragma unroll
                for (int j = 0; j < 8; ++j) ss += f[j] * f[j];
                ss += __shfl_xor(ss, 1); ss += __shfl_xor(ss, 2); ss += __shfl_xor(ss, 4);
                const float rs = rsqrtf(ss * (1.0f / 64.0f) + 1e-6f);
#pragma unroll
                for (int j = 0; j < 8; ++j) f[j] = f[j] * rs * gn[j];
                w.x = pk2(f[0], f[1]); w.y = pk2(f[2], f[3]); w.z = pk2(f[4], f[5]); w.w = pk2(f[6], f[7]);
            }
            *(LAS u32x4*)(dst + r * KPB + sub * 16) = w;
        } }
}

__device__ __forceinline__ void load_q_raw(u32x4 (&raw)[2], const bf16* qrow  , int g) {
#pragma unroll
    for (int s = 0; s < 2; ++s) raw[s] = *(const u32x4*)(qrow + 32 * s + 8 * g);
}
__device__ __forceinline__ void finish_q(bf16x8 (&qf)[2], const u32x4 (&raw)[2], const float* gain, int g) {
    float f[2][8]; float ss = 0.f;
#pragma unroll
    for (int s = 0; s < 2; ++s) { const u32x4 v = raw[s];
        f[s][0] = bf_lo(v.x); f[s][1] = bf_hi(v.x); f[s][2] = bf_lo(v.y); f[s][3] = bf_hi(v.y); f[s][4] = bf_lo(v.z); f[s][5] = bf_hi(v.z); f[s][6] = bf_lo(v.w); f[s][7] = bf_hi(v.w);
#pragma unroll
        for (int j = 0; j < 8; ++j) ss += f[s][j] * f[s][j]; }
    ss += __shfl_xor(ss, 16); ss += __shfl_xor(ss, 32);
    const float rs = rsqrtf(ss * (1.0f / 64.0f) + 1e-6f) * (0.125f * LOG2E);
#pragma unroll
    for (int s = 0; s < 2; ++s) { float o[8];
#pragma unroll
        for (int j = 0; j < 8; ++j) o[j] = f[s][j] * rs * gain[32 * s + 8 * g + j];
        u32x4 w; w.x = pk2(o[0], o[1]); w.y = pk2(o[2], o[3]); w.z = pk2(o[4], o[5]); w.w = pk2(o[6], o[7]);
        qf[s] = __builtin_bit_cast(bf16x8, w); }
}

template <int NT, class RB>
__device__ __forceinline__ void scores(f32x4 (&sc)[NT], ldsp Kb, const bf16x8 (&qf)[2], const RB& rb, int lane) {
    const int fr = lane & 15, g = lane >> 4;
#pragma unroll
    for (int t = 0; t < NT; ++t) { ldsp kp = Kb + (rb(t) + fr) * KPB + g * 16; f32x4 a = (f32x4){0.f, 0.f, 0.f, 0.f};
#pragma unroll
        for (int s = 0; s < 2; ++s) { const bf16x8 kf = *(const LAS bf16x8*)(kp + s * 64); a = mfma16(kf, qf[s], a); }
        sc[t] = a; if ((t & 3) == 3) __builtin_amdgcn_sched_barrier(0); }
}
template <int NT>
__device__ __forceinline__ float softmax_pack(f32x4 (&sc)[NT], bf16x8 (&pf)[NT / 2], float sink2, bool has_sink) {
    float m = -INFINITY;
#pragma unroll
    for (int t = 0; t < NT; ++t)
#pragma unroll
        for (int r = 0; r < 4; ++r) m = fmaxf(m, sc[t][r]);
    m = fmaxf(m, __shfl_xor(m, 16)); m = fmaxf(m, __shfl_xor(m, 32));
    if (has_sink) m = fmaxf(m, sink2);
    float sum = 0.f;
#pragma unroll
    for (int t = 0; t < NT; ++t)
#pragma unroll
        for (int r = 0; r < 4; ++r) { const float p = ex2(sc[t][r] - m); sc[t][r] = p; sum += p; }
    sum += __shfl_xor(sum, 16); sum += __shfl_xor(sum, 32);
    if (has_sink) sum += ex2(sink2 - m);
#pragma unroll
    for (int k = 0; k < NT / 2; ++k) { u32x4 w; w.x = pk2(sc[2 * k][0], sc[2 * k][1]); w.y = pk2(sc[2 * k][2], sc[2 * k][3]); w.z = pk2(sc[2 * k + 1][0], sc[2 * k + 1][1]); w.w = pk2(sc[2 * k + 1][2], sc[2 * k + 1][3]);
        pf[k] = __builtin_bit_cast(bf16x8, w); }
    return sum;
}
template <int NT, class RB>
__device__ __forceinline__ void pv_store(ldsp Vb, const bf16x8 (&pf)[NT / 2], const RB& rb, float sum, bf16* orow  , int lane) {
    const int g = lane >> 4, q4 = (lane & 15) >> 2, p4 = lane & 3;
    f32x4 o[4];
#pragma unroll
    for (int dt = 0; dt < 4; ++dt) o[dt] = (f32x4){0.f, 0.f, 0.f, 0.f};
#pragma unroll
    for (int k = 0; k < NT / 2; ++k) { ldsp v0 = Vb + (rb(2 * k) + 4 * g + q4) * KPB + p4 * 8; ldsp v1 = Vb + (rb(2 * k + 1) + 4 * g + q4) * KPB + p4 * 8;
#pragma unroll
        for (int dt = 0; dt < 4; ++dt) { const bf16x8 vf = cat8(vtr(v0 + dt * 32), vtr(v1 + dt * 32)); o[dt] = mfma16(vf, pf[k], o[dt]); } }
    const float inv = 1.0f / sum;
#pragma unroll
    for (int dt = 0; dt < 4; ++dt) { u32x2 w; w.x = pk2(o[dt][0] * inv, o[dt][1] * inv); w.y = pk2(o[dt][2] * inv, o[dt][3] * inv); *(u32x2*)(orow + dt * 16 + 4 * g) = w; }
}

struct RbWin { int mt; __device__ __forceinline__ int operator()(int t) const { return 16 * (mt + t); } };
struct RbNa { int off, ct0, ct1; __device__ __forceinline__ int operator()(int t) const { return (off + (t >> 1)) * 64 + ((t & 1) ? ct1 : ct0) * 16; } };

struct AttnArgs { const bf16* qkv; bf16* o; const float* qn_a; const float* kn_a; const float* sink_a; const float* qn_b; const float* kn_b; const float* rpb; };

__device__ __forceinline__ void window_tile(ldsp Kb, ldsp Vb, const AttnArgs& A, int n, int kvh, int idx, const u32x4 (&qraw)[2], int lane) {
    const int fr = lane & 15, g = lane >> 4;
    const int g4 = idx >> 3, mt = idx & 7, hq = kvh * 4 + g4;
    const int qtok = n * 128 + mt * 16 + fr;
    bf16x8 qf[2]; finish_q(qf, qraw, A.qn_a, g);
    RbWin rb{mt};
    f32x4 sc[18]; scores<18>(sc, Kb, qf, rb, lane);
    const float slope2 = exp2f(-(float)(hq + 1)) * LOG2E;
    {
        const float cl = (float)(4 * g - 128 - fr);
        const float lo = (float)max(-128, -qtok), hi = (float)min(128, SEQ - 1 - qtok);
#pragma unroll
        for (int t = 0; t < 18; ++t)
#pragma unroll
            for (int r = 0; r < 4; ++r) { const float rel = cl + (float)(16 * t + r); sc[t][r] = (rel >= lo && rel <= hi) ? fmaf(-slope2, fabsf(rel), sc[t][r]) : -INFINITY; }
    }
    bf16x8 pf[9]; const float sum = softmax_pack<18>(sc, pf, A.sink_a[hq] * LOG2E, true);
    pv_store<18>(Vb, pf, rb, sum, A.o + (size_t)qtok * LDO + hq * 64, lane);
}
__device__ __forceinline__ void window_compute(ldsp lds, const AttnArgs& A, int unit, int tid) {
    const int n = unit >> 1, kvh = unit & 1, lane = tid & 63, wid = __builtin_amdgcn_readfirstlane(tid >> 6);
    ldsp Kb = lds, Vb = lds + 400 * KPB;
    const int tok0 = (n - 1) * 128;
    const int fr = lane & 15, g = lane >> 4;
    u32x4 qa[2], qb[2];
    const bf16* qbase = A.qkv + (size_t)(n * 128 + fr) * LDQ + COL_QA + kvh * 256;
    auto qptr = [&](int it) { const int idx = wid * 4 + it; return qbase + (size_t)((idx & 7) * 16) * LDQ + (idx >> 3) * 64; };
    load_q_raw(qa, qptr(0), g);
    for (int it = 0; it < 4; it += 2) {
        load_q_raw(qb, qptr(it + 1), g);
        window_tile(Kb, Vb, A, n, kvh, wid * 4 + it, qa, lane);
        if (it + 2 < 4) load_q_raw(qa, qptr(it + 2), g);
        window_tile(Kb, Vb, A, n, kvh, wid * 4 + it + 1, qb, lane);
    }
}

constexpr int NA_ROWS = 704;
constexpr int NA_RPB_OFF = NA_ROWS * KPB;

__device__ __forceinline__ void na_unit(ldsp lds, const AttnArgs& A, int unit, int next_unit, u32x4 (&kreg)[11], int tid) {
    const int rq4 = unit >> 3, h = unit & 7, lane = tid & 63, wid = __builtin_amdgcn_readfirstlane(tid >> 6);
    const int r0 = 4 * rq4; const int base = min(max(r0 - 4, 0), 248);
    const int rq = r0 + (wid >> 1); const int rstart = min(max(rq - 4, 0), 248);
    const int fr = lane & 15, g = lane >> 4;
    store_rows<11, true>(lds, kreg, NA_ROWS, A.kn_b, tid);
    __syncthreads();
    const LAS float* rpl = (const LAS float*)(lds + NA_RPB_OFF);
    bf16x8 pf[2][8]; float sum[2]; int qtok[2]; int qcs[2]; u32x4 qraw[2][2];
#pragma unroll
    for (int it = 0; it < 2; ++it) { const int mt = 2 * (wid & 1) + it; qcs[it] = (mt < 3) ? 8 + 16 * mt + fr : (fr < 8 ? fr : 48 + fr); qtok[it] = rq * 64 + qcs[it];
        load_q_raw(qraw[it], A.qkv + (size_t)qtok[it] * LDQ + COL_QB + h * 64, g); }
#pragma unroll
    for (int it = 0; it < 2; ++it) {
        const int mt = 2 * (wid & 1) + it; const int qc = qcs[it];
        bf16x8 qf[2]; finish_q(qf, qraw[it], A.qn_b, g);
        RbNa rb{rstart - base, (mt < 3) ? mt : 0, (mt < 3) ? mt + 1 : 3};
        f32x4 sc[16]; scores<16>(sc, lds, qf, rb, lane);
        const int cstart = min(max(qc - 8, 0), 48);
        const int d0 = 4 * g - cstart;
        const LAS float* rpl0 = rpl + (rstart - rq + 7) * 128 + (4 * g - qc + 64);
#pragma unroll
        for (int t = 0; t < 16; ++t) { const int ct = (t & 1) ? rb.ct1 : rb.ct0; const LAS float* rp = rpl0 + (t >> 1) * 128 + 16 * ct; const int kb = 16 * ct + d0;
#pragma unroll
            for (int r = 0; r < 4; ++r) sc[t][r] = ((unsigned)(kb + r) < 16u) ? sc[t][r] + rp[r] : -INFINITY;
            if ((t & 3) == 3) __builtin_amdgcn_sched_barrier(0); }
        sum[it] = softmax_pack<16>(sc, pf[it], 0.f, false);
        __builtin_amdgcn_sched_barrier(0);
    }
    u32x4 vreg[11]; load_rows<11>(vreg, A.qkv + COL_VB + h * 64, base * 64, NA_ROWS, tid);
    __syncthreads();
    store_rows<11, false>(lds, vreg, NA_ROWS, nullptr, tid);
    if (next_unit >= 0) { const int nb = min(max(4 * (next_unit >> 3) - 4, 0), 248); load_rows<11>(kreg, A.qkv + COL_KB + h * 64, nb * 64, NA_ROWS, tid); }
    __syncthreads();
#pragma unroll
    for (int it = 0; it < 2; ++it) { const int mt = 2 * (wid & 1) + it; RbNa rb{rstart - base, (mt < 3) ? mt : 0, (mt < 3) ? mt + 1 : 3};
        pv_store<16>(lds, pf[it], rb, sum[it], A.o + (size_t)qtok[it] * LDO + 512 + h * 64, lane); __builtin_amdgcn_sched_barrier(0); }
    __syncthreads();
}

__device__ __forceinline__ void attn_phase(ldsp lds, const AttnArgs& A, int vcu, int G, int tid) {
    const int h = vcu & 7;
    u32x4 kreg[11];
#ifndef ATT_REP_WIN
#define ATT_REP_WIN 1
#define ATT_REP_NA 1
#endif
    for (int rw = 0; rw < ATT_REP_WIN; ++rw) {
        const int n = vcu >> 1, kvh = vcu & 1, tok0 = (n - 1) * 128;
        u32x4 kw[7], vw[7];
        load_rows<7>(kw, A.qkv + COL_KA + kvh * 64, tok0, 384, tid);
        load_rows<7>(vw, A.qkv + COL_VA + kvh * 64, tok0, 384, tid);
        store_rows<7, true>(lds, kw, 400, A.kn_a, tid);
        store_rows<7, false>(lds + 400 * KPB, vw, 400, nullptr, tid);
        __syncthreads();
        window_compute(lds, A, vcu, tid);
        __syncthreads();
    }
    for (int rn = 0; rn < ATT_REP_NA; ++rn) {
    { const int b0 = min(max(4 * (vcu >> 3) - 4, 0), 248); load_rows<11>(kreg, A.qkv + COL_KB + h * 64, b0 * 64, NA_ROWS, tid); }
    for (int i = tid; i < 15 * 128; i += 512) { const int ri = i >> 7, dc = i & 127; const int ci = min(max(dc - 49, 0), 30); ((LAS float*)(lds + NA_RPB_OFF))[i] = A.rpb[h * 465 + ri * 31 + ci] * LOG2E; }
    for (int k = 0; k < 2; ++k) { int t2 = tid; asm volatile("" : "+v"(t2));
        na_unit(lds, A, vcu + 256 * k, (k < 1) ? vcu + 256 * (k + 1) : -1, kreg, t2); }
    }
}
}
namespace ret {
constexpr int SEQ = 16384, LDG = 3072, NCH = 128;
constexpr int COL_Q = 0, COL_K = 512, COL_V = 1024, COL_G = 2048;
constexpr int KPB = 288;
constexpr int VPB = 544;
constexpr int UPB = 528;
constexpr int R0 = 0, R1 = 128 * KPB, R2 = 2 * 128 * KPB, RSTAT = R2 + 128 * VPB;
constexpr size_t ST_CHUNK = 128 * 256;

__device__ __forceinline__ unsigned pk2a(float lo, float hi) { unsigned r; asm volatile("v_cvt_pk_bf16_f32 %0, %1, %2" : "=v"(r) : "v"(lo), "v"(hi)); return r; }
struct RetArgs { bf16* G; bf16* ST; const float* l2;   const float* gn; int grp; int dry; bf16* Y; };

template <bool SCALE>
__device__ __forceinline__ void stage128(ldsp dst, const bf16* src, int ld, float a, float b, int tid) {
#pragma unroll
    for (int i = 0; i < 4; ++i) { const int idx = tid + i * 512, row = idx >> 4, ch = idx & 15;
        u32x4 v = *(const u32x4*)(src + (size_t)row * ld + ch * 8);
        if (SCALE) { const float s = ex2(a * (float)row + b);
            v.x = pk2a(bf_lo(v.x) * s, bf_hi(v.x) * s); v.y = pk2a(bf_lo(v.y) * s, bf_hi(v.y) * s); v.z = pk2a(bf_lo(v.z) * s, bf_hi(v.z) * s); v.w = pk2a(bf_lo(v.w) * s, bf_hi(v.w) * s); }
        *(LAS u32x4*)(dst + row * KPB + ch * 16) = v; }
}
__device__ __forceinline__ void stage256(ldsp dst, const bf16* src, int ld, int tid) {
#pragma unroll
    for (int i = 0; i < 8; ++i) { const int idx = tid + i * 512, row = idx >> 5, ch = idx & 31;
        const u32x4 v = *(const u32x4*)(src + (size_t)row * ld + ch * 8);
        *(LAS u32x4*)(dst + row * VPB + ch * 16) = v; }
}
__device__ __forceinline__ bf16x8 trfrag(ldsp X, int pitch, int k0, int n0, int lane) {
    const int g = lane >> 4, q4 = (lane & 15) >> 2, p4 = lane & 3;
    ldsp p = X + (k0 + 8 * g + q4) * pitch + (n0 + 4 * p4) * 2;
    return cat8(vtr(p), vtr(p + 4 * pitch));
}

__device__ __forceinline__ void ld128(u32x4 (&r)[4], const bf16* src, int ld, int tid) {
    const unsigned off0 = (unsigned)(((tid >> 4) * ld + (tid & 15) * 8) * 2);
#pragma unroll
    for (int i = 0; i < 4; ++i) r[i] = *(const u32x4*)((const char*)src + (size_t)i * 32 * ld * 2 + off0);
}
__device__ __forceinline__ void st128(ldsp dst, const u32x4 (&r)[4], int tid) {
    ldsp d0 = dst + (tid >> 4) * KPB + (tid & 15) * 16;
#pragma unroll
    for (int i = 0; i < 4; ++i) *(LAS u32x4*)(d0 + i * 32 * KPB) = r[i];
}
__device__ __forceinline__ void st128s(ldsp dst, const u32x4 (&r)[4], float a, float b, int tid) {
    ldsp d0 = dst + (tid >> 4) * KPB + (tid & 15) * 16;
#pragma unroll
    for (int i = 0; i < 4; ++i) { const int row = (tid >> 4) + 32 * i; const float s = ex2(a * (float)row + b); u32x4 v = r[i];
        v.x = pk2(bf_lo(v.x) * s, bf_hi(v.x) * s); v.y = pk2(bf_lo(v.y) * s, bf_hi(v.y) * s); v.z = pk2(bf_lo(v.z) * s, bf_hi(v.z) * s); v.w = pk2(bf_lo(v.w) * s, bf_hi(v.w) * s);
        *(LAS u32x4*)(d0 + i * 32 * KPB) = v; }
}
__device__ __forceinline__ void ld64(u32x4 (&r)[4], const bf16* src, int ld, int tid) {
    const unsigned off0 = (unsigned)(((tid >> 5) * ld + (tid & 31) * 8) * 2);
#pragma unroll
    for (int i = 0; i < 4; ++i) r[i] = *(const u32x4*)((const char*)src + (size_t)i * 16 * ld * 2 + off0);
}
__device__ __forceinline__ void st64(ldsp dst, const u32x4 (&r)[4], int tid) {
    ldsp d0 = dst + (tid >> 5) * VPB + (tid & 31) * 16;
#pragma unroll
    for (int i = 0; i < 4; ++i) *(LAS u32x4*)(d0 + i * 16 * VPB) = r[i];
}

__device__ __forceinline__ void ret_a_phase(ldsp lds, const RetArgs& A, int vcu, int G, int tid_in) {
    int tid = tid_in;
    const int wid = __builtin_amdgcn_readfirstlane(tid >> 6);
    int u = vcu; if (u >= 512) return;
    u32x4 rk[4], rv0[4], rv1[4];
    { const bf16* rows = A.G + (size_t)(u >> 2) * 128 * LDG; const int hl = u & 3;
      ld128(rk, rows + COL_K + hl * 128, LDG, tid); ld64(rv0, rows + COL_V + hl * 256, LDG, tid); ld64(rv1, rows + (size_t)64 * LDG + COL_V + hl * 256, LDG, tid); }
    for (;;) {
        asm volatile("" : "+v"(tid));
        const int lane = tid & 63, fr = lane & 15, g = lane >> 4;
        const int hl = u & 3, c = u >> 2, h = A.grp * 4 + hl;
        const float l2f = A.l2[h], l2b = A.l2[8 + h];
        st128s(lds + R0, rk, -l2f, 127.0f * l2f, tid);
        st128s(lds + R1, rk, l2b, 0.f, tid);
        st64(lds + R2, rv0, tid); st64(lds + R2 + 64 * VPB, rv1, tid);
        const int un = u + G; const bool has_next = un < 512;
        if (has_next) { const bf16* rows = A.G + (size_t)(un >> 2) * 128 * LDG; const int nhl = un & 3;
            ld128(rk, rows + COL_K + nhl * 128, LDG, tid); ld64(rv0, rows + COL_V + nhl * 256, LDG, tid); ld64(rv1, rows + (size_t)64 * LDG + COL_V + nhl * 256, LDG, tid); }
        __syncthreads();
        f32x4 acc[2][2][8];
#pragma unroll
        for (int dir = 0; dir < 2; ++dir) {
            ldsp Kx = lds + (dir ? R1 : R0);
#pragma unroll
            for (int et = 0; et < 2; ++et)
#pragma unroll
                for (int dt = 0; dt < 8; ++dt) acc[dir][et][dt] = (f32x4){0.f, 0.f, 0.f, 0.f};
#pragma unroll
            for (int ks = 0; ks < 4; ++ks) {
                bf16x8 vf[2];
#pragma unroll
                for (int et = 0; et < 2; ++et) vf[et] = trfrag(lds + R2, VPB, 32 * ks, 32 * wid + 16 * et, lane);
#pragma unroll
                for (int dt = 0; dt < 8; ++dt) { const bf16x8 kf = trfrag(Kx, KPB, 32 * ks, 16 * dt, lane);
#pragma unroll
                    for (int et = 0; et < 2; ++et) acc[dir][et][dt] = mfma16(vf[et], kf, acc[dir][et][dt]);
                    if ((dt & 3) == 3) __builtin_amdgcn_sched_barrier(0); }
            }
        }
        __syncthreads();
#pragma unroll
        for (int dir = 0; dir < 2; ++dir)
#pragma unroll
            for (int et = 0; et < 2; ++et)
#pragma unroll
                for (int dt = 0; dt < 8; ++dt) { u32x2 w; w.x = pk2(acc[dir][et][dt][0], acc[dir][et][dt][1]); w.y = pk2(acc[dir][et][dt][2], acc[dir][et][dt][3]);
                    *(LAS u32x2*)(lds + dir * (128 * UPB) + (16 * dt + fr) * UPB + (32 * wid + 16 * et + 4 * g) * 2) = w; }
        __syncthreads();
#pragma unroll
        for (int dir = 0; dir < 2; ++dir) { char* st = (char*)(A.ST + ((size_t)((dir * 4 + hl) * NCH + c)) * ST_CHUNK); const unsigned soff = (unsigned)((tid >> 5) * 512 + (tid & 31) * 16);
            ldsp s0 = lds + dir * (128 * UPB) + (tid >> 5) * UPB + (tid & 31) * 16;
#pragma unroll
            for (int i = 0; i < 8; ++i) *(u32x4*)(st + (size_t)i * 16 * 512 + soff) = *(const LAS u32x4*)(s0 + i * 16 * UPB); }
        __syncthreads();
        if (!has_next) break;
        u = un;
    }
}

__device__ __forceinline__ void ret_b(const RetArgs& A, int vcu, int G, int tid) {
    const int NT = 8 * 16384;
    for (int T = vcu * 512 + tid; T < NT; T += G * 512) {
        const int dh = T >> 14, w = T & 16383, dir = dh >> 2, hl = dh & 3, h = A.grp * 4 + hl;
        const float dec = ex2(128.0f * A.l2[dir * 8 + h]);
        unsigned* p = (unsigned*)(A.ST + (size_t)dh * NCH * ST_CHUNK) + w;
        const ptrdiff_t cs = dir ? -(ptrdiff_t)(ST_CHUNK / 2) : (ptrdiff_t)(ST_CHUNK / 2);
        if (dir) p += (size_t)(NCH - 1) * (ST_CHUNK / 2);
        float s0 = 0.f, s1 = 0.f;
        for (int c = 0; c < NCH; c += 32) {
            unsigned u[32];
#pragma unroll
            for (int k = 0; k < 32; ++k) u[k] = p[(ptrdiff_t)k * cs];
#pragma unroll
            for (int k = 0; k < 32; ++k) { p[(ptrdiff_t)k * cs] = A.dry ? u[k] : pk2(s0, s1); s0 = dec * s0 + bf_lo(u[k]); s1 = dec * s1 + bf_hi(u[k]); }
            p += 32 * cs;
        }
    }
}

constexpr int C_Q = 0, C_KA = 128 * KPB, C_B0 = 2 * 128 * KPB, C_B1 = C_B0 + 64 * VPB, C_STAT = C_B1 + 64 * VPB;
struct CPtrs { const bf16 *q, *k, *v, *sf, *sb; bf16* g; };
__device__ __forceinline__ CPtrs cptrs(const RetArgs& A, int unit) {
    const int hl = unit & 3, c = unit >> 2; bf16* rows = A.G + (size_t)c * 128 * LDG; CPtrs P;
    P.q = rows + COL_Q + hl * 128; P.k = rows + COL_K + hl * 128; P.v = rows + COL_V + hl * 256; P.g = rows + COL_G + hl * 256;
    P.sf = A.ST + ((size_t)((0 * 4 + hl) * NCH + c)) * ST_CHUNK; P.sb = A.ST + ((size_t)((1 * 4 + hl) * NCH + c)) * ST_CHUNK; return P;
}
__device__ __forceinline__ void half_mma(f32x4 (&acc)[2][8], ldsp buf, ldsp Bop, int kofs, int wid, int lane) {
    const int fr = lane & 15, g = lane >> 4;
#pragma unroll
    for (int ks = 0; ks < 2; ++ks) {
        bf16x8 xf[2];
#pragma unroll
        for (int et = 0; et < 2; ++et) xf[et] = trfrag(buf, VPB, 32 * ks, 32 * wid + 16 * et, lane);
#pragma unroll
        for (int it = 0; it < 8; ++it) { const bf16x8 bfrag = *(const LAS bf16x8*)(Bop + (16 * it + fr) * KPB + (kofs + 32 * ks + 8 * g) * 2);
#pragma unroll
            for (int et = 0; et < 2; ++et) acc[et][it] = mfma16(xf[et], bfrag, acc[et][it]);
            if ((it & 3) == 3) __builtin_amdgcn_sched_barrier(0); }
    }
}
__device__ __forceinline__ void ret_c_phase(ldsp lds, const RetArgs& A, int vcu, int G, int tid_in) {
    int tid = tid_in;
    const int wid = __builtin_amdgcn_readfirstlane(tid >> 6);
    int u = vcu; if (u >= 512) return;
    CPtrs P = cptrs(A, u);
    u32x4 r0[4], r1[4], r2[4], r3[4];
    ld128(r0, P.q, LDG, tid); ld128(r1, P.k, LDG, tid); ld64(r2, P.sf, 256, tid); ld64(r3, P.sf + 64 * 256, 256, tid);
    LAS float* stat = (LAS float*)(lds + C_STAT);
    for (;;) {
        asm volatile("" : "+v"(tid));
        const int lane = tid & 63, fr = lane & 15, g = lane >> 4;
        const int un = u + G; const bool has_next = un < 512;
        CPtrs N = P; if (has_next) N = cptrs(A, un);
        const int hl = u & 3, c = u >> 2, h = A.grp * 4 + hl;
        const float l2f = A.l2[h], l2b = A.l2[8 + h];
        st128(lds + C_Q, r0, tid); st128(lds + C_KA, r1, tid);
        ld64(r0, P.sb, 256, tid); ld64(r1, P.sb + 64 * 256, 256, tid);
        __syncthreads();
        f32x4 sa[8];
#pragma unroll
        for (int it = 0; it < 8; ++it) sa[it] = (f32x4){0.f, 0.f, 0.f, 0.f};
#pragma unroll
        for (int ks = 0; ks < 4; ++ks) { const bf16x8 kf = *(const LAS bf16x8*)(lds + C_KA + (16 * wid + fr) * KPB + (32 * ks + 8 * g) * 2);
#pragma unroll
            for (int it = 0; it < 8; ++it) { const bf16x8 qf = *(const LAS bf16x8*)(lds + C_Q + (16 * it + fr) * KPB + (32 * ks + 8 * g) * 2); sa[it] = mfma16(kf, qf, sa[it]); if ((it & 3) == 3) __builtin_amdgcn_sched_barrier(0); } }
        st64(lds + C_B0, r2, tid); ld64(r2, P.v, LDG, tid);
        __syncthreads();
#pragma unroll
        for (int it = 0; it < 8; ++it) { const int i = 16 * it + fr; float v[4];
#pragma unroll
            for (int r = 0; r < 4; ++r) { const int j = 16 * wid + 4 * g + r; const int dl = i - j; const float dm = dl >= 0 ? ex2((float)dl * l2f) : ex2((float)(-dl) * l2b); v[r] = sa[it][r] * dm; }
            u32x2 w; w.x = pk2(v[0], v[1]); w.y = pk2(v[2], v[3]);
            *(LAS u32x2*)(lds + C_KA + i * KPB + (16 * wid + 4 * g) * 2) = w; if (it & 1) __builtin_amdgcn_sched_barrier(0); }
        st64(lds + C_B1, r3, tid); ld64(r3, P.v + (size_t)64 * LDG, LDG, tid);
        f32x4 acc[2][8];
#pragma unroll
        for (int et = 0; et < 2; ++et)
#pragma unroll
            for (int it = 0; it < 8; ++it) acc[et][it] = (f32x4){0.f, 0.f, 0.f, 0.f};
        half_mma(acc, lds + C_B0, lds + C_Q, 0, wid, lane);
        __syncthreads();
        st64(lds + C_B0, r0, tid); if (has_next) ld128(r0, N.q, LDG, tid);
        half_mma(acc, lds + C_B1, lds + C_Q, 64, wid, lane);
        __syncthreads();
#pragma unroll
        for (int it = 0; it < 8; ++it) { const float fi = (float)(16 * it + fr); const float rt = ex2((fi + 1.0f) * l2f - (128.0f - fi) * l2b); acc[0][it] *= rt; acc[1][it] *= rt; }
        st64(lds + C_B1, r1, tid); if (has_next) ld128(r1, N.k, LDG, tid);
        half_mma(acc, lds + C_B0, lds + C_Q, 0, wid, lane);
        __syncthreads();
        st64(lds + C_B0, r2, tid); if (has_next) ld64(r2, N.sf, 256, tid);
        half_mma(acc, lds + C_B1, lds + C_Q, 64, wid, lane);
        __syncthreads();
#pragma unroll
        for (int it = 0; it < 8; ++it) { const float fi = (float)(16 * it + fr); const float sb = ex2((128.0f - fi) * l2b); acc[0][it] *= sb; acc[1][it] *= sb; }
        st64(lds + C_B1, r3, tid); if (has_next) ld64(r3, N.sf + 64 * 256, 256, tid);
        u32x2 gv[8][2]; f32x4 gw[2]; const unsigned goff = (unsigned)((fr * LDG + 32 * wid + 4 * g) * 2);
#pragma unroll
        for (int et = 0; et < 2; ++et) { const int e = 32 * wid + 16 * et + 4 * g; gw[et] = *(const f32x4*)(A.gn + h * 256 + e);
#pragma unroll
            for (int it = 0; it < 8; ++it) gv[it][et] = *(const u32x2*)((const char*)P.g + (size_t)(16 * it * LDG + 16 * et) * 2 + goff); }
        half_mma(acc, lds + C_B0, lds + C_KA, 0, wid, lane);
        __syncthreads();
        half_mma(acc, lds + C_B1, lds + C_KA, 64, wid, lane);
#pragma unroll
        for (int it = 0; it < 8; ++it) { float s1 = 0.f, s2 = 0.f;
#pragma unroll
            for (int et = 0; et < 2; ++et)
#pragma unroll
                for (int r = 0; r < 4; ++r) { const float y = acc[et][it][r]; s1 += y; s2 += y * y; }
            s1 += __shfl_xor(s1, 16); s1 += __shfl_xor(s1, 32); s2 += __shfl_xor(s2, 16); s2 += __shfl_xor(s2, 32);
            if (g == 0) { stat[((16 * it + fr) * 8 + wid) * 2] = s1; stat[((16 * it + fr) * 8 + wid) * 2 + 1] = s2; }
            if (it & 1) __builtin_amdgcn_sched_barrier(0); }
        __syncthreads();
#pragma unroll
        for (int it = 0; it < 8; ++it) { float s1 = 0.f, s2 = 0.f;
#pragma unroll
            for (int w = 0; w < 8; ++w) { s1 += stat[((16 * it + fr) * 8 + w) * 2]; s2 += stat[((16 * it + fr) * 8 + w) * 2 + 1]; }
            const float mu = s1 * (1.0f / 256.0f); const float var = fmaxf(s2 * (1.0f / 256.0f) - mu * mu, 0.f); const float rs = rsqrtf(var + 1e-5f);
#pragma unroll
            for (int et = 0; et < 2; ++et) { const int e = 32 * wid + 16 * et + 4 * g; const f32x4 y = acc[et][it]; const u32x2 gg = gv[it][et];
                u32x2 w; w.x = pk2(bf_lo(gg.x) * ((y[0] - mu) * rs * gw[et][0]), bf_hi(gg.x) * ((y[1] - mu) * rs * gw[et][1]));
                w.y = pk2(bf_lo(gg.y) * ((y[2] - mu) * rs * gw[et][2]), bf_hi(gg.y) * ((y[3] - mu) * rs * gw[et][3]));
                *(LAS u32x2*)(lds + C_B0 + (16 * it + fr) * UPB + e * 2) = w; }
            __builtin_amdgcn_sched_barrier(0); }
        __syncthreads();
        { char* yb = (char*)(A.Y + (size_t)c * 128 * 2048 + h * 256); const unsigned yoff = (unsigned)((tid >> 5) * 4096 + (tid & 31) * 16);
          ldsp s0 = lds + C_B0 + (tid >> 5) * UPB + (tid & 31) * 16;
#pragma unroll
          for (int i = 0; i < 8; ++i) *(u32x4*)(yb + (size_t)i * 16 * 4096 + yoff) = *(const LAS u32x4*)(s0 + i * 16 * UPB); }
        if (!has_next) break;
        u = un; P = N;
    }
    __syncthreads();
}
}
#define XB_TMO      128
#define XB_XCNT(j)  (256  + 64 * (j))
#define XB_XSUB(j)  (1280 + 64 * (j))
#define XB_XGEN(j)  (2304 + 64 * (j))
#define XB_TOP      3328
#define XB_TOPGEN   3392
#define XCD_BAR_WORDS 3456
#define XB_SPIN_CAP (1u << 18)

__device__ __forceinline__ unsigned xb_ld(unsigned* p)              { return __hip_atomic_load(p, __ATOMIC_RELAXED, __HIP_MEMORY_SCOPE_AGENT); }
__device__ __forceinline__ unsigned xb_add(unsigned* p, unsigned v) { return __hip_atomic_fetch_add(p, v, __ATOMIC_RELAXED, __HIP_MEMORY_SCOPE_AGENT); }
__device__ __forceinline__ unsigned xb_xcc_id() { return (unsigned)__builtin_amdgcn_s_getreg((3 << 11) | 20) & 0xFu; }
#define XB_SPIN(cond, bar) do { unsigned _sp = 0; while (cond) { __builtin_amdgcn_s_sleep(1); \
    if ((++_sp & 255u) == 0u) { if (xb_ld(&(bar)[XB_TMO])) break; if (_sp > XB_SPIN_CAP) { atomicAdd(&(bar)[XB_TMO], 1u); break; } } } } while (0)

struct XcdBarrier {
    unsigned* bar; unsigned x;
    volatile LAS unsigned* st;
};

__device__ __forceinline__ XcdBarrier xcd_barrier_post(unsigned* bar, volatile LAS unsigned* st) {
    XcdBarrier b; b.bar = bar; b.x = xb_xcc_id(); b.st = st;
    if (threadIdx.x == 0) (void)xb_add(&bar[XB_XCNT(b.x)], 1u);
    return b;
}
__device__ __forceinline__ void xcd_barrier_complete(unsigned* bar, unsigned x, unsigned& nloc, unsigned& nx) {
    const unsigned G = gridDim.x * gridDim.y * gridDim.z;
    unsigned sum, cnt, mine, sp = 0u;
    for (;;) {
        sum = 0u; cnt = 0u; mine = 0u;
#pragma unroll
        for (unsigned j = 0; j < 16; ++j) { const unsigned c = xb_ld(&bar[XB_XCNT(j)]); sum += c; cnt += (c > 0u) ? 1u : 0u; mine = (j == x) ? c : mine; }
        if (sum == G) break;
        __builtin_amdgcn_s_sleep(1);
        if ((++sp & 255u) == 0u) { if (xb_ld(&bar[XB_TMO])) break; if (sp > XB_SPIN_CAP) { atomicAdd(&bar[XB_TMO], 1u); break; } }
    }
    nloc = mine > 0u ? mine : 1u; nx = cnt > 0u ? cnt : 1u;
}

__device__ __forceinline__ void xcd_barrier(const XcdBarrier& b) {
    asm volatile("s_waitcnt vmcnt(0)" ::: "memory");
    __syncthreads();
    if (threadIdx.x == 0) {
        unsigned* bar = b.bar;
        __builtin_amdgcn_s_waitcnt(0);
        unsigned nloc = b.st[0], nx = b.st[1];
        if (nloc == 0u) { xcd_barrier_complete(bar, b.x, nloc, nx); b.st[0] = nloc; b.st[1] = nx; }
        const unsigned old = xb_add(&bar[XB_XSUB(b.x)], 1u);
        const unsigned gen = old / nloc;
        if (old + 1u == (gen + 1u) * nloc) {
            __builtin_amdgcn_fence(__ATOMIC_RELEASE, "agent");
            asm volatile("s_waitcnt vmcnt(0)" ::: "memory");
            const unsigned og = xb_add(&bar[XB_TOP], 1u);
            const unsigned tg = og / nx;
            if (og + 1u == (tg + 1u) * nx) xb_add(&bar[XB_TOPGEN], 1u);
            else XB_SPIN(xb_ld(&bar[XB_TOPGEN]) == tg, bar);
            __builtin_amdgcn_fence(__ATOMIC_ACQUIRE, "agent");
            xb_add(&bar[XB_XGEN(b.x)], 1u);
            asm volatile("s_waitcnt vmcnt(0)" ::: "memory");
        } else {
            XB_SPIN(xb_ld(&bar[XB_XGEN(b.x)]) == gen, bar);
            __builtin_amdgcn_fence(__ATOMIC_ACQUIRE, "agent");
            asm volatile("s_waitcnt vmcnt(0)" ::: "memory");
        }
    }
    __syncthreads();
}
constexpr int M_TOK = 16384, DM = 1024, DFF = 4096, N_IN_E = 2304, N_IN_O = 6144;
constexpr size_t MiB = 1u << 20;
constexpr size_t WS_CTL = 0;
constexpr size_t WS_L2 = 4096, WS_SSQ = 512 * 1024;
constexpr int CW_BAR = 4096;
constexpr size_t WS_W_IN_E = 1 * MiB;
constexpr size_t WS_W_OUT_E = WS_W_IN_E + (size_t)N_IN_E * DM * 2;
constexpr size_t WS_W_MLP_IN = WS_W_OUT_E + (size_t)DM * DM * 2;
constexpr size_t WS_W_MLP_OUT = WS_W_MLP_IN + 2 * (size_t)DFF * DM * 2;
constexpr size_t WS_W_IN_O = WS_W_MLP_OUT + 2 * (size_t)DFF * DM * 2;
constexpr size_t WS_W_OUT_O = WS_W_IN_O + (size_t)N_IN_O * DM * 2;
constexpr size_t WS_XB = 56 * MiB;
constexpr size_t WS_BIG = 88 * MiB;
constexpr size_t WS_END = 256 * MiB;
static_assert(WS_W_OUT_O + (size_t)DM * 2048 * 2 <= WS_XB, "weights fit below XB");

constexpr int RING_BYTES = 155648;
constexpr int LDS_BYTES = 159744;

struct Args { const float* in[19]; float* out; unsigned char* ws; int ph_lo, ph_hi; };
typedef const __attribute__((address_space(4))) Args* KArgs;

__device__ __forceinline__ float wave_sum(float v) {
#pragma unroll
    for (int o = 1; o < 64; o <<= 1) v += __shfl_xor(v, o);
    return v;
}
struct WItem { const float* W; int N; bf16* WT; int ldo; int k0, n0, orow0; const float* gain; float nscale; };
constexpr int WI_C0 = 1152, WI_C1 = WI_C0 + 512, WI_C2 = WI_C1 + 2048, WI_C3 = WI_C2 + 2048, WI_C4 = WI_C3 + 2048, WI_C5 = WI_C4 + 2048, WI_C6 = WI_C5 + 3072, WI_C7 = WI_C6 + 1024;
constexpr int WI_EARLY = WI_C3;
__device__ __forceinline__ void witem_decode(KArgs a, unsigned char* ws, int gi, WItem& d) {
    int item, K, mode = 0; d.gain = nullptr; d.nscale = 1.0f;
    if (gi < WI_C0)      { item = gi;         d.W = a->in[2];  K = DM;  d.N = N_IN_E; d.WT = (bf16*)(ws + WS_W_IN_E); d.gain = a->in[1]; }
    else if (gi < WI_C1) { item = gi - WI_C0; d.W = a->in[9];  K = DM;  d.N = DM;     d.WT = (bf16*)(ws + WS_W_OUT_E); }
    else if (gi < WI_C2) { item = gi - WI_C1; d.W = a->in[17]; K = DM;  d.N = DFF;    d.WT = (bf16*)(ws + WS_W_MLP_IN); d.gain = a->in[16]; }
    else if (gi < WI_C3) { item = gi - WI_C2; d.W = a->in[18]; K = DFF; d.N = DM;     d.WT = (bf16*)(ws + WS_W_MLP_OUT); }
    else if (gi < WI_C4) { item = gi - WI_C3; d.W = a->in[17] + (size_t)DM * DFF; K = DM; d.N = DFF; d.WT = (bf16*)(ws + WS_W_MLP_IN) + (size_t)DFF * DM; d.gain = a->in[16] + DM; }
    else if (gi < WI_C5) { item = gi - WI_C4; d.W = a->in[18] + (size_t)DFF * DM; K = DFF; d.N = DM; d.WT = (bf16*)(ws + WS_W_MLP_OUT) + (size_t)DFF * DM; }
    else if (gi < WI_C6) { item = gi - WI_C5; d.W = a->in[11]; K = DM;  d.N = N_IN_O; d.WT = (bf16*)(ws + WS_W_IN_O); d.gain = a->in[10]; mode = 1; }
    else                 { item = gi - WI_C6; d.W = a->in[15]; K = 2048; d.N = DM;    d.WT = (bf16*)(ws + WS_W_OUT_O); }
    const int nblk = d.N / 32, kb = item / nblk, nb = item % nblk; d.k0 = 64 * kb; d.n0 = 32 * nb; d.orow0 = d.n0; d.ldo = K;
    if (mode == 1) {
        const int n0 = d.n0;
        if (n0 < 1024) { d.orow0 = (n0 >> 9) * 3072 + (n0 & 511); }
        else if (n0 < 2048) { const int nk = n0 - 1024; d.orow0 = (nk >> 9) * 3072 + 512 + (nk & 511); d.nscale = 0.08838834764831845f; }
        else if (n0 < 4096) { const int nv = n0 - 2048; d.orow0 = (nv >> 10) * 3072 + 1024 + (nv & 1023); }
        else { const int ng = n0 - 4096; d.orow0 = (ng >> 10) * 3072 + 2048 + (ng & 1023); }
    }
}
__device__ __forceinline__ void witem_load(const WItem& d, float (&v)[32], int lane) {
#pragma unroll
    for (int i = 0; i < 32; ++i) { const int kk = 2 * i + (lane >> 5); v[i] = d.W[(size_t)(d.k0 + kk) * d.N + d.n0 + (lane & 31)]; }
}
__device__ __forceinline__ void witem_finish(const WItem& d, const float (&v)[32], LAS float* scr, int lane) {
#pragma unroll
    for (int i = 0; i < 32; ++i) { const int kk = 2 * i + (lane >> 5); const float gsc = d.gain ? d.gain[d.k0 + kk] * d.nscale : d.nscale; scr[kk * 33 + (lane & 31)] = v[i] * gsc; }
    asm volatile("s_waitcnt lgkmcnt(0)" ::: "memory");
    const int c = lane & 7;
#pragma unroll
    for (int j = 0; j < 4; ++j) { const int n = (lane >> 3) + 8 * j; const LAS float* s = scr + (8 * c) * 33 + n;
        u32x4 o; o.x = pk2(s[0 * 33], s[1 * 33]); o.y = pk2(s[2 * 33], s[3 * 33]); o.z = pk2(s[4 * 33], s[5 * 33]); o.w = pk2(s[6 * 33], s[7 * 33]);
        *(u32x4*)(d.WT + (size_t)(d.orow0 + n) * d.ldo + d.k0 + 8 * c) = o; }
    asm volatile("s_waitcnt lgkmcnt(0)" ::: "memory");
}
__device__ __forceinline__ void convert_items(KArgs a, ldsp lds, int gbeg, int gend, int wv, int nw, int tid) {
    const int lane = tid & 63, wave = __builtin_amdgcn_readfirstlane(tid >> 6);
    unsigned char* ws = a->ws;
    LAS float* scr = (LAS float*)(lds + wave * 16384);
    WItem cur, nxt; float va[32], vb[32];
    int gi = gbeg + wv;
    if (gi < gend) { witem_decode(a, ws, gi, cur); witem_load(cur, va, lane); }
    while (gi < gend) {
        const int g1 = gi + nw, g2 = gi + 2 * nw;
        if (g1 < gend) { witem_decode(a, ws, g1, nxt); witem_load(nxt, vb, lane); }
        witem_finish(cur, va, scr, lane);
        if (g1 >= gend) break;
        if (g2 < gend) { witem_decode(a, ws, g2, cur); witem_load(cur, va, lane); }
        witem_finish(nxt, vb, scr, lane);
        gi = g2;
    }
}
__device__ __forceinline__ void prologue(KArgs a, ldsp lds, int vcu, int G, int tid) {
    const int lane = tid & 63, wave = __builtin_amdgcn_readfirstlane(tid >> 6);
    unsigned char* ws = a->ws;
    const int gw = vcu * 8 + wave, NGW = G * 8;
    convert_items(a, lds, 0, WI_EARLY, gw, NGW, tid);
    const float* x = a->in[0]; bf16* XB = (bf16*)(ws + WS_XB); float* ssq = (float*)(ws + WS_SSQ);
    for (int m = gw; m < M_TOK; m += 2 * NGW) {
        const int m2 = m + NGW;
        const f32x4* xr0 = (const f32x4*)(x + (size_t)m * DM) + lane; const f32x4* xr1 = (const f32x4*)(x + (size_t)m2 * DM) + lane;
        f32x4 v0[4], v1[4];
#pragma unroll
        for (int j = 0; j < 4; ++j) { v0[j] = xr0[64 * j]; v1[j] = xr1[64 * j]; }
        unsigned long long* o0 = (unsigned long long*)(XB + (size_t)m * DM) + lane; unsigned long long* o1 = (unsigned long long*)(XB + (size_t)m2 * DM) + lane;
        float s0 = 0.f, s1 = 0.f;
#pragma unroll
        for (int j = 0; j < 4; ++j) { s0 += (v0[j][0] * v0[j][0] + v0[j][1] * v0[j][1]) + (v0[j][2] * v0[j][2] + v0[j][3] * v0[j][3]);
            s1 += (v1[j][0] * v1[j][0] + v1[j][1] * v1[j][1]) + (v1[j][2] * v1[j][2] + v1[j][3] * v1[j][3]);
            o0[64 * j] = (unsigned long long)pk2(v0[j][0], v0[j][1]) | ((unsigned long long)pk2(v0[j][2], v0[j][3]) << 32);
            o1[64 * j] = (unsigned long long)pk2(v1[j][0], v1[j][1]) | ((unsigned long long)pk2(v1[j][2], v1[j][3]) << 32); }
        s0 = wave_sum(s0); s1 = wave_sum(s1);
        if (lane == 0) { *(f32x4*)(ssq + 4 * (size_t)m) = (f32x4){s0, 0.f, 0.f, 0.f}; *(f32x4*)(ssq + 4 * (size_t)m2) = (f32x4){s1, 0.f, 0.f, 0.f}; }
    }
    if (vcu == 0 && tid < 16) { const float d = (tid < 8 ? a->in[12] : a->in[13])[tid & 7]; const float e = __expf(-d);
        const float l1p = (e < 0.0625f) ? e * (1.0f - e * (0.5f - e * ((1.0f / 3.0f) - e * (0.25f - e * 0.2f)))) : __logf(1.0f + e);
        ((float*)(ws + WS_L2))[tid] = -l1p * LOG2E; }
}

#ifndef DBG_DUMP
#define DBG_DUMP 0
#endif
#ifndef GEMM_ALIGN
#define GEMM_ALIGN true
#endif
#ifndef REP_PH
#define REP_PH (-1)
#define REP_N 0
#endif
#ifndef REP_COND
#define REP_COND true
#endif
#ifndef DBG_STRIDE
#define DBG_STRIDE 1
#endif
#ifndef DBG_HI
#define DBG_HI PH_COUNT
#endif
#ifndef DBG_LO
#define DBG_LO 0
#endif
#ifndef DBG_AOFF
#define DBG_AOFF 2048
#endif
#ifndef DBG_LDA
#define DBG_LDA 3072
#endif
#ifndef DBG_LDB
#define DBG_LDB 2048
#endif
#ifndef DBG_K
#define DBG_K 1024
#endif
enum { PH_PRO = 0, PH_IN_E, PH_ATTN, PH_OUT_E, PH_MLP_IN0, PH_MLP_OUT0, PH_IN_O0, PH_RA0, PH_RB0, PH_RC0, PH_IN_O1, PH_RA1, PH_RB1, PH_RC1, PH_OUT_O, PH_MLP_IN1, PH_MLP_OUT1, PH_COUNT };

__global__ void __launch_bounds__(512, 2) mk_fwd(Args a_unused) {
    extern __shared__ __attribute__((aligned(16))) unsigned char lds_raw[];
    cg::grid_group grid = cg::this_grid();
    const ldsp lds = (ldsp)lds_raw;
    volatile LAS unsigned* MISC = (volatile LAS unsigned*)(lds + RING_BYTES);
    if (threadIdx.x < 32) MISC[threadIdx.x] = 0u;
    __syncthreads();
    const XcdBarrier bar = xcd_barrier_post((unsigned*)(((KArgs)__builtin_amdgcn_kernarg_segment_ptr())->ws + WS_CTL) + CW_BAR, MISC + 8);
    const int G = gridDim.x;
    int repcnt = 0;
    const int ph_lo = ((KArgs)__builtin_amdgcn_kernarg_segment_ptr())->ph_lo, ph_hi = ((KArgs)__builtin_amdgcn_kernarg_segment_ptr())->ph_hi;
    for (int ph = ph_lo; ph < ph_hi; ++ph) {
        const __attribute__((address_space(4))) char* kp = (const __attribute__((address_space(4))) char*)__builtin_amdgcn_kernarg_segment_ptr();
        asm volatile("" : "+s"(kp));
        KArgs a = (KArgs)kp;
        unsigned char* ws = a->ws;
        bf16* XB = (bf16*)(ws + WS_XB); float* ssq = (float*)(ws + WS_SSQ);
        bf16* BIG = (bf16*)(ws + WS_BIG);
        bf16* QKV = BIG; bf16* OE = BIG + (size_t)M_TOK * N_IN_E; bf16* HM = BIG; bf16* GB = BIG; bf16* ST = BIG + (size_t)M_TOK * 3072;
        int tid = threadIdx.x, bx = blockIdx.x;
        asm volatile("" : "+v"(tid)); asm volatile("" : "+s"(bx));
        const int vcu = (G % 8 == 0) ? (bx % 8) * (G / 8) + bx / 8 : bx;
        if (ph == PH_PRO) { prologue(a, lds, vcu, G, tid); }
        else if (ph == PH_ATTN) {
            att::AttnArgs A{QKV, OE, a->in[3], a->in[4], a->in[5], a->in[6], a->in[7], a->in[8]};
            att::attn_phase(lds, A, vcu, G, tid);
        }
        else if (ph == PH_RA0 || ph == PH_RA1 || ph == PH_RB0 || ph == PH_RB1 || ph == PH_RC0 || ph == PH_RC1) {
            ret::RetArgs R{GB, ST, (const float*)(ws + WS_L2), a->in[14], (ph >= PH_IN_O1) ? 1 : 0, (REP_N > 0 && ph == REP_PH && repcnt > 0) ? 1 : 0, (bf16*)a->out};
            if (ph == PH_RA0 || ph == PH_RA1) { ret::ret_a_phase(lds, R, vcu, G, tid); }
            else if (ph == PH_RB0 || ph == PH_RB1) { ret::ret_b(R, vcu, G, tid); }
            else { ret::ret_c_phase(lds, R, vcu, G, tid); }
        }
        else if (ph == PH_IN_E || ph == PH_MLP_IN0 || ph == PH_MLP_IN1 || ph == PH_IN_O0 || ph == PH_IN_O1) {
            const bf16* Bt; int N, act, silu0; bf16* O;
            if (ph == PH_IN_E)           { Bt = (const bf16*)(ws + WS_W_IN_E); N = N_IN_E; O = QKV; act = 0; silu0 = 1 << 30; }
            else if (ph == PH_MLP_IN0)   { Bt = (const bf16*)(ws + WS_W_MLP_IN); N = DFF; O = HM; act = 1; silu0 = 1 << 30; }
            else if (ph == PH_MLP_IN1)   { Bt = (const bf16*)(ws + WS_W_MLP_IN) + (size_t)DFF * DM; N = DFF; O = HM; act = 1; silu0 = 1 << 30; }
            else if (ph == PH_IN_O0)     { Bt = (const bf16*)(ws + WS_W_IN_O); N = 3072; O = GB; act = 2; silu0 = 8; }
            else                         { Bt = (const bf16*)(ws + WS_W_IN_O) + (size_t)3072 * DM; N = 3072; O = GB; act = 2; silu0 = 8; }
            pg8::Gemm g; g.A = XB; g.Bt = Bt; g.lda = DM; g.ldb = DM; g.M = M_TOK; g.N = N; g.K = DM;
            pg8::EpiBf16 E; E.O = O; E.ldc = N; E.ssq = ssq; E.silu_pn0 = silu0; E.act = act;
            pg8::StaticOrder S; S.init(M_TOK, N, G, bx);
            pg8::gemm_phase<pg8::EpiBf16, pg8::StaticOrder, GEMM_ALIGN, true>(lds, g, S, E, tid);
            if (ph == PH_IN_E && bx >= 64) convert_items(a, lds, WI_EARLY, WI_C7, (bx - 64) * 8 + __builtin_amdgcn_readfirstlane(tid >> 6), (G - 64) * 8, tid);
        }
        else {
            const bf16* A; const bf16* Bt; int lda, ldb, K; const float* basef; const bf16* baseb; float* outf; bf16* xb; float* sso;
            if (ph == PH_OUT_E)          { A = OE; lda = DM; K = DM; Bt = (const bf16*)(ws + WS_W_OUT_E); ldb = DM; basef = nullptr; baseb = XB; outf = nullptr; xb = XB; sso = ssq; }
            else if (ph == PH_MLP_OUT0)  { A = HM; lda = DFF; K = DFF; Bt = (const bf16*)(ws + WS_W_MLP_OUT); ldb = DFF; basef = nullptr; baseb = XB; outf = nullptr; xb = XB; sso = ssq; }
            else if (ph == PH_MLP_OUT1)  { A = HM; lda = DFF; K = DFF; Bt = (const bf16*)(ws + WS_W_MLP_OUT) + (size_t)DFF * DM; ldb = DFF; basef = nullptr; baseb = XB; outf = a->out; xb = nullptr; sso = nullptr; }
            else                         { A = (const bf16*)a->out; lda = 2048; K = 2048; Bt = (const bf16*)(ws + WS_W_OUT_O); ldb = 2048; basef = nullptr; baseb = XB; outf = nullptr; xb = XB; sso = ssq; }
            pg8::Gemm g; g.A = A; g.Bt = Bt; g.lda = lda; g.ldb = ldb; g.M = M_TOK; g.N = DM; g.K = K;
            pg8::EpiResid E; E.basef = basef; E.baseb = baseb; E.outf = outf; E.xb = xb; E.ssq_out = sso; E.ldc = DM;
            E.accscale = (REP_N > 0 && ph == REP_PH && repcnt > 0 && ph != PH_OUT_E && ph != PH_MLP_OUT1) ? 0.f : 1.f;
            pg8::StaticOrder S; S.init(M_TOK, DM, G, bx);
            pg8::gemm_phase<pg8::EpiResid, pg8::StaticOrder, false, true>(lds, g, S, E, tid);
        }
        if (ph + 1 == ph_hi && DBG_DUMP) {
            xcd_barrier(bar);
            const bf16* srcb = (DBG_DUMP == 1) ? GB : ST;
            for (size_t i = (size_t)bx * 512 + tid; i < (size_t)M_TOK * DM; i += (size_t)G * 512) a->out[i] = bf_lo((unsigned)srcb[i * DBG_STRIDE]);
        }
#ifdef NOP_REPS
        if (ph == NOP_AT) { for (int q = 0; q < NOP_REPS; ++q) xcd_barrier(bar); }
#endif
        if (ph + 1 < ph_hi) {
            if (ph_lo < 0) {
                asm volatile("s_waitcnt vmcnt(0)" ::: "memory");
                grid.sync();
                __builtin_amdgcn_fence(__ATOMIC_ACQUIRE, "agent");
                asm volatile("s_waitcnt vmcnt(0)" ::: "memory");
                __syncthreads();
            }
            xcd_barrier(bar);
        }
        if (REP_N > 0 && ph == REP_PH && repcnt < REP_N && REP_COND) { ++repcnt; --ph; }
    }
}

extern "C" void kernel_launch(void* const* d_in, const int* in_sizes, int n_in, void* d_out, int out_size, void* d_ws, size_t ws_size, hipStream_t stream) {
    static int grid = 0;
    if (grid == 0) {
        int dev = 0, cus = 0, per_cu = 0;
        (void)hipGetDevice(&dev);
        (void)hipDeviceGetAttribute(&cus, hipDeviceAttributeMultiprocessorCount, dev);
        (void)hipFuncSetAttribute((const void*)mk_fwd, hipFuncAttributeMaxDynamicSharedMemorySize, LDS_BYTES);
        (void)hipOccupancyMaxActiveBlocksPerMultiprocessor(&per_cu, (const void*)mk_fwd, 512, LDS_BYTES);
        grid = (n_in == 19 && per_cu >= 1 && cus == 256 && ws_size >= WS_END && out_size == M_TOK * DM) ? 256 : -1;
        if (grid < 0) fprintf(stderr, "kernel_launch: unsupported configuration (cus %d per_cu %d ws %zu n_in %d)\n", cus, per_cu, ws_size, n_in);
    }
    if (grid < 0) return;
    if (hipMemsetAsync((char*)d_ws + WS_CTL, 0, 65536, stream) != hipSuccess) { fprintf(stderr, "kernel_launch: memset failed\n"); return; }
    Args a{};
    for (int i = 0; i < 19; ++i) a.in[i] = (const float*)d_in[i];
    a.out = (float*)d_out; a.ws = (unsigned char*)d_ws; a.ph_lo = DBG_LO; a.ph_hi = DBG_HI;
    void* args[] = {&a};
#ifdef PLAIN_LAUNCH
    hipError_t e = hipLaunchKernel((void*)mk_fwd, dim3(grid), dim3(512), args, LDS_BYTES, stream);
#else
    hipError_t e = hipLaunchCooperativeKernel((void*)mk_fwd, dim3(grid), dim3(512), args, LDS_BYTES, stream);
#endif
    if (e != hipSuccess) fprintf(stderr, "cooperative launch failed: %s\n", hipGetErrorString(e));
}
```

```cpp
#include <hip/hip_runtime.h>
#include <hip/hip_cooperative_groups.h>
#include <cstdio>
#include <cstdint>
#include <cmath>
namespace cg = cooperative_groups;
namespace pg8 {
#define PG8_LAS __attribute__((address_space(3)))
typedef unsigned short bf16_t;
typedef short bf16x8 __attribute__((ext_vector_type(8)));
typedef float f32x4 __attribute__((ext_vector_type(4)));
typedef float f32x2 __attribute__((ext_vector_type(2)));
typedef unsigned u32x4 __attribute__((ext_vector_type(4)));
typedef unsigned u32x2 __attribute__((ext_vector_type(2)));
constexpr int BM = 256, BK = 64, HALF = 128, HTB = HALF * BK * 2  , STAGE_BYTES = 8 * HTB, NXCD = 8, WGM = 8;

__host__ __device__ __forceinline__ int lds_byte(int r, int c) { const int st = (r >> 4) * 2 + (c >> 5), rr = r & 15, cc = c & 31, ob = rr * 64 + cc * 2; return st * 1024 + (ob ^ (((ob >> 9) & 1) << 5)); }
__host__ __device__ __forceinline__ void stage_rc(int b, int& R, int& C) { const int st = b / 1024, sb = b % 1024, swz = sb ^ (((sb >> 9) & 1) << 5); R = (st >> 1) * 16 + swz / 64; C = (st & 1) * 32 + (swz % 64) / 2; }
__host__ __device__ __forceinline__ int perm32(int rho) { const int n = rho >> 4, i = rho & 15; return 8 * (i >> 2) + 4 * n + (i & 3); }

struct Unit { int pm, pn; };
struct Gemm { const bf16_t* A; const bf16_t* Bt; int lda, ldb, M, N, K; };

struct StaticOrder {
    int nM, nN, nwg, G, c;
    __host__ __device__ void init(int M, int N, int G_, int c_) { nM = M / BM; nN = N / BM; nwg = nM * nN; G = G_; c = c_; }
    __host__ __device__ bool next(int i, Unit& u) const {
        const long L = (long)i * G + c; if (L >= nwg) return false;
        int wgid = (int)L; { const int q = nwg / NXCD, r = nwg % NXCD, xcd = wgid % NXCD, off = wgid / NXCD; wgid = (xcd < r ? xcd * (q + 1) : r * (q + 1) + (xcd - r) * q) + off; }
        const int nig = WGM * nN, gid = wgid / nig, fm = gid * WGM, gsz = (nM - fm) < WGM ? (nM - fm) : WGM;
        u.pm = fm + ((wgid % nig) % gsz); u.pn = (wgid % nig) / gsz; return true;
    }
};

typedef float f32x2_cv __attribute__((ext_vector_type(2))); typedef __bf16 bf16x2_cv __attribute__((ext_vector_type(2)));
__device__ __forceinline__ unsigned cvt_pk_bf16(float lo, float hi) { const f32x2_cv v = {lo, hi}; const bf16x2_cv b = __builtin_convertvector(v, bf16x2_cv); return __builtin_bit_cast(unsigned, b); }


__device__ __forceinline__ float row_rstd(const float* ssq, int row) { const f32x4 p = *(const f32x4*)(ssq + 4 * (size_t)row); return rsqrtf(((p[0] + p[1]) + (p[2] + p[3])) * (1.0f / 1024.0f) + 1e-6f); }

struct EpiBf16 {
    static constexpr bool PERM = true, AFTER_DRAIN = false;
    bf16_t* O; int ldc; const float* ssq; int silu_pn0; int act;
    __device__ __forceinline__ void preload(float (&rsv)[8], int pm, int wr, int fr) const {
        const int row0 = pm * BM + wr * 64 + fr;
#pragma unroll
        for (int ai = 0; ai < 2; ++ai)
#pragma unroll
            for (int m = 0; m < 4; ++m) rsv[ai * 4 + m] = row_rstd(ssq, row0 + ai * HALF + m * 16);
    }
    __device__ __forceinline__ void operator()(const f32x4 (&acc)[2][2][4][2], const Unit& u, int wr, int wc, int fr, int fq, float (&rsv)[8], int& rs_pm) const {
        if (rs_pm != u.pm) { preload(rsv, u.pm, wr, fr); rs_pm = u.pm; }
        const int row0 = u.pm * BM + wr * 64 + fr; const int col0 = u.pn * BM + wc * 32 + 8 * fq;
        const bool do_silu = (act == 2) && (u.pn >= silu_pn0);
#if 1
        const __amdgpu_buffer_rsrc_t rsrc = __builtin_amdgcn_make_buffer_rsrc((void*)O, 0, 0x7fffffff, 0x00020000);
#endif
#pragma unroll
        for (int ai = 0; ai < 2; ++ai)
#pragma unroll
            for (int m = 0; m < 4; ++m) { const int row = row0 + ai * HALF + m * 16; const float rs = rsv[ai * 4 + m]; bf16_t* rowp = O + (size_t)row * ldc + col0;
#pragma unroll
                for (int bj = 0; bj < 2; ++bj) { f32x4 v0 = acc[ai][bj][m][0] * rs, v1 = acc[ai][bj][m][1] * rs;
                    if (act == 1) {
#pragma unroll
                        for (int e = 0; e < 4; ++e) { const float a = fmaxf(v0[e], 0.f), b = fmaxf(v1[e], 0.f); v0[e] = a * a; v1[e] = b * b; } }
                    if (do_silu) {
#pragma unroll
                        for (int e = 0; e < 4; ++e) { v0[e] = v0[e] * __builtin_amdgcn_rcpf(1.0f + __builtin_amdgcn_exp2f(-1.4426950408889634f * v0[e])); v1[e] = v1[e] * __builtin_amdgcn_rcpf(1.0f + __builtin_amdgcn_exp2f(-1.4426950408889634f * v1[e])); } }
                    u32x4 w; w.x = cvt_pk_bf16(v0[0], v0[1]); w.y = cvt_pk_bf16(v0[2], v0[3]); w.z = cvt_pk_bf16(v1[0], v1[1]); w.w = cvt_pk_bf16(v1[2], v1[3]);
#if 1
                    __builtin_amdgcn_raw_buffer_store_b128(w, rsrc, (unsigned)(((size_t)row * ldc + col0 + bj * HALF) * 2), 0, 16);
#else
                    *(u32x4*)(rowp + bj * HALF) = w;
#endif
                    } }
    }
};

struct EpiResid {
    static constexpr bool PERM = true, AFTER_DRAIN = true;
    const float* basef; const bf16_t* baseb; float* outf; bf16_t* xb; float* ssq_out; int ldc; float accscale;
    __device__ __forceinline__ void fused(f32x4 (&acc)[2][2][4][2], const Unit& u, int wr, int wc, int fr, int fq, PG8_LAS unsigned char* lds, int wid, int lane) const {
        PG8_LAS float* P = (PG8_LAS float*)lds;
        const int col0 = u.pn * BM + wc * 32 + 8 * fq;
#ifdef WT_MORE
        const __amdgpu_buffer_rsrc_t xrs = __builtin_amdgcn_make_buffer_rsrc((void*)xb, 0, 0x7fffffff, 0x00020000);
#endif
#pragma unroll
        for (int ai = 0; ai < 2; ++ai)
#pragma unroll
            for (int m = 0; m < 4; ++m) { const int r = ai * HALF + wr * 64 + m * 16 + fr; const size_t off = (size_t)(u.pm * BM + r) * ldc + col0; float s = 0.f;
#pragma unroll
                for (int bj = 0; bj < 2; ++bj) { const size_t o2 = off + bj * HALF; f32x4 b0, b1;
                    if (basef) { b0 = *(const f32x4*)(basef + o2); b1 = *(const f32x4*)(basef + o2 + 4); }
                    else { const u32x4 b = *(const u32x4*)(baseb + o2);
                        b0 = (f32x4){__uint_as_float(b.x << 16), __uint_as_float(b.x & 0xffff0000u), __uint_as_float(b.y << 16), __uint_as_float(b.y & 0xffff0000u)};
                        b1 = (f32x4){__uint_as_float(b.z << 16), __uint_as_float(b.z & 0xffff0000u), __uint_as_float(b.w << 16), __uint_as_float(b.w & 0xffff0000u)}; }
                    const f32x4 o0 = b0 + acc[ai][bj][m][0] * accscale, o1 = b1 + acc[ai][bj][m][1] * accscale;
                    if (outf) { *(f32x4*)(outf + o2) = o0; *(f32x4*)(outf + o2 + 4) = o1; }
                    if (xb) { u32x4 w; w.x = cvt_pk_bf16(o0[0], o0[1]); w.y = cvt_pk_bf16(o0[2], o0[3]); w.z = cvt_pk_bf16(o1[0], o1[1]); w.w = cvt_pk_bf16(o1[2], o1[3]);
#ifdef WT_MORE
                        __builtin_amdgcn_raw_buffer_store_b128(w, xrs, (unsigned)(o2 * 2), 0, 16);
#else
                        *(u32x4*)(xb + o2) = w;
#endif
                    }
                    s += ((o0[0] * o0[0] + o0[1] * o0[1]) + (o0[2] * o0[2] + o0[3] * o0[3])) + ((o1[0] * o1[0] + o1[1] * o1[1]) + (o1[2] * o1[2] + o1[3] * o1[3])); }
                if (ssq_out) { s += __shfl_xor(s, 16); s += __shfl_xor(s, 32); if (fq == 0) P[r * 4 + wc] = s; }
                if (m & 1) asm volatile("" ::: "memory"); }
        if (ssq_out) {
            __syncthreads();
            const int t = wid * 64 + lane;
            if (t < 256) { const float s = (P[t * 4 + 0] + P[t * 4 + 1]) + (P[t * 4 + 2] + P[t * 4 + 3]); ssq_out[(size_t)(u.pm * BM + t) * 4 + u.pn] = s; }
            __syncthreads();
        }
    }
};

template <class Epi, class Sched, bool ALIGN_EPI = false, bool SP2 = false>
__device__ __forceinline__ void gemm_phase(PG8_LAS unsigned char* lds, const Gemm g, const Sched& S, const Epi& E, const int tid) {
    const int wid = __builtin_amdgcn_readfirstlane(tid >> 6), lane = tid & 63, wr = wid >> 2, wc = wid & 3, fr = lane & 15, fq = lane >> 4;
    const int K = g.K, nt = K / BK;
    unsigned voffA[2], voffB[2];
#pragma unroll
    for (int i = 0; i < 2; ++i) { int R, C; stage_rc(tid * 16 + i * 8192, R, C); const int Rb = Epi::PERM ? ((R & ~31) + perm32(R & 31)) : R;
        voffA[i] = (unsigned)(R * g.lda + C) * 2u; voffB[i] = (unsigned)(Rb * g.ldb + C) * 2u; }
    const size_t kstep = (size_t)(BK * 2);
    const size_t hstepA = (size_t)HALF * g.lda * 2, hstepB = (size_t)HALF * g.ldb * 2;
    const size_t tstepA = 2 * hstepA, tstepB = 2 * hstepB;
    const unsigned ldsw = (unsigned)wid * 1024u;
    const int aoff = lds_byte(wr * 64 + fr, fq * 8), boff = lds_byte(wc * 32 + fr, fq * 8);
#define PG8_SA(b, h) (((b) * 2 + (h)) * HTB)
#define PG8_SB(b, h) ((4 + (b) * 2 + (h)) * HTB)
#define PG8_STAGE(bufoff, gbase, voff) do { _Pragma("unroll") for (int _i = 0; _i < 2; ++_i) \
        __builtin_amdgcn_global_load_lds((const unsigned*)((const char*)(gbase) + (voff)[_i]), (PG8_LAS unsigned*)(lds + (bufoff) + ldsw + _i * 8192), 16, 0, 0); } while (0)
#define PG8_LDA(dst, b, h) do { _Pragma("unroll") for (int m = 0; m < 4; ++m) _Pragma("unroll") for (int k = 0; k < 2; ++k) dst[m][k] = *(const PG8_LAS bf16x8*)(lds + PG8_SA(b, h) + aoff + m * 2048 + k * 1024); } while (0)
#define PG8_LDB(dst, b, h) do { _Pragma("unroll") for (int n = 0; n < 2; ++n) _Pragma("unroll") for (int k = 0; k < 2; ++k) dst[n][k] = *(const PG8_LAS bf16x8*)(lds + PG8_SB(b, h) + boff + n * 2048 + k * 1024); } while (0)
#define PG8_MMA(ai, bj, At, Bt) do { __builtin_amdgcn_s_setprio(1); _Pragma("unroll") for (int m = 0; m < 4; ++m) _Pragma("unroll") for (int n = 0; n < 2; ++n) _Pragma("unroll") for (int k = 0; k < 2; ++k) \
        acc[ai][bj][m][n] = __builtin_amdgcn_mfma_f32_16x16x32_bf16(Bt[n][k], At[m][k], acc[ai][bj][m][n], 0, 0, 0); __builtin_amdgcn_s_setprio(0); } while (0)
#define PG8_WAIT_V(n) asm volatile("s_waitcnt vmcnt(" #n ")" ::: "memory")
#define PG8_WAIT_L(n) asm volatile("s_waitcnt lgkmcnt(" #n ")" ::: "memory")
#define PG8_BAR __builtin_amdgcn_s_barrier()
#define PG8_SCHED __builtin_amdgcn_sched_barrier(0)
    Unit cur, nxt; int ui = 0;
    if (!S.next(0, cur)) return;
    f32x4 acc[2][2][4][2];
#pragma unroll
    for (int a = 0; a < 2; ++a)
#pragma unroll
        for (int b = 0; b < 2; ++b)
#pragma unroll
            for (int m = 0; m < 4; ++m)
#pragma unroll
                for (int n = 0; n < 2; ++n) acc[a][b][m][n] = (f32x4){0.f, 0.f, 0.f, 0.f};
    bf16x8 At[4][2], B0[2][2], B1[2][2];
    const char* cA = (const char*)g.A + (size_t)cur.pm * tstepA; const char* cB = (const char*)g.Bt + (size_t)cur.pn * tstepB;
    float rsv[8]; int rs_pm = -1;
    if constexpr (!Epi::AFTER_DRAIN) { E.preload(rsv, cur.pm, wr, fr); rs_pm = cur.pm; }
    if constexpr (SP2) {
        PG8_STAGE(PG8_SB(0, 0), cB, voffB); PG8_STAGE(PG8_SB(0, 1), cB + hstepB, voffB); PG8_STAGE(PG8_SA(0, 0), cA, voffA); PG8_STAGE(PG8_SA(0, 1), cA + hstepA, voffA);
        if (wr == 1) PG8_BAR;
        PG8_WAIT_V(2); PG8_BAR;
        PG8_STAGE(PG8_SB(1, 0), cB + kstep, voffB); PG8_STAGE(PG8_SA(1, 0), cA + kstep, voffA); PG8_STAGE(PG8_SB(1, 1), cB + hstepB + kstep, voffB);
        PG8_WAIT_V(6); PG8_BAR;
    } else {
        PG8_STAGE(PG8_SB(0, 0), cB, voffB); PG8_STAGE(PG8_SA(0, 0), cA, voffA); PG8_STAGE(PG8_SB(0, 1), cB + hstepB, voffB); PG8_STAGE(PG8_SA(0, 1), cA + hstepA, voffA);
        if (wr == 1) PG8_BAR;
        PG8_WAIT_V(4); PG8_BAR;
        PG8_STAGE(PG8_SB(1, 0), cB + kstep, voffB); PG8_STAGE(PG8_SA(1, 0), cA + kstep, voffA); PG8_STAGE(PG8_SB(1, 1), cB + hstepB + kstep, voffB);
        PG8_WAIT_V(6); PG8_BAR;
    }
    for (;;) {
        const bool has_next = S.next(ui + 1, nxt);
        const char* nA = has_next ? (const char*)g.A + (size_t)nxt.pm * tstepA : cA; const char* nB = has_next ? (const char*)g.Bt + (size_t)nxt.pn * tstepB : cB;
        for (int t = 0; t < nt; t += 2) {
            const bool last = (t == nt - 2);
            const char* a1 = cA + (size_t)(t + 1) * kstep;
            const char* a2 = last ? nA : cA + (size_t)(t + 2) * kstep; const char* b2 = last ? nB : cB + (size_t)(t + 2) * kstep;
            const char* a3 = a2 + kstep; const char* b3 = b2 + kstep;
            if constexpr (SP2) {
            PG8_LDB(B0, 0, 0); PG8_LDB(B1, 0, 1); PG8_SCHED; PG8_LDA(At, 0, 0); PG8_STAGE(PG8_SA(1, 1), a1 + hstepA, voffA);
            PG8_WAIT_V(8); PG8_WAIT_L(0); PG8_BAR; PG8_MMA(0, 0, At, B0); PG8_MMA(0, 1, At, B1); PG8_BAR; PG8_SCHED;
            PG8_LDA(At, 0, 1); PG8_STAGE(PG8_SB(0, 0), b2, voffB); PG8_STAGE(PG8_SB(0, 1), b2 + hstepB, voffB); PG8_STAGE(PG8_SA(0, 0), a2, voffA);
            PG8_WAIT_V(8); PG8_WAIT_L(0); PG8_BAR; PG8_MMA(1, 0, At, B0); PG8_MMA(1, 1, At, B1); PG8_BAR; PG8_SCHED;
            PG8_LDB(B0, 1, 0); PG8_LDB(B1, 1, 1); PG8_SCHED; PG8_LDA(At, 1, 0); PG8_STAGE(PG8_SA(0, 1), a2 + hstepA, voffA);
            PG8_WAIT_V(8); PG8_WAIT_L(0); PG8_BAR; PG8_MMA(0, 0, At, B0); PG8_MMA(0, 1, At, B1); PG8_BAR; PG8_SCHED;
            PG8_LDA(At, 1, 1); PG8_STAGE(PG8_SB(1, 0), b3, voffB); PG8_STAGE(PG8_SB(1, 1), b3 + hstepB, voffB); PG8_STAGE(PG8_SA(1, 0), a3, voffA);
            PG8_WAIT_V(8); PG8_WAIT_L(0); PG8_BAR; PG8_MMA(1, 0, At, B0); PG8_MMA(1, 1, At, B1); PG8_BAR; PG8_SCHED;
            } else {
            PG8_LDB(B0, 0, 0); PG8_SCHED; PG8_LDA(At, 0, 0); PG8_STAGE(PG8_SA(1, 1), a1 + hstepA, voffA);
            PG8_WAIT_L(8); PG8_BAR; PG8_WAIT_L(0); PG8_MMA(0, 0, At, B0); PG8_BAR; PG8_SCHED;
            PG8_LDB(B1, 0, 1); PG8_STAGE(PG8_SB(0, 0), b2, voffB);
            PG8_BAR; PG8_WAIT_L(0); PG8_MMA(0, 1, At, B1); PG8_BAR;
            PG8_LDA(At, 0, 1); PG8_STAGE(PG8_SA(0, 0), a2, voffA);
            PG8_BAR; PG8_WAIT_L(0); PG8_MMA(1, 0, At, B0); PG8_BAR; PG8_SCHED;
            PG8_STAGE(PG8_SB(0, 1), b2 + hstepB, voffB);
            PG8_WAIT_V(6); PG8_BAR; PG8_MMA(1, 1, At, B1); PG8_BAR;
            PG8_LDB(B0, 1, 0); PG8_SCHED; PG8_LDA(At, 1, 0); PG8_STAGE(PG8_SA(0, 1), a2 + hstepA, voffA);
            PG8_WAIT_L(8); PG8_BAR; PG8_WAIT_L(0); PG8_MMA(0, 0, At, B0); PG8_BAR; PG8_SCHED;
            PG8_LDB(B1, 1, 1); PG8_STAGE(PG8_SB(1, 0), b3, voffB);
            PG8_BAR; PG8_WAIT_L(0); PG8_MMA(0, 1, At, B1); PG8_BAR;
            PG8_LDA(At, 1, 1); PG8_STAGE(PG8_SA(1, 0), a3, voffA);
            PG8_BAR; PG8_WAIT_L(0); PG8_MMA(1, 0, At, B0); PG8_BAR; PG8_SCHED;
            PG8_STAGE(PG8_SB(1, 1), b3 + hstepB, voffB);
            PG8_WAIT_V(6); PG8_BAR; PG8_MMA(1, 1, At, B1); PG8_BAR;
            }
        }
        if constexpr (ALIGN_EPI) { if (wr == 0) PG8_BAR; }
        if constexpr (!Epi::AFTER_DRAIN) { E(acc, cur, wr, wc, fr, fq, rsv, rs_pm); }
        if (!has_next) break;
#pragma unroll
        for (int a = 0; a < 2; ++a)
#pragma unroll
            for (int b = 0; b < 2; ++b)
#pragma unroll
                for (int m = 0; m < 4; ++m)
#pragma unroll
                    for (int n = 0; n < 2; ++n) acc[a][b][m][n] = (f32x4){0.f, 0.f, 0.f, 0.f};
        cur = nxt; cA = nA; cB = nB; ++ui;
        if constexpr (ALIGN_EPI) { if (wr == 1) PG8_BAR; }
    }
    PG8_WAIT_V(0);
    if constexpr (!ALIGN_EPI) { if (wr == 0) PG8_BAR; }
    PG8_BAR;
    if constexpr (Epi::AFTER_DRAIN) { E.fused(acc, cur, wr, wc, fr, fq, lds, wid, lane); }
#undef PG8_SA
#undef PG8_SB
#undef PG8_STAGE
#undef PG8_LDA
#undef PG8_LDB
#undef PG8_MMA
#undef PG8_WAIT_V
#undef PG8_WAIT_L
#undef PG8_BAR
#undef PG8_SCHED
}
}
#define LAS __attribute__((address_space(3)))
typedef unsigned short bf16;
typedef short bf16x8 __attribute__((ext_vector_type(8)));
typedef short s16x4 __attribute__((ext_vector_type(4)));
typedef float f32x4 __attribute__((ext_vector_type(4)));
typedef unsigned u32x4 __attribute__((ext_vector_type(4)));
typedef unsigned u32x2 __attribute__((ext_vector_type(2)));
typedef LAS unsigned char* ldsp;
constexpr float LOG2E = 1.4426950408889634f;

__device__ __forceinline__ float bf_lo(unsigned w) { return __uint_as_float(w << 16); }
__device__ __forceinline__ float bf_hi(unsigned w) { return __uint_as_float(w & 0xffff0000u); }
__device__ __forceinline__ unsigned pk2(float lo, float hi) { return pg8::cvt_pk_bf16(lo, hi); }
__device__ __forceinline__ s16x4 vtr(ldsp p) { typedef short v4i16_t __attribute__((ext_vector_type(4))); return __builtin_bit_cast(s16x4, __builtin_amdgcn_ds_read_tr16_b64_v4i16((LAS v4i16_t*)p)); }
__device__ __forceinline__ bf16x8 cat8(s16x4 lo, s16x4 hi) { return (bf16x8){lo[0], lo[1], lo[2], lo[3], hi[0], hi[1], hi[2], hi[3]}; }
__device__ __forceinline__ f32x4 mfma16(bf16x8 a, bf16x8 b, f32x4 c) { return __builtin_amdgcn_mfma_f32_16x16x32_bf16(a, b, c, 0, 0, 0); }
__device__ __forceinline__ float ex2(float x) { return __builtin_amdgcn_exp2f(x); }

namespace att {
constexpr int SEQ = 16384, LDQ = 2304, LDO = 1024;
constexpr int KPB = 160;
constexpr int COL_QA = 0, COL_KA = 512, COL_VA = 640, COL_QB = 768, COL_KB = 1280, COL_VB = 1792;

template <int NP>
__device__ __forceinline__ void load_rows(u32x4 (&v)[NP], const bf16* src, int tok0, int nvalid, int tid) {
    const int sub = tid & 7;
#pragma unroll
    for (int p = 0; p < NP; ++p) { const int r = (tid >> 3) + 64 * p, tok = tok0 + r; const bool ok = (tok >= 0) && (tok < SEQ) && (r < nvalid);
        v[p] = (u32x4){0u, 0u, 0u, 0u};
        if (ok) v[p] = *(const u32x4*)(src + (size_t)tok * LDQ + sub * 8); }
}
template <int NP, bool NORM>
__device__ __forceinline__ void store_rows(ldsp dst, const u32x4 (&v)[NP], int nrows, const float* gain, int tid) {
    const int sub = tid & 7;
    float gn[8];
    if (NORM) {
#pragma unroll
        for (int j = 0; j < 8; ++j) gn[j] = gain[sub * 8 + j];
    }
#pragma unroll
    for (int p = 0; p < NP; ++p) { const int r = (tid >> 3) + 64 * p;
        if (r < nrows) {
            u32x4 w = v[p];
            if (NORM) {
                float f[8]; f[0] = bf_lo(w.x); f[1] = bf_hi(w.x); f[2] = bf_lo(w.y); f[3] = bf_hi(w.y); f[4] = bf_lo(w.z); f[5] = bf_hi(w.z); f[6] = bf_lo(w.w); f[7] = bf_hi(w.w);
                float ss = 0.f;
#pragma unroll
                for (int j = 0; j < 8; ++j) ss += f[j] * f[j];
                ss += __shfl_xor(ss, 1); ss += __shfl_xor(ss, 2); ss += __shfl_xor(ss, 4);
                const float rs = rsqrtf(ss * (1.0f / 64.0f) + 1e-6f);
#pragma unroll
                for (int j = 0; j < 8; ++j) f[j] = f[j] * rs * gn[j];
                w.x = pk2(f[0], f[1]); w.y = pk2(f[2], f[3]); w.z = pk2(f[4], f[5]); w.w = pk2(f[6], f[7]);
            }
            *(LAS u32x4*)(dst + r * KPB + sub * 16) = w;
        } }
}

__device__ __forceinline__ void load_q_raw(u32x4 (&raw)[2], const bf16* qrow  , int g) {
#pragma unroll
    for (int s = 0; s < 2; ++s) raw[s] = *(const u32x4*)(qrow + 32 * s + 8 * g);
}
__device__ __forceinline__ void finish_q(bf16x8 (&qf)[2], const u32x4 (&raw)[2], const float* gain, int g) {
    float f[2][8]; float ss = 0.f;
#pragma unroll
    for (int s = 0; s < 2; ++s) { const u32x4 v = raw[s];
        f[s][0] = bf_lo(v.x); f[s][1] = bf_hi(v.x); f[s][2] = bf_lo(v.y); f[s][3] = bf_hi(v.y); f[s][4] = bf_lo(v.z); f[s][5] = bf_hi(v.z); f[s][6] = bf_lo(v.w); f[s][7] = bf_hi(v.w);
#pragma unroll
        for (int j = 0; j < 8; ++j) ss += f[s][j] * f[s][j]; }
    ss += __shfl_xor(ss, 16); ss += __shfl_xor(ss, 32);
    const float rs = rsqrtf(ss * (1.0f / 64.0f) + 1e-6f) * (0.125f * LOG2E);
#pragma unroll
    for (int s = 0; s < 2; ++s) { float o[8];
#pragma unroll
        for (int j = 0; j < 8; ++j) o[j] = f[s][j] * rs * gain[32 * s + 8 * g + j];
        u32x4 w; w.x = pk2(o[0], o[1]); w.y = pk2(o[2], o[3]); w.z = pk2(o[4], o[5]); w.w = pk2(o[6], o[7]);
        qf[s] = __builtin_bit_cast(bf16x8, w); }
}

template <int NT, class RB>
__device__ __forceinline__ void scores(f32x4 (&sc)[NT], ldsp Kb, const bf16x8 (&qf)[2], const RB& rb, int lane) {
    const int fr = lane & 15, g = lane >> 4;
#pragma unroll
    for (int t = 0; t < NT; ++t) { ldsp kp = Kb + (rb(t) + fr) * KPB + g * 16; f32x4 a = (f32x4){0.f, 0.f, 0.f, 0.f};
#pragma unroll
        for (int s = 0; s < 2; ++s) { const bf16x8 kf = *(const LAS bf16x8*)(kp + s * 64); a = mfma16(kf, qf[s], a); }
        sc[t] = a; if ((t & 3) == 3) __builtin_amdgcn_sched_barrier(0); }
}
template <int NT>
__device__ __forceinline__ float softmax_pack(f32x4 (&sc)[NT], bf16x8 (&pf)[NT / 2], float sink2, bool has_sink) {
    float m = -INFINITY;
#pragma unroll
    for (int t = 0; t < NT; ++t)
#pragma unroll
        for (int r = 0; r < 4; ++r) m = fmaxf(m, sc[t][r]);
    m = fmaxf(m, __shfl_xor(m, 16)); m = fmaxf(m, __shfl_xor(m, 32));
    if (has_sink) m = fmaxf(m, sink2);
    float sum = 0.f;
#pragma unroll
    for (int t = 0; t < NT; ++t)
#pragma unroll
        for (int r = 0; r < 4; ++r) { const float p = ex2(sc[t][r] - m); sc[t][r] = p; sum += p; }
    sum += __shfl_xor(sum, 16); sum += __shfl_xor(sum, 32);
    if (has_sink) sum += ex2(sink2 - m);
#pragma unroll
    for (int k = 0; k < NT / 2; ++k) { u32x4 w; w.x = pk2(sc[2 * k][0], sc[2 * k][1]); w.y = pk2(sc[2 * k][2], sc[2 * k][3]); w.z = pk2(sc[2 * k + 1][0], sc[2 * k + 1][1]); w.w = pk2(sc[2 * k + 1][2], sc[2 * k + 1][3]);
        pf[k] = __builtin_bit_cast(bf16x8, w); }
    return sum;
}
template <int NT, class RB>
__device__ __forceinline__ void pv_store(ldsp Vb, const bf16x8 (&pf)[NT / 2], const RB& rb, float sum, bf16* orow  , int lane) {
    const int g = lane >> 4, q4 = (lane & 15) >> 2, p4 = lane & 3;
    f32x4 o[4];
#pragma unroll
    for (int dt = 0; dt < 4; ++dt) o[dt] = (f32x4){0.f, 0.f, 0.f, 0.f};
#pragma unroll
    for (int k = 0; k < NT / 2; ++k) { ldsp v0 = Vb + (rb(2 * k) + 4 * g + q4) * KPB + p4 * 8; ldsp v1 = Vb + (rb(2 * k + 1) + 4 * g + q4) * KPB + p4 * 8;
#pragma unroll
        for (int dt = 0; dt < 4; ++dt) { const bf16x8 vf = cat8(vtr(v0 + dt * 32), vtr(v1 + dt * 32)); o[dt] = mfma16(vf, pf[k], o[dt]); } }
    const float inv = 1.0f / sum;
#pragma unroll
    for (int dt = 0; dt < 4; ++dt) { u32x2 w; w.x = pk2(o[dt][0] * inv, o[dt][1] * inv); w.y = pk2(o[dt][2] * inv, o[dt][3] * inv); *(u32x2*)(orow + dt * 16 + 4 * g) = w; }
}

struct RbWin { int mt; __device__ __forceinline__ int operator()(int t) const { return 16 * (mt + t); } };
struct RbNa { int off, ct0, ct1; __device__ __forceinline__ int operator()(int t) const { return (off + (t >> 1)) * 64 + ((t & 1) ? ct1 : ct0) * 16; } };

struct AttnArgs { const bf16* qkv; bf16* o; const float* qn_a; const float* kn_a; const float* sink_a; const float* qn_b; const float* kn_b; const float* rpb; };

__device__ __forceinline__ void window_pair(ldsp Kb, ldsp Vb, const AttnArgs& A, int n, int kvh, int mt, int g4a, const u32x4 (&qra)[2], const u32x4 (&qrb)[2], int lane) {
    const int fr = lane & 15, g = lane >> 4, q4 = fr >> 2, p4 = lane & 3;
    const int hqa = kvh * 4 + g4a, hqb = hqa + 1;
    const int qtok = n * 128 + mt * 16 + fr;
    bf16x8 qfa[2], qfb[2]; finish_q(qfa, qra, A.qn_a, g); finish_q(qfb, qrb, A.qn_a, g);
    f32x4 sa[18], sb[18];
#pragma unroll
    for (int t = 0; t < 18; ++t) { ldsp kp = Kb + (16 * (mt + t) + fr) * KPB + g * 16; f32x4 a = (f32x4){0.f, 0.f, 0.f, 0.f}, b = a;
#pragma unroll
        for (int s = 0; s < 2; ++s) { const bf16x8 kf = *(const LAS bf16x8*)(kp + s * 64); a = mfma16(kf, qfa[s], a); b = mfma16(kf, qfb[s], b); }
        sa[t] = a; sb[t] = b; if ((t & 3) == 3) __builtin_amdgcn_sched_barrier(0); }
    {
        const float sla = exp2f(-(float)(hqa + 1)) * LOG2E, slb = sla * 0.5f;
        float cl = (float)(4 * g - 128 - fr); asm volatile("" : "+v"(cl));
        const float lo = (float)max(-128, -qtok), hi = (float)min(128, SEQ - 1 - qtok);
#pragma unroll
        for (int t = 0; t < 18; ++t)
#pragma unroll
            for (int r = 0; r < 4; ++r) { const float rel = cl + (float)(16 * t + r); const bool ok = (rel >= lo && rel <= hi); const float ar = fabsf(rel);
                sa[t][r] = ok ? fmaf(-sla, ar, sa[t][r]) : -INFINITY; sb[t][r] = ok ? fmaf(-slb, ar, sb[t][r]) : -INFINITY; }
    }
    bf16x8 pa[9], pb[9];
    const float suma = softmax_pack<18>(sa, pa, A.sink_a[hqa] * LOG2E, true);
    const float sumb = softmax_pack<18>(sb, pb, A.sink_a[hqb] * LOG2E, true);
    f32x4 oa[4], ob[4];
#pragma unroll
    for (int dt = 0; dt < 4; ++dt) { oa[dt] = (f32x4){0.f, 0.f, 0.f, 0.f}; ob[dt] = oa[dt]; }
#pragma unroll
    for (int k = 0; k < 9; ++k) { ldsp v0 = Vb + (16 * (mt + 2 * k) + 4 * g + q4) * KPB + p4 * 8; ldsp v1 = v0 + 16 * KPB;
#pragma unroll
        for (int dt = 0; dt < 4; ++dt) { const bf16x8 vf = cat8(vtr(v0 + dt * 32), vtr(v1 + dt * 32)); oa[dt] = mfma16(vf, pa[k], oa[dt]); ob[dt] = mfma16(vf, pb[k], ob[dt]); } }
    const float ia = 1.0f / suma, ib = 1.0f / sumb;
    bf16* orow = A.o + (size_t)qtok * LDO + hqa * 64;
#pragma unroll
    for (int dt = 0; dt < 4; ++dt) { u32x2 w; w.x = pk2(oa[dt][0] * ia, oa[dt][1] * ia); w.y = pk2(oa[dt][2] * ia, oa[dt][3] * ia); *(u32x2*)(orow + dt * 16 + 4 * g) = w;
        u32x2 w2; w2.x = pk2(ob[dt][0] * ib, ob[dt][1] * ib); w2.y = pk2(ob[dt][2] * ib, ob[dt][3] * ib); *(u32x2*)(orow + 64 + dt * 16 + 4 * g) = w2; }
}

__device__ __forceinline__ void window_compute(ldsp lds, const AttnArgs& A, int unit, int tid) {
    const int n = unit >> 1, kvh = unit & 1, lane = tid & 63, wid = __builtin_amdgcn_readfirstlane(tid >> 6);
    ldsp Kb = lds, Vb = lds + 400 * KPB;
    const int fr = lane & 15, g = lane >> 4;
    const bf16* qbase = A.qkv + (size_t)(n * 128 + wid * 16 + fr) * LDQ + COL_QA + kvh * 256;
    u32x4 q0[2], q1[2], q2[2], q3[2];
    load_q_raw(q0, qbase, g); load_q_raw(q1, qbase + 64, g); load_q_raw(q2, qbase + 128, g); load_q_raw(q3, qbase + 192, g);
    window_pair(Kb, Vb, A, n, kvh, wid, 0, q0, q1, lane);
    __builtin_amdgcn_sched_barrier(0);
    window_pair(Kb, Vb, A, n, kvh, wid, 2, q2, q3, lane);
}

constexpr int NA_ROWS = 704;
constexpr int NA_RPB_OFF = NA_ROWS * KPB;

__device__ __forceinline__ void na_unit(ldsp lds, const AttnArgs& A, int unit, int next_unit, u32x4 (&kreg)[11], int tid) {
    const int rq4 = unit >> 3, h = unit & 7, lane = tid & 63, wid = __builtin_amdgcn_readfirstlane(tid >> 6);
    const int r0 = 4 * rq4; const int base = min(max(r0 - 4, 0), 248);
    const int rq = r0 + (wid >> 1); const int rstart = min(max(rq - 4, 0), 248);
    const int fr = lane & 15, g = lane >> 4;
    store_rows<11, true>(lds, kreg, NA_ROWS, A.kn_b, tid);
    __syncthreads();
    const LAS float* rpl = (const LAS float*)(lds + NA_RPB_OFF);
    bf16x8 pf[2][8]; float sum[2]; int qtok[2]; int qcs[2]; u32x4 qraw[2][2];
#pragma unroll
    for (int it = 0; it < 2; ++it) { const int mt = 2 * (wid & 1) + it; qcs[it] = (mt < 3) ? 8 + 16 * mt + fr : (fr < 8 ? fr : 48 + fr); qtok[it] = rq * 64 + qcs[it];
        load_q_raw(qraw[it], A.qkv + (size_t)qtok[it] * LDQ + COL_QB + h * 64, g); }
#pragma unroll
    for (int it = 0; it < 2; ++it) {
        const int mt = 2 * (wid & 1) + it; const int qc = qcs[it];
        bf16x8 qf[2]; finish_q(qf, qraw[it], A.qn_b, g);
        RbNa rb{rstart - base, (mt < 3) ? mt : 0, (mt < 3) ? mt + 1 : 3};
        f32x4 sc[16]; scores<16>(sc, lds, qf, rb, lane);
        const int cstart = min(max(qc - 8, 0), 48);
        const int d0 = 4 * g - cstart;
        const LAS float* rpl0 = rpl + (rstart - rq + 7) * 128 + (4 * g - qc + 64);
#pragma unroll
        for (int t = 0; t < 16; ++t) { const int ct = (t & 1) ? rb.ct1 : rb.ct0; const LAS float* rp = rpl0 + (t >> 1) * 128 + 16 * ct; const int kb = 16 * ct + d0;
#pragma unroll
            for (int r = 0; r < 4; ++r) sc[t][r] = ((unsigned)(kb + r) < 16u) ? sc[t][r] + rp[r] : -INFINITY;
            if ((t & 3) == 3) __builtin_amdgcn_sched_barrier(0); }
        sum[it] = softmax_pack<16>(sc, pf[it], 0.f, false);
        __builtin_amdgcn_sched_barrier(0);
    }
    u32x4 vreg[11]; load_rows<11>(vreg, A.qkv + COL_VB + h * 64, base * 64, NA_ROWS, tid);
    __syncthreads();
    store_rows<11, false>(lds, vreg, NA_ROWS, nullptr, tid);
    if (next_unit >= 0) { const int nb = min(max(4 * (next_unit >> 3) - 4, 0), 248); load_rows<11>(kreg, A.qkv + COL_KB + h * 64, nb * 64, NA_ROWS, tid); }
    __syncthreads();
#pragma unroll
    for (int it = 0; it < 2; ++it) { const int mt = 2 * (wid & 1) + it; RbNa rb{rstart - base, (mt < 3) ? mt : 0, (mt < 3) ? mt + 1 : 3};
        pv_store<16>(lds, pf[it], rb, sum[it], A.o + (size_t)qtok[it] * LDO + 512 + h * 64, lane); __builtin_amdgcn_sched_barrier(0); }
    __syncthreads();
}

__device__ __forceinline__ void attn_phase(ldsp lds, const AttnArgs& A, int vcu, int G, int tid) {
    const int h = vcu & 7;
    u32x4 kreg[11];
#ifndef ATT_REP_WIN
#define ATT_REP_WIN 1
#define ATT_REP_NA 1
#endif
    for (int rw = 0; rw < ATT_REP_WIN; ++rw) {
        const int n = vcu >> 1, kvh = vcu & 1, tok0 = (n - 1) * 128;
        u32x4 kw[7], vw[7];
        load_rows<7>(kw, A.qkv + COL_KA + kvh * 64, tok0, 384, tid);
        load_rows<7>(vw, A.qkv + COL_VA + kvh * 64, tok0, 384, tid);
        store_rows<7, true>(lds, kw, 400, A.kn_a, tid);
        store_rows<7, false>(lds + 400 * KPB, vw, 400, nullptr, tid);
        __syncthreads();
        window_compute(lds, A, vcu, tid);
        __syncthreads();
    }
    for (int rn = 0; rn < ATT_REP_NA; ++rn) {
    { const int b0 = min(max(4 * (vcu >> 3) - 4, 0), 248); load_rows<11>(kreg, A.qkv + COL_KB + h * 64, b0 * 64, NA_ROWS, tid); }
    for (int i = tid; i < 15 * 128; i += 512) { const int ri = i >> 7, dc = i & 127; const int ci = min(max(dc - 49, 0), 30); ((LAS float*)(lds + NA_RPB_OFF))[i] = A.rpb[h * 465 + ri * 31 + ci] * LOG2E; }
    for (int k = 0; k < 2; ++k) { int t2 = tid; asm volatile("" : "+v"(t2));
        na_unit(lds, A, vcu + 256 * k, (k < 1) ? vcu + 256 * (k + 1) : -1, kreg, t2); }
    }
}
}
namespace ret {
constexpr int SEQ = 16384, LDG = 3072, NCH = 128;
constexpr int COL_Q = 0, COL_K = 512, COL_V = 1024, COL_G = 2048;
constexpr int KPB = 288;
constexpr int VPB = 544;
constexpr int UPB = 528;
constexpr int R0 = 0, R1 = 128 * KPB, R2 = 2 * 128 * KPB, RSTAT = R2 + 128 * VPB;
constexpr size_t ST_CHUNK = 128 * 256;

__device__ __forceinline__ unsigned pk2a(float lo, float hi) { unsigned r; asm volatile("v_cvt_pk_bf16_f32 %0, %1, %2" : "=v"(r) : "v"(lo), "v"(hi)); return r; }
struct RetArgs { bf16* G; bf16* ST; const float* l2;   const float* gn; int grp; int dry; bf16* Y; };

template <bool SCALE>
__device__ __forceinline__ void stage128(ldsp dst, const bf16* src, int ld, float a, float b, int tid) {
#pragma unroll
    for (int i = 0; i < 4; ++i) { const int idx = tid + i * 512, row = idx >> 4, ch = idx & 15;
        u32x4 v = *(const u32x4*)(src + (size_t)row * ld + ch * 8);
        if (SCALE) { const float s = ex2(a * (float)row + b);
            v.x = pk2a(bf_lo(v.x) * s, bf_hi(v.x) * s); v.y = pk2a(bf_lo(v.y) * s, bf_hi(v.y) * s); v.z = pk2a(bf_lo(v.z) * s, bf_hi(v.z) * s); v.w = pk2a(bf_lo(v.w) * s, bf_hi(v.w) * s); }
        *(LAS u32x4*)(dst + row * KPB + ch * 16) = v; }
}
__device__ __forceinline__ void stage256(ldsp dst, const bf16* src, int ld, int tid) {
#pragma unroll
    for (int i = 0; i < 8; ++i) { const int idx = tid + i * 512, row = idx >> 5, ch = idx & 31;
        const u32x4 v = *(const u32x4*)(src + (size_t)row * ld + ch * 8);
        *(LAS u32x4*)(dst + row * VPB + ch * 16) = v; }
}
__device__ __forceinline__ bf16x8 trfrag(ldsp X, int pitch, int k0, int n0, int lane) {
    const int g = lane >> 4, q4 = (lane & 15) >> 2, p4 = lane & 3;
    ldsp p = X + (k0 + 8 * g + q4) * pitch + (n0 + 4 * p4) * 2;
    return cat8(vtr(p), vtr(p + 4 * pitch));
}

__device__ __forceinline__ void ld128(u32x4 (&r)[4], const bf16* src, int ld, int tid) {
    const unsigned off0 = (unsigned)(((tid >> 4) * ld + (tid & 15) * 8) * 2);
#pragma unroll
    for (int i = 0; i < 4; ++i) r[i] = *(const u32x4*)((const char*)src + (size_t)i * 32 * ld * 2 + off0);
}
__device__ __forceinline__ void ld128nt(u32x4 (&r)[4], const bf16* src, int ld, int tid) {
    const unsigned off0 = (unsigned)(((tid >> 4) * ld + (tid & 15) * 8) * 2);
#pragma unroll
    for (int i = 0; i < 4; ++i) r[i] = __builtin_nontemporal_load((const u32x4*)((const char*)src + (size_t)i * 32 * ld * 2 + off0));
}
__device__ __forceinline__ void st128(ldsp dst, const u32x4 (&r)[4], int tid) {
    ldsp d0 = dst + (tid >> 4) * KPB + (tid & 15) * 16;
#pragma unroll
    for (int i = 0; i < 4; ++i) *(LAS u32x4*)(d0 + i * 32 * KPB) = r[i];
}
__device__ __forceinline__ void st128s(ldsp dst, const u32x4 (&r)[4], float a, float b, int tid) {
    ldsp d0 = dst + (tid >> 4) * KPB + (tid & 15) * 16;
#pragma unroll
    for (int i = 0; i < 4; ++i) { const int row = (tid >> 4) + 32 * i; const float s = ex2(a * (float)row + b); u32x4 v = r[i];
        v.x = pk2(bf_lo(v.x) * s, bf_hi(v.x) * s); v.y = pk2(bf_lo(v.y) * s, bf_hi(v.y) * s); v.z = pk2(bf_lo(v.z) * s, bf_hi(v.z) * s); v.w = pk2(bf_lo(v.w) * s, bf_hi(v.w) * s);
        *(LAS u32x4*)(d0 + i * 32 * KPB) = v; }
}
__device__ __forceinline__ void ld64(u32x4 (&r)[4], const bf16* src, int ld, int tid) {
    const unsigned off0 = (unsigned)(((tid >> 5) * ld + (tid & 31) * 8) * 2);
#pragma unroll
    for (int i = 0; i < 4; ++i) r[i] = *(const u32x4*)((const char*)src + (size_t)i * 16 * ld * 2 + off0);
}
__device__ __forceinline__ void ld64nt(u32x4 (&r)[4], const bf16* src, int ld, int tid) {
    const unsigned off0 = (unsigned)(((tid >> 5) * ld + (tid & 31) * 8) * 2);
#pragma unroll
    for (int i = 0; i < 4; ++i) r[i] = __builtin_nontemporal_load((const u32x4*)((const char*)src + (size_t)i * 16 * ld * 2 + off0));
}
__device__ __forceinline__ void st64(ldsp dst, const u32x4 (&r)[4], int tid) {
    ldsp d0 = dst + (tid >> 5) * VPB + (tid & 31) * 16;
#pragma unroll
    for (int i = 0; i < 4; ++i) *(LAS u32x4*)(d0 + i * 16 * VPB) = r[i];
}

__device__ __forceinline__ void ret_a_phase(ldsp lds, const RetArgs& A, int vcu, int G, int tid_in) {
    int tid = tid_in;
    const int wid = __builtin_amdgcn_readfirstlane(tid >> 6);
    int u = vcu; if (u >= 512) return;
    u32x4 rk[4], rv0[4], rv1[4];
    { const bf16* rows = A.G + (size_t)(u >> 2) * 128 * LDG; const int hl = u & 3;
      ld128nt(rk, rows + COL_K + hl * 128, LDG, tid); ld64nt(rv0, rows + COL_V + hl * 256, LDG, tid); ld64nt(rv1, rows + (size_t)64 * LDG + COL_V + hl * 256, LDG, tid); }
    for (;;) {
        asm volatile("" : "+v"(tid));
        const int lane = tid & 63, fr = lane & 15, g = lane >> 4;
        const int hl = u & 3, c = u >> 2, h = A.grp * 4 + hl;
        const float l2f = A.l2[h], l2b = A.l2[8 + h];
        st128s(lds + R0, rk, -l2f, 127.0f * l2f, tid);
        st128s(lds + R1, rk, l2b, 0.f, tid);
        st64(lds + R2, rv0, tid); st64(lds + R2 + 64 * VPB, rv1, tid);
        const int un = u + G; const bool has_next = un < 512;
        if (has_next) { const bf16* rows = A.G + (size_t)(un >> 2) * 128 * LDG; const int nhl = un & 3;
            ld128nt(rk, rows + COL_K + nhl * 128, LDG, tid); ld64nt(rv0, rows + COL_V + nhl * 256, LDG, tid); ld64nt(rv1, rows + (size_t)64 * LDG + COL_V + nhl * 256, LDG, tid); }
        __syncthreads();
        f32x4 acc[2][2][8];
#pragma unroll
        for (int dir = 0; dir < 2; ++dir) {
            ldsp Kx = lds + (dir ? R1 : R0);
#pragma unroll
            for (int et = 0; et < 2; ++et)
#pragma unroll
                for (int dt = 0; dt < 8; ++dt) acc[dir][et][dt] = (f32x4){0.f, 0.f, 0.f, 0.f};
#pragma unroll
            for (int ks = 0; ks < 4; ++ks) {
                bf16x8 vf[2];
#pragma unroll
                for (int et = 0; et < 2; ++et) vf[et] = trfrag(lds + R2, VPB, 32 * ks, 32 * wid + 16 * et, lane);
#pragma unroll
                for (int dt = 0; dt < 8; ++dt) { const bf16x8 kf = trfrag(Kx, KPB, 32 * ks, 16 * dt, lane);
#pragma unroll
                    for (int et = 0; et < 2; ++et) acc[dir][et][dt] = mfma16(vf[et], kf, acc[dir][et][dt]);
                    if ((dt & 3) == 3) __builtin_amdgcn_sched_barrier(0); }
            }
        }
        __syncthreads();
#pragma unroll
        for (int dir = 0; dir < 2; ++dir)
#pragma unroll
            for (int et = 0; et < 2; ++et)
#pragma unroll
                for (int dt = 0; dt < 8; ++dt) { u32x2 w; w.x = pk2(acc[dir][et][dt][0], acc[dir][et][dt][1]); w.y = pk2(acc[dir][et][dt][2], acc[dir][et][dt][3]);
                    *(LAS u32x2*)(lds + dir * (128 * UPB) + (16 * dt + fr) * UPB + (32 * wid + 16 * et + 4 * g) * 2) = w; }
        __syncthreads();
#pragma unroll
        for (int dir = 0; dir < 2; ++dir) { char* st = (char*)(A.ST + ((size_t)((dir * 4 + hl) * NCH + c)) * ST_CHUNK); const unsigned soff = (unsigned)((tid >> 5) * 512 + (tid & 31) * 16);
            ldsp s0 = lds + dir * (128 * UPB) + (tid >> 5) * UPB + (tid & 31) * 16;
#ifdef WT_MORE
            { const __amdgpu_buffer_rsrc_t srs = __builtin_amdgcn_make_buffer_rsrc((void*)st, 0, 0x7fffffff, 0x00020000);
#pragma unroll
            for (int i = 0; i < 8; ++i) __builtin_amdgcn_raw_buffer_store_b128(*(const LAS u32x4*)(s0 + i * 16 * UPB), srs, soff + i * 16 * 512, 0, 16); } }
#else
#pragma unroll
            for (int i = 0; i < 8; ++i) *(u32x4*)(st + (size_t)i * 16 * 512 + soff) = *(const LAS u32x4*)(s0 + i * 16 * UPB); }
#endif
        __syncthreads();
        if (!has_next) break;
        u = un;
    }
}

__device__ __forceinline__ void ret_b(const RetArgs& A, int vcu, int G, int tid) {
    const int NT = 8 * 16384;
    for (int T = vcu * 512 + tid; T < NT; T += G * 512) {
        const int dh = T >> 14, w = T & 16383, dir = dh >> 2, hl = dh & 3, h = A.grp * 4 + hl;
        const float dec = ex2(128.0f * A.l2[dir * 8 + h]);
        unsigned* p = (unsigned*)(A.ST + (size_t)dh * NCH * ST_CHUNK) + w;
        const ptrdiff_t cs = dir ? -(ptrdiff_t)(ST_CHUNK / 2) : (ptrdiff_t)(ST_CHUNK / 2);
        if (dir) p += (size_t)(NCH - 1) * (ST_CHUNK / 2);
        float s0 = 0.f, s1 = 0.f;
        for (int c = 0; c < NCH; c += 32) {
            unsigned u[32];
#pragma unroll
            for (int k = 0; k < 32; ++k) u[k] = __builtin_nontemporal_load(&p[(ptrdiff_t)k * cs]);
#pragma unroll
            for (int k = 0; k < 32; ++k) { p[(ptrdiff_t)k * cs] = A.dry ? u[k] : pk2(s0, s1); s0 = dec * s0 + bf_lo(u[k]); s1 = dec * s1 + bf_hi(u[k]); }
            p += 32 * cs;
        }
    }
}

constexpr int C_Q = 0, C_KA = 128 * KPB, C_B0 = 2 * 128 * KPB, C_B1 = C_B0 + 64 * VPB, C_STAT = C_B1 + 64 * VPB;
struct CPtrs { const bf16 *q, *k, *v, *sf, *sb; bf16* g; };
__device__ __forceinline__ CPtrs cptrs(const RetArgs& A, int unit) {
    const int hl = unit & 3, c = unit >> 2; bf16* rows = A.G + (size_t)c * 128 * LDG; CPtrs P;
    P.q = rows + COL_Q + hl * 128; P.k = rows + COL_K + hl * 128; P.v = rows + COL_V + hl * 256; P.g = rows + COL_G + hl * 256;
    P.sf = A.ST + ((size_t)((0 * 4 + hl) * NCH + c)) * ST_CHUNK; P.sb = A.ST + ((size_t)((1 * 4 + hl) * NCH + c)) * ST_CHUNK; return P;
}
__device__ __forceinline__ void half_mma(f32x4 (&acc)[2][8], ldsp buf, ldsp Bop, int kofs, int wid, int lane) {
    const int fr = lane & 15, g = lane >> 4;
#pragma unroll
    for (int ks = 0; ks < 2; ++ks) {
        bf16x8 xf[2];
#pragma unroll
        for (int et = 0; et < 2; ++et) xf[et] = trfrag(buf, VPB, 32 * ks, 32 * wid + 16 * et, lane);
#pragma unroll
        for (int it = 0; it < 8; ++it) { const bf16x8 bfrag = *(const LAS bf16x8*)(Bop + (16 * it + fr) * KPB + (kofs + 32 * ks + 8 * g) * 2);
#pragma unroll
            for (int et = 0; et < 2; ++et) acc[et][it] = mfma16(xf[et], bfrag, acc[et][it]);
            if ((it & 3) == 3) __builtin_amdgcn_sched_barrier(0); }
    }
}
__device__ __forceinline__ void ret_c_phase(ldsp lds, const RetArgs& A, int vcu, int G, int tid_in) {
    int tid = tid_in;
    const int wid = __builtin_amdgcn_readfirstlane(tid >> 6);
    int u = vcu; if (u >= 512) return;
    CPtrs P = cptrs(A, u);
    u32x4 r0[4], r1[4], r2[4], r3[4];
    ld128(r0, P.q, LDG, tid); ld128(r1, P.k, LDG, tid); ld64nt(r2, P.sf, 256, tid); ld64nt(r3, P.sf + 64 * 256, 256, tid);
    LAS float* stat = (LAS float*)(lds + C_STAT);
    for (;;) {
        asm volatile("" : "+v"(tid));
        const int lane = tid & 63, fr = lane & 15, g = lane >> 4;
        const int un = u + G; const bool has_next = un < 512;
        CPtrs N = P; if (has_next) N = cptrs(A, un);
        const int hl = u & 3, c = u >> 2, h = A.grp * 4 + hl;
        const float l2f = A.l2[h], l2b = A.l2[8 + h];
        st128(lds + C_Q, r0, tid); st128(lds + C_KA, r1, tid);
        ld64nt(r0, P.sb, 256, tid); ld64nt(r1, P.sb + 64 * 256, 256, tid);
        __syncthreads();
        f32x4 sa[8];
#pragma unroll
        for (int it = 0; it < 8; ++it) sa[it] = (f32x4){0.f, 0.f, 0.f, 0.f};
#pragma unroll
        for (int ks = 0; ks < 4; ++ks) { const bf16x8 kf = *(const LAS bf16x8*)(lds + C_KA + (16 * wid + fr) * KPB + (32 * ks + 8 * g) * 2);
#pragma unroll
            for (int it = 0; it < 8; ++it) { const bf16x8 qf = *(const LAS bf16x8*)(lds + C_Q + (16 * it + fr) * KPB + (32 * ks + 8 * g) * 2); sa[it] = mfma16(kf, qf, sa[it]); if ((it & 3) == 3) __builtin_amdgcn_sched_barrier(0); } }
        st64(lds + C_B0, r2, tid); ld64(r2, P.v, LDG, tid);
        __syncthreads();
#pragma unroll
        for (int it = 0; it < 8; ++it) { const int i = 16 * it + fr; float v[4];
#pragma unroll
            for (int r = 0; r < 4; ++r) { const int j = 16 * wid + 4 * g + r; const int dl = i - j; const float dm = dl >= 0 ? ex2((float)dl * l2f) : ex2((float)(-dl) * l2b); v[r] = sa[it][r] * dm; }
            u32x2 w; w.x = pk2(v[0], v[1]); w.y = pk2(v[2], v[3]);
            *(LAS u32x2*)(lds + C_KA + i * KPB + (16 * wid + 4 * g) * 2) = w; if (it & 1) __builtin_amdgcn_sched_barrier(0); }
        st64(lds + C_B1, r3, tid); ld64(r3, P.v + (size_t)64 * LDG, LDG, tid);
        f32x4 acc[2][8];
#pragma unroll
        for (int et = 0; et < 2; ++et)
#pragma unroll
            for (int it = 0; it < 8; ++it) acc[et][it] = (f32x4){0.f, 0.f, 0.f, 0.f};
        half_mma(acc, lds + C_B0, lds + C_Q, 0, wid, lane);
        __syncthreads();
        st64(lds + C_B0, r0, tid); if (has_next) ld128(r0, N.q, LDG, tid);
        half_mma(acc, lds + C_B1, lds + C_Q, 64, wid, lane);
        __syncthreads();
#pragma unroll
        for (int it = 0; it < 8; ++it) { const float fi = (float)(16 * it + fr); const float rt = ex2((fi + 1.0f) * l2f - (128.0f - fi) * l2b); acc[0][it] *= rt; acc[1][it] *= rt; }
        st64(lds + C_B1, r1, tid); if (has_next) ld128(r1, N.k, LDG, tid);
        half_mma(acc, lds + C_B0, lds + C_Q, 0, wid, lane);
        __syncthreads();
        st64(lds + C_B0, r2, tid); if (has_next) ld64nt(r2, N.sf, 256, tid);
        half_mma(acc, lds + C_B1, lds + C_Q, 64, wid, lane);
        __syncthreads();
#pragma unroll
        for (int it = 0; it < 8; ++it) { const float fi = (float)(16 * it + fr); const float sb = ex2((128.0f - fi) * l2b); acc[0][it] *= sb; acc[1][it] *= sb; }
        st64(lds + C_B1, r3, tid); if (has_next) ld64nt(r3, N.sf + 64 * 256, 256, tid);
        u32x2 gv[8][2]; f32x4 gw[2]; const unsigned goff = (unsigned)((fr * LDG + 32 * wid + 4 * g) * 2);
#pragma unroll
        for (int et = 0; et < 2; ++et) { const int e = 32 * wid + 16 * et + 4 * g; gw[et] = *(const f32x4*)(A.gn + h * 256 + e);
#pragma unroll
            for (int it = 0; it < 8; ++it) gv[it][et] = *(const u32x2*)((const char*)P.g + (size_t)(16 * it * LDG + 16 * et) * 2 + goff); }
        half_mma(acc, lds + C_B0, lds + C_KA, 0, wid, lane);
        __syncthreads();
        half_mma(acc, lds + C_B1, lds + C_KA, 64, wid, lane);
#pragma unroll
        for (int it = 0; it < 8; ++it) { float s1 = 0.f, s2 = 0.f;
#pragma unroll
            for (int et = 0; et < 2; ++et)
#pragma unroll
                for (int r = 0; r < 4; ++r) { const float y = acc[et][it][r]; s1 += y; s2 += y * y; }
            s1 += __shfl_xor(s1, 16); s1 += __shfl_xor(s1, 32); s2 += __shfl_xor(s2, 16); s2 += __shfl_xor(s2, 32);
            if (g == 0) { stat[((16 * it + fr) * 8 + wid) * 2] = s1; stat[((16 * it + fr) * 8 + wid) * 2 + 1] = s2; }
            if (it & 1) __builtin_amdgcn_sched_barrier(0); }
        __syncthreads();
#pragma unroll
        for (int it = 0; it < 8; ++it) { float s1 = 0.f, s2 = 0.f;
#pragma unroll
            for (int w = 0; w < 8; ++w) { s1 += stat[((16 * it + fr) * 8 + w) * 2]; s2 += stat[((16 * it + fr) * 8 + w) * 2 + 1]; }
            const float mu = s1 * (1.0f / 256.0f); const float var = fmaxf(s2 * (1.0f / 256.0f) - mu * mu, 0.f); const float rs = rsqrtf(var + 1e-5f);
#pragma unroll
            for (int et = 0; et < 2; ++et) { const int e = 32 * wid + 16 * et + 4 * g; const f32x4 y = acc[et][it]; const u32x2 gg = gv[it][et];
                u32x2 w; w.x = pk2(bf_lo(gg.x) * ((y[0] - mu) * rs * gw[et][0]), bf_hi(gg.x) * ((y[1] - mu) * rs * gw[et][1]));
                w.y = pk2(bf_lo(gg.y) * ((y[2] - mu) * rs * gw[et][2]), bf_hi(gg.y) * ((y[3] - mu) * rs * gw[et][3]));
                *(LAS u32x2*)(lds + C_B0 + (16 * it + fr) * UPB + e * 2) = w; }
            __builtin_amdgcn_sched_barrier(0); }
        __syncthreads();
        { char* yb = (char*)(A.Y + (size_t)c * 128 * 2048 + h * 256); const unsigned yoff = (unsigned)((tid >> 5) * 4096 + (tid & 31) * 16);
          ldsp s0 = lds + C_B0 + (tid >> 5) * UPB + (tid & 31) * 16;
#ifdef WT_MORE
          { const __amdgpu_buffer_rsrc_t yrs = __builtin_amdgcn_make_buffer_rsrc((void*)yb, 0, 0x7fffffff, 0x00020000);
#pragma unroll
          for (int i = 0; i < 8; ++i) __builtin_amdgcn_raw_buffer_store_b128(*(const LAS u32x4*)(s0 + i * 16 * UPB), yrs, yoff + i * 16 * 4096, 0, 16); } }
#else
#pragma unroll
          for (int i = 0; i < 8; ++i) *(u32x4*)(yb + (size_t)i * 16 * 4096 + yoff) = *(const LAS u32x4*)(s0 + i * 16 * UPB); }
#endif
        if (!has_next) break;
        u = un; P = N;
    }
    __syncthreads();
}
}
#define XB_TMO      128
#define XB_XCNT(j)  (256  + 64 * (j))
#define XB_XSUB(j)  (1280 + 64 * (j))
#define XB_XGEN(j)  (2304 + 64 * (j))
#define XB_TOP      3328
#define XB_TOPGEN   3392
#define XCD_BAR_WORDS 3456
#define XB_SPIN_CAP (1u << 18)

__device__ __forceinline__ unsigned xb_ld(unsigned* p)              { return __hip_atomic_load(p, __ATOMIC_RELAXED, __HIP_MEMORY_SCOPE_AGENT); }
__device__ __forceinline__ unsigned xb_add(unsigned* p, unsigned v) { return __hip_atomic_fetch_add(p, v, __ATOMIC_RELAXED, __HIP_MEMORY_SCOPE_AGENT); }
__device__ __forceinline__ unsigned xb_xcc_id() { return (unsigned)__builtin_amdgcn_s_getreg((3 << 11) | 20) & 0xFu; }
#define XB_SPIN(cond, bar) do { unsigned _sp = 0; while (cond) { __builtin_amdgcn_s_sleep(1); \
    if ((++_sp & 255u) == 0u) { if (xb_ld(&(bar)[XB_TMO])) break; if (_sp > XB_SPIN_CAP) { atomicAdd(&(bar)[XB_TMO], 1u); break; } } } } while (0)

struct XcdBarrier {
    unsigned* bar; unsigned x;
    volatile LAS unsigned* st;
};

__device__ __forceinline__ XcdBarrier xcd_barrier_post(unsigned* bar, volatile LAS unsigned* st) {
    XcdBarrier b; b.bar = bar; b.x = xb_xcc_id(); b.st = st;
    if (threadIdx.x == 0) (void)xb_add(&bar[XB_XCNT(b.x)], 1u);
    return b;
}
__device__ __forceinline__ void xcd_barrier_complete(unsigned* bar, unsigned x, unsigned& nloc, unsigned& nx) {
    const unsigned G = gridDim.x * gridDim.y * gridDim.z;
    unsigned sum, cnt, mine, sp = 0u;
    for (;;) {
        sum = 0u; cnt = 0u; mine = 0u;
#pragma unroll
        for (unsigned j = 0; j < 16; ++j) { const unsigned c = xb_ld(&bar[XB_XCNT(j)]); sum += c; cnt += (c > 0u) ? 1u : 0u; mine = (j == x) ? c : mine; }
        if (sum == G) break;
        __builtin_amdgcn_s_sleep(1);
        if ((++sp & 255u) == 0u) { if (xb_ld(&bar[XB_TMO])) break; if (sp > XB_SPIN_CAP) { atomicAdd(&bar[XB_TMO], 1u); break; } }
    }
    nloc = mine > 0u ? mine : 1u; nx = cnt > 0u ? cnt : 1u;
}

__device__ __forceinline__ void xcd_barrier(const XcdBarrier& b) {
    asm volatile("s_waitcnt vmcnt(0)" ::: "memory");
    __syncthreads();
    if (threadIdx.x == 0) {
        unsigned* bar = b.bar;
        __builtin_amdgcn_s_waitcnt(0);
        unsigned nloc = b.st[0], nx = b.st[1];
        if (nloc == 0u) { xcd_barrier_complete(bar, b.x, nloc, nx); b.st[0] = nloc; b.st[1] = nx; }
        const unsigned old = xb_add(&bar[XB_XSUB(b.x)], 1u);
        const unsigned gen = old / nloc;
        if (old + 1u == (gen + 1u) * nloc) {
            __builtin_amdgcn_fence(__ATOMIC_RELEASE, "agent");
            asm volatile("s_waitcnt vmcnt(0)" ::: "memory");
            const unsigned og = xb_add(&bar[XB_TOP], 1u);
            const unsigned tg = og / nx;
            if (og + 1u == (tg + 1u) * nx) xb_add(&bar[XB_TOPGEN], 1u);
            else XB_SPIN(xb_ld(&bar[XB_TOPGEN]) == tg, bar);
            __builtin_amdgcn_fence(__ATOMIC_ACQUIRE, "agent");
            xb_add(&bar[XB_XGEN(b.x)], 1u);
            asm volatile("s_waitcnt vmcnt(0)" ::: "memory");
        } else {
            XB_SPIN(xb_ld(&bar[XB_XGEN(b.x)]) == gen, bar);
            __builtin_amdgcn_fence(__ATOMIC_ACQUIRE, "agent");
            asm volatile("s_waitcnt vmcnt(0)" ::: "memory");
        }
    }
    __syncthreads();
}
constexpr int M_TOK = 16384, DM = 1024, DFF = 4096, N_IN_E = 2304, N_IN_O = 6144;
constexpr size_t MiB = 1u << 20;
constexpr size_t WS_CTL = 0;
constexpr size_t WS_L2 = 4096, WS_SSQ = 512 * 1024;
constexpr int CW_BAR = 4096;
constexpr size_t WS_W_IN_E = 1 * MiB;
constexpr size_t WS_W_OUT_E = WS_W_IN_E + (size_t)N_IN_E * DM * 2;
constexpr size_t WS_W_MLP_IN = WS_W_OUT_E + (size_t)DM * DM * 2;
constexpr size_t WS_W_MLP_OUT = WS_W_MLP_IN + 2 * (size_t)DFF * DM * 2;
constexpr size_t WS_W_IN_O = WS_W_MLP_OUT + 2 * (size_t)DFF * DM * 2;
constexpr size_t WS_W_OUT_O = WS_W_IN_O + (size_t)N_IN_O * DM * 2;
constexpr size_t WS_XB = 56 * MiB;
constexpr size_t WS_BIG = 88 * MiB;
constexpr size_t WS_END = 256 * MiB;
static_assert(WS_W_OUT_O + (size_t)DM * 2048 * 2 <= WS_XB, "weights fit below XB");

constexpr int RING_BYTES = 155648;
constexpr int LDS_BYTES = 159744;

struct Args { const float* in[19]; float* out; unsigned char* ws; int ph_lo, ph_hi; };
typedef const __attribute__((address_space(4))) Args* KArgs;

__device__ __forceinline__ float wave_sum(float v) {
#pragma unroll
    for (int o = 1; o < 64; o <<= 1) v += __shfl_xor(v, o);
    return v;
}
struct WItem { const float* W; int N; bf16* WT; int ldo; int k0, n0, orow0; const float* gain; float nscale; };
constexpr int WI_C0 = 1152, WI_C1 = WI_C0 + 512, WI_C2 = WI_C1 + 2048, WI_C3 = WI_C2 + 2048, WI_C4 = WI_C3 + 2048, WI_C5 = WI_C4 + 2048, WI_C6 = WI_C5 + 3072, WI_C7 = WI_C6 + 1024;
constexpr int WI_EARLY = WI_C3;
__device__ __forceinline__ void witem_decode(KArgs a, unsigned char* ws, int gi, WItem& d) {
    int item, K, mode = 0; d.gain = nullptr; d.nscale = 1.0f;
    if (gi < WI_C0)      { item = gi;         d.W = a->in[2];  K = DM;  d.N = N_IN_E; d.WT = (bf16*)(ws + WS_W_IN_E); d.gain = a->in[1]; }
    else if (gi < WI_C1) { item = gi - WI_C0; d.W = a->in[9];  K = DM;  d.N = DM;     d.WT = (bf16*)(ws + WS_W_OUT_E); }
    else if (gi < WI_C2) { item = gi - WI_C1; d.W = a->in[17]; K = DM;  d.N = DFF;    d.WT = (bf16*)(ws + WS_W_MLP_IN); d.gain = a->in[16]; }
    else if (gi < WI_C3) { item = gi - WI_C2; d.W = a->in[18]; K = DFF; d.N = DM;     d.WT = (bf16*)(ws + WS_W_MLP_OUT); }
    else if (gi < WI_C4) { item = gi - WI_C3; d.W = a->in[17] + (size_t)DM * DFF; K = DM; d.N = DFF; d.WT = (bf16*)(ws + WS_W_MLP_IN) + (size_t)DFF * DM; d.gain = a->in[16] + DM; }
    else if (gi < WI_C5) { item = gi - WI_C4; d.W = a->in[18] + (size_t)DFF * DM; K = DFF; d.N = DM; d.WT = (bf16*)(ws + WS_W_MLP_OUT) + (size_t)DFF * DM; }
    else if (gi < WI_C6) { item = gi - WI_C5; d.W = a->in[11]; K = DM;  d.N = N_IN_O; d.WT = (bf16*)(ws + WS_W_IN_O); d.gain = a->in[10]; mode = 1; }
    else                 { item = gi - WI_C6; d.W = a->in[15]; K = 2048; d.N = DM;    d.WT = (bf16*)(ws + WS_W_OUT_O); }
    const int nblk = d.N / 32, kb = item / nblk, nb = item % nblk; d.k0 = 64 * kb; d.n0 = 32 * nb; d.orow0 = d.n0; d.ldo = K;
    if (mode == 1) {
        const int n0 = d.n0;
        if (n0 < 1024) { d.orow0 = (n0 >> 9) * 3072 + (n0 & 511); }
        else if (n0 < 2048) { const int nk = n0 - 1024; d.orow0 = (nk >> 9) * 3072 + 512 + (nk & 511); d.nscale = 0.08838834764831845f; }
        else if (n0 < 4096) { const int nv = n0 - 2048; d.orow0 = (nv >> 10) * 3072 + 1024 + (nv & 1023); }
        else { const int ng = n0 - 4096; d.orow0 = (ng >> 10) * 3072 + 2048 + (ng & 1023); }
    }
}
__device__ __forceinline__ void witem_load(const WItem& d, float (&v)[32], int lane) {
#pragma unroll
    for (int i = 0; i < 32; ++i) { const int kk = 2 * i + (lane >> 5); v[i] = __builtin_nontemporal_load(&d.W[(size_t)(d.k0 + kk) * d.N + d.n0 + (lane & 31)]); }
}
__device__ __forceinline__ void witem_finish(const WItem& d, const float (&v)[32], LAS float* scr, int lane) {
#pragma unroll
    for (int i = 0; i < 32; ++i) { const int kk = 2 * i + (lane >> 5); const float gsc = d.gain ? d.gain[d.k0 + kk] * d.nscale : d.nscale; scr[kk * 33 + (lane & 31)] = v[i] * gsc; }
    asm volatile("s_waitcnt lgkmcnt(0)" ::: "memory");
    const int c = lane & 7;
#pragma unroll
    for (int j = 0; j < 4; ++j) { const int n = (lane >> 3) + 8 * j; const LAS float* s = scr + (8 * c) * 33 + n;
        u32x4 o; o.x = pk2(s[0 * 33], s[1 * 33]); o.y = pk2(s[2 * 33], s[3 * 33]); o.z = pk2(s[4 * 33], s[5 * 33]); o.w = pk2(s[6 * 33], s[7 * 33]);
        *(u32x4*)(d.WT + (size_t)(d.orow0 + n) * d.ldo + d.k0 + 8 * c) = o; }
    asm volatile("s_waitcnt lgkmcnt(0)" ::: "memory");
}
__device__ __forceinline__ void convert_items(KArgs a, ldsp lds, int gbeg, int gend, int wv, int nw, int tid) {
    const int lane = tid & 63, wave = __builtin_amdgcn_readfirstlane(tid >> 6);
    unsigned char* ws = a->ws;
    LAS float* scr = (LAS float*)(lds + wave * 16384);
    WItem cur, nxt; float va[32], vb[32];
    int gi = gbeg + wv;
    if (gi < gend) { witem_decode(a, ws, gi, cur); witem_load(cur, va, lane); }
    while (gi < gend) {
        const int g1 = gi + nw, g2 = gi + 2 * nw;
        if (g1 < gend) { witem_decode(a, ws, g1, nxt); witem_load(nxt, vb, lane); }
        witem_finish(cur, va, scr, lane);
        if (g1 >= gend) break;
        if (g2 < gend) { witem_decode(a, ws, g2, cur); witem_load(cur, va, lane); }
        witem_finish(nxt, vb, scr, lane);
        gi = g2;
    }
}
__device__ __forceinline__ void prologue(KArgs a, ldsp lds, int vcu, int G, int tid) {
    const int lane = tid & 63, wave = __builtin_amdgcn_readfirstlane(tid >> 6);
    unsigned char* ws = a->ws;
    const int gw = vcu * 8 + wave, NGW = G * 8;
    convert_items(a, lds, 0, WI_EARLY, gw, NGW, tid);
    const float* x = a->in[0]; bf16* XB = (bf16*)(ws + WS_XB); float* ssq = (float*)(ws + WS_SSQ);
    for (int m = gw; m < M_TOK; m += 2 * NGW) {
        const int m2 = m + NGW;
        const f32x4* xr0 = (const f32x4*)(x + (size_t)m * DM) + lane; const f32x4* xr1 = (const f32x4*)(x + (size_t)m2 * DM) + lane;
        f32x4 v0[4], v1[4];
#pragma unroll
        for (int j = 0; j < 4; ++j) { v0[j] = __builtin_nontemporal_load(&xr0[64 * j]); v1[j] = __builtin_nontemporal_load(&xr1[64 * j]); }
        unsigned long long* o0 = (unsigned long long*)(XB + (size_t)m * DM) + lane; unsigned long long* o1 = (unsigned long long*)(XB + (size_t)m2 * DM) + lane;
        float s0 = 0.f, s1 = 0.f;
#pragma unroll
        for (int j = 0; j < 4; ++j) { s0 += (v0[j][0] * v0[j][0] + v0[j][1] * v0[j][1]) + (v0[j][2] * v0[j][2] + v0[j][3] * v0[j][3]);
            s1 += (v1[j][0] * v1[j][0] + v1[j][1] * v1[j][1]) + (v1[j][2] * v1[j][2] + v1[j][3] * v1[j][3]);
            o0[64 * j] = (unsigned long long)pk2(v0[j][0], v0[j][1]) | ((unsigned long long)pk2(v0[j][2], v0[j][3]) << 32);
            o1[64 * j] = (unsigned long long)pk2(v1[j][0], v1[j][1]) | ((unsigned long long)pk2(v1[j][2], v1[j][3]) << 32); }
        s0 = wave_sum(s0); s1 = wave_sum(s1);
        if (lane == 0) { *(f32x4*)(ssq + 4 * (size_t)m) = (f32x4){s0, 0.f, 0.f, 0.f}; *(f32x4*)(ssq + 4 * (size_t)m2) = (f32x4){s1, 0.f, 0.f, 0.f}; }
    }
    if (vcu == 0 && tid < 16) { const float d = (tid < 8 ? a->in[12] : a->in[13])[tid & 7]; const float e = __expf(-d);
        const float l1p = (e < 0.0625f) ? e * (1.0f - e * (0.5f - e * ((1.0f / 3.0f) - e * (0.25f - e * 0.2f)))) : __logf(1.0f + e);
        ((float*)(ws + WS_L2))[tid] = -l1p * LOG2E; }
}

#ifndef DBG_DUMP
#define DBG_DUMP 0
#endif
#ifndef TS_T0
#define TS_T0 0
#define TS_GAIN 1e-3f
#endif
#ifndef GEMM_ALIGN
#define GEMM_ALIGN true
#endif
#ifndef GEMM_SP2
#define GEMM_SP2 true
#endif
#ifndef REP_PH
#define REP_PH (-1)
#define REP_N 0
#endif
#ifndef REP_COND
#define REP_COND true
#endif
#ifndef DBG_STRIDE
#define DBG_STRIDE 1
#endif
#ifndef DBG_HI
#define DBG_HI PH_COUNT
#endif
#ifndef DBG_LO
#define DBG_LO 0
#endif
#ifndef DBG_AOFF
#define DBG_AOFF 2048
#endif
#ifndef DBG_LDA
#define DBG_LDA 3072
#endif
#ifndef DBG_LDB
#define DBG_LDB 2048
#endif
#ifndef DBG_K
#define DBG_K 1024
#endif
enum { PH_PRO = 0, PH_IN_E, PH_ATTN, PH_OUT_E, PH_MLP_IN0, PH_MLP_OUT0, PH_IN_O0, PH_RA0, PH_RB0, PH_RC0, PH_IN_O1, PH_RA1, PH_RB1, PH_RC1, PH_OUT_O, PH_MLP_IN1, PH_MLP_OUT1, PH_COUNT };

__global__ void __launch_bounds__(512, 2) mk_fwd(Args a_unused) {
    extern __shared__ __attribute__((aligned(16))) unsigned char lds_raw[];
    cg::grid_group grid = cg::this_grid();
    const ldsp lds = (ldsp)lds_raw;
    volatile LAS unsigned* MISC = (volatile LAS unsigned*)(lds + RING_BYTES);
    if (threadIdx.x < 32) MISC[threadIdx.x] = 0u;
    __syncthreads();
    const XcdBarrier bar = xcd_barrier_post((unsigned*)(((KArgs)__builtin_amdgcn_kernarg_segment_ptr())->ws + WS_CTL) + CW_BAR, MISC + 8);
    const int G = gridDim.x;
    int repcnt = 0;
#ifdef TS_PH
    if (blockIdx.x == 0 && threadIdx.x == 0) ((volatile unsigned long long*)(((KArgs)__builtin_amdgcn_kernarg_segment_ptr())->ws + 32768))[0] = __builtin_amdgcn_s_memrealtime();
#endif
    const int ph_lo = ((KArgs)__builtin_amdgcn_kernarg_segment_ptr())->ph_lo, ph_hi = ((KArgs)__builtin_amdgcn_kernarg_segment_ptr())->ph_hi;
    for (int ph = ph_lo; ph < ph_hi; ++ph) {
        const __attribute__((address_space(4))) char* kp = (const __attribute__((address_space(4))) char*)__builtin_amdgcn_kernarg_segment_ptr();
        asm volatile("" : "+s"(kp));
        KArgs a = (KArgs)kp;
        unsigned char* ws = a->ws;
        bf16* XB = (bf16*)(ws + WS_XB); float* ssq = (float*)(ws + WS_SSQ);
        bf16* BIG = (bf16*)(ws + WS_BIG);
        bf16* QKV = BIG; bf16* OE = BIG + (size_t)M_TOK * N_IN_E; bf16* HM = BIG; bf16* GB = BIG; bf16* ST = BIG + (size_t)M_TOK * 3072;
        int tid = threadIdx.x, bx = blockIdx.x;
        asm volatile("" : "+v"(tid)); asm volatile("" : "+s"(bx));
        const int vcu = (G % 8 == 0) ? (bx % 8) * (G / 8) + bx / 8 : bx;
        if (ph == PH_PRO) { prologue(a, lds, vcu, G, tid); }
        else if (ph == PH_ATTN) {
            att::AttnArgs A{QKV, OE, a->in[3], a->in[4], a->in[5], a->in[6], a->in[7], a->in[8]};
            att::attn_phase(lds, A, vcu, G, tid);
        }
        else if (ph == PH_RA0 || ph == PH_RA1 || ph == PH_RB0 || ph == PH_RB1 || ph == PH_RC0 || ph == PH_RC1) {
            ret::RetArgs R{GB, ST, (const float*)(ws + WS_L2), a->in[14], (ph >= PH_IN_O1) ? 1 : 0, (REP_N > 0 && ph == REP_PH && repcnt > 0) ? 1 : 0, (bf16*)a->out};
            if (ph == PH_RA0 || ph == PH_RA1) { ret::ret_a_phase(lds, R, vcu, G, tid); }
            else if (ph == PH_RB0 || ph == PH_RB1) { ret::ret_b(R, vcu, G, tid); }
            else { ret::ret_c_phase(lds, R, vcu, G, tid); }
        }
        else if (ph == PH_IN_E || ph == PH_MLP_IN0 || ph == PH_MLP_IN1 || ph == PH_IN_O0 || ph == PH_IN_O1) {
            const bf16* Bt; int N, act, silu0; bf16* O;
            if (ph == PH_IN_E)           { Bt = (const bf16*)(ws + WS_W_IN_E); N = N_IN_E; O = QKV; act = 0; silu0 = 1 << 30; }
            else if (ph == PH_MLP_IN0)   { Bt = (const bf16*)(ws + WS_W_MLP_IN); N = DFF; O = HM; act = 1; silu0 = 1 << 30; }
            else if (ph == PH_MLP_IN1)   { Bt = (const bf16*)(ws + WS_W_MLP_IN) + (size_t)DFF * DM; N = DFF; O = HM; act = 1; silu0 = 1 << 30; }
            else if (ph == PH_IN_O0)     { Bt = (const bf16*)(ws + WS_W_IN_O); N = 3072; O = GB; act = 2; silu0 = 8; }
            else                         { Bt = (const bf16*)(ws + WS_W_IN_O) + (size_t)3072 * DM; N = 3072; O = GB; act = 2; silu0 = 8; }
            pg8::Gemm g; g.A = XB; g.Bt = Bt; g.lda = DM; g.ldb = DM; g.M = M_TOK; g.N = N; g.K = DM;
            pg8::EpiBf16 E; E.O = O; E.ldc = N; E.ssq = ssq; E.silu_pn0 = silu0; E.act = act;
            pg8::StaticOrder S; S.init(M_TOK, N, G, bx);
            pg8::gemm_phase<pg8::EpiBf16, pg8::StaticOrder, GEMM_ALIGN, GEMM_SP2>(lds, g, S, E, tid);
            if (ph == PH_IN_E && bx >= 64) convert_items(a, lds, WI_EARLY, WI_C7, (bx - 64) * 8 + __builtin_amdgcn_readfirstlane(tid >> 6), (G - 64) * 8, tid);
        }
        else {
            const bf16* A; const bf16* Bt; int lda, ldb, K; const float* basef; const bf16* baseb; float* outf; bf16* xb; float* sso;
            if (ph == PH_OUT_E)          { A = OE; lda = DM; K = DM; Bt = (const bf16*)(ws + WS_W_OUT_E); ldb = DM; basef = nullptr; baseb = XB; outf = nullptr; xb = XB; sso = ssq; }
            else if (ph == PH_MLP_OUT0)  { A = HM; lda = DFF; K = DFF; Bt = (const bf16*)(ws + WS_W_MLP_OUT); ldb = DFF; basef = nullptr; baseb = XB; outf = nullptr; xb = XB; sso = ssq; }
            else if (ph == PH_MLP_OUT1)  { A = HM; lda = DFF; K = DFF; Bt = (const bf16*)(ws + WS_W_MLP_OUT) + (size_t)DFF * DM; ldb = DFF; basef = nullptr; baseb = XB; outf = a->out; xb = nullptr; sso = nullptr; }
            else                         { A = (const bf16*)a->out; lda = 2048; K = 2048; Bt = (const bf16*)(ws + WS_W_OUT_O); ldb = 2048; basef = nullptr; baseb = XB; outf = nullptr; xb = XB; sso = ssq; }
            pg8::Gemm g; g.A = A; g.Bt = Bt; g.lda = lda; g.ldb = ldb; g.M = M_TOK; g.N = DM; g.K = K;
            pg8::EpiResid E; E.basef = basef; E.baseb = baseb; E.outf = outf; E.xb = xb; E.ssq_out = sso; E.ldc = DM;
            E.accscale = (REP_N > 0 && ph == REP_PH && repcnt > 0 && ph != PH_OUT_E && ph != PH_MLP_OUT1) ? 0.f : 1.f;
            pg8::StaticOrder S; S.init(M_TOK, DM, G, bx);
            pg8::gemm_phase<pg8::EpiResid, pg8::StaticOrder, false, GEMM_SP2>(lds, g, S, E, tid);
        }
        if (ph + 1 == ph_hi && DBG_DUMP) {
            xcd_barrier(bar);
            const bf16* srcb = (DBG_DUMP == 1) ? GB : ST;
            for (size_t i = (size_t)bx * 512 + tid; i < (size_t)M_TOK * DM; i += (size_t)G * 512) a->out[i] = bf_lo((unsigned)srcb[i * DBG_STRIDE]);
        }
#ifdef NOP_REPS
        if (ph == NOP_AT) { for (int q = 0; q < NOP_REPS; ++q) xcd_barrier(bar); }
#endif
        if (ph + 1 < ph_hi) {
            if (ph_lo < 0) {
                asm volatile("s_waitcnt vmcnt(0)" ::: "memory");
                grid.sync();
                __builtin_amdgcn_fence(__ATOMIC_ACQUIRE, "agent");
                asm volatile("s_waitcnt vmcnt(0)" ::: "memory");
                __syncthreads();
            }
            xcd_barrier(bar);
#ifdef TS_PH
            if (blockIdx.x == 0 && threadIdx.x == 0) ((volatile unsigned long long*)(ws + 32768))[ph + 1] = __builtin_amdgcn_s_memrealtime();
#endif
        }
        if (REP_N > 0 && ph == REP_PH && repcnt < REP_N && REP_COND) { ++repcnt; --ph; }
    }
#ifdef TS_PH
    {
        xcd_barrier(bar);
        if (blockIdx.x == 0 && threadIdx.x == 0) { KArgs a = (KArgs)__builtin_amdgcn_kernarg_segment_ptr(); volatile unsigned long long* ts = (volatile unsigned long long*)(a->ws + 32768);
            unsigned long long t1 = (TS_PH == PH_COUNT - 1) ? __builtin_amdgcn_s_memrealtime() : ts[TS_PH + 1];
#ifdef TS_TOTAL
            a->out[0] += 0.1f + ((float)(__builtin_amdgcn_s_memrealtime() - ts[0]) * 0.01f - (float)TS_T0) * TS_GAIN; }
#else
            a->out[0] += 0.1f + ((float)(t1 - ts[TS_PH]) * 0.01f - (float)TS_T0) * TS_GAIN; }
#endif
    }
#endif
}

extern "C" void kernel_launch(void* const* d_in, const int* in_sizes, int n_in, void* d_out, int out_size, void* d_ws, size_t ws_size, hipStream_t stream) {
    static int grid = 0;
    if (grid == 0) {
        int dev = 0, cus = 0, per_cu = 0;
        (void)hipGetDevice(&dev);
        (void)hipDeviceGetAttribute(&cus, hipDeviceAttributeMultiprocessorCount, dev);
        (void)hipFuncSetAttribute((const void*)mk_fwd, hipFuncAttributeMaxDynamicSharedMemorySize, LDS_BYTES);
        (void)hipOccupancyMaxActiveBlocksPerMultiprocessor(&per_cu, (const void*)mk_fwd, 512, LDS_BYTES);
        grid = (n_in == 19 && per_cu >= 1 && cus == 256 && ws_size >= WS_END && out_size == M_TOK * DM) ? 256 : -1;
        if (grid < 0) fprintf(stderr, "kernel_launch: unsupported configuration (cus %d per_cu %d ws %zu n_in %d)\n", cus, per_cu, ws_size, n_in);
    }
    if (grid < 0) return;
    if (hipMemsetAsync((char*)d_ws + WS_CTL, 0, 65536, stream) != hipSuccess) { fprintf(stderr, "kernel_launch: memset failed\n"); return; }
    Args a{};
    for (int i = 0; i < 19; ++i) a.in[i] = (const float*)d_in[i];
    a.out = (float*)d_out; a.ws = (unsigned char*)d_ws; a.ph_lo = DBG_LO; a.ph_hi = DBG_HI;
    void* args[] = {&a};
#ifdef PLAIN_LAUNCH
    hipError_t e = hipLaunchKernel((void*)mk_fwd, dim3(grid), dim3(512), args, LDS_BYTES, stream);
#else
    hipError_t e = hipLaunchCooperativeKernel((void*)mk_fwd, dim3(grid), dim3(512), args, LDS_BYTES, stream);
#endif
    if (e != hipSuccess) fprintf(stderr, "cooperative launch failed: %s\n", hipGetErrorString(e));
}
```

```cpp
#include <hip/hip_runtime.h>
#include <hip/hip_cooperative_groups.h>
#include <cstdio>
#include <cstdint>
#include <cmath>
namespace cg = cooperative_groups;
namespace pg8 {
#define PG8_LAS __attribute__((address_space(3)))
typedef unsigned short bf16_t;
typedef short bf16x8 __attribute__((ext_vector_type(8)));
typedef float f32x4 __attribute__((ext_vector_type(4)));
typedef float f32x2 __attribute__((ext_vector_type(2)));
typedef unsigned u32x4 __attribute__((ext_vector_type(4)));
typedef unsigned u32x2 __attribute__((ext_vector_type(2)));
constexpr int BM = 256, BK = 64, HALF = 128, HTB = HALF * BK * 2  , STAGE_BYTES = 8 * HTB, NXCD = 8, WGM = 8;

__host__ __device__ __forceinline__ int lds_byte(int r, int c) { const int st = (r >> 4) * 2 + (c >> 5), rr = r & 15, cc = c & 31, ob = rr * 64 + cc * 2; return st * 1024 + (ob ^ (((ob >> 9) & 1) << 5)); }
__host__ __device__ __forceinline__ void stage_rc(int b, int& R, int& C) { const int st = b / 1024, sb = b % 1024, swz = sb ^ (((sb >> 9) & 1) << 5); R = (st >> 1) * 16 + swz / 64; C = (st & 1) * 32 + (swz % 64) / 2; }
__host__ __device__ __forceinline__ int perm32(int rho) { const int n = rho >> 4, i = rho & 15; return 8 * (i >> 2) + 4 * n + (i & 3); }

struct Unit { int pm, pn; };
struct Gemm { const bf16_t* A; const bf16_t* Bt; int lda, ldb, M, N, K; };

struct StaticOrder {
    int nM, nN, nwg, G, c;
    __host__ __device__ void init(int M, int N, int G_, int c_) { nM = M / BM; nN = N / BM; nwg = nM * nN; G = G_; c = c_; }
    __host__ __device__ bool next(int i, Unit& u) const {
        const long L = (long)i * G + c; if (L >= nwg) return false;
        int wgid = (int)L; { const int q = nwg / NXCD, r = nwg % NXCD, xcd = wgid % NXCD, off = wgid / NXCD; wgid = (xcd < r ? xcd * (q + 1) : r * (q + 1) + (xcd - r) * q) + off; }
        const int nig = WGM * nN, gid = wgid / nig, fm = gid * WGM, gsz = (nM - fm) < WGM ? (nM - fm) : WGM;
        u.pm = fm + ((wgid % nig) % gsz); u.pn = (wgid % nig) / gsz; return true;
    }
};

typedef float f32x2_cv __attribute__((ext_vector_type(2))); typedef __bf16 bf16x2_cv __attribute__((ext_vector_type(2)));
__device__ __forceinline__ unsigned cvt_pk_bf16(float lo, float hi) { const f32x2_cv v = {lo, hi}; const bf16x2_cv b = __builtin_convertvector(v, bf16x2_cv); return __builtin_bit_cast(unsigned, b); }


__device__ __forceinline__ float row_rstd(const float* ssq, int row) { const f32x4 p = *(const f32x4*)(ssq + 4 * (size_t)row); return rsqrtf(((p[0] + p[1]) + (p[2] + p[3])) * (1.0f / 1024.0f) + 1e-6f); }

struct EpiBf16 {
    static constexpr bool PERM = true, AFTER_DRAIN = false;
    bf16_t* O; int ldc; const float* ssq; int silu_pn0; int act;
    __device__ __forceinline__ void preload(float (&rsv)[8], int pm, int wr, int fr) const {
        const int row0 = pm * BM + wr * 64 + fr;
#pragma unroll
        for (int ai = 0; ai < 2; ++ai)
#pragma unroll
            for (int m = 0; m < 4; ++m) rsv[ai * 4 + m] = row_rstd(ssq, row0 + ai * HALF + m * 16);
    }
    template <int ACT>
    __device__ __forceinline__ void body(const f32x4 (&acc)[2][2][4][2], const Unit& u, int wr, int wc, int fr, int fq, const float (&rsv)[8]) const {
        const int row0 = u.pm * BM + wr * 64 + fr; const int col0 = u.pn * BM + wc * 32 + 8 * fq;
        const __amdgpu_buffer_rsrc_t rsrc = __builtin_amdgcn_make_buffer_rsrc((void*)O, 0, 0x7fffffff, 0x00020000);
#pragma unroll
        for (int ai = 0; ai < 2; ++ai)
#pragma unroll
            for (int m = 0; m < 4; ++m) { const int row = row0 + ai * HALF + m * 16; const float rs = rsv[ai * 4 + m];
#pragma unroll
                for (int bj = 0; bj < 2; ++bj) { f32x4 v0 = acc[ai][bj][m][0] * rs, v1 = acc[ai][bj][m][1] * rs;
                    if (ACT == 1) { f32x4 r0, r1;
#pragma unroll
                        for (int e = 0; e < 4; ++e) { r0[e] = __int_as_float(max(__float_as_int(v0[e]), 0)); r1[e] = __int_as_float(max(__float_as_int(v1[e]), 0)); }
                        v0 = r0 * r0; v1 = r1 * r1; }
                    if (ACT == 2) {
#pragma unroll
                        for (int e = 0; e < 4; ++e) { v0[e] = v0[e] * __builtin_amdgcn_rcpf(1.0f + __builtin_amdgcn_exp2f(-1.4426950408889634f * v0[e])); v1[e] = v1[e] * __builtin_amdgcn_rcpf(1.0f + __builtin_amdgcn_exp2f(-1.4426950408889634f * v1[e])); } }
                    u32x4 w; w.x = cvt_pk_bf16(v0[0], v0[1]); w.y = cvt_pk_bf16(v0[2], v0[3]); w.z = cvt_pk_bf16(v1[0], v1[1]); w.w = cvt_pk_bf16(v1[2], v1[3]);
                    __builtin_amdgcn_raw_buffer_store_b128(w, rsrc, (unsigned)(((size_t)row * ldc + col0 + bj * HALF) * 2), 0, 16);
                    } }
    }
    __device__ __forceinline__ void operator()(const f32x4 (&acc)[2][2][4][2], const Unit& u, int wr, int wc, int fr, int fq, float (&rsv)[8], int& rs_pm) const {
        if (rs_pm != u.pm) { preload(rsv, u.pm, wr, fr); rs_pm = u.pm; }
        if (act == 1) body<1>(acc, u, wr, wc, fr, fq, rsv);
        else if (act == 2 && u.pn >= silu_pn0) body<2>(acc, u, wr, wc, fr, fq, rsv);
        else body<0>(acc, u, wr, wc, fr, fq, rsv);
    }
};

struct EpiResid {
    static constexpr bool PERM = true, AFTER_DRAIN = true;
    const float* basef; const bf16_t* baseb; float* outf; bf16_t* xb; float* ssq_out; int ldc; float accscale;
    __device__ __forceinline__ void fused(f32x4 (&acc)[2][2][4][2], const Unit& u, int wr, int wc, int fr, int fq, PG8_LAS unsigned char* lds, int wid, int lane) const {
        PG8_LAS float* P = (PG8_LAS float*)lds;
        const int col0 = u.pn * BM + wc * 32 + 8 * fq;
#ifdef WT_MORE
        const __amdgpu_buffer_rsrc_t xrs = __builtin_amdgcn_make_buffer_rsrc((void*)xb, 0, 0x7fffffff, 0x00020000);
#endif
#pragma unroll
        for (int ai = 0; ai < 2; ++ai)
#pragma unroll
            for (int m = 0; m < 4; ++m) { const int r = ai * HALF + wr * 64 + m * 16 + fr; const size_t off = (size_t)(u.pm * BM + r) * ldc + col0; float s = 0.f;
#pragma unroll
                for (int bj = 0; bj < 2; ++bj) { const size_t o2 = off + bj * HALF; f32x4 b0, b1;
                    if (basef) { b0 = *(const f32x4*)(basef + o2); b1 = *(const f32x4*)(basef + o2 + 4); }
                    else { const u32x4 b = *(const u32x4*)(baseb + o2);
                        b0 = (f32x4){__uint_as_float(b.x << 16), __uint_as_float(b.x & 0xffff0000u), __uint_as_float(b.y << 16), __uint_as_float(b.y & 0xffff0000u)};
                        b1 = (f32x4){__uint_as_float(b.z << 16), __uint_as_float(b.z & 0xffff0000u), __uint_as_float(b.w << 16), __uint_as_float(b.w & 0xffff0000u)}; }
                    const f32x4 o0 = b0 + acc[ai][bj][m][0] * accscale, o1 = b1 + acc[ai][bj][m][1] * accscale;
                    if (outf) { *(f32x4*)(outf + o2) = o0; *(f32x4*)(outf + o2 + 4) = o1; }
                    if (xb) { u32x4 w; w.x = cvt_pk_bf16(o0[0], o0[1]); w.y = cvt_pk_bf16(o0[2], o0[3]); w.z = cvt_pk_bf16(o1[0], o1[1]); w.w = cvt_pk_bf16(o1[2], o1[3]);
#ifdef WT_MORE
                        __builtin_amdgcn_raw_buffer_store_b128(w, xrs, (unsigned)(o2 * 2), 0, 16);
#else
                        *(u32x4*)(xb + o2) = w;
#endif
                    }
                    s += ((o0[0] * o0[0] + o0[1] * o0[1]) + (o0[2] * o0[2] + o0[3] * o0[3])) + ((o1[0] * o1[0] + o1[1] * o1[1]) + (o1[2] * o1[2] + o1[3] * o1[3])); }
                if (ssq_out) { s += __shfl_xor(s, 16); s += __shfl_xor(s, 32); if (fq == 0) P[r * 4 + wc] = s; }
                if (m & 1) asm volatile("" ::: "memory"); }
        if (ssq_out) {
            __syncthreads();
            const int t = wid * 64 + lane;
            if (t < 256) { const float s = (P[t * 4 + 0] + P[t * 4 + 1]) + (P[t * 4 + 2] + P[t * 4 + 3]); ssq_out[(size_t)(u.pm * BM + t) * 4 + u.pn] = s; }
            __syncthreads();
        }
    }
};

template <class Epi, class Sched, bool ALIGN_EPI = false, bool SP2 = false>
__device__ __forceinline__ void gemm_phase(PG8_LAS unsigned char* lds, const Gemm g, const Sched& S, const Epi& E, const int tid) {
    const int wid = __builtin_amdgcn_readfirstlane(tid >> 6), lane = tid & 63, wr = wid >> 2, wc = wid & 3, fr = lane & 15, fq = lane >> 4;
    const int K = g.K, nt = K / BK;
    unsigned voffA[2], voffB[2];
#pragma unroll
    for (int i = 0; i < 2; ++i) { int R, C; stage_rc(tid * 16 + i * 8192, R, C); const int Rb = Epi::PERM ? ((R & ~31) + perm32(R & 31)) : R;
        voffA[i] = (unsigned)(R * g.lda + C) * 2u; voffB[i] = (unsigned)(Rb * g.ldb + C) * 2u; }
    const size_t kstep = (size_t)(BK * 2);
    const size_t hstepA = (size_t)HALF * g.lda * 2, hstepB = (size_t)HALF * g.ldb * 2;
    const size_t tstepA = 2 * hstepA, tstepB = 2 * hstepB;
    const unsigned ldsw = (unsigned)wid * 1024u;
    const int aoff = lds_byte(wr * 64 + fr, fq * 8), boff = lds_byte(wc * 32 + fr, fq * 8);
#define PG8_SA(b, h) (((b) * 2 + (h)) * HTB)
#define PG8_SB(b, h) ((4 + (b) * 2 + (h)) * HTB)
#define PG8_STAGE(bufoff, gbase, voff) do { _Pragma("unroll") for (int _i = 0; _i < 2; ++_i) \
        __builtin_amdgcn_global_load_lds((const unsigned*)((const char*)(gbase) + (voff)[_i]), (PG8_LAS unsigned*)(lds + (bufoff) + ldsw + _i * 8192), 16, 0, 0); } while (0)
#define PG8_LDA(dst, b, h) do { _Pragma("unroll") for (int m = 0; m < 4; ++m) _Pragma("unroll") for (int k = 0; k < 2; ++k) dst[m][k] = *(const PG8_LAS bf16x8*)(lds + PG8_SA(b, h) + aoff + m * 2048 + k * 1024); } while (0)
#define PG8_LDB(dst, b, h) do { _Pragma("unroll") for (int n = 0; n < 2; ++n) _Pragma("unroll") for (int k = 0; k < 2; ++k) dst[n][k] = *(const PG8_LAS bf16x8*)(lds + PG8_SB(b, h) + boff + n * 2048 + k * 1024); } while (0)
#define PG8_MMA(ai, bj, At, Bt) do { __builtin_amdgcn_s_setprio(1); _Pragma("unroll") for (int m = 0; m < 4; ++m) _Pragma("unroll") for (int n = 0; n < 2; ++n) _Pragma("unroll") for (int k = 0; k < 2; ++k) \
        acc[ai][bj][m][n] = __builtin_amdgcn_mfma_f32_16x16x32_bf16(Bt[n][k], At[m][k], acc[ai][bj][m][n], 0, 0, 0); __builtin_amdgcn_s_setprio(0); } while (0)
#define PG8_WAIT_V(n) asm volatile("s_waitcnt vmcnt(" #n ")" ::: "memory")
#define PG8_WAIT_L(n) asm volatile("s_waitcnt lgkmcnt(" #n ")" ::: "memory")
#define PG8_BAR __builtin_amdgcn_s_barrier()
#define PG8_SCHED __builtin_amdgcn_sched_barrier(0)
    Unit cur, nxt; int ui = 0;
    if (!S.next(0, cur)) return;
    f32x4 acc[2][2][4][2];
#pragma unroll
    for (int a = 0; a < 2; ++a)
#pragma unroll
        for (int b = 0; b < 2; ++b)
#pragma unroll
            for (int m = 0; m < 4; ++m)
#pragma unroll
                for (int n = 0; n < 2; ++n) acc[a][b][m][n] = (f32x4){0.f, 0.f, 0.f, 0.f};
    bf16x8 At[4][2], B0[2][2], B1[2][2];
    const char* cA = (const char*)g.A + (size_t)cur.pm * tstepA; const char* cB = (const char*)g.Bt + (size_t)cur.pn * tstepB;
    float rsv[8]; int rs_pm = -1;
    if constexpr (!Epi::AFTER_DRAIN) { E.preload(rsv, cur.pm, wr, fr); rs_pm = cur.pm; }
    if constexpr (SP2) {
        PG8_STAGE(PG8_SB(0, 0), cB, voffB); PG8_STAGE(PG8_SB(0, 1), cB + hstepB, voffB); PG8_STAGE(PG8_SA(0, 0), cA, voffA); PG8_STAGE(PG8_SA(0, 1), cA + hstepA, voffA);
        if (wr == 1) PG8_BAR;
        PG8_WAIT_V(2); PG8_BAR;
        PG8_STAGE(PG8_SB(1, 0), cB + kstep, voffB); PG8_STAGE(PG8_SA(1, 0), cA + kstep, voffA); PG8_STAGE(PG8_SB(1, 1), cB + hstepB + kstep, voffB);
        PG8_WAIT_V(6); PG8_BAR;
    } else {
        PG8_STAGE(PG8_SB(0, 0), cB, voffB); PG8_STAGE(PG8_SA(0, 0), cA, voffA); PG8_STAGE(PG8_SB(0, 1), cB + hstepB, voffB); PG8_STAGE(PG8_SA(0, 1), cA + hstepA, voffA);
        if (wr == 1) PG8_BAR;
        PG8_WAIT_V(4); PG8_BAR;
        PG8_STAGE(PG8_SB(1, 0), cB + kstep, voffB); PG8_STAGE(PG8_SA(1, 0), cA + kstep, voffA); PG8_STAGE(PG8_SB(1, 1), cB + hstepB + kstep, voffB);
        PG8_WAIT_V(6); PG8_BAR;
    }
    for (;;) {
        const bool has_next = S.next(ui + 1, nxt);
        const char* nA = has_next ? (const char*)g.A + (size_t)nxt.pm * tstepA : cA; const char* nB = has_next ? (const char*)g.Bt + (size_t)nxt.pn * tstepB : cB;
        for (int t = 0; t < nt; t += 2) {
            const bool last = (t == nt - 2);
            const char* a1 = cA + (size_t)(t + 1) * kstep;
            const char* a2 = last ? nA : cA + (size_t)(t + 2) * kstep; const char* b2 = last ? nB : cB + (size_t)(t + 2) * kstep;
            const char* a3 = a2 + kstep; const char* b3 = b2 + kstep;
            if constexpr (SP2) {
            PG8_LDB(B0, 0, 0); PG8_LDB(B1, 0, 1); PG8_SCHED; PG8_LDA(At, 0, 0); PG8_STAGE(PG8_SA(1, 1), a1 + hstepA, voffA);
            PG8_WAIT_V(8); PG8_WAIT_L(0); PG8_BAR; PG8_MMA(0, 0, At, B0); PG8_MMA(0, 1, At, B1); PG8_BAR; PG8_SCHED;
            PG8_LDA(At, 0, 1); PG8_STAGE(PG8_SB(0, 0), b2, voffB); PG8_STAGE(PG8_SB(0, 1), b2 + hstepB, voffB); PG8_STAGE(PG8_SA(0, 0), a2, voffA);
            PG8_WAIT_V(8); PG8_WAIT_L(0); PG8_BAR; PG8_MMA(1, 0, At, B0); PG8_MMA(1, 1, At, B1); PG8_BAR; PG8_SCHED;
            PG8_LDB(B0, 1, 0); PG8_LDB(B1, 1, 1); PG8_SCHED; PG8_LDA(At, 1, 0); PG8_STAGE(PG8_SA(0, 1), a2 + hstepA, voffA);
            PG8_WAIT_V(8); PG8_WAIT_L(0); PG8_BAR; PG8_MMA(0, 0, At, B0); PG8_MMA(0, 1, At, B1); PG8_BAR; PG8_SCHED;
            PG8_LDA(At, 1, 1); PG8_STAGE(PG8_SB(1, 0), b3, voffB); PG8_STAGE(PG8_SB(1, 1), b3 + hstepB, voffB); PG8_STAGE(PG8_SA(1, 0), a3, voffA);
            PG8_WAIT_V(8); PG8_WAIT_L(0); PG8_BAR; PG8_MMA(1, 0, At, B0); PG8_MMA(1, 1, At, B1); PG8_BAR; PG8_SCHED;
            } else {
            PG8_LDB(B0, 0, 0); PG8_SCHED; PG8_LDA(At, 0, 0); PG8_STAGE(PG8_SA(1, 1), a1 + hstepA, voffA);
            PG8_WAIT_L(8); PG8_BAR; PG8_WAIT_L(0); PG8_MMA(0, 0, At, B0); PG8_BAR; PG8_SCHED;
            PG8_LDB(B1, 0, 1); PG8_STAGE(PG8_SB(0, 0), b2, voffB);
            PG8_BAR; PG8_WAIT_L(0); PG8_MMA(0, 1, At, B1); PG8_BAR;
            PG8_LDA(At, 0, 1); PG8_STAGE(PG8_SA(0, 0), a2, voffA);
            PG8_BAR; PG8_WAIT_L(0); PG8_MMA(1, 0, At, B0); PG8_BAR; PG8_SCHED;
            PG8_STAGE(PG8_SB(0, 1), b2 + hstepB, voffB);
            PG8_WAIT_V(6); PG8_BAR; PG8_MMA(1, 1, At, B1); PG8_BAR;
            PG8_LDB(B0, 1, 0); PG8_SCHED; PG8_LDA(At, 1, 0); PG8_STAGE(PG8_SA(0, 1), a2 + hstepA, voffA);
            PG8_WAIT_L(8); PG8_BAR; PG8_WAIT_L(0); PG8_MMA(0, 0, At, B0); PG8_BAR; PG8_SCHED;
            PG8_LDB(B1, 1, 1); PG8_STAGE(PG8_SB(1, 0), b3, voffB);
            PG8_BAR; PG8_WAIT_L(0); PG8_MMA(0, 1, At, B1); PG8_BAR;
            PG8_LDA(At, 1, 1); PG8_STAGE(PG8_SA(1, 0), a3, voffA);
            PG8_BAR; PG8_WAIT_L(0); PG8_MMA(1, 0, At, B0); PG8_BAR; PG8_SCHED;
            PG8_STAGE(PG8_SB(1, 1), b3 + hstepB, voffB);
            PG8_WAIT_V(6); PG8_BAR; PG8_MMA(1, 1, At, B1); PG8_BAR;
            }
        }
        if constexpr (ALIGN_EPI) { if (wr == 0) PG8_BAR; }
        if constexpr (!Epi::AFTER_DRAIN) { E(acc, cur, wr, wc, fr, fq, rsv, rs_pm); }
        if (!has_next) break;
#pragma unroll
        for (int a = 0; a < 2; ++a)
#pragma unroll
            for (int b = 0; b < 2; ++b)
#pragma unroll
                for (int m = 0; m < 4; ++m)
#pragma unroll
                    for (int n = 0; n < 2; ++n) acc[a][b][m][n] = (f32x4){0.f, 0.f, 0.f, 0.f};
        cur = nxt; cA = nA; cB = nB; ++ui;
        if constexpr (ALIGN_EPI) { if (wr == 1) PG8_BAR; }
    }
    PG8_WAIT_V(0);
    if constexpr (!ALIGN_EPI) { if (wr == 0) PG8_BAR; }
    PG8_BAR;
    if constexpr (Epi::AFTER_DRAIN) { E.fused(acc, cur, wr, wc, fr, fq, lds, wid, lane); }
#undef PG8_SA
#undef PG8_SB
#undef PG8_STAGE
#undef PG8_LDA
#undef PG8_LDB
#undef PG8_MMA
#undef PG8_WAIT_V
#undef PG8_WAIT_L
#undef PG8_BAR
#undef PG8_SCHED
}
}
#define LAS __attribute__((address_space(3)))
typedef unsigned short bf16;
typedef short bf16x8 __attribute__((ext_vector_type(8)));
typedef short s16x4 __attribute__((ext_vector_type(4)));
typedef float f32x4 __attribute__((ext_vector_type(4)));
typedef unsigned u32x4 __attribute__((ext_vector_type(4)));
typedef unsigned u32x2 __attribute__((ext_vector_type(2)));
typedef LAS unsigned char* ldsp;
constexpr float LOG2E = 1.4426950408889634f;

__device__ __forceinline__ float bf_lo(unsigned w) { return __uint_as_float(w << 16); }
__device__ __forceinline__ float bf_hi(unsigned w) { return __uint_as_float(w & 0xffff0000u); }
__device__ __forceinline__ unsigned pk2(float lo, float hi) { return pg8::cvt_pk_bf16(lo, hi); }
__device__ __forceinline__ s16x4 vtr(ldsp p) { typedef short v4i16_t __attribute__((ext_vector_type(4))); return __builtin_bit_cast(s16x4, __builtin_amdgcn_ds_read_tr16_b64_v4i16((LAS v4i16_t*)p)); }
__device__ __forceinline__ bf16x8 cat8(s16x4 lo, s16x4 hi) { return (bf16x8){lo[0], lo[1], lo[2], lo[3], hi[0], hi[1], hi[2], hi[3]}; }
__device__ __forceinline__ f32x4 mfma16(bf16x8 a, bf16x8 b, f32x4 c) { return __builtin_amdgcn_mfma_f32_16x16x32_bf16(a, b, c, 0, 0, 0); }
__device__ __forceinline__ float ex2(float x) { return __builtin_amdgcn_exp2f(x); }

namespace att {
constexpr int SEQ = 16384, LDQ = 2304, LDO = 1024;
constexpr int KPB = 160;
constexpr int COL_QA = 0, COL_KA = 512, COL_VA = 640, COL_QB = 768, COL_KB = 1280, COL_VB = 1792;

template <int NP>
__device__ __forceinline__ void load_rows(u32x4 (&v)[NP], const bf16* src, int tok0, int nvalid, int tid) {
    const int sub = tid & 7;
#pragma unroll
    for (int p = 0; p < NP; ++p) { const int r = (tid >> 3) + 64 * p, tok = tok0 + r; const bool ok = (tok >= 0) && (tok < SEQ) && (r < nvalid);
        v[p] = (u32x4){0u, 0u, 0u, 0u};
        if (ok) v[p] = *(const u32x4*)(src + (size_t)tok * LDQ + sub * 8); }
}
template <int NP, bool NORM>
__device__ __forceinline__ void store_rows(ldsp dst, const u32x4 (&v)[NP], int nrows, const float* gain, int tid) {
    const int sub = tid & 7;
    float gn[8];
    if (NORM) {
#pragma unroll
        for (int j = 0; j < 8; ++j) gn[j] = gain[sub * 8 + j];
    }
#pragma unroll
    for (int p = 0; p < NP; ++p) { const int r = (tid >> 3) + 64 * p;
        if (r < nrows) {
            u32x4 w = v[p];
            if (NORM) {
                float f[8]; f[0] = bf_lo(w.x); f[1] = bf_hi(w.x); f[2] = bf_lo(w.y); f[3] = bf_hi(w.y); f[4] = bf_lo(w.z); f[5] = bf_hi(w.z); f[6] = bf_lo(w.w); f[7] = bf_hi(w.w);
                float ss = 0.f;
#pragma unroll
                for (int j = 0; j < 8; ++j) ss += f[j] * f[j];
                ss += __shfl_xor(ss, 1); ss += __shfl_xor(ss, 2); ss += __shfl_xor(ss, 4);
                const float rs = rsqrtf(ss * (1.0f / 64.0f) + 1e-6f);
#pragma unroll
                for (int j = 0; j < 8; ++j) f[j] = f[j] * rs * gn[j];
                w.x = pk2(f[0], f[1]); w.y = pk2(f[2], f[3]); w.z = pk2(f[4], f[5]); w.w = pk2(f[6], f[7]);
            }
            *(LAS u32x4*)(dst + r * KPB + sub * 16) = w;
        } }
}

__device__ __forceinline__ void load_q_raw(u32x4 (&raw)[2], const bf16* qrow  , int g) {
#pragma unroll
    for (int s = 0; s < 2; ++s) raw[s] = *(const u32x4*)(qrow + 32 * s + 8 * g);
}
__device__ __forceinline__ void finish_q(bf16x8 (&qf)[2], const u32x4 (&raw)[2], const float* gain, int g) {
    float f[2][8]; float ss = 0.f;
#pragma unroll
    for (int s = 0; s < 2; ++s) { const u32x4 v = raw[s];
        f[s][0] = bf_lo(v.x); f[s][1] = bf_hi(v.x); f[s][2] = bf_lo(v.y); f[s][3] = bf_hi(v.y); f[s][4] = bf_lo(v.z); f[s][5] = bf_hi(v.z); f[s][6] = bf_lo(v.w); f[s][7] = bf_hi(v.w);
#pragma unroll
        for (int j = 0; j < 8; ++j) ss += f[s][j] * f[s][j]; }
    ss += __shfl_xor(ss, 16); ss += __shfl_xor(ss, 32);
    const float rs = rsqrtf(ss * (1.0f / 64.0f) + 1e-6f) * (0.125f * LOG2E);
#pragma unroll
    for (int s = 0; s < 2; ++s) { float o[8];
#pragma unroll
        for (int j = 0; j < 8; ++j) o[j] = f[s][j] * rs * gain[32 * s + 8 * g + j];
        u32x4 w; w.x = pk2(o[0], o[1]); w.y = pk2(o[2], o[3]); w.z = pk2(o[4], o[5]); w.w = pk2(o[6], o[7]);
        qf[s] = __builtin_bit_cast(bf16x8, w); }
}

template <int NT, class RB>
__device__ __forceinline__ void scores(f32x4 (&sc)[NT], ldsp Kb, const bf16x8 (&qf)[2], const RB& rb, int lane) {
    const int fr = lane & 15, g = lane >> 4;
#pragma unroll
    for (int t = 0; t < NT; ++t) { ldsp kp = Kb + (rb(t) + fr) * KPB + g * 16; f32x4 a = (f32x4){0.f, 0.f, 0.f, 0.f};
#pragma unroll
        for (int s = 0; s < 2; ++s) { const bf16x8 kf = *(const LAS bf16x8*)(kp + s * 64); a = mfma16(kf, qf[s], a); }
        sc[t] = a; if ((t & 3) == 3) __builtin_amdgcn_sched_barrier(0); }
}
template <int NT>
__device__ __forceinline__ float softmax_pack(f32x4 (&sc)[NT], bf16x8 (&pf)[NT / 2], float sink2, bool has_sink) {
    float m = -INFINITY;
#pragma unroll
    for (int t = 0; t < NT; ++t)
#pragma unroll
        for (int r = 0; r < 4; ++r) m = fmaxf(m, sc[t][r]);
    m = fmaxf(m, __shfl_xor(m, 16)); m = fmaxf(m, __shfl_xor(m, 32));
    if (has_sink) m = fmaxf(m, sink2);
    float sum = 0.f;
#pragma unroll
    for (int t = 0; t < NT; ++t)
#pragma unroll
        for (int r = 0; r < 4; ++r) { const float p = ex2(sc[t][r] - m); sc[t][r] = p; sum += p; }
    sum += __shfl_xor(sum, 16); sum += __shfl_xor(sum, 32);
    if (has_sink) sum += ex2(sink2 - m);
#pragma unroll
    for (int k = 0; k < NT / 2; ++k) { u32x4 w; w.x = pk2(sc[2 * k][0], sc[2 * k][1]); w.y = pk2(sc[2 * k][2], sc[2 * k][3]); w.z = pk2(sc[2 * k + 1][0], sc[2 * k + 1][1]); w.w = pk2(sc[2 * k + 1][2], sc[2 * k + 1][3]);
        pf[k] = __builtin_bit_cast(bf16x8, w); }
    return sum;
}
template <int NT, class RB>
__device__ __forceinline__ void pv_store(ldsp Vb, const bf16x8 (&pf)[NT / 2], const RB& rb, float sum, bf16* orow  , int lane) {
    const int g = lane >> 4, q4 = (lane & 15) >> 2, p4 = lane & 3;
    f32x4 o[4];
#pragma unroll
    for (int dt = 0; dt < 4; ++dt) o[dt] = (f32x4){0.f, 0.f, 0.f, 0.f};
#pragma unroll
    for (int k = 0; k < NT / 2; ++k) { ldsp v0 = Vb + (rb(2 * k) + 4 * g + q4) * KPB + p4 * 8; ldsp v1 = Vb + (rb(2 * k + 1) + 4 * g + q4) * KPB + p4 * 8;
#pragma unroll
        for (int dt = 0; dt < 4; ++dt) { const bf16x8 vf = cat8(vtr(v0 + dt * 32), vtr(v1 + dt * 32)); o[dt] = mfma16(vf, pf[k], o[dt]); } }
    const float inv = 1.0f / sum;
#pragma unroll
    for (int dt = 0; dt < 4; ++dt) { u32x2 w; w.x = pk2(o[dt][0] * inv, o[dt][1] * inv); w.y = pk2(o[dt][2] * inv, o[dt][3] * inv); *(u32x2*)(orow + dt * 16 + 4 * g) = w; }
}

struct RbWin { int mt; __device__ __forceinline__ int operator()(int t) const { return 16 * (mt + t); } };
struct RbNa { int off, ct0, ct1; __device__ __forceinline__ int operator()(int t) const { return (off + (t >> 1)) * 64 + ((t & 1) ? ct1 : ct0) * 16; } };

struct AttnArgs { const bf16* qkv; bf16* o; const float* qn_a; const float* kn_a; const float* sink_a; const float* qn_b; const float* kn_b; const float* rpb; };

__device__ __forceinline__ void window_pair(ldsp Kb, ldsp Vb, const AttnArgs& A, int n, int kvh, int mt, int g4a, const u32x4 (&qra)[2], const u32x4 (&qrb)[2], int lane) {
    const int fr = lane & 15, g = lane >> 4, q4 = fr >> 2, p4 = lane & 3;
    const int hqa = kvh * 4 + g4a, hqb = hqa + 1;
    const int qtok = n * 128 + mt * 16 + fr;
    bf16x8 qfa[2], qfb[2]; finish_q(qfa, qra, A.qn_a, g); finish_q(qfb, qrb, A.qn_a, g);
    f32x4 sa[18], sb[18];
#pragma unroll
    for (int t = 0; t < 18; ++t) { ldsp kp = Kb + (16 * (mt + t) + fr) * KPB + g * 16; f32x4 a = (f32x4){0.f, 0.f, 0.f, 0.f}, b = a;
#pragma unroll
        for (int s = 0; s < 2; ++s) { const bf16x8 kf = *(const LAS bf16x8*)(kp + s * 64); a = mfma16(kf, qfa[s], a); b = mfma16(kf, qfb[s], b); }
        sa[t] = a; sb[t] = b; if ((t & 3) == 3) __builtin_amdgcn_sched_barrier(0); }
    {
        const float sla = exp2f(-(float)(hqa + 1)) * LOG2E, slb = sla * 0.5f;
        float cl = (float)(4 * g - 128 - fr); asm volatile("" : "+v"(cl));
        const float lo = (float)max(-128, -qtok), hi = (float)min(128, SEQ - 1 - qtok);
#pragma unroll
        for (int t = 0; t < 18; ++t)
#pragma unroll
            for (int r = 0; r < 4; ++r) { const float rel = cl + (float)(16 * t + r); const bool ok = (rel >= lo && rel <= hi); const float ar = fabsf(rel);
                sa[t][r] = ok ? fmaf(-sla, ar, sa[t][r]) : -INFINITY; sb[t][r] = ok ? fmaf(-slb, ar, sb[t][r]) : -INFINITY; }
    }
    bf16x8 pa[9], pb[9];
    const float suma = softmax_pack<18>(sa, pa, A.sink_a[hqa] * LOG2E, true);
    const float sumb = softmax_pack<18>(sb, pb, A.sink_a[hqb] * LOG2E, true);
    f32x4 oa[4], ob[4];
#pragma unroll
    for (int dt = 0; dt < 4; ++dt) { oa[dt] = (f32x4){0.f, 0.f, 0.f, 0.f}; ob[dt] = oa[dt]; }
#pragma unroll
    for (int k = 0; k < 9; ++k) { ldsp v0 = Vb + (16 * (mt + 2 * k) + 4 * g + q4) * KPB + p4 * 8; ldsp v1 = v0 + 16 * KPB;
#pragma unroll
        for (int dt = 0; dt < 4; ++dt) { const bf16x8 vf = cat8(vtr(v0 + dt * 32), vtr(v1 + dt * 32)); oa[dt] = mfma16(vf, pa[k], oa[dt]); ob[dt] = mfma16(vf, pb[k], ob[dt]); } }
    const float ia = 1.0f / suma, ib = 1.0f / sumb;
    bf16* orow = A.o + (size_t)qtok * LDO + hqa * 64;
#pragma unroll
    for (int dt = 0; dt < 4; ++dt) { u32x2 w; w.x = pk2(oa[dt][0] * ia, oa[dt][1] * ia); w.y = pk2(oa[dt][2] * ia, oa[dt][3] * ia); *(u32x2*)(orow + dt * 16 + 4 * g) = w;
        u32x2 w2; w2.x = pk2(ob[dt][0] * ib, ob[dt][1] * ib); w2.y = pk2(ob[dt][2] * ib, ob[dt][3] * ib); *(u32x2*)(orow + 64 + dt * 16 + 4 * g) = w2; }
}

__device__ __forceinline__ void window_compute(ldsp lds, const AttnArgs& A, int unit, int tid) {
    const int n = unit >> 1, kvh = unit & 1, lane = tid & 63, wid = __builtin_amdgcn_readfirstlane(tid >> 6);
    ldsp Kb = lds, Vb = lds + 400 * KPB;
    const int fr = lane & 15, g = lane >> 4;
    const bf16* qbase = A.qkv + (size_t)(n * 128 + wid * 16 + fr) * LDQ + COL_QA + kvh * 256;
    u32x4 q0[2], q1[2], q2[2], q3[2];
    load_q_raw(q0, qbase, g); load_q_raw(q1, qbase + 64, g); load_q_raw(q2, qbase + 128, g); load_q_raw(q3, qbase + 192, g);
    window_pair(Kb, Vb, A, n, kvh, wid, 0, q0, q1, lane);
    __builtin_amdgcn_sched_barrier(0);
    window_pair(Kb, Vb, A, n, kvh, wid, 2, q2, q3, lane);
}

constexpr int NA_ROWS = 704;
constexpr int NA_RPB_OFF = NA_ROWS * KPB;

__device__ __forceinline__ void na_unit(ldsp lds, const AttnArgs& A, int unit, int next_unit, u32x4 (&kreg)[11], int tid) {
    const int rq4 = unit >> 3, h = unit & 7, lane = tid & 63, wid = __builtin_amdgcn_readfirstlane(tid >> 6);
    const int r0 = 4 * rq4; const int base = min(max(r0 - 4, 0), 248);
    const int rq = r0 + (wid >> 1); const int rstart = min(max(rq - 4, 0), 248);
    const int fr = lane & 15, g = lane >> 4;
    store_rows<11, true>(lds, kreg, NA_ROWS, A.kn_b, tid);
    __syncthreads();
    const LAS float* rpl = (const LAS float*)(lds + NA_RPB_OFF);
    bf16x8 pf[2][8]; float sum[2]; int qtok[2]; int qcs[2]; u32x4 qraw[2][2];
#pragma unroll
    for (int it = 0; it < 2; ++it) { const int mt = 2 * (wid & 1) + it; qcs[it] = (mt < 3) ? 8 + 16 * mt + fr : (fr < 8 ? fr : 48 + fr); qtok[it] = rq * 64 + qcs[it];
        load_q_raw(qraw[it], A.qkv + (size_t)qtok[it] * LDQ + COL_QB + h * 64, g); }
#pragma unroll
    for (int it = 0; it < 2; ++it) {
        const int mt = 2 * (wid & 1) + it; const int qc = qcs[it];
        bf16x8 qf[2]; finish_q(qf, qraw[it], A.qn_b, g);
        RbNa rb{rstart - base, (mt < 3) ? mt : 0, (mt < 3) ? mt + 1 : 3};
        f32x4 sc[16]; scores<16>(sc, lds, qf, rb, lane);
        const int cstart = min(max(qc - 8, 0), 48);
        const int d0 = 4 * g - cstart;
        const LAS float* rpl0 = rpl + (rstart - rq + 7) * 128 + (4 * g - qc + 64);
#pragma unroll
        for (int t = 0; t < 16; ++t) { const int ct = (t & 1) ? rb.ct1 : rb.ct0; const LAS float* rp = rpl0 + (t >> 1) * 128 + 16 * ct; const int kb = 16 * ct + d0;
#pragma unroll
            for (int r = 0; r < 4; ++r) sc[t][r] = ((unsigned)(kb + r) < 16u) ? sc[t][r] + rp[r] : -INFINITY;
            if ((t & 3) == 3) __builtin_amdgcn_sched_barrier(0); }
        sum[it] = softmax_pack<16>(sc, pf[it], 0.f, false);
        __builtin_amdgcn_sched_barrier(0);
    }
    u32x4 vreg[11]; load_rows<11>(vreg, A.qkv + COL_VB + h * 64, base * 64, NA_ROWS, tid);
    __syncthreads();
    store_rows<11, false>(lds, vreg, NA_ROWS, nullptr, tid);
    if (next_unit >= 0) { const int nb = min(max(4 * (next_unit >> 3) - 4, 0), 248); load_rows<11>(kreg, A.qkv + COL_KB + h * 64, nb * 64, NA_ROWS, tid); }
    __syncthreads();
#pragma unroll
    for (int it = 0; it < 2; ++it) { const int mt = 2 * (wid & 1) + it; RbNa rb{rstart - base, (mt < 3) ? mt : 0, (mt < 3) ? mt + 1 : 3};
        pv_store<16>(lds, pf[it], rb, sum[it], A.o + (size_t)qtok[it] * LDO + 512 + h * 64, lane); __builtin_amdgcn_sched_barrier(0); }
    __syncthreads();
}

__device__ __forceinline__ void attn_phase(ldsp lds, const AttnArgs& A, int vcu, int G, int tid) {
    const int h = vcu & 7;
    u32x4 kreg[11];
#ifndef ATT_REP_WIN
#define ATT_REP_WIN 1
#define ATT_REP_NA 1
#endif
    for (int rw = 0; rw < ATT_REP_WIN; ++rw) {
        const int n = vcu >> 1, kvh = vcu & 1, tok0 = (n - 1) * 128;
        u32x4 kw[7], vw[7];
        load_rows<7>(kw, A.qkv + COL_KA + kvh * 64, tok0, 384, tid);
        load_rows<7>(vw, A.qkv + COL_VA + kvh * 64, tok0, 384, tid);
        store_rows<7, true>(lds, kw, 400, A.kn_a, tid);
        store_rows<7, false>(lds + 400 * KPB, vw, 400, nullptr, tid);
        __syncthreads();
        window_compute(lds, A, vcu, tid);
        __syncthreads();
    }
    for (int rn = 0; rn < ATT_REP_NA; ++rn) {
    { const int b0 = min(max(4 * (vcu >> 3) - 4, 0), 248); load_rows<11>(kreg, A.qkv + COL_KB + h * 64, b0 * 64, NA_ROWS, tid); }
    for (int i = tid; i < 15 * 128; i += 512) { const int ri = i >> 7, dc = i & 127; const int ci = min(max(dc - 49, 0), 30); ((LAS float*)(lds + NA_RPB_OFF))[i] = A.rpb[h * 465 + ri * 31 + ci] * LOG2E; }
    for (int k = 0; k < 2; ++k) { int t2 = tid; asm volatile("" : "+v"(t2));
        na_unit(lds, A, vcu + 256 * k, (k < 1) ? vcu + 256 * (k + 1) : -1, kreg, t2); }
    }
}
}
namespace ret {
constexpr int SEQ = 16384, LDG = 3072, NCH = 128;
constexpr int COL_Q = 0, COL_K = 512, COL_V = 1024, COL_G = 2048;
constexpr int KPB = 288;
constexpr int VPB = 544;
constexpr int UPB = 528;
constexpr int R0 = 0, R1 = 128 * KPB, R2 = 2 * 128 * KPB, RSTAT = R2 + 128 * VPB;
constexpr size_t ST_CHUNK = 128 * 256;

__device__ __forceinline__ unsigned pk2a(float lo, float hi) { unsigned r; asm volatile("v_cvt_pk_bf16_f32 %0, %1, %2" : "=v"(r) : "v"(lo), "v"(hi)); return r; }
struct RetArgs { bf16* G; bf16* ST; const float* l2;   const float* gn; int grp; int dry; bf16* Y; };

template <bool SCALE>
__device__ __forceinline__ void stage128(ldsp dst, const bf16* src, int ld, float a, float b, int tid) {
#pragma unroll
    for (int i = 0; i < 4; ++i) { const int idx = tid + i * 512, row = idx >> 4, ch = idx & 15;
        u32x4 v = *(const u32x4*)(src + (size_t)row * ld + ch * 8);
        if (SCALE) { const float s = ex2(a * (float)row + b);
            v.x = pk2a(bf_lo(v.x) * s, bf_hi(v.x) * s); v.y = pk2a(bf_lo(v.y) * s, bf_hi(v.y) * s); v.z = pk2a(bf_lo(v.z) * s, bf_hi(v.z) * s); v.w = pk2a(bf_lo(v.w) * s, bf_hi(v.w) * s); }
        *(LAS u32x4*)(dst + row * KPB + ch * 16) = v; }
}
__device__ __forceinline__ void stage256(ldsp dst, const bf16* src, int ld, int tid) {
#pragma unroll
    for (int i = 0; i < 8; ++i) { const int idx = tid + i * 512, row = idx >> 5, ch = idx & 31;
        const u32x4 v = *(const u32x4*)(src + (size_t)row * ld + ch * 8);
        *(LAS u32x4*)(dst + row * VPB + ch * 16) = v; }
}
__device__ __forceinline__ bf16x8 trfrag(ldsp X, int pitch, int k0, int n0, int lane) {
    const int g = lane >> 4, q4 = (lane & 15) >> 2, p4 = lane & 3;
    ldsp p = X + (k0 + 8 * g + q4) * pitch + (n0 + 4 * p4) * 2;
    return cat8(vtr(p), vtr(p + 4 * pitch));
}

__device__ __forceinline__ void ld128(u32x4 (&r)[4], const bf16* src, int ld, int tid) {
    const unsigned off0 = (unsigned)(((tid >> 4) * ld + (tid & 15) * 8) * 2);
#pragma unroll
    for (int i = 0; i < 4; ++i) r[i] = *(const u32x4*)((const char*)src + (size_t)i * 32 * ld * 2 + off0);
}
__device__ __forceinline__ void ld128nt(u32x4 (&r)[4], const bf16* src, int ld, int tid) {
    const unsigned off0 = (unsigned)(((tid >> 4) * ld + (tid & 15) * 8) * 2);
#pragma unroll
    for (int i = 0; i < 4; ++i) r[i] = __builtin_nontemporal_load((const u32x4*)((const char*)src + (size_t)i * 32 * ld * 2 + off0));
}
__device__ __forceinline__ void st128(ldsp dst, const u32x4 (&r)[4], int tid) {
    ldsp d0 = dst + (tid >> 4) * KPB + (tid & 15) * 16;
#pragma unroll
    for (int i = 0; i < 4; ++i) *(LAS u32x4*)(d0 + i * 32 * KPB) = r[i];
}
__device__ __forceinline__ void st128s(ldsp dst, const u32x4 (&r)[4], float a, float b, int tid) {
    ldsp d0 = dst + (tid >> 4) * KPB + (tid & 15) * 16;
#pragma unroll
    for (int i = 0; i < 4; ++i) { const int row = (tid >> 4) + 32 * i; const float s = ex2(a * (float)row + b); u32x4 v = r[i];
        v.x = pk2(bf_lo(v.x) * s, bf_hi(v.x) * s); v.y = pk2(bf_lo(v.y) * s, bf_hi(v.y) * s); v.z = pk2(bf_lo(v.z) * s, bf_hi(v.z) * s); v.w = pk2(bf_lo(v.w) * s, bf_hi(v.w) * s);
        *(LAS u32x4*)(d0 + i * 32 * KPB) = v; }
}
__device__ __forceinline__ void ld64(u32x4 (&r)[4], const bf16* src, int ld, int tid) {
    const unsigned off0 = (unsigned)(((tid >> 5) * ld + (tid & 31) * 8) * 2);
#pragma unroll
    for (int i = 0; i < 4; ++i) r[i] = *(const u32x4*)((const char*)src + (size_t)i * 16 * ld * 2 + off0);
}
__device__ __forceinline__ void ld64nt(u32x4 (&r)[4], const bf16* src, int ld, int tid) {
    const unsigned off0 = (unsigned)(((tid >> 5) * ld + (tid & 31) * 8) * 2);
#pragma unroll
    for (int i = 0; i < 4; ++i) r[i] = __builtin_nontemporal_load((const u32x4*)((const char*)src + (size_t)i * 16 * ld * 2 + off0));
}
__device__ __forceinline__ void st64(ldsp dst, const u32x4 (&r)[4], int tid) {
    ldsp d0 = dst + (tid >> 5) * VPB + (tid & 31) * 16;
#pragma unroll
    for (int i = 0; i < 4; ++i) *(LAS u32x4*)(d0 + i * 16 * VPB) = r[i];
}

__device__ __forceinline__ void ret_a_phase(ldsp lds, const RetArgs& A, int vcu, int G, int tid_in) {
    int tid = tid_in;
    const int wid = __builtin_amdgcn_readfirstlane(tid >> 6);
    int u = vcu; if (u >= 512) return;
    u32x4 rk[4], rv0[4], rv1[4];
    { const bf16* rows = A.G + (size_t)(u >> 2) * 128 * LDG; const int hl = u & 3;
      ld128nt(rk, rows + COL_K + hl * 128, LDG, tid); ld64nt(rv0, rows + COL_V + hl * 256, LDG, tid); ld64nt(rv1, rows + (size_t)64 * LDG + COL_V + hl * 256, LDG, tid); }
    for (;;) {
        asm volatile("" : "+v"(tid));
        const int lane = tid & 63, fr = lane & 15, g = lane >> 4;
        const int hl = u & 3, c = u >> 2, h = A.grp * 4 + hl;
        const float l2f = A.l2[h], l2b = A.l2[8 + h];
        st128s(lds + R0, rk, -l2f, 127.0f * l2f, tid);
        st128s(lds + R1, rk, l2b, 0.f, tid);
        st64(lds + R2, rv0, tid); st64(lds + R2 + 64 * VPB, rv1, tid);
        const int un = u + G; const bool has_next = un < 512;
        if (has_next) { const bf16* rows = A.G + (size_t)(un >> 2) * 128 * LDG; const int nhl = un & 3;
            ld128nt(rk, rows + COL_K + nhl * 128, LDG, tid); ld64nt(rv0, rows + COL_V + nhl * 256, LDG, tid); ld64nt(rv1, rows + (size_t)64 * LDG + COL_V + nhl * 256, LDG, tid); }
        __syncthreads();
        f32x4 acc[2][2][8];
#pragma unroll
        for (int dir = 0; dir < 2; ++dir) {
            ldsp Kx = lds + (dir ? R1 : R0);
#pragma unroll
            for (int et = 0; et < 2; ++et)
#pragma unroll
                for (int dt = 0; dt < 8; ++dt) acc[dir][et][dt] = (f32x4){0.f, 0.f, 0.f, 0.f};
#pragma unroll
            for (int ks = 0; ks < 4; ++ks) {
                bf16x8 vf[2];
#pragma unroll
                for (int et = 0; et < 2; ++et) vf[et] = trfrag(lds + R2, VPB, 32 * ks, 32 * wid + 16 * et, lane);
#pragma unroll
                for (int dt = 0; dt < 8; ++dt) { const bf16x8 kf = trfrag(Kx, KPB, 32 * ks, 16 * dt, lane);
#pragma unroll
                    for (int et = 0; et < 2; ++et) acc[dir][et][dt] = mfma16(vf[et], kf, acc[dir][et][dt]);
                    if ((dt & 3) == 3) __builtin_amdgcn_sched_barrier(0); }
            }
        }
        __syncthreads();
#pragma unroll
        for (int dir = 0; dir < 2; ++dir)
#pragma unroll
            for (int et = 0; et < 2; ++et)
#pragma unroll
                for (int dt = 0; dt < 8; ++dt) { u32x2 w; w.x = pk2(acc[dir][et][dt][0], acc[dir][et][dt][1]); w.y = pk2(acc[dir][et][dt][2], acc[dir][et][dt][3]);
                    *(LAS u32x2*)(lds + dir * (128 * UPB) + (16 * dt + fr) * UPB + (32 * wid + 16 * et + 4 * g) * 2) = w; }
        __syncthreads();
#pragma unroll
        for (int dir = 0; dir < 2; ++dir) { char* st = (char*)(A.ST + ((size_t)((dir * 4 + hl) * NCH + c)) * ST_CHUNK); const unsigned soff = (unsigned)((tid >> 5) * 512 + (tid & 31) * 16);
            ldsp s0 = lds + dir * (128 * UPB) + (tid >> 5) * UPB + (tid & 31) * 16;
#ifdef WT_MORE
            { const __amdgpu_buffer_rsrc_t srs = __builtin_amdgcn_make_buffer_rsrc((void*)st, 0, 0x7fffffff, 0x00020000);
#pragma unroll
            for (int i = 0; i < 8; ++i) __builtin_amdgcn_raw_buffer_store_b128(*(const LAS u32x4*)(s0 + i * 16 * UPB), srs, soff + i * 16 * 512, 0, 16); } }
#else
#pragma unroll
            for (int i = 0; i < 8; ++i) *(u32x4*)(st + (size_t)i * 16 * 512 + soff) = *(const LAS u32x4*)(s0 + i * 16 * UPB); }
#endif
        __syncthreads();
        if (!has_next) break;
        u = un;
    }
}

__device__ __forceinline__ void ret_b(const RetArgs& A, int vcu, int G, int tid) {
    const int NT = 8 * 16384;
    for (int T = vcu * 512 + tid; T < NT; T += G * 512) {
        const int dh = T >> 14, w = T & 16383, dir = dh >> 2, hl = dh & 3, h = A.grp * 4 + hl;
        const float dec = ex2(128.0f * A.l2[dir * 8 + h]);
        unsigned* p = (unsigned*)(A.ST + (size_t)dh * NCH * ST_CHUNK) + w;
        const ptrdiff_t cs = dir ? -(ptrdiff_t)(ST_CHUNK / 2) : (ptrdiff_t)(ST_CHUNK / 2);
        if (dir) p += (size_t)(NCH - 1) * (ST_CHUNK / 2);
        float s0 = 0.f, s1 = 0.f;
        for (int c = 0; c < NCH; c += 32) {
            unsigned u[32];
#pragma unroll
            for (int k = 0; k < 32; ++k) u[k] = __builtin_nontemporal_load(&p[(ptrdiff_t)k * cs]);
#pragma unroll
            for (int k = 0; k < 32; ++k) { p[(ptrdiff_t)k * cs] = A.dry ? u[k] : pk2(s0, s1); s0 = dec * s0 + bf_lo(u[k]); s1 = dec * s1 + bf_hi(u[k]); }
            p += 32 * cs;
        }
    }
}

constexpr int C_Q = 0, C_KA = 128 * KPB, C_B0 = 2 * 128 * KPB, C_B1 = C_B0 + 64 * VPB, C_STAT = C_B1 + 64 * VPB;
struct CPtrs { const bf16 *q, *k, *v, *sf, *sb; bf16* g; };
__device__ __forceinline__ CPtrs cptrs(const RetArgs& A, int unit) {
    const int hl = unit & 3, c = unit >> 2; bf16* rows = A.G + (size_t)c * 128 * LDG; CPtrs P;
    P.q = rows + COL_Q + hl * 128; P.k = rows + COL_K + hl * 128; P.v = rows + COL_V + hl * 256; P.g = rows + COL_G + hl * 256;
    P.sf = A.ST + ((size_t)((0 * 4 + hl) * NCH + c)) * ST_CHUNK; P.sb = A.ST + ((size_t)((1 * 4 + hl) * NCH + c)) * ST_CHUNK; return P;
}
__device__ __forceinline__ void half_mma(f32x4 (&acc)[2][8], ldsp buf, ldsp Bop, int kofs, int wid, int lane) {
    const int fr = lane & 15, g = lane >> 4;
#pragma unroll
    for (int ks = 0; ks < 2; ++ks) {
        bf16x8 xf[2];
#pragma unroll
        for (int et = 0; et < 2; ++et) xf[et] = trfrag(buf, VPB, 32 * ks, 32 * wid + 16 * et, lane);
#pragma unroll
        for (int it = 0; it < 8; ++it) { const bf16x8 bfrag = *(const LAS bf16x8*)(Bop + (16 * it + fr) * KPB + (kofs + 32 * ks + 8 * g) * 2);
#pragma unroll
            for (int et = 0; et < 2; ++et) acc[et][it] = mfma16(xf[et], bfrag, acc[et][it]);
            if ((it & 3) == 3) __builtin_amdgcn_sched_barrier(0); }
    }
}
__device__ __forceinline__ void ret_c_phase(ldsp lds, const RetArgs& A, int vcu, int G, int tid_in) {
    int tid = tid_in;
    const int wid = __builtin_amdgcn_readfirstlane(tid >> 6);
    int u = vcu; if (u >= 512) return;
    CPtrs P = cptrs(A, u);
    u32x4 r0[4], r1[4], r2[4], r3[4];
    ld128(r0, P.q, LDG, tid); ld128(r1, P.k, LDG, tid); ld64nt(r2, P.sf, 256, tid); ld64nt(r3, P.sf + 64 * 256, 256, tid);
    LAS float* stat = (LAS float*)(lds + C_STAT);
    for (;;) {
        asm volatile("" : "+v"(tid));
        const int lane = tid & 63, fr = lane & 15, g = lane >> 4;
        const int un = u + G; const bool has_next = un < 512;
        CPtrs N = P; if (has_next) N = cptrs(A, un);
        const int hl = u & 3, c = u >> 2, h = A.grp * 4 + hl;
        const float l2f = A.l2[h], l2b = A.l2[8 + h];
        st128(lds + C_Q, r0, tid); st128(lds + C_KA, r1, tid);
        ld64nt(r0, P.sb, 256, tid); ld64nt(r1, P.sb + 64 * 256, 256, tid);
        __syncthreads();
        f32x4 sa[8];
#pragma unroll
        for (int it = 0; it < 8; ++it) sa[it] = (f32x4){0.f, 0.f, 0.f, 0.f};
#pragma unroll
        for (int ks = 0; ks < 4; ++ks) { const bf16x8 kf = *(const LAS bf16x8*)(lds + C_KA + (16 * wid + fr) * KPB + (32 * ks + 8 * g) * 2);
#pragma unroll
            for (int it = 0; it < 8; ++it) { const bf16x8 qf = *(const LAS bf16x8*)(lds + C_Q + (16 * it + fr) * KPB + (32 * ks + 8 * g) * 2); sa[it] = mfma16(kf, qf, sa[it]); if ((it & 3) == 3) __builtin_amdgcn_sched_barrier(0); } }
        st64(lds + C_B0, r2, tid); ld64(r2, P.v, LDG, tid);
        __syncthreads();
#pragma unroll
        for (int it = 0; it < 8; ++it) { const int i = 16 * it + fr; float v[4];
#pragma unroll
            for (int r = 0; r < 4; ++r) { const int j = 16 * wid + 4 * g + r; const int dl = i - j; const float dm = dl >= 0 ? ex2((float)dl * l2f) : ex2((float)(-dl) * l2b); v[r] = sa[it][r] * dm; }
            u32x2 w; w.x = pk2(v[0], v[1]); w.y = pk2(v[2], v[3]);
            *(LAS u32x2*)(lds + C_KA + i * KPB + (16 * wid + 4 * g) * 2) = w; if (it & 1) __builtin_amdgcn_sched_barrier(0); }
        st64(lds + C_B1, r3, tid); ld64(r3, P.v + (size_t)64 * LDG, LDG, tid);
        f32x4 acc[2][8];
#pragma unroll
        for (int et = 0; et < 2; ++et)
#pragma unroll
            for (int it = 0; it < 8; ++it) acc[et][it] = (f32x4){0.f, 0.f, 0.f, 0.f};
        half_mma(acc, lds + C_B0, lds + C_Q, 0, wid, lane);
        __syncthreads();
        st64(lds + C_B0, r0, tid); if (has_next) ld128(r0, N.q, LDG, tid);
        half_mma(acc, lds + C_B1, lds + C_Q, 64, wid, lane);
        __syncthreads();
#pragma unroll
        for (int it = 0; it < 8; ++it) { const float fi = (float)(16 * it + fr); const float rt = ex2((fi + 1.0f) * l2f - (128.0f - fi) * l2b); acc[0][it] *= rt; acc[1][it] *= rt; }
        st64(lds + C_B1, r1, tid); if (has_next) ld128(r1, N.k, LDG, tid);
        half_mma(acc, lds + C_B0, lds + C_Q, 0, wid, lane);
        __syncthreads();
        st64(lds + C_B0, r2, tid); if (has_next) ld64nt(r2, N.sf, 256, tid);
        half_mma(acc, lds + C_B1, lds + C_Q, 64, wid, lane);
        __syncthreads();
#pragma unroll
        for (int it = 0; it < 8; ++it) { const float fi = (float)(16 * it + fr); const float sb = ex2((128.0f - fi) * l2b); acc[0][it] *= sb; acc[1][it] *= sb; }
        st64(lds + C_B1, r3, tid); if (has_next) ld64nt(r3, N.sf + 64 * 256, 256, tid);
        u32x2 gv[8][2]; f32x4 gw[2]; const unsigned goff = (unsigned)((fr * LDG + 32 * wid + 4 * g) * 2);
#pragma unroll
        for (int et = 0; et < 2; ++et) { const int e = 32 * wid + 16 * et + 4 * g; gw[et] = *(const f32x4*)(A.gn + h * 256 + e);
#pragma unroll
            for (int it = 0; it < 8; ++it) gv[it][et] = *(const u32x2*)((const char*)P.g + (size_t)(16 * it * LDG + 16 * et) * 2 + goff); }
        half_mma(acc, lds + C_B0, lds + C_KA, 0, wid, lane);
        __syncthreads();
        half_mma(acc, lds + C_B1, lds + C_KA, 64, wid, lane);
#pragma unroll
        for (int it = 0; it < 8; ++it) { float s1 = 0.f, s2 = 0.f;
#pragma unroll
            for (int et = 0; et < 2; ++et)
#pragma unroll
                for (int r = 0; r < 4; ++r) { const float y = acc[et][it][r]; s1 += y; s2 += y * y; }
            s1 += __shfl_xor(s1, 16); s1 += __shfl_xor(s1, 32); s2 += __shfl_xor(s2, 16); s2 += __shfl_xor(s2, 32);
            if (g == 0) { stat[((16 * it + fr) * 8 + wid) * 2] = s1; stat[((16 * it + fr) * 8 + wid) * 2 + 1] = s2; }
            if (it & 1) __builtin_amdgcn_sched_barrier(0); }
        __syncthreads();
#pragma unroll
        for (int it = 0; it < 8; ++it) { float s1 = 0.f, s2 = 0.f;
#pragma unroll
            for (int w = 0; w < 8; ++w) { s1 += stat[((16 * it + fr) * 8 + w) * 2]; s2 += stat[((16 * it + fr) * 8 + w) * 2 + 1]; }
            const float mu = s1 * (1.0f / 256.0f); const float var = fmaxf(s2 * (1.0f / 256.0f) - mu * mu, 0.f); const float rs = rsqrtf(var + 1e-5f);
#pragma unroll
            for (int et = 0; et < 2; ++et) { const int e = 32 * wid + 16 * et + 4 * g; const f32x4 y = acc[et][it]; const u32x2 gg = gv[it][et];
                u32x2 w; w.x = pk2(bf_lo(gg.x) * ((y[0] - mu) * rs * gw[et][0]), bf_hi(gg.x) * ((y[1] - mu) * rs * gw[et][1]));
                w.y = pk2(bf_lo(gg.y) * ((y[2] - mu) * rs * gw[et][2]), bf_hi(gg.y) * ((y[3] - mu) * rs * gw[et][3]));
                *(LAS u32x2*)(lds + C_B0 + (16 * it + fr) * UPB + e * 2) = w; }
            __builtin_amdgcn_sched_barrier(0); }
        __syncthreads();
        { char* yb = (char*)(A.Y + (size_t)c * 128 * 2048 + h * 256); const unsigned yoff = (unsigned)((tid >> 5) * 4096 + (tid & 31) * 16);
          ldsp s0 = lds + C_B0 + (tid >> 5) * UPB + (tid & 31) * 16;
#ifdef WT_MORE
          { const __amdgpu_buffer_rsrc_t yrs = __builtin_amdgcn_make_buffer_rsrc((void*)yb, 0, 0x7fffffff, 0x00020000);
#pragma unroll
          for (int i = 0; i < 8; ++i) __builtin_amdgcn_raw_buffer_store_b128(*(const LAS u32x4*)(s0 + i * 16 * UPB), yrs, yoff + i * 16 * 4096, 0, 16); } }
#else
#pragma unroll
          for (int i = 0; i < 8; ++i) *(u32x4*)(yb + (size_t)i * 16 * 4096 + yoff) = *(const LAS u32x4*)(s0 + i * 16 * UPB); }
#endif
        if (!has_next) break;
        u = un; P = N;
    }
    __syncthreads();
}
}
#define XB_TMO      128
#define XB_XCNT(j)  (256  + 64 * (j))
#define XB_XSUB(j)  (1280 + 64 * (j))
#define XB_XGEN(j)  (2304 + 64 * (j))
#define XB_TOP      3328
#define XB_TOPGEN   3392
#define XCD_BAR_WORDS 3456
#define XB_SPIN_CAP (1u << 18)

__device__ __forceinline__ unsigned xb_ld(unsigned* p)              { return __hip_atomic_load(p, __ATOMIC_RELAXED, __HIP_MEMORY_SCOPE_AGENT); }
__device__ __forceinline__ unsigned xb_add(unsigned* p, unsigned v) { return __hip_atomic_fetch_add(p, v, __ATOMIC_RELAXED, __HIP_MEMORY_SCOPE_AGENT); }
__device__ __forceinline__ unsigned xb_xcc_id() { return (unsigned)__builtin_amdgcn_s_getreg((3 << 11) | 20) & 0xFu; }
#define XB_SPIN(cond, bar) do { unsigned _sp = 0; while (cond) { __builtin_amdgcn_s_sleep(1); \
    if ((++_sp & 255u) == 0u) { if (xb_ld(&(bar)[XB_TMO])) break; if (_sp > XB_SPIN_CAP) { atomicAdd(&(bar)[XB_TMO], 1u); break; } } } } while (0)

struct XcdBarrier {
    unsigned* bar; unsigned x;
    volatile LAS unsigned* st;
};

__device__ __forceinline__ XcdBarrier xcd_barrier_post(unsigned* bar, volatile LAS unsigned* st) {
    XcdBarrier b; b.bar = bar; b.x = xb_xcc_id(); b.st = st;
    if (threadIdx.x == 0) (void)xb_add(&bar[XB_XCNT(b.x)], 1u);
    return b;
}
__device__ __forceinline__ void xcd_barrier_complete(unsigned* bar, unsigned x, unsigned& nloc, unsigned& nx) {
    const unsigned G = gridDim.x * gridDim.y * gridDim.z;
    unsigned sum, cnt, mine, sp = 0u;
    for (;;) {
        sum = 0u; cnt = 0u; mine = 0u;
#pragma unroll
        for (unsigned j = 0; j < 16; ++j) { const unsigned c = xb_ld(&bar[XB_XCNT(j)]); sum += c; cnt += (c > 0u) ? 1u : 0u; mine = (j == x) ? c : mine; }
        if (sum == G) break;
        __builtin_amdgcn_s_sleep(1);
        if ((++sp & 255u) == 0u) { if (xb_ld(&bar[XB_TMO])) break; if (sp > XB_SPIN_CAP) { atomicAdd(&bar[XB_TMO], 1u); break; } }
    }
    nloc = mine > 0u ? mine : 1u; nx = cnt > 0u ? cnt : 1u;
}

__device__ __forceinline__ void xcd_barrier(const XcdBarrier& b) {
    asm volatile("s_waitcnt vmcnt(0)" ::: "memory");
    __syncthreads();
    if (threadIdx.x == 0) {
        unsigned* bar = b.bar;
        __builtin_amdgcn_s_waitcnt(0);
        unsigned nloc = b.st[0], nx = b.st[1];
        if (nloc == 0u) { xcd_barrier_complete(bar, b.x, nloc, nx); b.st[0] = nloc; b.st[1] = nx; }
        const unsigned old = xb_add(&bar[XB_XSUB(b.x)], 1u);
        const unsigned gen = old / nloc;
        if (old + 1u == (gen + 1u) * nloc) {
            __builtin_amdgcn_fence(__ATOMIC_RELEASE, "agent");
            asm volatile("s_waitcnt vmcnt(0)" ::: "memory");
            const unsigned og = xb_add(&bar[XB_TOP], 1u);
            const unsigned tg = og / nx;
            if (og + 1u == (tg + 1u) * nx) xb_add(&bar[XB_TOPGEN], 1u);
            else XB_SPIN(xb_ld(&bar[XB_TOPGEN]) == tg, bar);
            __builtin_amdgcn_fence(__ATOMIC_ACQUIRE, "agent");
            xb_add(&bar[XB_XGEN(b.x)], 1u);
            asm volatile("s_waitcnt vmcnt(0)" ::: "memory");
        } else {
            XB_SPIN(xb_ld(&bar[XB_XGEN(b.x)]) == gen, bar);
            __builtin_amdgcn_fence(__ATOMIC_ACQUIRE, "agent");
            asm volatile("s_waitcnt vmcnt(0)" ::: "memory");
        }
    }
    __syncthreads();
}
constexpr int M_TOK = 16384, DM = 1024, DFF = 4096, N_IN_E = 2304, N_IN_O = 6144;
constexpr size_t MiB = 1u << 20;
constexpr size_t WS_CTL = 0;
constexpr size_t WS_L2 = 4096, WS_SSQ = 512 * 1024;
constexpr int CW_BAR = 4096;
constexpr size_t WS_W_IN_E = 1 * MiB;
constexpr size_t WS_W_OUT_E = WS_W_IN_E + (size_t)N_IN_E * DM * 2;
constexpr size_t WS_W_MLP_IN = WS_W_OUT_E + (size_t)DM * DM * 2;
constexpr size_t WS_W_MLP_OUT = WS_W_MLP_IN + 2 * (size_t)DFF * DM * 2;
constexpr size_t WS_W_IN_O = WS_W_MLP_OUT + 2 * (size_t)DFF * DM * 2;
constexpr size_t WS_W_OUT_O = WS_W_IN_O + (size_t)N_IN_O * DM * 2;
constexpr size_t WS_XB = 56 * MiB;
constexpr size_t WS_BIG = 88 * MiB;
constexpr size_t WS_END = 256 * MiB;
static_assert(WS_W_OUT_O + (size_t)DM * 2048 * 2 <= WS_XB, "weights fit below XB");

constexpr int RING_BYTES = 155648;
constexpr int LDS_BYTES = 159744;

struct Args { const float* in[19]; float* out; unsigned char* ws; int ph_lo, ph_hi; };
typedef const __attribute__((address_space(4))) Args* KArgs;

__device__ __forceinline__ float wave_sum(float v) {
#pragma unroll
    for (int o = 1; o < 64; o <<= 1) v += __shfl_xor(v, o);
    return v;
}
struct WItem { const float* W; int N; bf16* WT; int ldo; int k0, n0, orow0; const float* gain; float nscale; };
constexpr int WI_C0 = 1152, WI_C1 = WI_C0 + 512, WI_C2 = WI_C1 + 2048, WI_C3 = WI_C2 + 2048, WI_C4 = WI_C3 + 2048, WI_C5 = WI_C4 + 2048, WI_C6 = WI_C5 + 3072, WI_C7 = WI_C6 + 1024;
constexpr int WI_EARLY = WI_C3;
__device__ __forceinline__ void witem_decode(KArgs a, unsigned char* ws, int gi, WItem& d) {
    int item, K, mode = 0; d.gain = nullptr; d.nscale = 1.0f;
    if (gi < WI_C0)      { item = gi;         d.W = a->in[2];  K = DM;  d.N = N_IN_E; d.WT = (bf16*)(ws + WS_W_IN_E); d.gain = a->in[1]; }
    else if (gi < WI_C1) { item = gi - WI_C0; d.W = a->in[9];  K = DM;  d.N = DM;     d.WT = (bf16*)(ws + WS_W_OUT_E); }
    else if (gi < WI_C2) { item = gi - WI_C1; d.W = a->in[17]; K = DM;  d.N = DFF;    d.WT = (bf16*)(ws + WS_W_MLP_IN); d.gain = a->in[16]; }
    else if (gi < WI_C3) { item = gi - WI_C2; d.W = a->in[18]; K = DFF; d.N = DM;     d.WT = (bf16*)(ws + WS_W_MLP_OUT); }
    else if (gi < WI_C4) { item = gi - WI_C3; d.W = a->in[17] + (size_t)DM * DFF; K = DM; d.N = DFF; d.WT = (bf16*)(ws + WS_W_MLP_IN) + (size_t)DFF * DM; d.gain = a->in[16] + DM; }
    else if (gi < WI_C5) { item = gi - WI_C4; d.W = a->in[18] + (size_t)DFF * DM; K = DFF; d.N = DM; d.WT = (bf16*)(ws + WS_W_MLP_OUT) + (size_t)DFF * DM; }
    else if (gi < WI_C6) { item = gi - WI_C5; d.W = a->in[11]; K = DM;  d.N = N_IN_O; d.WT = (bf16*)(ws + WS_W_IN_O); d.gain = a->in[10]; mode = 1; }
    else                 { item = gi - WI_C6; d.W = a->in[15]; K = 2048; d.N = DM;    d.WT = (bf16*)(ws + WS_W_OUT_O); }
    const int nblk = d.N / 32, kb = item / nblk, nb = item % nblk; d.k0 = 64 * kb; d.n0 = 32 * nb; d.orow0 = d.n0; d.ldo = K;
    if (mode == 1) {
        const int n0 = d.n0;
        if (n0 < 1024) { d.orow0 = (n0 >> 9) * 3072 + (n0 & 511); }
        else if (n0 < 2048) { const int nk = n0 - 1024; d.orow0 = (nk >> 9) * 3072 + 512 + (nk & 511); d.nscale = 0.08838834764831845f; }
        else if (n0 < 4096) { const int nv = n0 - 2048; d.orow0 = (nv >> 10) * 3072 + 1024 + (nv & 1023); }
        else { const int ng = n0 - 4096; d.orow0 = (ng >> 10) * 3072 + 2048 + (ng & 1023); }
    }
}
__device__ __forceinline__ void witem_load(const WItem& d, float (&v)[32], int lane) {
#pragma unroll
    for (int i = 0; i < 32; ++i) { const int kk = 2 * i + (lane >> 5); v[i] = __builtin_nontemporal_load(&d.W[(size_t)(d.k0 + kk) * d.N + d.n0 + (lane & 31)]); }
}
__device__ __forceinline__ void witem_finish(const WItem& d, const float (&v)[32], LAS float* scr, int lane) {
#pragma unroll
    for (int i = 0; i < 32; ++i) { const int kk = 2 * i + (lane >> 5); const float gsc = d.gain ? d.gain[d.k0 + kk] * d.nscale : d.nscale; scr[kk * 33 + (lane & 31)] = v[i] * gsc; }
    asm volatile("s_waitcnt lgkmcnt(0)" ::: "memory");
    const int c = lane & 7;
#pragma unroll
    for (int j = 0; j < 4; ++j) { const int n = (lane >> 3) + 8 * j; const LAS float* s = scr + (8 * c) * 33 + n;
        u32x4 o; o.x = pk2(s[0 * 33], s[1 * 33]); o.y = pk2(s[2 * 33], s[3 * 33]); o.z = pk2(s[4 * 33], s[5 * 33]); o.w = pk2(s[6 * 33], s[7 * 33]);
        *(u32x4*)(d.WT + (size_t)(d.orow0 + n) * d.ldo + d.k0 + 8 * c) = o; }
    asm volatile("s_waitcnt lgkmcnt(0)" ::: "memory");
}
__device__ __forceinline__ void convert_items(KArgs a, ldsp lds, int gbeg, int gend, int wv, int nw, int tid) {
    const int lane = tid & 63, wave = __builtin_amdgcn_readfirstlane(tid >> 6);
    unsigned char* ws = a->ws;
    LAS float* scr = (LAS float*)(lds + wave * 16384);
    WItem cur, nxt; float va[32], vb[32];
    int gi = gbeg + wv;
    if (gi < gend) { witem_decode(a, ws, gi, cur); witem_load(cur, va, lane); }
    while (gi < gend) {
        const int g1 = gi + nw, g2 = gi + 2 * nw;
        if (g1 < gend) { witem_decode(a, ws, g1, nxt); witem_load(nxt, vb, lane); }
        witem_finish(cur, va, scr, lane);
        if (g1 >= gend) break;
        if (g2 < gend) { witem_decode(a, ws, g2, cur); witem_load(cur, va, lane); }
        witem_finish(nxt, vb, scr, lane);
        gi = g2;
    }
}
__device__ __forceinline__ void prologue(KArgs a, ldsp lds, int vcu, int G, int tid) {
    const int lane = tid & 63, wave = __builtin_amdgcn_readfirstlane(tid >> 6);
    unsigned char* ws = a->ws;
    const int gw = vcu * 8 + wave, NGW = G * 8;
    convert_items(a, lds, 0, WI_EARLY, gw, NGW, tid);
    const float* x = a->in[0]; bf16* XB = (bf16*)(ws + WS_XB); float* ssq = (float*)(ws + WS_SSQ);
    for (int m = gw; m < M_TOK; m += 2 * NGW) {
        const int m2 = m + NGW;
        const f32x4* xr0 = (const f32x4*)(x + (size_t)m * DM) + lane; const f32x4* xr1 = (const f32x4*)(x + (size_t)m2 * DM) + lane;
        f32x4 v0[4], v1[4];
#pragma unroll
        for (int j = 0; j < 4; ++j) { v0[j] = __builtin_nontemporal_load(&xr0[64 * j]); v1[j] = __builtin_nontemporal_load(&xr1[64 * j]); }
        unsigned long long* o0 = (unsigned long long*)(XB + (size_t)m * DM) + lane; unsigned long long* o1 = (unsigned long long*)(XB + (size_t)m2 * DM) + lane;
        float s0 = 0.f, s1 = 0.f;
#pragma unroll
        for (int j = 0; j < 4; ++j) { s0 += (v0[j][0] * v0[j][0] + v0[j][1] * v0[j][1]) + (v0[j][2] * v0[j][2] + v0[j][3] * v0[j][3]);
            s1 += (v1[j][0] * v1[j][0] + v1[j][1] * v1[j][1]) + (v1[j][2] * v1[j][2] + v1[j][3] * v1[j][3]);
            o0[64 * j] = (unsigned long long)pk2(v0[j][0], v0[j][1]) | ((unsigned long long)pk2(v0[j][2], v0[j][3]) << 32);
            o1[64 * j] = (unsigned long long)pk2(v1[j][0], v1[j][1]) | ((unsigned long long)pk2(v1[j][2], v1[j][3]) << 32); }
        s0 = wave_sum(s0); s1 = wave_sum(s1);
        if (lane == 0) { *(f32x4*)(ssq + 4 * (size_t)m) = (f32x4){s0, 0.f, 0.f, 0.f}; *(f32x4*)(ssq + 4 * (size_t)m2) = (f32x4){s1, 0.f, 0.f, 0.f}; }
    }
    if (vcu == 0 && tid < 16) { const float d = (tid < 8 ? a->in[12] : a->in[13])[tid & 7]; const float e = __expf(-d);
        const float l1p = (e < 0.0625f) ? e * (1.0f - e * (0.5f - e * ((1.0f / 3.0f) - e * (0.25f - e * 0.2f)))) : __logf(1.0f + e);
        ((float*)(ws + WS_L2))[tid] = -l1p * LOG2E; }
}

#ifndef DBG_DUMP
#define DBG_DUMP 0
#endif
#ifndef TS_T0
#define TS_T0 0
#define TS_GAIN 1e-3f
#endif
#ifndef GEMM_ALIGN
#define GEMM_ALIGN true
#endif
#ifndef GEMM_SP2
#define GEMM_SP2 true
#endif
#ifndef REP_PH
#define REP_PH (-1)
#define REP_N 0
#endif
#ifndef REP_COND
#define REP_COND true
#endif
#ifndef DBG_STRIDE
#define DBG_STRIDE 1
#endif
#ifndef DBG_HI
#define DBG_HI PH_COUNT
#endif
#ifndef DBG_LO
#define DBG_LO 0
#endif
#ifndef DBG_AOFF
#define DBG_AOFF 2048
#endif
#ifndef DBG_LDA
#define DBG_LDA 3072
#endif
#ifndef DBG_LDB
#define DBG_LDB 2048
#endif
#ifndef DBG_K
#define DBG_K 1024
#endif
enum { PH_PRO = 0, PH_IN_E, PH_ATTN, PH_OUT_E, PH_MLP_IN0, PH_MLP_OUT0, PH_IN_O0, PH_RA0, PH_RB0, PH_RC0, PH_IN_O1, PH_RA1, PH_RB1, PH_RC1, PH_OUT_O, PH_MLP_IN1, PH_MLP_OUT1, PH_COUNT };

__global__ void __launch_bounds__(512, 2) mk_fwd(Args a_unused) {
    extern __shared__ __attribute__((aligned(16))) unsigned char lds_raw[];
    cg::grid_group grid = cg::this_grid();
    const ldsp lds = (ldsp)lds_raw;
    volatile LAS unsigned* MISC = (volatile LAS unsigned*)(lds + RING_BYTES);
    if (threadIdx.x < 32) MISC[threadIdx.x] = 0u;
    __syncthreads();
    const XcdBarrier bar = xcd_barrier_post((unsigned*)(((KArgs)__builtin_amdgcn_kernarg_segment_ptr())->ws + WS_CTL) + CW_BAR, MISC + 8);
    const int G = gridDim.x;
    int repcnt = 0;
#ifdef TS_PH
    if (blockIdx.x == 0 && threadIdx.x == 0) ((volatile unsigned long long*)(((KArgs)__builtin_amdgcn_kernarg_segment_ptr())->ws + 32768))[0] = __builtin_amdgcn_s_memrealtime();
#endif
    const int ph_lo = ((KArgs)__builtin_amdgcn_kernarg_segment_ptr())->ph_lo, ph_hi = ((KArgs)__builtin_amdgcn_kernarg_segment_ptr())->ph_hi;
    for (int ph = ph_lo; ph < ph_hi; ++ph) {
        const __attribute__((address_space(4))) char* kp = (const __attribute__((address_space(4))) char*)__builtin_amdgcn_kernarg_segment_ptr();
        asm volatile("" : "+s"(kp));
        KArgs a = (KArgs)kp;
        unsigned char* ws = a->ws;
        bf16* XB = (bf16*)(ws + WS_XB); float* ssq = (float*)(ws + WS_SSQ);
        bf16* BIG = (bf16*)(ws + WS_BIG);
        bf16* QKV = BIG; bf16* OE = BIG + (size_t)M_TOK * N_IN_E; bf16* HM = BIG; bf16* GB = BIG; bf16* ST = BIG + (size_t)M_TOK * 3072;
        int tid = threadIdx.x, bx = blockIdx.x;
        asm volatile("" : "+v"(tid)); asm volatile("" : "+s"(bx));
        const int vcu = (G % 8 == 0) ? (bx % 8) * (G / 8) + bx / 8 : bx;
        if (ph == PH_PRO) { prologue(a, lds, vcu, G, tid); }
        else if (ph == PH_ATTN) {
            att::AttnArgs A{QKV, OE, a->in[3], a->in[4], a->in[5], a->in[6], a->in[7], a->in[8]};
            att::attn_phase(lds, A, vcu, G, tid);
        }
        else if (ph == PH_RA0 || ph == PH_RA1 || ph == PH_RB0 || ph == PH_RB1 || ph == PH_RC0 || ph == PH_RC1) {
            ret::RetArgs R{GB, ST, (const float*)(ws + WS_L2), a->in[14], (ph >= PH_IN_O1) ? 1 : 0, (REP_N > 0 && ph == REP_PH && repcnt > 0) ? 1 : 0, (bf16*)a->out};
            if (ph == PH_RA0 || ph == PH_RA1) { ret::ret_a_phase(lds, R, vcu, G, tid); }
            else if (ph == PH_RB0 || ph == PH_RB1) { ret::ret_b(R, vcu, G, tid); }
            else { ret::ret_c_phase(lds, R, vcu, G, tid); }
        }
        else if (ph == PH_IN_E || ph == PH_MLP_IN0 || ph == PH_MLP_IN1 || ph == PH_IN_O0 || ph == PH_IN_O1) {
            const bf16* Bt; int N, act, silu0; bf16* O;
            if (ph == PH_IN_E)           { Bt = (const bf16*)(ws + WS_W_IN_E); N = N_IN_E; O = QKV; act = 0; silu0 = 1 << 30; }
            else if (ph == PH_MLP_IN0)   { Bt = (const bf16*)(ws + WS_W_MLP_IN); N = DFF; O = HM; act = 1; silu0 = 1 << 30; }
            else if (ph == PH_MLP_IN1)   { Bt = (const bf16*)(ws + WS_W_MLP_IN) + (size_t)DFF * DM; N = DFF; O = HM; act = 1; silu0 = 1 << 30; }
            else if (ph == PH_IN_O0)     { Bt = (const bf16*)(ws + WS_W_IN_O); N = 3072; O = GB; act = 2; silu0 = 8; }
            else                         { Bt = (const bf16*)(ws + WS_W_IN_O) + (size_t)3072 * DM; N = 3072; O = GB; act = 2; silu0 = 8; }
            pg8::Gemm g; g.A = XB; g.Bt = Bt; g.lda = DM; g.ldb = DM; g.M = M_TOK; g.N = N; g.K = DM;
            pg8::EpiBf16 E; E.O = O; E.ldc = N; E.ssq = ssq; E.silu_pn0 = silu0; E.act = act;
            pg8::StaticOrder S; S.init(M_TOK, N, G, bx);
            pg8::gemm_phase<pg8::EpiBf16, pg8::StaticOrder, GEMM_ALIGN, GEMM_SP2>(lds, g, S, E, tid);
            if (ph == PH_IN_E && bx >= 64) convert_items(a, lds, WI_EARLY, WI_C7, (bx - 64) * 8 + __builtin_amdgcn_readfirstlane(tid >> 6), (G - 64) * 8, tid);
        }
        else {
            const bf16* A; const bf16* Bt; int lda, ldb, K; const float* basef; const bf16* baseb; float* outf; bf16* xb; float* sso;
            if (ph == PH_OUT_E)          { A = OE; lda = DM; K = DM; Bt = (const bf16*)(ws + WS_W_OUT_E); ldb = DM; basef = nullptr; baseb = XB; outf = nullptr; xb = XB; sso = ssq; }
            else if (ph == PH_MLP_OUT0)  { A = HM; lda = DFF; K = DFF; Bt = (const bf16*)(ws + WS_W_MLP_OUT); ldb = DFF; basef = nullptr; baseb = XB; outf = nullptr; xb = XB; sso = ssq; }
            else if (ph == PH_MLP_OUT1)  { A = HM; lda = DFF; K = DFF; Bt = (const bf16*)(ws + WS_W_MLP_OUT) + (size_t)DFF * DM; ldb = DFF; basef = nullptr; baseb = XB; outf = a->out; xb = nullptr; sso = nullptr; }
            else                         { A = (const bf16*)a->out; lda = 2048; K = 2048; Bt = (const bf16*)(ws + WS_W_OUT_O); ldb = 2048; basef = nullptr; baseb = XB; outf = nullptr; xb = XB; sso = ssq; }
            pg8::Gemm g; g.A = A; g.Bt = Bt; g.lda = lda; g.ldb = ldb; g.M = M_TOK; g.N = DM; g.K = K;
            pg8::EpiResid E; E.basef = basef; E.baseb = baseb; E.outf = outf; E.xb = xb; E.ssq_out = sso; E.ldc = DM;
            E.accscale = (REP_N > 0 && ph == REP_PH && repcnt > 0 && ph != PH_OUT_E && ph != PH_MLP_OUT1) ? 0.f : 1.f;
            pg8::StaticOrder S; S.init(M_TOK, DM, G, bx);
            pg8::gemm_phase<pg8::EpiResid, pg8::StaticOrder, false, GEMM_SP2>(lds, g, S, E, tid);
        }
        if (ph + 1 == ph_hi && DBG_DUMP) {
            xcd_barrier(bar);
            const bf16* srcb = (DBG_DUMP == 1) ? GB : ST;
            for (size_t i = (size_t)bx * 512 + tid; i < (size_t)M_TOK * DM; i += (size_t)G * 512) a->out[i] = bf_lo((unsigned)srcb[i * DBG_STRIDE]);
        }
#ifdef NOP_REPS
        if (ph == NOP_AT) { for (int q = 0; q < NOP_REPS; ++q) xcd_barrier(bar); }
#endif
        if (ph + 1 < ph_hi) {
            if (ph_lo < 0) {
                asm volatile("s_waitcnt vmcnt(0)" ::: "memory");
                grid.sync();
                __builtin_amdgcn_fence(__ATOMIC_ACQUIRE, "agent");
                asm volatile("s_waitcnt vmcnt(0)" ::: "memory");
                __syncthreads();
            }
            xcd_barrier(bar);
#ifdef TS_PH
            if (blockIdx.x == 0 && threadIdx.x == 0) ((volatile unsigned long long*)(ws + 32768))[ph + 1] = __builtin_amdgcn_s_memrealtime();
#endif
        }
        if (REP_N > 0 && ph == REP_PH && repcnt < REP_N && REP_COND) { ++repcnt; --ph; }
    }
#ifdef TS_PH
    {
        xcd_barrier(bar);
        if (blockIdx.x == 0 && threadIdx.x == 0) { KArgs a = (KArgs)__builtin_amdgcn_kernarg_segment_ptr(); volatile unsigned long long* ts = (volatile unsigned long long*)(a->ws + 32768);
            unsigned long long t1 = (TS_PH == PH_COUNT - 1) ? __builtin_amdgcn_s_memrealtime() : ts[TS_PH + 1];
#ifdef TS_TOTAL
            a->out[0] += 0.1f + ((float)(__builtin_amdgcn_s_memrealtime() - ts[0]) * 0.01f - (float)TS_T0) * TS_GAIN; }
#else
            a->out[0] += 0.1f + ((float)(t1 - ts[TS_PH]) * 0.01f - (float)TS_T0) * TS_GAIN; }
#endif
    }
#endif
}

extern "C" void kernel_launch(void* const* d_in, const int* in_sizes, int n_in, void* d_out, int out_size, void* d_ws, size_t ws_size, hipStream_t stream) {
    static int grid = 0;
    if (grid == 0) {
        int dev = 0, cus = 0, per_cu = 0;
        (void)hipGetDevice(&dev);
        (void)hipDeviceGetAttribute(&cus, hipDeviceAttributeMultiprocessorCount, dev);
        (void)hipFuncSetAttribute((const void*)mk_fwd, hipFuncAttributeMaxDynamicSharedMemorySize, LDS_BYTES);
        (void)hipOccupancyMaxActiveBlocksPerMultiprocessor(&per_cu, (const void*)mk_fwd, 512, LDS_BYTES);
        grid = (n_in == 19 && per_cu >= 1 && cus == 256 && ws_size >= WS_END && out_size == M_TOK * DM) ? 256 : -1;
        if (grid < 0) fprintf(stderr, "kernel_launch: unsupported configuration (cus %d per_cu %d ws %zu n_in %d)\n", cus, per_cu, ws_size, n_in);
    }
    if (grid < 0) return;
    if (hipMemsetAsync((char*)d_ws + WS_CTL, 0, 65536, stream) != hipSuccess) { fprintf(stderr, "kernel_launch: memset failed\n"); return; }
    Args a{};
    for (int i = 0; i < 19; ++i) a.in[i] = (const float*)d_in[i];
    a.out = (float*)d_out; a.ws = (unsigned char*)d_ws; a.ph_lo = DBG_LO; a.ph_hi = DBG_HI;
    void* args[] = {&a};
#ifdef PLAIN_LAUNCH
    hipError_t e = hipLaunchKernel((void*)mk_fwd, dim3(grid), dim3(512), args, LDS_BYTES, stream);
#else
    hipError_t e = hipLaunchCooperativeKernel((void*)mk_fwd, dim3(grid), dim3(512), args, LDS_BYTES, stream);
#endif
    if (e != hipSuccess) fprintf(stderr, "cooperative launch failed: %s\n", hipGetErrorString(e));
}
```

```cpp
#include <hip/hip_runtime.h>
#include <hip/hip_cooperative_groups.h>
#include <cstdio>
#include <cstdint>
#include <cmath>
namespace cg = cooperative_groups;
namespace pg8 {
#define PG8_LAS __attribute__((address_space(3)))
typedef unsigned short bf16_t;
typedef short bf16x8 __attribute__((ext_vector_type(8)));
typedef float f32x4 __attribute__((ext_vector_type(4)));
typedef float f32x2 __attribute__((ext_vector_type(2)));
typedef unsigned u32x4 __attribute__((ext_vector_type(4)));
typedef unsigned u32x2 __attribute__((ext_vector_type(2)));
constexpr int BM = 256, BK = 64, HALF = 128, HTB = HALF * BK * 2  , STAGE_BYTES = 8 * HTB, NXCD = 8, WGM = 8;

__host__ __device__ __forceinline__ int lds_byte(int r, int c) { const int st = (r >> 4) * 2 + (c >> 5), rr = r & 15, cc = c & 31, ob = rr * 64 + cc * 2; return st * 1024 + (ob ^ (((ob >> 9) & 1) << 5)); }
__host__ __device__ __forceinline__ void stage_rc(int b, int& R, int& C) { const int st = b / 1024, sb = b % 1024, swz = sb ^ (((sb >> 9) & 1) << 5); R = (st >> 1) * 16 + swz / 64; C = (st & 1) * 32 + (swz % 64) / 2; }
__host__ __device__ __forceinline__ int perm32(int rho) { const int n = rho >> 4, i = rho & 15; return 8 * (i >> 2) + 4 * n + (i & 3); }

struct Unit { int pm, pn; };
struct Gemm { const bf16_t* A; const bf16_t* Bt; int lda, ldb, M, N, K; };

struct StaticOrder {
    int nM, nN, nwg, G, c;
    __host__ __device__ void init(int M, int N, int G_, int c_) { nM = M / BM; nN = N / BM; nwg = nM * nN; G = G_; c = c_; }
    __host__ __device__ bool next(int i, Unit& u) const {
        const long L = (long)i * G + c; if (L >= nwg) return false;
        int wgid = (int)L; { const int q = nwg / NXCD, r = nwg % NXCD, xcd = wgid % NXCD, off = wgid / NXCD; wgid = (xcd < r ? xcd * (q + 1) : r * (q + 1) + (xcd - r) * q) + off; }
        const int nig = WGM * nN, gid = wgid / nig, fm = gid * WGM, gsz = (nM - fm) < WGM ? (nM - fm) : WGM;
        u.pm = fm + ((wgid % nig) % gsz); u.pn = (wgid % nig) / gsz; return true;
    }
};

typedef float f32x2_cv __attribute__((ext_vector_type(2))); typedef __bf16 bf16x2_cv __attribute__((ext_vector_type(2)));
__device__ __forceinline__ unsigned cvt_pk_bf16(float lo, float hi) { const f32x2_cv v = {lo, hi}; const bf16x2_cv b = __builtin_convertvector(v, bf16x2_cv); return __builtin_bit_cast(unsigned, b); }


__device__ __forceinline__ float row_rstd(const float* ssq, int row) { const f32x4 p = *(const f32x4*)(ssq + 4 * (size_t)row); return rsqrtf(((p[0] + p[1]) + (p[2] + p[3])) * (1.0f / 1024.0f) + 1e-6f); }

struct EpiBf16 {
    static constexpr bool PERM = true, AFTER_DRAIN = false;
    bf16_t* O; int ldc; const float* ssq; int silu_pn0; int act;
    __device__ __forceinline__ void preload(float (&rsv)[8], int pm, int wr, int fr) const {
        const int row0 = pm * BM + wr * 64 + fr;
#pragma unroll
        for (int ai = 0; ai < 2; ++ai)
#pragma unroll
            for (int m = 0; m < 4; ++m) rsv[ai * 4 + m] = row_rstd(ssq, row0 + ai * HALF + m * 16);
    }
    template <int ACT>
    __device__ __forceinline__ void body(const f32x4 (&acc)[2][2][4][2], const Unit& u, int wr, int wc, int fr, int fq, const float (&rsv)[8]) const {
        const int row0 = u.pm * BM + wr * 64 + fr; const int col0 = u.pn * BM + wc * 32 + 8 * fq;
        const __amdgpu_buffer_rsrc_t rsrc = __builtin_amdgcn_make_buffer_rsrc((void*)O, 0, 0x7fffffff, 0x00020000);
#pragma unroll
        for (int ai = 0; ai < 2; ++ai)
#pragma unroll
            for (int m = 0; m < 4; ++m) { const int row = row0 + ai * HALF + m * 16; const float rs = rsv[ai * 4 + m];
#pragma unroll
                for (int bj = 0; bj < 2; ++bj) { f32x4 v0 = acc[ai][bj][m][0] * rs, v1 = acc[ai][bj][m][1] * rs;
                    if (ACT == 1) { f32x4 r0, r1;
#pragma unroll
                        for (int e = 0; e < 4; ++e) { r0[e] = __int_as_float(max(__float_as_int(v0[e]), 0)); r1[e] = __int_as_float(max(__float_as_int(v1[e]), 0)); }
                        v0 = r0 * r0; v1 = r1 * r1; }
                    if (ACT == 2) {
#pragma unroll
                        for (int e = 0; e < 4; ++e) { v0[e] = v0[e] * __builtin_amdgcn_rcpf(1.0f + __builtin_amdgcn_exp2f(-1.4426950408889634f * v0[e])); v1[e] = v1[e] * __builtin_amdgcn_rcpf(1.0f + __builtin_amdgcn_exp2f(-1.4426950408889634f * v1[e])); } }
                    u32x4 w; w.x = cvt_pk_bf16(v0[0], v0[1]); w.y = cvt_pk_bf16(v0[2], v0[3]); w.z = cvt_pk_bf16(v1[0], v1[1]); w.w = cvt_pk_bf16(v1[2], v1[3]);
                    __builtin_amdgcn_raw_buffer_store_b128(w, rsrc, (unsigned)(((size_t)row * ldc + col0 + bj * HALF) * 2), 0, 16);
                    } }
    }
    __device__ __forceinline__ void operator()(const f32x4 (&acc)[2][2][4][2], const Unit& u, int wr, int wc, int fr, int fq, float (&rsv)[8], int& rs_pm) const {
        if (rs_pm != u.pm) { preload(rsv, u.pm, wr, fr); rs_pm = u.pm; }
        if (act == 1) body<1>(acc, u, wr, wc, fr, fq, rsv);
        else if (act == 2 && u.pn >= silu_pn0) body<2>(acc, u, wr, wc, fr, fq, rsv);
        else body<0>(acc, u, wr, wc, fr, fq, rsv);
    }
};

struct EpiResid {
    static constexpr bool PERM = true, AFTER_DRAIN = true;
    const float* basef; const bf16_t* baseb; float* outf; bf16_t* xb; float* ssq_out; int ldc; float accscale;
    __device__ __forceinline__ void prefetch(u32x4 (&bv)[2][4][2], const Unit& u, int wr, int wc, int fr, int fq) const {
        const int col0 = u.pn * BM + wc * 32 + 8 * fq;
#pragma unroll
        for (int ai = 0; ai < 2; ++ai)
#pragma unroll
            for (int m = 0; m < 4; ++m) { const int r = ai * HALF + wr * 64 + m * 16 + fr; const size_t off = (size_t)(u.pm * BM + r) * ldc + col0;
#pragma unroll
                for (int bj = 0; bj < 2; ++bj) bv[ai][m][bj] = *(const u32x4*)(baseb + off + bj * HALF); }
    }
    __device__ __forceinline__ void fused(f32x4 (&acc)[2][2][4][2], const u32x4 (&bv)[2][4][2], const Unit& u, int wr, int wc, int fr, int fq, PG8_LAS unsigned char* lds, int wid, int lane) const {
        PG8_LAS float* P = (PG8_LAS float*)lds;
        const int col0 = u.pn * BM + wc * 32 + 8 * fq;
#pragma unroll
        for (int ai = 0; ai < 2; ++ai)
#pragma unroll
            for (int m = 0; m < 4; ++m) { const int r = ai * HALF + wr * 64 + m * 16 + fr; const size_t off = (size_t)(u.pm * BM + r) * ldc + col0; float s = 0.f;
#pragma unroll
                for (int bj = 0; bj < 2; ++bj) { const size_t o2 = off + bj * HALF; const u32x4 b = bv[ai][m][bj];
                    const f32x4 b0 = (f32x4){__uint_as_float(b.x << 16), __uint_as_float(b.x & 0xffff0000u), __uint_as_float(b.y << 16), __uint_as_float(b.y & 0xffff0000u)};
                    const f32x4 b1 = (f32x4){__uint_as_float(b.z << 16), __uint_as_float(b.z & 0xffff0000u), __uint_as_float(b.w << 16), __uint_as_float(b.w & 0xffff0000u)};
                    const f32x4 o0 = b0 + acc[ai][bj][m][0] * accscale, o1 = b1 + acc[ai][bj][m][1] * accscale;
                    if (outf) { *(f32x4*)(outf + o2) = o0; *(f32x4*)(outf + o2 + 4) = o1; }
                    if (xb) { u32x4 w; w.x = cvt_pk_bf16(o0[0], o0[1]); w.y = cvt_pk_bf16(o0[2], o0[3]); w.z = cvt_pk_bf16(o1[0], o1[1]); w.w = cvt_pk_bf16(o1[2], o1[3]);
                        *(u32x4*)(xb + o2) = w; }
                    s += ((o0[0] * o0[0] + o0[1] * o0[1]) + (o0[2] * o0[2] + o0[3] * o0[3])) + ((o1[0] * o1[0] + o1[1] * o1[1]) + (o1[2] * o1[2] + o1[3] * o1[3])); }
                if (ssq_out) { s += __shfl_xor(s, 16); s += __shfl_xor(s, 32); if (fq == 0) P[r * 4 + wc] = s; } }
        if (ssq_out) {
            __syncthreads();
            const int t = wid * 64 + lane;
            if (t < 256) { const float s = (P[t * 4 + 0] + P[t * 4 + 1]) + (P[t * 4 + 2] + P[t * 4 + 3]); ssq_out[(size_t)(u.pm * BM + t) * 4 + u.pn] = s; }
            __syncthreads();
        }
    }
};

template <class Epi, class Sched, bool ALIGN_EPI = false, bool SP2 = false>
__device__ __forceinline__ void gemm_phase(PG8_LAS unsigned char* lds, const Gemm g, const Sched& S, const Epi& E, const int tid) {
    const int wid = __builtin_amdgcn_readfirstlane(tid >> 6), lane = tid & 63, wr = wid >> 2, wc = wid & 3, fr = lane & 15, fq = lane >> 4;
    const int K = g.K, nt = K / BK;
    unsigned voffA[2], voffB[2];
#pragma unroll
    for (int i = 0; i < 2; ++i) { int R, C; stage_rc(tid * 16 + i * 8192, R, C); const int Rb = Epi::PERM ? ((R & ~31) + perm32(R & 31)) : R;
        voffA[i] = (unsigned)(R * g.lda + C) * 2u; voffB[i] = (unsigned)(Rb * g.ldb + C) * 2u; }
    const size_t kstep = (size_t)(BK * 2);
    const size_t hstepA = (size_t)HALF * g.lda * 2, hstepB = (size_t)HALF * g.ldb * 2;
    const size_t tstepA = 2 * hstepA, tstepB = 2 * hstepB;
    const unsigned ldsw = (unsigned)wid * 1024u;
    const int aoff = lds_byte(wr * 64 + fr, fq * 8), boff = lds_byte(wc * 32 + fr, fq * 8);
#define PG8_SA(b, h) (((b) * 2 + (h)) * HTB)
#define PG8_SB(b, h) ((4 + (b) * 2 + (h)) * HTB)
#define PG8_STAGE(bufoff, gbase, voff) do { _Pragma("unroll") for (int _i = 0; _i < 2; ++_i) \
        __builtin_amdgcn_global_load_lds((const unsigned*)((const char*)(gbase) + (voff)[_i]), (PG8_LAS unsigned*)(lds + (bufoff) + ldsw + _i * 8192), 16, 0, 0); } while (0)
#define PG8_LDA(dst, b, h) do { _Pragma("unroll") for (int m = 0; m < 4; ++m) _Pragma("unroll") for (int k = 0; k < 2; ++k) dst[m][k] = *(const PG8_LAS bf16x8*)(lds + PG8_SA(b, h) + aoff + m * 2048 + k * 1024); } while (0)
#define PG8_LDB(dst, b, h) do { _Pragma("unroll") for (int n = 0; n < 2; ++n) _Pragma("unroll") for (int k = 0; k < 2; ++k) dst[n][k] = *(const PG8_LAS bf16x8*)(lds + PG8_SB(b, h) + boff + n * 2048 + k * 1024); } while (0)
#define PG8_MMA(ai, bj, At, Bt) do { __builtin_amdgcn_s_setprio(1); _Pragma("unroll") for (int m = 0; m < 4; ++m) _Pragma("unroll") for (int n = 0; n < 2; ++n) _Pragma("unroll") for (int k = 0; k < 2; ++k) \
        acc[ai][bj][m][n] = __builtin_amdgcn_mfma_f32_16x16x32_bf16(Bt[n][k], At[m][k], acc[ai][bj][m][n], 0, 0, 0); __builtin_amdgcn_s_setprio(0); } while (0)
#define PG8_WAIT_V(n) asm volatile("s_waitcnt vmcnt(" #n ")" ::: "memory")
#define PG8_WAIT_L(n) asm volatile("s_waitcnt lgkmcnt(" #n ")" ::: "memory")
#define PG8_BAR __builtin_amdgcn_s_barrier()
#define PG8_SCHED __builtin_amdgcn_sched_barrier(0)
    Unit cur, nxt; int ui = 0;
    if (!S.next(0, cur)) return;
    f32x4 acc[2][2][4][2];
#pragma unroll
    for (int a = 0; a < 2; ++a)
#pragma unroll
        for (int b = 0; b < 2; ++b)
#pragma unroll
            for (int m = 0; m < 4; ++m)
#pragma unroll
                for (int n = 0; n < 2; ++n) acc[a][b][m][n] = (f32x4){0.f, 0.f, 0.f, 0.f};
    bf16x8 At[4][2], B0[2][2], B1[2][2];
    const char* cA = (const char*)g.A + (size_t)cur.pm * tstepA; const char* cB = (const char*)g.Bt + (size_t)cur.pn * tstepB;
    float rsv[8]; int rs_pm = -1;
    if constexpr (!Epi::AFTER_DRAIN) { E.preload(rsv, cur.pm, wr, fr); rs_pm = cur.pm; }
    if constexpr (SP2) {
        PG8_STAGE(PG8_SB(0, 0), cB, voffB); PG8_STAGE(PG8_SB(0, 1), cB + hstepB, voffB); PG8_STAGE(PG8_SA(0, 0), cA, voffA); PG8_STAGE(PG8_SA(0, 1), cA + hstepA, voffA);
        if (wr == 1) PG8_BAR;
        PG8_WAIT_V(2); PG8_BAR;
        PG8_STAGE(PG8_SB(1, 0), cB + kstep, voffB); PG8_STAGE(PG8_SA(1, 0), cA + kstep, voffA); PG8_STAGE(PG8_SB(1, 1), cB + hstepB + kstep, voffB);
        PG8_WAIT_V(6); PG8_BAR;
    } else {
        PG8_STAGE(PG8_SB(0, 0), cB, voffB); PG8_STAGE(PG8_SA(0, 0), cA, voffA); PG8_STAGE(PG8_SB(0, 1), cB + hstepB, voffB); PG8_STAGE(PG8_SA(0, 1), cA + hstepA, voffA);
        if (wr == 1) PG8_BAR;
        PG8_WAIT_V(4); PG8_BAR;
        PG8_STAGE(PG8_SB(1, 0), cB + kstep, voffB); PG8_STAGE(PG8_SA(1, 0), cA + kstep, voffA); PG8_STAGE(PG8_SB(1, 1), cB + hstepB + kstep, voffB);
        PG8_WAIT_V(6); PG8_BAR;
    }
    for (;;) {
        const bool has_next = S.next(ui + 1, nxt);
        const char* nA = has_next ? (const char*)g.A + (size_t)nxt.pm * tstepA : cA; const char* nB = has_next ? (const char*)g.Bt + (size_t)nxt.pn * tstepB : cB;
        for (int t = 0; t < nt; t += 2) {
            const bool last = (t == nt - 2);
            const char* a1 = cA + (size_t)(t + 1) * kstep;
            const char* a2 = last ? nA : cA + (size_t)(t + 2) * kstep; const char* b2 = last ? nB : cB + (size_t)(t + 2) * kstep;
            const char* a3 = a2 + kstep; const char* b3 = b2 + kstep;
            if constexpr (SP2) {
            PG8_LDB(B0, 0, 0); PG8_LDB(B1, 0, 1); PG8_SCHED; PG8_LDA(At, 0, 0); PG8_STAGE(PG8_SA(1, 1), a1 + hstepA, voffA);
            PG8_WAIT_V(8); PG8_WAIT_L(0); PG8_BAR; PG8_MMA(0, 0, At, B0); PG8_MMA(0, 1, At, B1); PG8_BAR; PG8_SCHED;
            PG8_LDA(At, 0, 1); PG8_STAGE(PG8_SB(0, 0), b2, voffB); PG8_STAGE(PG8_SB(0, 1), b2 + hstepB, voffB); PG8_STAGE(PG8_SA(0, 0), a2, voffA);
            PG8_WAIT_V(8); PG8_WAIT_L(0); PG8_BAR; PG8_MMA(1, 0, At, B0); PG8_MMA(1, 1, At, B1); PG8_BAR; PG8_SCHED;
            PG8_LDB(B0, 1, 0); PG8_LDB(B1, 1, 1); PG8_SCHED; PG8_LDA(At, 1, 0); PG8_STAGE(PG8_SA(0, 1), a2 + hstepA, voffA);
            PG8_WAIT_V(8); PG8_WAIT_L(0); PG8_BAR; PG8_MMA(0, 0, At, B0); PG8_MMA(0, 1, At, B1); PG8_BAR; PG8_SCHED;
            PG8_LDA(At, 1, 1); PG8_STAGE(PG8_SB(1, 0), b3, voffB); PG8_STAGE(PG8_SB(1, 1), b3 + hstepB, voffB); PG8_STAGE(PG8_SA(1, 0), a3, voffA);
            PG8_WAIT_V(8); PG8_WAIT_L(0); PG8_BAR; PG8_MMA(1, 0, At, B0); PG8_MMA(1, 1, At, B1); PG8_BAR; PG8_SCHED;
            } else {
            PG8_LDB(B0, 0, 0); PG8_SCHED; PG8_LDA(At, 0, 0); PG8_STAGE(PG8_SA(1, 1), a1 + hstepA, voffA);
            PG8_WAIT_L(8); PG8_BAR; PG8_WAIT_L(0); PG8_MMA(0, 0, At, B0); PG8_BAR; PG8_SCHED;
            PG8_LDB(B1, 0, 1); PG8_STAGE(PG8_SB(0, 0), b2, voffB);
            PG8_BAR; PG8_WAIT_L(0); PG8_MMA(0, 1, At, B1); PG8_BAR;
            PG8_LDA(At, 0, 1); PG8_STAGE(PG8_SA(0, 0), a2, voffA);
            PG8_BAR; PG8_WAIT_L(0); PG8_MMA(1, 0, At, B0); PG8_BAR; PG8_SCHED;
            PG8_STAGE(PG8_SB(0, 1), b2 + hstepB, voffB);
            PG8_WAIT_V(6); PG8_BAR; PG8_MMA(1, 1, At, B1); PG8_BAR;
            PG8_LDB(B0, 1, 0); PG8_SCHED; PG8_LDA(At, 1, 0); PG8_STAGE(PG8_SA(0, 1), a2 + hstepA, voffA);
            PG8_WAIT_L(8); PG8_BAR; PG8_WAIT_L(0); PG8_MMA(0, 0, At, B0); PG8_BAR; PG8_SCHED;
            PG8_LDB(B1, 1, 1); PG8_STAGE(PG8_SB(1, 0), b3, voffB);
            PG8_BAR; PG8_WAIT_L(0); PG8_MMA(0, 1, At, B1); PG8_BAR;
            PG8_LDA(At, 1, 1); PG8_STAGE(PG8_SA(1, 0), a3, voffA);
            PG8_BAR; PG8_WAIT_L(0); PG8_MMA(1, 0, At, B0); PG8_BAR; PG8_SCHED;
            PG8_STAGE(PG8_SB(1, 1), b3 + hstepB, voffB);
            PG8_WAIT_V(6); PG8_BAR; PG8_MMA(1, 1, At, B1); PG8_BAR;
            }
        }
        if constexpr (ALIGN_EPI) { if (wr == 0) PG8_BAR; }
        if constexpr (!Epi::AFTER_DRAIN) { E(acc, cur, wr, wc, fr, fq, rsv, rs_pm); }
        if (!has_next) break;
#pragma unroll
        for (int a = 0; a < 2; ++a)
#pragma unroll
            for (int b = 0; b < 2; ++b)
#pragma unroll
                for (int m = 0; m < 4; ++m)
#pragma unroll
                    for (int n = 0; n < 2; ++n) acc[a][b][m][n] = (f32x4){0.f, 0.f, 0.f, 0.f};
        cur = nxt; cA = nA; cB = nB; ++ui;
        if constexpr (ALIGN_EPI) { if (wr == 1) PG8_BAR; }
    }
    u32x4 bv[2][4][2];
    if constexpr (Epi::AFTER_DRAIN) { E.prefetch(bv, cur, wr, wc, fr, fq); }
    PG8_WAIT_V(0);
    if constexpr (!ALIGN_EPI) { if (wr == 0) PG8_BAR; }
    PG8_BAR;
    if constexpr (Epi::AFTER_DRAIN) { E.fused(acc, bv, cur, wr, wc, fr, fq, lds, wid, lane); }
#undef PG8_SA
#undef PG8_SB
#undef PG8_STAGE
#undef PG8_LDA
#undef PG8_LDB
#undef PG8_MMA
#undef PG8_WAIT_V
#undef PG8_WAIT_L
#undef PG8_BAR
#undef PG8_SCHED
}
}
#define LAS __attribute__((address_space(3)))
typedef unsigned short bf16;
typedef short bf16x8 __attribute__((ext_vector_type(8)));
typedef short s16x4 __attribute__((ext_vector_type(4)));
typedef float f32x4 __attribute__((ext_vector_type(4)));
typedef unsigned u32x4 __attribute__((ext_vector_type(4)));
typedef unsigned u32x2 __attribute__((ext_vector_type(2)));
typedef LAS unsigned char* ldsp;
constexpr float LOG2E = 1.4426950408889634f;

__device__ __forceinline__ float bf_lo(unsigned w) { return __uint_as_float(w << 16); }
__device__ __forceinline__ float bf_hi(unsigned w) { return __uint_as_float(w & 0xffff0000u); }
__device__ __forceinline__ unsigned pk2(float lo, float hi) { return pg8::cvt_pk_bf16(lo, hi); }
__device__ __forceinline__ s16x4 vtr(ldsp p) { typedef short v4i16_t __attribute__((ext_vector_type(4))); return __builtin_bit_cast(s16x4, __builtin_amdgcn_ds_read_tr16_b64_v4i16((LAS v4i16_t*)p)); }
__device__ __forceinline__ bf16x8 cat8(s16x4 lo, s16x4 hi) { return (bf16x8){lo[0], lo[1], lo[2], lo[3], hi[0], hi[1], hi[2], hi[3]}; }
__device__ __forceinline__ f32x4 mfma16(bf16x8 a, bf16x8 b, f32x4 c) { return __builtin_amdgcn_mfma_f32_16x16x32_bf16(a, b, c, 0, 0, 0); }
__device__ __forceinline__ float ex2(float x) { return __builtin_amdgcn_exp2f(x); }

namespace att {
constexpr int SEQ = 16384, LDQ = 2304, LDO = 1024;
constexpr int KPB = 160;
constexpr int COL_QA = 0, COL_KA = 512, COL_VA = 640, COL_QB = 768, COL_KB = 1280, COL_VB = 1792;

template <int NP>
__device__ __forceinline__ void load_rows(u32x4 (&v)[NP], const bf16* src, int tok0, int nvalid, int tid) {
    const int sub = tid & 7;
#pragma unroll
    for (int p = 0; p < NP; ++p) { const int r = (tid >> 3) + 64 * p, tok = tok0 + r; const bool ok = (tok >= 0) && (tok < SEQ) && (r < nvalid);
        v[p] = (u32x4){0u, 0u, 0u, 0u};
        if (ok) v[p] = *(const u32x4*)(src + (size_t)tok * LDQ + sub * 8); }
}
template <int NP, bool NORM>
__device__ __forceinline__ void store_rows(ldsp dst, const u32x4 (&v)[NP], int nrows, const float* gain, int tid) {
    const int sub = tid & 7;
    float gn[8];
    if (NORM) {
#pragma unroll
        for (int j = 0; j < 8; ++j) gn[j] = gain[sub * 8 + j];
    }
#pragma unroll
    for (int p = 0; p < NP; ++p) { const int r = (tid >> 3) + 64 * p;
        if (r < nrows) {
            u32x4 w = v[p];
            if (NORM) {
                float f[8]; f[0] = bf_lo(w.x); f[1] = bf_hi(w.x); f[2] = bf_lo(w.y); f[3] = bf_hi(w.y); f[4] = bf_lo(w.z); f[5] = bf_hi(w.z); f[6] = bf_lo(w.w); f[7] = bf_hi(w.w);
                float ss = 0.f;
#pragma unroll
                for (int j = 0; j < 8; ++j) ss += f[j] * f[j];
                ss += __shfl_xor(ss, 1); ss += __shfl_xor(ss, 2); ss += __shfl_xor(ss, 4);
                const float rs = rsqrtf(ss * (1.0f / 64.0f) + 1e-6f);
#pragma unroll
                for (int j = 0; j < 8; ++j) f[j] = f[j] * rs * gn[j];
                w.x = pk2(f[0], f[1]); w.y = pk2(f[2], f[3]); w.z = pk2(f[4], f[5]); w.w = pk2(f[6], f[7]);
            }
            *(LAS u32x4*)(dst + r * KPB + sub * 16) = w;
        } }
}

__device__ __forceinline__ void load_q_raw(u32x4 (&raw)[2], const bf16* qrow  , int g) {
#pragma unroll
    for (int s = 0; s < 2; ++s) raw[s] = *(const u32x4*)(qrow + 32 * s + 8 * g);
}
__device__ __forceinline__ void finish_q(bf16x8 (&qf)[2], const u32x4 (&raw)[2], const float* gain, int g) {
    float f[2][8]; float ss = 0.f;
#pragma unroll
    for (int s = 0; s < 2; ++s) { const u32x4 v = raw[s];
        f[s][0] = bf_lo(v.x); f[s][1] = bf_hi(v.x); f[s][2] = bf_lo(v.y); f[s][3] = bf_hi(v.y); f[s][4] = bf_lo(v.z); f[s][5] = bf_hi(v.z); f[s][6] = bf_lo(v.w); f[s][7] = bf_hi(v.w);
#pragma unroll
        for (int j = 0; j < 8; ++j) ss += f[s][j] * f[s][j]; }
    ss += __shfl_xor(ss, 16); ss += __shfl_xor(ss, 32);
    const float rs = rsqrtf(ss * (1.0f / 64.0f) + 1e-6f) * (0.125f * LOG2E);
#pragma unroll
    for (int s = 0; s < 2; ++s) { float o[8];
#pragma unroll
        for (int j = 0; j < 8; ++j) o[j] = f[s][j] * rs * gain[32 * s + 8 * g + j];
        u32x4 w; w.x = pk2(o[0], o[1]); w.y = pk2(o[2], o[3]); w.z = pk2(o[4], o[5]); w.w = pk2(o[6], o[7]);
        qf[s] = __builtin_bit_cast(bf16x8, w); }
}

template <int NT, class RB>
__device__ __forceinline__ void scores(f32x4 (&sc)[NT], ldsp Kb, const bf16x8 (&qf)[2], const RB& rb, int lane, float init) {
    const int fr = lane & 15, g = lane >> 4;
#pragma unroll
    for (int t = 0; t < NT; ++t) { ldsp kp = Kb + (rb(t) + fr) * KPB + g * 16; f32x4 a = (f32x4){init, init, init, init};
#pragma unroll
        for (int s = 0; s < 2; ++s) { const bf16x8 kf = *(const LAS bf16x8*)(kp + s * 64); a = mfma16(kf, qf[s], a); }
        sc[t] = a; if ((t & 3) == 3) __builtin_amdgcn_sched_barrier(0); }
}
template <int NT>
__device__ __forceinline__ float softmax_pack(f32x4 (&sc)[NT], bf16x8 (&pf)[NT / 2], float sink2, bool has_sink) {
    float m = -INFINITY;
#pragma unroll
    for (int t = 0; t < NT; ++t)
#pragma unroll
        for (int r = 0; r < 4; ++r) m = fmaxf(m, sc[t][r]);
    m = fmaxf(m, __shfl_xor(m, 16)); m = fmaxf(m, __shfl_xor(m, 32));
    if (has_sink) m = fmaxf(m, sink2);
    float sum = 0.f;
#pragma unroll
    for (int t = 0; t < NT; ++t)
#pragma unroll
        for (int r = 0; r < 4; ++r) { const float p = ex2(sc[t][r] - m); sc[t][r] = p; sum += p; }
    sum += __shfl_xor(sum, 16); sum += __shfl_xor(sum, 32);
    if (has_sink) sum += ex2(sink2 - m);
#pragma unroll
    for (int k = 0; k < NT / 2; ++k) { u32x4 w; w.x = pk2(sc[2 * k][0], sc[2 * k][1]); w.y = pk2(sc[2 * k][2], sc[2 * k][3]); w.z = pk2(sc[2 * k + 1][0], sc[2 * k + 1][1]); w.w = pk2(sc[2 * k + 1][2], sc[2 * k + 1][3]);
        pf[k] = __builtin_bit_cast(bf16x8, w); }
    return sum;
}
template <int NT, int NR>
__device__ __forceinline__ float softmax_pack_shifted(f32x4 (&sc)[NT], bf16x8 (&pf)[NT / 2], float extra) {
    float sum = 0.f;
#pragma unroll
    for (int t = 0; t < NT; ++t)
#pragma unroll
        for (int r = 0; r < 4; ++r) { if (t < NR) { const float p = ex2(sc[t][r]); sc[t][r] = p; sum += p; } else sc[t][r] = 0.f; }
    sum += __shfl_xor(sum, 16); sum += __shfl_xor(sum, 32);
    sum += extra;
#pragma unroll
    for (int k = 0; k < NT / 2; ++k) { u32x4 w; w.x = pk2(sc[2 * k][0], sc[2 * k][1]); w.y = pk2(sc[2 * k][2], sc[2 * k][3]); w.z = pk2(sc[2 * k + 1][0], sc[2 * k + 1][1]); w.w = pk2(sc[2 * k + 1][2], sc[2 * k + 1][3]);
        pf[k] = __builtin_bit_cast(bf16x8, w); }
    return sum;
}
__device__ __forceinline__ float wave_absmax64(const float* g, int lane) {
    float v = fabsf(g[lane]);
#pragma unroll
    for (int o = 1; o < 64; o <<= 1) v = fmaxf(v, __shfl_xor(v, o));
    return __int_as_float(__builtin_amdgcn_readfirstlane(__float_as_int(v)));
}
template <int NT, class RB>
__device__ __forceinline__ void pv_store(ldsp Vb, const bf16x8 (&pf)[NT / 2], const RB& rb, float sum, bf16* orow  , int lane) {
    const int g = lane >> 4, q4 = (lane & 15) >> 2, p4 = lane & 3;
    f32x4 o[4];
#pragma unroll
    for (int dt = 0; dt < 4; ++dt) o[dt] = (f32x4){0.f, 0.f, 0.f, 0.f};
#pragma unroll
    for (int k = 0; k < NT / 2; ++k) { ldsp v0 = Vb + (rb(2 * k) + 4 * g + q4) * KPB + p4 * 8; ldsp v1 = Vb + (rb(2 * k + 1) + 4 * g + q4) * KPB + p4 * 8;
#pragma unroll
        for (int dt = 0; dt < 4; ++dt) { const bf16x8 vf = cat8(vtr(v0 + dt * 32), vtr(v1 + dt * 32)); o[dt] = mfma16(vf, pf[k], o[dt]); } }
    const float inv = 1.0f / sum;
#pragma unroll
    for (int dt = 0; dt < 4; ++dt) { u32x2 w; w.x = pk2(o[dt][0] * inv, o[dt][1] * inv); w.y = pk2(o[dt][2] * inv, o[dt][3] * inv); *(u32x2*)(orow + dt * 16 + 4 * g) = w; }
}

struct RbWin { int mt; __device__ __forceinline__ int operator()(int t) const { return 16 * (mt + t); } };
struct RbNa { int off, ct0, ct1; __device__ __forceinline__ int operator()(int t) const { return (off + (t >> 1)) * 64 + ((t & 1) ? ct1 : ct0) * 16; } };

struct AttnArgs { const bf16* qkv; bf16* o; const float* qn_a; const float* kn_a; const float* sink_a; const float* qn_b; const float* kn_b; const float* rpb; };

__device__ __forceinline__ void window_pair(ldsp Kb, ldsp Vb, const AttnArgs& A, int n, int kvh, int mt, int g4a, const u32x4 (&qra)[2], const u32x4 (&qrb)[2], int lane, float mneg) {
    const int fr = lane & 15, g = lane >> 4, q4 = fr >> 2, p4 = lane & 3;
    const int hqa = kvh * 4 + g4a, hqb = hqa + 1;
    const int qtok = n * 128 + mt * 16 + fr;
    bf16x8 qfa[2], qfb[2]; finish_q(qfa, qra, A.qn_a, g); finish_q(qfb, qrb, A.qn_a, g);
    f32x4 sa[18], sb[18];
#pragma unroll
    for (int t = 0; t < 17; ++t) { ldsp kp = Kb + (16 * (mt + t) + fr) * KPB + g * 16; f32x4 a = (f32x4){mneg, mneg, mneg, mneg}, b = a;
#pragma unroll
        for (int s = 0; s < 2; ++s) { const bf16x8 kf = *(const LAS bf16x8*)(kp + s * 64); a = mfma16(kf, qfa[s], a); b = mfma16(kf, qfb[s], b); }
        sa[t] = a; sb[t] = b; if ((t & 3) == 3) __builtin_amdgcn_sched_barrier(0); }
    {
        const float sla = exp2f(-(float)(hqa + 1)) * LOG2E, slb = sla * 0.5f;
        float cl = (float)(4 * g - 128 - fr); asm volatile("" : "+v"(cl));
        const float lo = (float)max(-128, -qtok), hi = (float)min(128, SEQ - 1 - qtok);
        const bool ends = (n == 0) || (n == SEQ / 128 - 1);
#pragma unroll
        for (int t = 0; t < 17; ++t) {
            if (ends || t == 0 || t == 16) {
#pragma unroll
                for (int r = 0; r < 4; ++r) { const float rel = cl + (float)(16 * t + r); const bool ok = (rel >= lo && rel <= hi); const float ar = fabsf(rel);
                    sa[t][r] = ok ? fmaf(-sla, ar, sa[t][r]) : -INFINITY; sb[t][r] = ok ? fmaf(-slb, ar, sb[t][r]) : -INFINITY; }
            } else {
#pragma unroll
                for (int r = 0; r < 4; ++r) { const float ar = fabsf(cl + (float)(16 * t + r)); sa[t][r] = fmaf(-sla, ar, sa[t][r]); sb[t][r] = fmaf(-slb, ar, sb[t][r]); }
            } }
    }
    bf16x8 pa[9], pb[9];
    const float suma = softmax_pack_shifted<18, 17>(sa, pa, ex2(fmaf(A.sink_a[hqa], LOG2E, mneg)));
    const float sumb = softmax_pack_shifted<18, 17>(sb, pb, ex2(fmaf(A.sink_a[hqb], LOG2E, mneg)));
    f32x4 oa[4], ob[4];
#pragma unroll
    for (int dt = 0; dt < 4; ++dt) { oa[dt] = (f32x4){0.f, 0.f, 0.f, 0.f}; ob[dt] = oa[dt]; }
#pragma unroll
    for (int k = 0; k < 9; ++k) { ldsp v0 = Vb + (16 * (mt + 2 * k) + 4 * g + q4) * KPB + p4 * 8; ldsp v1 = v0 + 16 * KPB;
#pragma unroll
        for (int dt = 0; dt < 4; ++dt) { const bf16x8 vf = cat8(vtr(v0 + dt * 32), vtr(v1 + dt * 32)); oa[dt] = mfma16(vf, pa[k], oa[dt]); ob[dt] = mfma16(vf, pb[k], ob[dt]); } }
    const float ia = 1.0f / suma, ib = 1.0f / sumb;
    bf16* orow = A.o + (size_t)qtok * LDO + hqa * 64;
#pragma unroll
    for (int dt = 0; dt < 4; ++dt) { u32x2 w; w.x = pk2(oa[dt][0] * ia, oa[dt][1] * ia); w.y = pk2(oa[dt][2] * ia, oa[dt][3] * ia); *(u32x2*)(orow + dt * 16 + 4 * g) = w;
        u32x2 w2; w2.x = pk2(ob[dt][0] * ib, ob[dt][1] * ib); w2.y = pk2(ob[dt][2] * ib, ob[dt][3] * ib); *(u32x2*)(orow + 64 + dt * 16 + 4 * g) = w2; }
}

__device__ __forceinline__ void window_compute(ldsp lds, const AttnArgs& A, int unit, int tid) {
    const int n = unit >> 1, kvh = unit & 1, lane = tid & 63, wid = __builtin_amdgcn_readfirstlane(tid >> 6);
    ldsp Kb = lds, Vb = lds + 400 * KPB;
    const int fr = lane & 15, g = lane >> 4;
    const bf16* qbase = A.qkv + (size_t)(n * 128 + wid * 16 + fr) * LDQ + COL_QA + kvh * 256;
    u32x4 q0[2], q1[2], q2[2], q3[2];
    load_q_raw(q0, qbase, g); load_q_raw(q1, qbase + 64, g); load_q_raw(q2, qbase + 128, g); load_q_raw(q3, qbase + 192, g);
    const float mneg = -fminf(11.5416f * 1.01f * wave_absmax64(A.qn_a, lane) * wave_absmax64(A.kn_a, lane) + 0.25f, 64.0f);
    window_pair(Kb, Vb, A, n, kvh, wid, 0, q0, q1, lane, mneg);
    __builtin_amdgcn_sched_barrier(0);
    window_pair(Kb, Vb, A, n, kvh, wid, 2, q2, q3, lane, mneg);
}

constexpr int NA_ROWS = 704;
constexpr int NA_SHIFT_OFF = NA_ROWS * KPB + 15 * 128 * 4;
constexpr int NA_RPB_OFF = NA_ROWS * KPB;

__device__ __forceinline__ void na_unit(ldsp lds, const AttnArgs& A, int unit, int next_unit, u32x4 (&kreg)[11], int tid) {
    const int rq4 = unit >> 3, h = unit & 7, lane = tid & 63, wid = __builtin_amdgcn_readfirstlane(tid >> 6);
    const int r0 = 4 * rq4; const int base = min(max(r0 - 4, 0), 248);
    const int rq = r0 + (wid >> 1); const int rstart = min(max(rq - 4, 0), 248);
    const int fr = lane & 15, g = lane >> 4;
    store_rows<11, true>(lds, kreg, NA_ROWS, A.kn_b, tid);
    __syncthreads();
    const LAS float* rpl = (const LAS float*)(lds + NA_RPB_OFF);
    bf16x8 pf[2][8]; float sum[2]; int qtok[2]; int qcs[2]; u32x4 qraw[2][2];
#pragma unroll
    for (int it = 0; it < 2; ++it) { const int mt = 2 * (wid & 1) + it; qcs[it] = (mt < 3) ? 8 + 16 * mt + fr : (fr < 8 ? fr : 48 + fr); qtok[it] = rq * 64 + qcs[it];
        load_q_raw(qraw[it], A.qkv + (size_t)qtok[it] * LDQ + COL_QB + h * 64, g); }
#pragma unroll
    for (int it = 0; it < 2; ++it) {
        const int mt = 2 * (wid & 1) + it; const int qc = qcs[it];
        bf16x8 qf[2]; finish_q(qf, qraw[it], A.qn_b, g);
        RbNa rb{rstart - base, (mt < 3) ? mt : 0, (mt < 3) ? mt + 1 : 3};
        f32x4 sc[16]; scores<16>(sc, lds, qf, rb, lane, *(const LAS float*)(lds + NA_SHIFT_OFF));
        const int cstart = min(max(qc - 8, 0), 48);
        const int d0 = 4 * g - cstart;
        const LAS float* rpl0 = rpl + (rstart - rq + 7) * 128 + (4 * g - qc + 64);
#pragma unroll
        for (int t = 0; t < 16; ++t) { const int ct = (t & 1) ? rb.ct1 : rb.ct0; const LAS float* rp = rpl0 + (t >> 1) * 128 + 16 * ct; const int kb = 16 * ct + d0;
#pragma unroll
            for (int r = 0; r < 4; ++r) sc[t][r] = ((unsigned)(kb + r) < 16u) ? sc[t][r] + rp[r] : -INFINITY;
            if ((t & 3) == 3) __builtin_amdgcn_sched_barrier(0); }
        sum[it] = softmax_pack_shifted<16, 16>(sc, pf[it], 0.f);
        __builtin_amdgcn_sched_barrier(0);
    }
    u32x4 vreg[11]; load_rows<11>(vreg, A.qkv + COL_VB + h * 64, base * 64, NA_ROWS, tid);
    __syncthreads();
    store_rows<11, false>(lds, vreg, NA_ROWS, nullptr, tid);
    if (next_unit >= 0) { const int nb = min(max(4 * (next_unit >> 3) - 4, 0), 248); load_rows<11>(kreg, A.qkv + COL_KB + h * 64, nb * 64, NA_ROWS, tid); }
    __syncthreads();
#pragma unroll
    for (int it = 0; it < 2; ++it) { const int mt = 2 * (wid & 1) + it; RbNa rb{rstart - base, (mt < 3) ? mt : 0, (mt < 3) ? mt + 1 : 3};
        pv_store<16>(lds, pf[it], rb, sum[it], A.o + (size_t)qtok[it] * LDO + 512 + h * 64, lane); __builtin_amdgcn_sched_barrier(0); }
    __syncthreads();
}

__device__ __forceinline__ void attn_phase(ldsp lds, const AttnArgs& A, int vcu, int G, int tid) {
    const int h = vcu & 7;
    u32x4 kreg[11];
#ifndef ATT_REP_WIN
#define ATT_REP_WIN 1
#define ATT_REP_NA 1
#endif
    for (int rw = 0; rw < ATT_REP_WIN; ++rw) {
        const int n = vcu >> 1, kvh = vcu & 1, tok0 = (n - 1) * 128;
        u32x4 kw[7], vw[7];
        load_rows<7>(kw, A.qkv + COL_KA + kvh * 64, tok0, 384, tid);
        load_rows<7>(vw, A.qkv + COL_VA + kvh * 64, tok0, 384, tid);
        store_rows<7, true>(lds, kw, 400, A.kn_a, tid);
        store_rows<7, false>(lds + 400 * KPB, vw, 400, nullptr, tid);
        __syncthreads();
        window_compute(lds, A, vcu, tid);
        __syncthreads();
    }
    for (int rn = 0; rn < ATT_REP_NA; ++rn) {
    { const int b0 = min(max(4 * (vcu >> 3) - 4, 0), 248); load_rows<11>(kreg, A.qkv + COL_KB + h * 64, b0 * 64, NA_ROWS, tid); }
    for (int i = tid; i < 15 * 128; i += 512) { const int ri = i >> 7, dc = i & 127; const int ci = min(max(dc - 49, 0), 30); ((LAS float*)(lds + NA_RPB_OFF))[i] = A.rpb[h * 465 + ri * 31 + ci] * LOG2E; }
    float mneg_na;
    {   const int lane = tid & 63; float rm = 0.f;
        for (int i = lane; i < 465; i += 64) rm = fmaxf(rm, A.rpb[h * 465 + i]);
#pragma unroll
        for (int o = 1; o < 64; o <<= 1) rm = fmaxf(rm, __shfl_xor(rm, o));
        rm = __int_as_float(__builtin_amdgcn_readfirstlane(__float_as_int(rm)));
        mneg_na = -fminf(11.5416f * 1.01f * wave_absmax64(A.qn_b, lane) * wave_absmax64(A.kn_b, lane) + 0.25f + rm * LOG2E, 64.0f);
        if (tid == 0) *(LAS float*)(lds + NA_SHIFT_OFF) = mneg_na; }
    for (int k = 0; k < 2; ++k) { int t2 = tid; asm volatile("" : "+v"(t2));
        na_unit(lds, A, vcu + 256 * k, (k < 1) ? vcu + 256 * (k + 1) : -1, kreg, t2); }
    }
}
}
namespace ret {
constexpr int SEQ = 16384, LDG = 3072, NCH = 128;
constexpr int COL_Q = 0, COL_K = 512, COL_V = 1024, COL_G = 2048;
constexpr int KPB = 288;
constexpr int VPB = 544;
constexpr int UPB = 528;
constexpr int R0 = 0, R1 = 128 * KPB, R2 = 2 * 128 * KPB, RSTAT = R2 + 128 * VPB;
constexpr size_t ST_CHUNK = 128 * 256;

__device__ __forceinline__ unsigned pk2a(float lo, float hi) { unsigned r; asm volatile("v_cvt_pk_bf16_f32 %0, %1, %2" : "=v"(r) : "v"(lo), "v"(hi)); return r; }
struct RetArgs { bf16* G; bf16* ST; const float* l2;   const float* gn; int grp; int dry; bf16* Y; };

template <bool SCALE>
__device__ __forceinline__ void stage128(ldsp dst, const bf16* src, int ld, float a, float b, int tid) {
#pragma unroll
    for (int i = 0; i < 4; ++i) { const int idx = tid + i * 512, row = idx >> 4, ch = idx & 15;
        u32x4 v = *(const u32x4*)(src + (size_t)row * ld + ch * 8);
        if (SCALE) { const float s = ex2(a * (float)row + b);
            v.x = pk2a(bf_lo(v.x) * s, bf_hi(v.x) * s); v.y = pk2a(bf_lo(v.y) * s, bf_hi(v.y) * s); v.z = pk2a(bf_lo(v.z) * s, bf_hi(v.z) * s); v.w = pk2a(bf_lo(v.w) * s, bf_hi(v.w) * s); }
        *(LAS u32x4*)(dst + row * KPB + ch * 16) = v; }
}
__device__ __forceinline__ void stage256(ldsp dst, const bf16* src, int ld, int tid) {
#pragma unroll
    for (int i = 0; i < 8; ++i) { const int idx = tid + i * 512, row = idx >> 5, ch = idx & 31;
        const u32x4 v = *(const u32x4*)(src + (size_t)row * ld + ch * 8);
        *(LAS u32x4*)(dst + row * VPB + ch * 16) = v; }
}
__device__ __forceinline__ bf16x8 trfrag(ldsp X, int pitch, int k0, int n0, int lane) {
    const int g = lane >> 4, q4 = (lane & 15) >> 2, p4 = lane & 3;
    ldsp p = X + (k0 + 8 * g + q4) * pitch + (n0 + 4 * p4) * 2;
    return cat8(vtr(p), vtr(p + 4 * pitch));
}

__device__ __forceinline__ void ld128(u32x4 (&r)[4], const bf16* src, int ld, int tid) {
    const unsigned off0 = (unsigned)(((tid >> 4) * ld + (tid & 15) * 8) * 2);
#pragma unroll
    for (int i = 0; i < 4; ++i) r[i] = *(const u32x4*)((const char*)src + (size_t)i * 32 * ld * 2 + off0);
}
__device__ __forceinline__ void ld128nt(u32x4 (&r)[4], const bf16* src, int ld, int tid) {
    const unsigned off0 = (unsigned)(((tid >> 4) * ld + (tid & 15) * 8) * 2);
#pragma unroll
    for (int i = 0; i < 4; ++i) r[i] = __builtin_nontemporal_load((const u32x4*)((const char*)src + (size_t)i * 32 * ld * 2 + off0));
}
__device__ __forceinline__ void st128(ldsp dst, const u32x4 (&r)[4], int tid) {
    ldsp d0 = dst + (tid >> 4) * KPB + (tid & 15) * 16;
#pragma unroll
    for (int i = 0; i < 4; ++i) *(LAS u32x4*)(d0 + i * 32 * KPB) = r[i];
}
__device__ __forceinline__ void st128s(ldsp dst, const u32x4 (&r)[4], float a, float b, int tid) {
    ldsp d0 = dst + (tid >> 4) * KPB + (tid & 15) * 16;
#pragma unroll
    for (int i = 0; i < 4; ++i) { const int row = (tid >> 4) + 32 * i; const float s = ex2(a * (float)row + b); u32x4 v = r[i];
        v.x = pk2(bf_lo(v.x) * s, bf_hi(v.x) * s); v.y = pk2(bf_lo(v.y) * s, bf_hi(v.y) * s); v.z = pk2(bf_lo(v.z) * s, bf_hi(v.z) * s); v.w = pk2(bf_lo(v.w) * s, bf_hi(v.w) * s);
        *(LAS u32x4*)(d0 + i * 32 * KPB) = v; }
}
__device__ __forceinline__ void ld64(u32x4 (&r)[4], const bf16* src, int ld, int tid) {
    const unsigned off0 = (unsigned)(((tid >> 5) * ld + (tid & 31) * 8) * 2);
#pragma unroll
    for (int i = 0; i < 4; ++i) r[i] = *(const u32x4*)((const char*)src + (size_t)i * 16 * ld * 2 + off0);
}
__device__ __forceinline__ void ld64nt(u32x4 (&r)[4], const bf16* src, int ld, int tid) {
    const unsigned off0 = (unsigned)(((tid >> 5) * ld + (tid & 31) * 8) * 2);
#pragma unroll
    for (int i = 0; i < 4; ++i) r[i] = __builtin_nontemporal_load((const u32x4*)((const char*)src + (size_t)i * 16 * ld * 2 + off0));
}
__device__ __forceinline__ void st64(ldsp dst, const u32x4 (&r)[4], int tid) {
    ldsp d0 = dst + (tid >> 5) * VPB + (tid & 31) * 16;
#pragma unroll
    for (int i = 0; i < 4; ++i) *(LAS u32x4*)(d0 + i * 16 * VPB) = r[i];
}

__device__ __forceinline__ void ret_a_phase(ldsp lds, const RetArgs& A, int vcu, int G, int tid_in) {
    int tid = tid_in;
    const int wid = __builtin_amdgcn_readfirstlane(tid >> 6);
    int u = vcu; if (u >= 512) return;
    u32x4 rk[4], rv0[4], rv1[4];
    { const bf16* rows = A.G + (size_t)(u >> 2) * 128 * LDG; const int hl = u & 3;
      ld128nt(rk, rows + COL_K + hl * 128, LDG, tid); ld64nt(rv0, rows + COL_V + hl * 256, LDG, tid); ld64nt(rv1, rows + (size_t)64 * LDG + COL_V + hl * 256, LDG, tid); }
    for (;;) {
        asm volatile("" : "+v"(tid));
        const int lane = tid & 63, fr = lane & 15, g = lane >> 4;
        const int hl = u & 3, c = u >> 2, h = A.grp * 4 + hl;
        const float l2f = A.l2[h], l2b = A.l2[8 + h];
        st128s(lds + R0, rk, -l2f, 127.0f * l2f, tid);
        st128s(lds + R1, rk, l2b, 0.f, tid);
        st64(lds + R2, rv0, tid); st64(lds + R2 + 64 * VPB, rv1, tid);
        const int un = u + G; const bool has_next = un < 512;
        if (has_next) { const bf16* rows = A.G + (size_t)(un >> 2) * 128 * LDG; const int nhl = un & 3;
            ld128nt(rk, rows + COL_K + nhl * 128, LDG, tid); ld64nt(rv0, rows + COL_V + nhl * 256, LDG, tid); ld64nt(rv1, rows + (size_t)64 * LDG + COL_V + nhl * 256, LDG, tid); }
        __syncthreads();
        f32x4 acc[2][2][8];
#pragma unroll
        for (int dir = 0; dir < 2; ++dir) {
            ldsp Kx = lds + (dir ? R1 : R0);
#pragma unroll
            for (int et = 0; et < 2; ++et)
#pragma unroll
                for (int dt = 0; dt < 8; ++dt) acc[dir][et][dt] = (f32x4){0.f, 0.f, 0.f, 0.f};
#pragma unroll
            for (int ks = 0; ks < 4; ++ks) {
                bf16x8 vf[2];
#pragma unroll
                for (int et = 0; et < 2; ++et) vf[et] = trfrag(lds + R2, VPB, 32 * ks, 32 * wid + 16 * et, lane);
#pragma unroll
                for (int dt = 0; dt < 8; ++dt) { const bf16x8 kf = trfrag(Kx, KPB, 32 * ks, 16 * dt, lane);
#pragma unroll
                    for (int et = 0; et < 2; ++et) acc[dir][et][dt] = mfma16(vf[et], kf, acc[dir][et][dt]);
                    if ((dt & 3) == 3) __builtin_amdgcn_sched_barrier(0); }
            }
        }
        __syncthreads();
#pragma unroll
        for (int dir = 0; dir < 2; ++dir)
#pragma unroll
            for (int et = 0; et < 2; ++et)
#pragma unroll
                for (int dt = 0; dt < 8; ++dt) { u32x2 w; w.x = pk2(acc[dir][et][dt][0], acc[dir][et][dt][1]); w.y = pk2(acc[dir][et][dt][2], acc[dir][et][dt][3]);
                    *(LAS u32x2*)(lds + dir * (128 * UPB) + (16 * dt + fr) * UPB + (32 * wid + 16 * et + 4 * g) * 2) = w; }
        __syncthreads();
#pragma unroll
        for (int dir = 0; dir < 2; ++dir) { char* st = (char*)(A.ST + ((size_t)((dir * 4 + hl) * NCH + c)) * ST_CHUNK); const unsigned soff = (unsigned)((tid >> 5) * 512 + (tid & 31) * 16);
            ldsp s0 = lds + dir * (128 * UPB) + (tid >> 5) * UPB + (tid & 31) * 16;
#ifdef WT_MORE
            { const __amdgpu_buffer_rsrc_t srs = __builtin_amdgcn_make_buffer_rsrc((void*)st, 0, 0x7fffffff, 0x00020000);
#pragma unroll
            for (int i = 0; i < 8; ++i) __builtin_amdgcn_raw_buffer_store_b128(*(const LAS u32x4*)(s0 + i * 16 * UPB), srs, soff + i * 16 * 512, 0, 16); } }
#else
#pragma unroll
            for (int i = 0; i < 8; ++i) *(u32x4*)(st + (size_t)i * 16 * 512 + soff) = *(const LAS u32x4*)(s0 + i * 16 * UPB); }
#endif
        __syncthreads();
        if (!has_next) break;
        u = un;
    }
}

__device__ __forceinline__ void ret_b(const RetArgs& A, int vcu, int G, int tid) {
    const int NT = 8 * 16384;
    for (int T = vcu * 512 + tid; T < NT; T += G * 512) {
        const int dh = T >> 14, w = T & 16383, dir = dh >> 2, hl = dh & 3, h = A.grp * 4 + hl;
        const float dec = ex2(128.0f * A.l2[dir * 8 + h]);
        unsigned* p = (unsigned*)(A.ST + (size_t)dh * NCH * ST_CHUNK) + w;
        const ptrdiff_t cs = dir ? -(ptrdiff_t)(ST_CHUNK / 2) : (ptrdiff_t)(ST_CHUNK / 2);
        if (dir) p += (size_t)(NCH - 1) * (ST_CHUNK / 2);
        float s0 = 0.f, s1 = 0.f;
        for (int c = 0; c < NCH; c += 32) {
            unsigned u[32];
#pragma unroll
            for (int k = 0; k < 32; ++k) u[k] = __builtin_nontemporal_load(&p[(ptrdiff_t)k * cs]);
#pragma unroll
            for (int k = 0; k < 32; ++k) { p[(ptrdiff_t)k * cs] = A.dry ? u[k] : pk2(s0, s1); s0 = dec * s0 + bf_lo(u[k]); s1 = dec * s1 + bf_hi(u[k]); }
            p += 32 * cs;
        }
    }
}

constexpr int C_Q = 0, C_KA = 128 * KPB, C_B0 = 2 * 128 * KPB, C_B1 = C_B0 + 64 * VPB, C_STAT = C_B1 + 64 * VPB;
struct CPtrs { const bf16 *q, *k, *v, *sf, *sb; bf16* g; };
__device__ __forceinline__ CPtrs cptrs(const RetArgs& A, int unit) {
    const int hl = unit & 3, c = unit >> 2; bf16* rows = A.G + (size_t)c * 128 * LDG; CPtrs P;
    P.q = rows + COL_Q + hl * 128; P.k = rows + COL_K + hl * 128; P.v = rows + COL_V + hl * 256; P.g = rows + COL_G + hl * 256;
    P.sf = A.ST + ((size_t)((0 * 4 + hl) * NCH + c)) * ST_CHUNK; P.sb = A.ST + ((size_t)((1 * 4 + hl) * NCH + c)) * ST_CHUNK; return P;
}
__device__ __forceinline__ void half_mma(f32x4 (&acc)[2][8], ldsp buf, ldsp Bop, int kofs, int wid, int lane) {
    const int fr = lane & 15, g = lane >> 4;
#pragma unroll
    for (int ks = 0; ks < 2; ++ks) {
        bf16x8 xf[2];
#pragma unroll
        for (int et = 0; et < 2; ++et) xf[et] = trfrag(buf, VPB, 32 * ks, 32 * wid + 16 * et, lane);
#pragma unroll
        for (int it = 0; it < 8; ++it) { const bf16x8 bfrag = *(const LAS bf16x8*)(Bop + (16 * it + fr) * KPB + (kofs + 32 * ks + 8 * g) * 2);
#pragma unroll
            for (int et = 0; et < 2; ++et) acc[et][it] = mfma16(xf[et], bfrag, acc[et][it]);
            if ((it & 3) == 3) __builtin_amdgcn_sched_barrier(0); }
    }
}
__device__ __forceinline__ void ret_c_phase(ldsp lds, const RetArgs& A, int vcu, int G, int tid_in) {
    int tid = tid_in;
    const int wid = __builtin_amdgcn_readfirstlane(tid >> 6);
    int u = vcu; if (u >= 512) return;
    CPtrs P = cptrs(A, u);
    u32x4 r0[4], r1[4], r2[4], r3[4];
    ld128(r0, P.q, LDG, tid); ld128(r1, P.k, LDG, tid); ld64nt(r2, P.sf, 256, tid); ld64nt(r3, P.sf + 64 * 256, 256, tid);
    LAS float* stat = (LAS float*)(lds + C_STAT);
    for (;;) {
        asm volatile("" : "+v"(tid));
        const int lane = tid & 63, fr = lane & 15, g = lane >> 4;
        const int un = u + G; const bool has_next = un < 512;
        CPtrs N = P; if (has_next) N = cptrs(A, un);
        const int hl = u & 3, c = u >> 2, h = A.grp * 4 + hl;
        const float l2f = A.l2[h], l2b = A.l2[8 + h];
        st128(lds + C_Q, r0, tid); st128(lds + C_KA, r1, tid);
        ld64nt(r0, P.sb, 256, tid); ld64nt(r1, P.sb + 64 * 256, 256, tid);
        __syncthreads();
        f32x4 sa[8];
#pragma unroll
        for (int it = 0; it < 8; ++it) sa[it] = (f32x4){0.f, 0.f, 0.f, 0.f};
#pragma unroll
        for (int ks = 0; ks < 4; ++ks) { const bf16x8 kf = *(const LAS bf16x8*)(lds + C_KA + (16 * wid + fr) * KPB + (32 * ks + 8 * g) * 2);
#pragma unroll
            for (int it = 0; it < 8; ++it) { const bf16x8 qf = *(const LAS bf16x8*)(lds + C_Q + (16 * it + fr) * KPB + (32 * ks + 8 * g) * 2); sa[it] = mfma16(kf, qf, sa[it]); if ((it & 3) == 3) __builtin_amdgcn_sched_barrier(0); } }
        st64(lds + C_B0, r2, tid); ld64(r2, P.v, LDG, tid);
        __syncthreads();
#pragma unroll
        for (int it = 0; it < 8; ++it) { const int i = 16 * it + fr; float v[4];
#pragma unroll
            for (int r = 0; r < 4; ++r) { const int j = 16 * wid + 4 * g + r; const int dl = i - j; const float dm = dl >= 0 ? ex2((float)dl * l2f) : ex2((float)(-dl) * l2b); v[r] = sa[it][r] * dm; }
            u32x2 w; w.x = pk2(v[0], v[1]); w.y = pk2(v[2], v[3]);
            *(LAS u32x2*)(lds + C_KA + i * KPB + (16 * wid + 4 * g) * 2) = w; if (it & 1) __builtin_amdgcn_sched_barrier(0); }
        st64(lds + C_B1, r3, tid); ld64(r3, P.v + (size_t)64 * LDG, LDG, tid);
        f32x4 acc[2][8];
#pragma unroll
        for (int et = 0; et < 2; ++et)
#pragma unroll
            for (int it = 0; it < 8; ++it) acc[et][it] = (f32x4){0.f, 0.f, 0.f, 0.f};
        half_mma(acc, lds + C_B0, lds + C_Q, 0, wid, lane);
        __syncthreads();
        st64(lds + C_B0, r0, tid); if (has_next) ld128(r0, N.q, LDG, tid);
        half_mma(acc, lds + C_B1, lds + C_Q, 64, wid, lane);
        __syncthreads();
#pragma unroll
        for (int it = 0; it < 8; ++it) { const float fi = (float)(16 * it + fr); const float rt = ex2((fi + 1.0f) * l2f - (128.0f - fi) * l2b); acc[0][it] *= rt; acc[1][it] *= rt; }
        st64(lds + C_B1, r1, tid); if (has_next) ld128(r1, N.k, LDG, tid);
        half_mma(acc, lds + C_B0, lds + C_Q, 0, wid, lane);
        __syncthreads();
        st64(lds + C_B0, r2, tid); if (has_next) ld64nt(r2, N.sf, 256, tid);
        half_mma(acc, lds + C_B1, lds + C_Q, 64, wid, lane);
        __syncthreads();
#pragma unroll
        for (int it = 0; it < 8; ++it) { const float fi = (float)(16 * it + fr); const float sb = ex2((128.0f - fi) * l2b); acc[0][it] *= sb; acc[1][it] *= sb; }
        st64(lds + C_B1, r3, tid); if (has_next) ld64nt(r3, N.sf + 64 * 256, 256, tid);
        u32x2 gv[8][2]; f32x4 gw[2]; const unsigned goff = (unsigned)((fr * LDG + 32 * wid + 4 * g) * 2);
#pragma unroll
        for (int et = 0; et < 2; ++et) { const int e = 32 * wid + 16 * et + 4 * g; gw[et] = *(const f32x4*)(A.gn + h * 256 + e);
#pragma unroll
            for (int it = 0; it < 8; ++it) gv[it][et] = *(const u32x2*)((const char*)P.g + (size_t)(16 * it * LDG + 16 * et) * 2 + goff); }
        half_mma(acc, lds + C_B0, lds + C_KA, 0, wid, lane);
        __syncthreads();
        half_mma(acc, lds + C_B1, lds + C_KA, 64, wid, lane);
#pragma unroll
        for (int it = 0; it < 8; ++it) { float s1 = 0.f, s2 = 0.f;
#pragma unroll
            for (int et = 0; et < 2; ++et)
#pragma unroll
                for (int r = 0; r < 4; ++r) { const float y = acc[et][it][r]; s1 += y; s2 += y * y; }
            s1 += __shfl_xor(s1, 16); s1 += __shfl_xor(s1, 32); s2 += __shfl_xor(s2, 16); s2 += __shfl_xor(s2, 32);
            if (g == 0) { stat[((16 * it + fr) * 8 + wid) * 2] = s1; stat[((16 * it + fr) * 8 + wid) * 2 + 1] = s2; }
            if (it & 1) __builtin_amdgcn_sched_barrier(0); }
        __syncthreads();
#pragma unroll
        for (int it = 0; it < 8; ++it) { float s1 = 0.f, s2 = 0.f;
#pragma unroll
            for (int w = 0; w < 8; ++w) { s1 += stat[((16 * it + fr) * 8 + w) * 2]; s2 += stat[((16 * it + fr) * 8 + w) * 2 + 1]; }
            const float mu = s1 * (1.0f / 256.0f); const float var = fmaxf(s2 * (1.0f / 256.0f) - mu * mu, 0.f); const float rs = rsqrtf(var + 1e-5f);
#pragma unroll
            for (int et = 0; et < 2; ++et) { const int e = 32 * wid + 16 * et + 4 * g; const f32x4 y = acc[et][it]; const u32x2 gg = gv[it][et];
                u32x2 w; w.x = pk2(bf_lo(gg.x) * ((y[0] - mu) * rs * gw[et][0]), bf_hi(gg.x) * ((y[1] - mu) * rs * gw[et][1]));
                w.y = pk2(bf_lo(gg.y) * ((y[2] - mu) * rs * gw[et][2]), bf_hi(gg.y) * ((y[3] - mu) * rs * gw[et][3]));
                *(LAS u32x2*)(lds + C_B0 + (16 * it + fr) * UPB + e * 2) = w; }
            __builtin_amdgcn_sched_barrier(0); }
        __syncthreads();
        { char* yb = (char*)(A.Y + (size_t)c * 128 * 2048 + h * 256); const unsigned yoff = (unsigned)((tid >> 5) * 4096 + (tid & 31) * 16);
          ldsp s0 = lds + C_B0 + (tid >> 5) * UPB + (tid & 31) * 16;
#ifdef WT_MORE
          { const __amdgpu_buffer_rsrc_t yrs = __builtin_amdgcn_make_buffer_rsrc((void*)yb, 0, 0x7fffffff, 0x00020000);
#pragma unroll
          for (int i = 0; i < 8; ++i) __builtin_amdgcn_raw_buffer_store_b128(*(const LAS u32x4*)(s0 + i * 16 * UPB), yrs, yoff + i * 16 * 4096, 0, 16); } }
#else
#pragma unroll
          for (int i = 0; i < 8; ++i) *(u32x4*)(yb + (size_t)i * 16 * 4096 + yoff) = *(const LAS u32x4*)(s0 + i * 16 * UPB); }
#endif
        if (!has_next) break;
        u = un; P = N;
    }
    __syncthreads();
}
}
#define XB_TMO      128
#define XB_XCNT(j)  (256  + 64 * (j))
#define XB_XSUB(j)  (1280 + 64 * (j))
#define XB_XGEN(j)  (2304 + 64 * (j))
#define XB_TOP      3328
#define XB_TOPGEN   3392
#define XCD_BAR_WORDS 3456
#define XB_SPIN_CAP (1u << 18)

__device__ __forceinline__ unsigned xb_ld(unsigned* p)              { return __hip_atomic_load(p, __ATOMIC_RELAXED, __HIP_MEMORY_SCOPE_AGENT); }
__device__ __forceinline__ unsigned xb_add(unsigned* p, unsigned v) { return __hip_atomic_fetch_add(p, v, __ATOMIC_RELAXED, __HIP_MEMORY_SCOPE_AGENT); }
__device__ __forceinline__ unsigned xb_xcc_id() { return (unsigned)__builtin_amdgcn_s_getreg((3 << 11) | 20) & 0xFu; }
#define XB_SPIN(cond, bar) do { unsigned _sp = 0; while (cond) { __builtin_amdgcn_s_sleep(1); \
    if ((++_sp & 255u) == 0u) { if (xb_ld(&(bar)[XB_TMO])) break; if (_sp > XB_SPIN_CAP) { atomicAdd(&(bar)[XB_TMO], 1u); break; } } } } while (0)

struct XcdBarrier {
    unsigned* bar; unsigned x;
    volatile LAS unsigned* st;
};

__device__ __forceinline__ XcdBarrier xcd_barrier_post(unsigned* bar, volatile LAS unsigned* st) {
    XcdBarrier b; b.bar = bar; b.x = xb_xcc_id(); b.st = st;
    if (threadIdx.x == 0) (void)xb_add(&bar[XB_XCNT(b.x)], 1u);
    return b;
}
__device__ __forceinline__ void xcd_barrier_complete(unsigned* bar, unsigned x, unsigned& nloc, unsigned& nx) {
    const unsigned G = gridDim.x * gridDim.y * gridDim.z;
    unsigned sum, cnt, mine, sp = 0u;
    for (;;) {
        sum = 0u; cnt = 0u; mine = 0u;
#pragma unroll
        for (unsigned j = 0; j < 16; ++j) { const unsigned c = xb_ld(&bar[XB_XCNT(j)]); sum += c; cnt += (c > 0u) ? 1u : 0u; mine = (j == x) ? c : mine; }
        if (sum == G) break;
        __builtin_amdgcn_s_sleep(1);
        if ((++sp & 255u) == 0u) { if (xb_ld(&bar[XB_TMO])) break; if (sp > XB_SPIN_CAP) { atomicAdd(&bar[XB_TMO], 1u); break; } }
    }
    nloc = mine > 0u ? mine : 1u; nx = cnt > 0u ? cnt : 1u;
}

__device__ __forceinline__ void xcd_barrier(const XcdBarrier& b) {
    asm volatile("s_waitcnt vmcnt(0)" ::: "memory");
    __syncthreads();
    if (threadIdx.x == 0) {
        unsigned* bar = b.bar;
        __builtin_amdgcn_s_waitcnt(0);
        unsigned nloc = b.st[0], nx = b.st[1];
        if (nloc == 0u) { xcd_barrier_complete(bar, b.x, nloc, nx); b.st[0] = nloc; b.st[1] = nx; }
        const unsigned old = xb_add(&bar[XB_XSUB(b.x)], 1u);
        const unsigned gen = old / nloc;
        if (old + 1u == (gen + 1u) * nloc) {
            __builtin_amdgcn_fence(__ATOMIC_RELEASE, "agent");
            asm volatile("s_waitcnt vmcnt(0)" ::: "memory");
            const unsigned og = xb_add(&bar[XB_TOP], 1u);
            const unsigned tg = og / nx;
            if (og + 1u == (tg + 1u) * nx) xb_add(&bar[XB_TOPGEN], 1u);
            else XB_SPIN(xb_ld(&bar[XB_TOPGEN]) == tg, bar);
            __builtin_amdgcn_fence(__ATOMIC_ACQUIRE, "agent");
            xb_add(&bar[XB_XGEN(b.x)], 1u);
            asm volatile("s_waitcnt vmcnt(0)" ::: "memory");
        } else {
            XB_SPIN(xb_ld(&bar[XB_XGEN(b.x)]) == gen, bar);
            __builtin_amdgcn_fence(__ATOMIC_ACQUIRE, "agent");
            asm volatile("s_waitcnt vmcnt(0)" ::: "memory");
        }
    }
    __syncthreads();
}
constexpr int M_TOK = 16384, DM = 1024, DFF = 4096, N_IN_E = 2304, N_IN_O = 6144;
constexpr size_t MiB = 1u << 20;
constexpr size_t WS_CTL = 0;
constexpr size_t WS_L2 = 4096, WS_SSQ = 512 * 1024;
constexpr int CW_BAR = 4096;
constexpr size_t WS_W_IN_E = 1 * MiB;
constexpr size_t WS_W_OUT_E = WS_W_IN_E + (size_t)N_IN_E * DM * 2;
constexpr size_t WS_W_MLP_IN = WS_W_OUT_E + (size_t)DM * DM * 2;
constexpr size_t WS_W_MLP_OUT = WS_W_MLP_IN + 2 * (size_t)DFF * DM * 2;
constexpr size_t WS_W_IN_O = WS_W_MLP_OUT + 2 * (size_t)DFF * DM * 2;
constexpr size_t WS_W_OUT_O = WS_W_IN_O + (size_t)N_IN_O * DM * 2;
constexpr size_t WS_XB = 56 * MiB;
constexpr size_t WS_BIG = 88 * MiB;
constexpr size_t WS_END = 256 * MiB;
static_assert(WS_W_OUT_O + (size_t)DM * 2048 * 2 <= WS_XB, "weights fit below XB");

constexpr int RING_BYTES = 155648;
constexpr int LDS_BYTES = 159744;

struct Args { const float* in[19]; float* out; unsigned char* ws; int ph_lo, ph_hi; };
typedef const __attribute__((address_space(4))) Args* KArgs;

__device__ __forceinline__ float wave_sum(float v) {
#pragma unroll
    for (int o = 1; o < 64; o <<= 1) v += __shfl_xor(v, o);
    return v;
}
struct WItem { const float* W; int N; bf16* WT; int ldo; int k0, n0, orow0; const float* gain; float nscale; };
constexpr int WI_C0 = 1152, WI_C1 = WI_C0 + 512, WI_C2 = WI_C1 + 2048, WI_C3 = WI_C2 + 2048, WI_C4 = WI_C3 + 2048, WI_C5 = WI_C4 + 2048, WI_C6 = WI_C5 + 3072, WI_C7 = WI_C6 + 1024;
constexpr int WI_EARLY = WI_C3;
__device__ __forceinline__ void witem_decode(KArgs a, unsigned char* ws, int gi, WItem& d) {
    int item, K, mode = 0; d.gain = nullptr; d.nscale = 1.0f;
    if (gi < WI_C0)      { item = gi;         d.W = a->in[2];  K = DM;  d.N = N_IN_E; d.WT = (bf16*)(ws + WS_W_IN_E); d.gain = a->in[1]; }
    else if (gi < WI_C1) { item = gi - WI_C0; d.W = a->in[9];  K = DM;  d.N = DM;     d.WT = (bf16*)(ws + WS_W_OUT_E); }
    else if (gi < WI_C2) { item = gi - WI_C1; d.W = a->in[17]; K = DM;  d.N = DFF;    d.WT = (bf16*)(ws + WS_W_MLP_IN); d.gain = a->in[16]; }
    else if (gi < WI_C3) { item = gi - WI_C2; d.W = a->in[18]; K = DFF; d.N = DM;     d.WT = (bf16*)(ws + WS_W_MLP_OUT); }
    else if (gi < WI_C4) { item = gi - WI_C3; d.W = a->in[17] + (size_t)DM * DFF; K = DM; d.N = DFF; d.WT = (bf16*)(ws + WS_W_MLP_IN) + (size_t)DFF * DM; d.gain = a->in[16] + DM; }
    else if (gi < WI_C5) { item = gi - WI_C4; d.W = a->in[18] + (size_t)DFF * DM; K = DFF; d.N = DM; d.WT = (bf16*)(ws + WS_W_MLP_OUT) + (size_t)DFF * DM; }
    else if (gi < WI_C6) { item = gi - WI_C5; d.W = a->in[11]; K = DM;  d.N = N_IN_O; d.WT = (bf16*)(ws + WS_W_IN_O); d.gain = a->in[10]; mode = 1; }
    else                 { item = gi - WI_C6; d.W = a->in[15]; K = 2048; d.N = DM;    d.WT = (bf16*)(ws + WS_W_OUT_O); }
    const int nblk = d.N / 32, kb = item / nblk, nb = item % nblk; d.k0 = 64 * kb; d.n0 = 32 * nb; d.orow0 = d.n0; d.ldo = K;
    if (mode == 1) {
        const int n0 = d.n0;
        if (n0 < 1024) { d.orow0 = (n0 >> 9) * 3072 + (n0 & 511); }
        else if (n0 < 2048) { const int nk = n0 - 1024; d.orow0 = (nk >> 9) * 3072 + 512 + (nk & 511); d.nscale = 0.08838834764831845f; }
        else if (n0 < 4096) { const int nv = n0 - 2048; d.orow0 = (nv >> 10) * 3072 + 1024 + (nv & 1023); }
        else { const int ng = n0 - 4096; d.orow0 = (ng >> 10) * 3072 + 2048 + (ng & 1023); }
    }
}
__device__ __forceinline__ void witem_load(const WItem& d, float (&v)[32], int lane) {
#pragma unroll
    for (int i = 0; i < 32; ++i) { const int kk = 2 * i + (lane >> 5); v[i] = __builtin_nontemporal_load(&d.W[(size_t)(d.k0 + kk) * d.N + d.n0 + (lane & 31)]); }
}
__device__ __forceinline__ void witem_finish(const WItem& d, const float (&v)[32], LAS float* scr, int lane) {
#pragma unroll
    for (int i = 0; i < 32; ++i) { const int kk = 2 * i + (lane >> 5); const float gsc = d.gain ? d.gain[d.k0 + kk] * d.nscale : d.nscale; scr[kk * 33 + (lane & 31)] = v[i] * gsc; }
    asm volatile("s_waitcnt lgkmcnt(0)" ::: "memory");
    const int c = lane & 7;
#pragma unroll
    for (int j = 0; j < 4; ++j) { const int n = (lane >> 3) + 8 * j; const LAS float* s = scr + (8 * c) * 33 + n;
        u32x4 o; o.x = pk2(s[0 * 33], s[1 * 33]); o.y = pk2(s[2 * 33], s[3 * 33]); o.z = pk2(s[4 * 33], s[5 * 33]); o.w = pk2(s[6 * 33], s[7 * 33]);
        *(u32x4*)(d.WT + (size_t)(d.orow0 + n) * d.ldo + d.k0 + 8 * c) = o; }
    asm volatile("s_waitcnt lgkmcnt(0)" ::: "memory");
}
__device__ __forceinline__ void convert_items(KArgs a, ldsp lds, int gbeg, int gend, int wv, int nw, int tid) {
    const int lane = tid & 63, wave = __builtin_amdgcn_readfirstlane(tid >> 6);
    unsigned char* ws = a->ws;
    LAS float* scr = (LAS float*)(lds + wave * 16384);
    WItem cur, nxt; float va[32], vb[32];
    int gi = gbeg + wv;
    if (gi < gend) { witem_decode(a, ws, gi, cur); witem_load(cur, va, lane); }
    while (gi < gend) {
        const int g1 = gi + nw, g2 = gi + 2 * nw;
        if (g1 < gend) { witem_decode(a, ws, g1, nxt); witem_load(nxt, vb, lane); }
        witem_finish(cur, va, scr, lane);
        if (g1 >= gend) break;
        if (g2 < gend) { witem_decode(a, ws, g2, cur); witem_load(cur, va, lane); }
        witem_finish(nxt, vb, scr, lane);
        gi = g2;
    }
}
__device__ __forceinline__ void prologue(KArgs a, ldsp lds, int vcu, int G, int tid) {
    const int lane = tid & 63, wave = __builtin_amdgcn_readfirstlane(tid >> 6);
    unsigned char* ws = a->ws;
    const int gw = vcu * 8 + wave, NGW = G * 8;
    convert_items(a, lds, 0, WI_EARLY, gw, NGW, tid);
    const float* x = a->in[0]; bf16* XB = (bf16*)(ws + WS_XB); float* ssq = (float*)(ws + WS_SSQ);
    for (int m = gw; m < M_TOK; m += 2 * NGW) {
        const int m2 = m + NGW;
        const f32x4* xr0 = (const f32x4*)(x + (size_t)m * DM) + lane; const f32x4* xr1 = (const f32x4*)(x + (size_t)m2 * DM) + lane;
        f32x4 v0[4], v1[4];
#pragma unroll
        for (int j = 0; j < 4; ++j) { v0[j] = __builtin_nontemporal_load(&xr0[64 * j]); v1[j] = __builtin_nontemporal_load(&xr1[64 * j]); }
        unsigned long long* o0 = (unsigned long long*)(XB + (size_t)m * DM) + lane; unsigned long long* o1 = (unsigned long long*)(XB + (size_t)m2 * DM) + lane;
        float s0 = 0.f, s1 = 0.f;
#pragma unroll
        for (int j = 0; j < 4; ++j) { s0 += (v0[j][0] * v0[j][0] + v0[j][1] * v0[j][1]) + (v0[j][2] * v0[j][2] + v0[j][3] * v0[j][3]);
            s1 += (v1[j][0] * v1[j][0] + v1[j][1] * v1[j][1]) + (v1[j][2] * v1[j][2] + v1[j][3] * v1[j][3]);
            o0[64 * j] = (unsigned long long)pk2(v0[j][0], v0[j][1]) | ((unsigned long long)pk2(v0[j][2], v0[j][3]) << 32);
            o1[64 * j] = (unsigned long long)pk2(v1[j][0], v1[j][1]) | ((unsigned long long)pk2(v1[j][2], v1[j][3]) << 32); }
        s0 = wave_sum(s0); s1 = wave_sum(s1);
        if (lane == 0) { *(f32x4*)(ssq + 4 * (size_t)m) = (f32x4){s0, 0.f, 0.f, 0.f}; *(f32x4*)(ssq + 4 * (size_t)m2) = (f32x4){s1, 0.f, 0.f, 0.f}; }
    }
    if (vcu == 0 && tid < 16) { const float d = (tid < 8 ? a->in[12] : a->in[13])[tid & 7]; const float e = __expf(-d);
        const float l1p = (e < 0.0625f) ? e * (1.0f - e * (0.5f - e * ((1.0f / 3.0f) - e * (0.25f - e * 0.2f)))) : __logf(1.0f + e);
        ((float*)(ws + WS_L2))[tid] = -l1p * LOG2E; }
}

#ifndef DBG_DUMP
#define DBG_DUMP 0
#endif
#ifndef TS_T0
#define TS_T0 0
#define TS_GAIN 1e-3f
#endif
#ifndef GEMM_ALIGN
#define GEMM_ALIGN true
#endif
#ifndef GEMM_SP2
#define GEMM_SP2 true
#endif
#ifndef REP_PH
#define REP_PH (-1)
#define REP_N 0
#endif
#ifndef REP_COND
#define REP_COND true
#endif
#ifndef DBG_STRIDE
#define DBG_STRIDE 1
#endif
#ifndef DBG_HI
#define DBG_HI PH_COUNT
#endif
#ifndef DBG_LO
#define DBG_LO 0
#endif
#ifndef DBG_AOFF
#define DBG_AOFF 2048
#endif
#ifndef DBG_LDA
#define DBG_LDA 3072
#endif
#ifndef DBG_LDB
#define DBG_LDB 2048
#endif
#ifndef DBG_K
#define DBG_K 1024
#endif
enum { PH_PRO = 0, PH_IN_E, PH_ATTN, PH_OUT_E, PH_MLP_IN0, PH_MLP_OUT0, PH_IN_O0, PH_RA0, PH_RB0, PH_RC0, PH_IN_O1, PH_RA1, PH_RB1, PH_RC1, PH_OUT_O, PH_MLP_IN1, PH_MLP_OUT1, PH_COUNT };

__global__ void __launch_bounds__(512, 2) mk_fwd(Args a_unused) {
    extern __shared__ __attribute__((aligned(16))) unsigned char lds_raw[];
    cg::grid_group grid = cg::this_grid();
    const ldsp lds = (ldsp)lds_raw;
    volatile LAS unsigned* MISC = (volatile LAS unsigned*)(lds + RING_BYTES);
    if (threadIdx.x < 32) MISC[threadIdx.x] = 0u;
    __syncthreads();
    const XcdBarrier bar = xcd_barrier_post((unsigned*)(((KArgs)__builtin_amdgcn_kernarg_segment_ptr())->ws + WS_CTL) + CW_BAR, MISC + 8);
    const int G = gridDim.x;
    int repcnt = 0;
#ifdef TS_PH
    if (blockIdx.x == 0 && threadIdx.x == 0) ((volatile unsigned long long*)(((KArgs)__builtin_amdgcn_kernarg_segment_ptr())->ws + 32768))[0] = __builtin_amdgcn_s_memrealtime();
#endif
    const int ph_lo = ((KArgs)__builtin_amdgcn_kernarg_segment_ptr())->ph_lo, ph_hi = ((KArgs)__builtin_amdgcn_kernarg_segment_ptr())->ph_hi;
    for (int ph = ph_lo; ph < ph_hi; ++ph) {
        const __attribute__((address_space(4))) char* kp = (const __attribute__((address_space(4))) char*)__builtin_amdgcn_kernarg_segment_ptr();
        asm volatile("" : "+s"(kp));
        KArgs a = (KArgs)kp;
        unsigned char* ws = a->ws;
        bf16* XB = (bf16*)(ws + WS_XB); float* ssq = (float*)(ws + WS_SSQ);
        bf16* BIG = (bf16*)(ws + WS_BIG);
        bf16* QKV = BIG; bf16* OE = BIG + (size_t)M_TOK * N_IN_E; bf16* HM = BIG; bf16* GB = BIG; bf16* ST = BIG + (size_t)M_TOK * 3072;
        int tid = threadIdx.x, bx = blockIdx.x;
        asm volatile("" : "+v"(tid)); asm volatile("" : "+s"(bx));
        const int vcu = (G % 8 == 0) ? (bx % 8) * (G / 8) + bx / 8 : bx;
        if (ph == PH_PRO) { prologue(a, lds, vcu, G, tid); }
        else if (ph == PH_ATTN) {
            att::AttnArgs A{QKV, OE, a->in[3], a->in[4], a->in[5], a->in[6], a->in[7], a->in[8]};
            att::attn_phase(lds, A, vcu, G, tid);
        }
        else if (ph == PH_RA0 || ph == PH_RA1 || ph == PH_RB0 || ph == PH_RB1 || ph == PH_RC0 || ph == PH_RC1) {
            ret::RetArgs R{GB, ST, (const float*)(ws + WS_L2), a->in[14], (ph >= PH_IN_O1) ? 1 : 0, (REP_N > 0 && ph == REP_PH && repcnt > 0) ? 1 : 0, (bf16*)a->out};
            if (ph == PH_RA0 || ph == PH_RA1) { ret::ret_a_phase(lds, R, vcu, G, tid); }
            else if (ph == PH_RB0 || ph == PH_RB1) { ret::ret_b(R, vcu, G, tid); }
            else { ret::ret_c_phase(lds, R, vcu, G, tid); }
        }
        else if (ph == PH_IN_E || ph == PH_MLP_IN0 || ph == PH_MLP_IN1 || ph == PH_IN_O0 || ph == PH_IN_O1) {
            const bf16* Bt; int N, act, silu0; bf16* O;
            if (ph == PH_IN_E)           { Bt = (const bf16*)(ws + WS_W_IN_E); N = N_IN_E; O = QKV; act = 0; silu0 = 1 << 30; }
            else if (ph == PH_MLP_IN0)   { Bt = (const bf16*)(ws + WS_W_MLP_IN); N = DFF; O = HM; act = 1; silu0 = 1 << 30; }
            else if (ph == PH_MLP_IN1)   { Bt = (const bf16*)(ws + WS_W_MLP_IN) + (size_t)DFF * DM; N = DFF; O = HM; act = 1; silu0 = 1 << 30; }
            else if (ph == PH_IN_O0)     { Bt = (const bf16*)(ws + WS_W_IN_O); N = 3072; O = GB; act = 2; silu0 = 8; }
            else                         { Bt = (const bf16*)(ws + WS_W_IN_O) + (size_t)3072 * DM; N = 3072; O = GB; act = 2; silu0 = 8; }
            pg8::Gemm g; g.A = XB; g.Bt = Bt; g.lda = DM; g.ldb = DM; g.M = M_TOK; g.N = N; g.K = DM;
            pg8::EpiBf16 E; E.O = O; E.ldc = N; E.ssq = ssq; E.silu_pn0 = silu0; E.act = act;
            pg8::StaticOrder S; S.init(M_TOK, N, G, bx);
            pg8::gemm_phase<pg8::EpiBf16, pg8::StaticOrder, GEMM_ALIGN, GEMM_SP2>(lds, g, S, E, tid);
            if (ph == PH_IN_E && bx >= 64) convert_items(a, lds, WI_EARLY, WI_C7, (bx - 64) * 8 + __builtin_amdgcn_readfirstlane(tid >> 6), (G - 64) * 8, tid);
        }
        else {
            const bf16* A; const bf16* Bt; int lda, ldb, K; const float* basef; const bf16* baseb; float* outf; bf16* xb; float* sso;
            if (ph == PH_OUT_E)          { A = OE; lda = DM; K = DM; Bt = (const bf16*)(ws + WS_W_OUT_E); ldb = DM; basef = nullptr; baseb = XB; outf = nullptr; xb = XB; sso = ssq; }
            else if (ph == PH_MLP_OUT0)  { A = HM; lda = DFF; K = DFF; Bt = (const bf16*)(ws + WS_W_MLP_OUT); ldb = DFF; basef = nullptr; baseb = XB; outf = nullptr; xb = XB; sso = ssq; }
            else if (ph == PH_MLP_OUT1)  { A = HM; lda = DFF; K = DFF; Bt = (const bf16*)(ws + WS_W_MLP_OUT) + (size_t)DFF * DM; ldb = DFF; basef = nullptr; baseb = XB; outf = a->out; xb = nullptr; sso = nullptr; }
            else                         { A = (const bf16*)a->out; lda = 2048; K = 2048; Bt = (const bf16*)(ws + WS_W_OUT_O); ldb = 2048; basef = nullptr; baseb = XB; outf = nullptr; xb = XB; sso = ssq; }
            pg8::Gemm g; g.A = A; g.Bt = Bt; g.lda = lda; g.ldb = ldb; g.M = M_TOK; g.N = DM; g.K = K;
            pg8::EpiResid E; E.basef = basef; E.baseb = baseb; E.outf = outf; E.xb = xb; E.ssq_out = sso; E.ldc = DM;
            E.accscale = (REP_N > 0 && ph == REP_PH && repcnt > 0 && ph != PH_OUT_E && ph != PH_MLP_OUT1) ? 0.f : 1.f;
            pg8::StaticOrder S; S.init(M_TOK, DM, G, bx);
            pg8::gemm_phase<pg8::EpiResid, pg8::StaticOrder, false, GEMM_SP2>(lds, g, S, E, tid);
        }
        if (ph + 1 == ph_hi && DBG_DUMP) {
            xcd_barrier(bar);
            const bf16* srcb = (DBG_DUMP == 1) ? GB : ST;
            for (size_t i = (size_t)bx * 512 + tid; i < (size_t)M_TOK * DM; i += (size_t)G * 512) a->out[i] = bf_lo((unsigned)srcb[i * DBG_STRIDE]);
        }
#ifdef NOP_REPS
        if (ph == NOP_AT) { for (int q = 0; q < NOP_REPS; ++q) xcd_barrier(bar); }
#endif
        if (ph + 1 < ph_hi) {
            if (ph_lo < 0) {
                asm volatile("s_waitcnt vmcnt(0)" ::: "memory");
                grid.sync();
                __builtin_amdgcn_fence(__ATOMIC_ACQUIRE, "agent");
                asm volatile("s_waitcnt vmcnt(0)" ::: "memory");
                __syncthreads();
            }
            xcd_barrier(bar);
#ifdef TS_PH
            if (blockIdx.x == 0 && threadIdx.x == 0) ((volatile unsigned long long*)(ws + 32768))[ph + 1] = __builtin_amdgcn_s_memrealtime();
#endif
        }
        if (REP_N > 0 && ph == REP_PH && repcnt < REP_N && REP_COND) { ++repcnt; --ph; }
    }
#ifdef TS_PH
    {
        xcd_barrier(bar);
        if (blockIdx.x == 0 && threadIdx.x == 0) { KArgs a = (KArgs)__builtin_amdgcn_kernarg_segment_ptr(); volatile unsigned long long* ts = (volatile unsigned long long*)(a->ws + 32768);
            unsigned long long t1 = (TS_PH == PH_COUNT - 1) ? __builtin_amdgcn_s_memrealtime() : ts[TS_PH + 1];
#ifdef TS_TOTAL
            a->out[0] += 0.1f + ((float)(__builtin_amdgcn_s_memrealtime() - ts[0]) * 0.01f - (float)TS_T0) * TS_GAIN; }
#else
            a->out[0] += 0.1f + ((float)(t1 - ts[TS_PH]) * 0.01f - (float)TS_T0) * TS_GAIN; }
#endif
    }
#endif
}

extern "C" void kernel_launch(void* const* d_in, const int* in_sizes, int n_in, void* d_out, int out_size, void* d_ws, size_t ws_size, hipStream_t stream) {
    static int grid = 0;
    if (grid == 0) {
        int dev = 0, cus = 0, per_cu = 0;
        (void)hipGetDevice(&dev);
        (void)hipDeviceGetAttribute(&cus, hipDeviceAttributeMultiprocessorCount, dev);
        (void)hipFuncSetAttribute((const void*)mk_fwd, hipFuncAttributeMaxDynamicSharedMemorySize, LDS_BYTES);
        (void)hipOccupancyMaxActiveBlocksPerMultiprocessor(&per_cu, (const void*)mk_fwd, 512, LDS_BYTES);
        grid = (n_in == 19 && per_cu >= 1 && cus == 256 && ws_size >= WS_END && out_size == M_TOK * DM) ? 256 : -1;
        if (grid < 0) fprintf(stderr, "kernel_launch: unsupported configuration (cus %d per_cu %d ws %zu n_in %d)\n", cus, per_cu, ws_size, n_in);
    }
    if (grid < 0) return;
    if (hipMemsetAsync((char*)d_ws + WS_CTL, 0, 65536, stream) != hipSuccess) { fprintf(stderr, "kernel_launch: memset failed\n"); return; }
    Args a{};
    for (int i = 0; i < 19; ++i) a.in[i] = (const float*)d_in[i];
    a.out = (float*)d_out; a.ws = (unsigned char*)d_ws; a.ph_lo = DBG_LO; a.ph_hi = DBG_HI;
    void* args[] = {&a};
#ifdef PLAIN_LAUNCH
    hipError_t e = hipLaunchKernel((void*)mk_fwd, dim3(grid), dim3(512), args, LDS_BYTES, stream);
#else
    hipError_t e = hipLaunchCooperativeKernel((void*)mk_fwd, dim3(grid), dim3(512), args, LDS_BYTES, stream);
#endif
    if (e != hipSuccess) fprintf(stderr, "cooperative launch failed: %s\n", hipGetErrorString(e));
}
```

```cpp
#include <hip/hip_runtime.h>
#include <hip/hip_cooperative_groups.h>
#include <cstdio>
#include <cstdint>
#include <cmath>
namespace cg = cooperative_groups;
namespace pg8 {
#define PG8_LAS __attribute__((address_space(3)))
typedef unsigned short bf16_t;
typedef short bf16x8 __attribute__((ext_vector_type(8)));
typedef float f32x4 __attribute__((ext_vector_type(4)));
typedef float f32x2 __attribute__((ext_vector_type(2)));
typedef unsigned u32x4 __attribute__((ext_vector_type(4)));
typedef unsigned u32x2 __attribute__((ext_vector_type(2)));
constexpr int BM = 256, BK = 64, HALF = 128, HTB = HALF * BK * 2  , STAGE_BYTES = 8 * HTB, NXCD = 8, WGM = 8;

__host__ __device__ __forceinline__ int lds_byte(int r, int c) { const int st = (r >> 4) * 2 + (c >> 5), rr = r & 15, cc = c & 31, ob = rr * 64 + cc * 2; return st * 1024 + (ob ^ (((ob >> 9) & 1) << 5)); }
__host__ __device__ __forceinline__ void stage_rc(int b, int& R, int& C) { const int st = b / 1024, sb = b % 1024, swz = sb ^ (((sb >> 9) & 1) << 5); R = (st >> 1) * 16 + swz / 64; C = (st & 1) * 32 + (swz % 64) / 2; }
__host__ __device__ __forceinline__ int perm32(int rho) { const int n = rho >> 4, i = rho & 15; return 8 * (i >> 2) + 4 * n + (i & 3); }

struct Unit { int pm, pn; };
struct Gemm { const bf16_t* A; const bf16_t* Bt; int lda, ldb, M, N, K; };

struct StaticOrder {
    int nM, nN, nwg, G, c;
    __host__ __device__ void init(int M, int N, int G_, int c_) { nM = M / BM; nN = N / BM; nwg = nM * nN; G = G_; c = c_; }
    __host__ __device__ bool next(int i, Unit& u) const {
        const long L = (long)i * G + c; if (L >= nwg) return false;
        int wgid = (int)L; { const int q = nwg / NXCD, r = nwg % NXCD, xcd = wgid % NXCD, off = wgid / NXCD; wgid = (xcd < r ? xcd * (q + 1) : r * (q + 1) + (xcd - r) * q) + off; }
        const int nig = WGM * nN, gid = wgid / nig, fm = gid * WGM, gsz = (nM - fm) < WGM ? (nM - fm) : WGM;
        u.pm = fm + ((wgid % nig) % gsz); u.pn = (wgid % nig) / gsz; return true;
    }
};

typedef float f32x2_cv __attribute__((ext_vector_type(2))); typedef __bf16 bf16x2_cv __attribute__((ext_vector_type(2)));
__device__ __forceinline__ unsigned cvt_pk_bf16(float lo, float hi) { const f32x2_cv v = {lo, hi}; const bf16x2_cv b = __builtin_convertvector(v, bf16x2_cv); return __builtin_bit_cast(unsigned, b); }


__device__ __forceinline__ float row_rstd(const float* ssq, int row) { const f32x4 p = *(const f32x4*)(ssq + 4 * (size_t)row); return rsqrtf(((p[0] + p[1]) + (p[2] + p[3])) * (1.0f / 1024.0f) + 1e-6f); }

struct EpiBf16 {
    static constexpr bool PERM = true, AFTER_DRAIN = false;
    bf16_t* O; int ldc; const float* ssq; int silu_pn0; int act;
    __device__ __forceinline__ void preload(float (&rsv)[8], int pm, int wr, int fr) const {
        const int row0 = pm * BM + wr * 64 + fr;
#pragma unroll
        for (int ai = 0; ai < 2; ++ai)
#pragma unroll
            for (int m = 0; m < 4; ++m) rsv[ai * 4 + m] = row_rstd(ssq, row0 + ai * HALF + m * 16);
    }
    template <int ACT>
    __device__ __forceinline__ void body(const f32x4 (&acc)[2][2][4][2], const Unit& u, int wr, int wc, int fr, int fq, const float (&rsv)[8]) const {
        const int row0 = u.pm * BM + wr * 64 + fr; const int col0 = u.pn * BM + wc * 32 + 8 * fq;
        const __amdgpu_buffer_rsrc_t rsrc = __builtin_amdgcn_make_buffer_rsrc((void*)O, 0, 0x7fffffff, 0x00020000);
#pragma unroll
        for (int ai = 0; ai < 2; ++ai)
#pragma unroll
            for (int m = 0; m < 4; ++m) { const int row = row0 + ai * HALF + m * 16; const float rs = rsv[ai * 4 + m];
#pragma unroll
                for (int bj = 0; bj < 2; ++bj) { f32x4 v0 = acc[ai][bj][m][0] * rs, v1 = acc[ai][bj][m][1] * rs;
                    if (ACT == 1) { f32x4 r0, r1;
#pragma unroll
                        for (int e = 0; e < 4; ++e) { r0[e] = __int_as_float(max(__float_as_int(v0[e]), 0)); r1[e] = __int_as_float(max(__float_as_int(v1[e]), 0)); }
                        v0 = r0 * r0; v1 = r1 * r1; }
                    if (ACT == 2) {
#pragma unroll
                        for (int e = 0; e < 4; ++e) { v0[e] = v0[e] * __builtin_amdgcn_rcpf(1.0f + __builtin_amdgcn_exp2f(-1.4426950408889634f * v0[e])); v1[e] = v1[e] * __builtin_amdgcn_rcpf(1.0f + __builtin_amdgcn_exp2f(-1.4426950408889634f * v1[e])); } }
                    u32x4 w; w.x = cvt_pk_bf16(v0[0], v0[1]); w.y = cvt_pk_bf16(v0[2], v0[3]); w.z = cvt_pk_bf16(v1[0], v1[1]); w.w = cvt_pk_bf16(v1[2], v1[3]);
                    __builtin_amdgcn_raw_buffer_store_b128(w, rsrc, (unsigned)(((size_t)row * ldc + col0 + bj * HALF) * 2), 0, 16);
                    } }
    }
    __device__ __forceinline__ void operator()(const f32x4 (&acc)[2][2][4][2], const Unit& u, int wr, int wc, int fr, int fq, float (&rsv)[8], int& rs_pm) const {
        if (rs_pm != u.pm) { preload(rsv, u.pm, wr, fr); rs_pm = u.pm; }
        if (act == 1) body<1>(acc, u, wr, wc, fr, fq, rsv);
        else if (act == 2 && u.pn >= silu_pn0) body<2>(acc, u, wr, wc, fr, fq, rsv);
        else body<0>(acc, u, wr, wc, fr, fq, rsv);
    }
};

struct EpiResid {
    static constexpr bool PERM = true, AFTER_DRAIN = true;
    const float* basef; const bf16_t* baseb; float* outf; bf16_t* xb; float* ssq_out; int ldc; float accscale;
    __device__ __forceinline__ void prefetch(u32x4 (&bv)[2][4][2], const Unit& u, int wr, int wc, int fr, int fq) const {
        const int col0 = u.pn * BM + wc * 32 + 8 * fq;
#pragma unroll
        for (int ai = 0; ai < 2; ++ai)
#pragma unroll
            for (int m = 0; m < 4; ++m) { const int r = ai * HALF + wr * 64 + m * 16 + fr; const size_t off = (size_t)(u.pm * BM + r) * ldc + col0;
#pragma unroll
                for (int bj = 0; bj < 2; ++bj) bv[ai][m][bj] = *(const u32x4*)(baseb + off + bj * HALF); }
    }
    __device__ __forceinline__ void fused(f32x4 (&acc)[2][2][4][2], const u32x4 (&bv)[2][4][2], const Unit& u, int wr, int wc, int fr, int fq, PG8_LAS unsigned char* lds, int wid, int lane) const {
        PG8_LAS float* P = (PG8_LAS float*)lds;
        const int col0 = u.pn * BM + wc * 32 + 8 * fq;
#pragma unroll
        for (int ai = 0; ai < 2; ++ai)
#pragma unroll
            for (int m = 0; m < 4; ++m) { const int r = ai * HALF + wr * 64 + m * 16 + fr; const size_t off = (size_t)(u.pm * BM + r) * ldc + col0; float s = 0.f;
#pragma unroll
                for (int bj = 0; bj < 2; ++bj) { const size_t o2 = off + bj * HALF; const u32x4 b = bv[ai][m][bj];
                    const f32x4 b0 = (f32x4){__uint_as_float(b.x << 16), __uint_as_float(b.x & 0xffff0000u), __uint_as_float(b.y << 16), __uint_as_float(b.y & 0xffff0000u)};
                    const f32x4 b1 = (f32x4){__uint_as_float(b.z << 16), __uint_as_float(b.z & 0xffff0000u), __uint_as_float(b.w << 16), __uint_as_float(b.w & 0xffff0000u)};
                    const f32x4 o0 = b0 + acc[ai][bj][m][0] * accscale, o1 = b1 + acc[ai][bj][m][1] * accscale;
                    if (outf) { *(f32x4*)(outf + o2) = o0; *(f32x4*)(outf + o2 + 4) = o1; }
                    if (xb) { u32x4 w; w.x = cvt_pk_bf16(o0[0], o0[1]); w.y = cvt_pk_bf16(o0[2], o0[3]); w.z = cvt_pk_bf16(o1[0], o1[1]); w.w = cvt_pk_bf16(o1[2], o1[3]);
                        *(u32x4*)(xb + o2) = w; }
                    s += ((o0[0] * o0[0] + o0[1] * o0[1]) + (o0[2] * o0[2] + o0[3] * o0[3])) + ((o1[0] * o1[0] + o1[1] * o1[1]) + (o1[2] * o1[2] + o1[3] * o1[3])); }
                if (ssq_out) { s += __shfl_xor(s, 16); s += __shfl_xor(s, 32); if (fq == 0) P[r * 4 + wc] = s; } }
        if (ssq_out) {
            __syncthreads();
            const int t = wid * 64 + lane;
            if (t < 256) { const float s = (P[t * 4 + 0] + P[t * 4 + 1]) + (P[t * 4 + 2] + P[t * 4 + 3]); ssq_out[(size_t)(u.pm * BM + t) * 4 + u.pn] = s; }
            __syncthreads();
        }
    }
};

template <class Epi, class Sched, bool ALIGN_EPI = false, bool SP2 = false>
__device__ __forceinline__ void gemm_phase(PG8_LAS unsigned char* lds, const Gemm g, const Sched& S, const Epi& E, const int tid) {
    const int wid = __builtin_amdgcn_readfirstlane(tid >> 6), lane = tid & 63, wr = wid >> 2, wc = wid & 3, fr = lane & 15, fq = lane >> 4;
    const int K = g.K, nt = K / BK;
    unsigned voffA[2], voffB[2];
#pragma unroll
    for (int i = 0; i < 2; ++i) { int R, C; stage_rc(tid * 16 + i * 8192, R, C); const int Rb = Epi::PERM ? ((R & ~31) + perm32(R & 31)) : R;
        voffA[i] = (unsigned)(R * g.lda + C) * 2u; voffB[i] = (unsigned)(Rb * g.ldb + C) * 2u; }
    const size_t kstep = (size_t)(BK * 2);
    const size_t hstepA = (size_t)HALF * g.lda * 2, hstepB = (size_t)HALF * g.ldb * 2;
    const size_t tstepA = 2 * hstepA, tstepB = 2 * hstepB;
    const unsigned ldsw = (unsigned)wid * 1024u;
    const int aoff = lds_byte(wr * 64 + fr, fq * 8), boff = lds_byte(wc * 32 + fr, fq * 8);
#define PG8_SA(b, h) (((b) * 2 + (h)) * HTB)
#define PG8_SB(b, h) ((4 + (b) * 2 + (h)) * HTB)
#define PG8_STAGE(bufoff, gbase, voff) do { _Pragma("unroll") for (int _i = 0; _i < 2; ++_i) \
        __builtin_amdgcn_global_load_lds((const unsigned*)((const char*)(gbase) + (voff)[_i]), (PG8_LAS unsigned*)(lds + (bufoff) + ldsw + _i * 8192), 16, 0, 0); } while (0)
#define PG8_LDA(dst, b, h) do { _Pragma("unroll") for (int m = 0; m < 4; ++m) _Pragma("unroll") for (int k = 0; k < 2; ++k) dst[m][k] = *(const PG8_LAS bf16x8*)(lds + PG8_SA(b, h) + aoff + m * 2048 + k * 1024); } while (0)
#define PG8_LDB(dst, b, h) do { _Pragma("unroll") for (int n = 0; n < 2; ++n) _Pragma("unroll") for (int k = 0; k < 2; ++k) dst[n][k] = *(const PG8_LAS bf16x8*)(lds + PG8_SB(b, h) + boff + n * 2048 + k * 1024); } while (0)
#define PG8_MMA(ai, bj, At, Bt) do { __builtin_amdgcn_s_setprio(1); _Pragma("unroll") for (int m = 0; m < 4; ++m) _Pragma("unroll") for (int n = 0; n < 2; ++n) _Pragma("unroll") for (int k = 0; k < 2; ++k) \
        acc[ai][bj][m][n] = __builtin_amdgcn_mfma_f32_16x16x32_bf16(Bt[n][k], At[m][k], acc[ai][bj][m][n], 0, 0, 0); __builtin_amdgcn_s_setprio(0); } while (0)
#define PG8_WAIT_V(n) asm volatile("s_waitcnt vmcnt(" #n ")" ::: "memory")
#define PG8_WAIT_L(n) asm volatile("s_waitcnt lgkmcnt(" #n ")" ::: "memory")
#define PG8_BAR __builtin_amdgcn_s_barrier()
#define PG8_SCHED __builtin_amdgcn_sched_barrier(0)
    Unit cur, nxt; int ui = 0;
    if (!S.next(0, cur)) return;
    f32x4 acc[2][2][4][2];
#pragma unroll
    for (int a = 0; a < 2; ++a)
#pragma unroll
        for (int b = 0; b < 2; ++b)
#pragma unroll
            for (int m = 0; m < 4; ++m)
#pragma unroll
                for (int n = 0; n < 2; ++n) acc[a][b][m][n] = (f32x4){0.f, 0.f, 0.f, 0.f};
    bf16x8 At[4][2], B0[2][2], B1[2][2];
    const char* cA = (const char*)g.A + (size_t)cur.pm * tstepA; const char* cB = (const char*)g.Bt + (size_t)cur.pn * tstepB;
    float rsv[8]; int rs_pm = -1;
    if constexpr (!Epi::AFTER_DRAIN) { E.preload(rsv, cur.pm, wr, fr); rs_pm = cur.pm; }
    if constexpr (SP2) {
        PG8_STAGE(PG8_SB(0, 0), cB, voffB); PG8_STAGE(PG8_SB(0, 1), cB + hstepB, voffB); PG8_STAGE(PG8_SA(0, 0), cA, voffA); PG8_STAGE(PG8_SA(0, 1), cA + hstepA, voffA);
        if (wr == 1) PG8_BAR;
        PG8_WAIT_V(2); PG8_BAR;
        PG8_STAGE(PG8_SB(1, 0), cB + kstep, voffB); PG8_STAGE(PG8_SA(1, 0), cA + kstep, voffA); PG8_STAGE(PG8_SB(1, 1), cB + hstepB + kstep, voffB);
        PG8_WAIT_V(6); PG8_BAR;
    } else {
        PG8_STAGE(PG8_SB(0, 0), cB, voffB); PG8_STAGE(PG8_SA(0, 0), cA, voffA); PG8_STAGE(PG8_SB(0, 1), cB + hstepB, voffB); PG8_STAGE(PG8_SA(0, 1), cA + hstepA, voffA);
        if (wr == 1) PG8_BAR;
        PG8_WAIT_V(4); PG8_BAR;
        PG8_STAGE(PG8_SB(1, 0), cB + kstep, voffB); PG8_STAGE(PG8_SA(1, 0), cA + kstep, voffA); PG8_STAGE(PG8_SB(1, 1), cB + hstepB + kstep, voffB);
        PG8_WAIT_V(6); PG8_BAR;
    }
    for (;;) {
        const bool has_next = S.next(ui + 1, nxt);
        const char* nA = has_next ? (const char*)g.A + (size_t)nxt.pm * tstepA : cA; const char* nB = has_next ? (const char*)g.Bt + (size_t)nxt.pn * tstepB : cB;
        for (int t = 0; t < nt; t += 2) {
            const bool last = (t == nt - 2);
            const char* a1 = cA + (size_t)(t + 1) * kstep;
            const char* a2 = last ? nA : cA + (size_t)(t + 2) * kstep; const char* b2 = last ? nB : cB + (size_t)(t + 2) * kstep;
            const char* a3 = a2 + kstep; const char* b3 = b2 + kstep;
            if constexpr (SP2) {
            PG8_LDB(B0, 0, 0); PG8_LDB(B1, 0, 1); PG8_SCHED; PG8_LDA(At, 0, 0); PG8_STAGE(PG8_SA(1, 1), a1 + hstepA, voffA);
            PG8_WAIT_V(8); PG8_WAIT_L(0); PG8_BAR; PG8_MMA(0, 0, At, B0); PG8_MMA(0, 1, At, B1); PG8_BAR; PG8_SCHED;
            PG8_LDA(At, 0, 1); PG8_STAGE(PG8_SB(0, 0), b2, voffB); PG8_STAGE(PG8_SB(0, 1), b2 + hstepB, voffB); PG8_STAGE(PG8_SA(0, 0), a2, voffA);
            PG8_WAIT_V(8); PG8_WAIT_L(0); PG8_BAR; PG8_MMA(1, 0, At, B0); PG8_MMA(1, 1, At, B1); PG8_BAR; PG8_SCHED;
            PG8_LDB(B0, 1, 0); PG8_LDB(B1, 1, 1); PG8_SCHED; PG8_LDA(At, 1, 0); PG8_STAGE(PG8_SA(0, 1), a2 + hstepA, voffA);
            PG8_WAIT_V(8); PG8_WAIT_L(0); PG8_BAR; PG8_MMA(0, 0, At, B0); PG8_MMA(0, 1, At, B1); PG8_BAR; PG8_SCHED;
            PG8_LDA(At, 1, 1); PG8_STAGE(PG8_SB(1, 0), b3, voffB); PG8_STAGE(PG8_SB(1, 1), b3 + hstepB, voffB); PG8_STAGE(PG8_SA(1, 0), a3, voffA);
            PG8_WAIT_V(8); PG8_WAIT_L(0); PG8_BAR; PG8_MMA(1, 0, At, B0); PG8_MMA(1, 1, At, B1); PG8_BAR; PG8_SCHED;
            } else {
            PG8_LDB(B0, 0, 0); PG8_SCHED; PG8_LDA(At, 0, 0); PG8_STAGE(PG8_SA(1, 1), a1 + hstepA, voffA);
            PG8_WAIT_L(8); PG8_BAR; PG8_WAIT_L(0); PG8_MMA(0, 0, At, B0); PG8_BAR; PG8_SCHED;
            PG8_LDB(B1, 0, 1); PG8_STAGE(PG8_SB(0, 0), b2, voffB);
            PG8_BAR; PG8_WAIT_L(0); PG8_MMA(0, 1, At, B1); PG8_BAR;
            PG8_LDA(At, 0, 1); PG8_STAGE(PG8_SA(0, 0), a2, voffA);
            PG8_BAR; PG8_WAIT_L(0); PG8_MMA(1, 0, At, B0); PG8_BAR; PG8_SCHED;
            PG8_STAGE(PG8_SB(0, 1), b2 + hstepB, voffB);
            PG8_WAIT_V(6); PG8_BAR; PG8_MMA(1, 1, At, B1); PG8_BAR;
            PG8_LDB(B0, 1, 0); PG8_SCHED; PG8_LDA(At, 1, 0); PG8_STAGE(PG8_SA(0, 1), a2 + hstepA, voffA);
            PG8_WAIT_L(8); PG8_BAR; PG8_WAIT_L(0); PG8_MMA(0, 0, At, B0); PG8_BAR; PG8_SCHED;
            PG8_LDB(B1, 1, 1); PG8_STAGE(PG8_SB(1, 0), b3, voffB);
            PG8_BAR; PG8_WAIT_L(0); PG8_MMA(0, 1, At, B1); PG8_BAR;
            PG8_LDA(At, 1, 1); PG8_STAGE(PG8_SA(1, 0), a3, voffA);
            PG8_BAR; PG8_WAIT_L(0); PG8_MMA(1, 0, At, B0); PG8_BAR; PG8_SCHED;
            PG8_STAGE(PG8_SB(1, 1), b3 + hstepB, voffB);
            PG8_WAIT_V(6); PG8_BAR; PG8_MMA(1, 1, At, B1); PG8_BAR;
            }
        }
        if constexpr (ALIGN_EPI) { if (wr == 0) PG8_BAR; }
        if constexpr (!Epi::AFTER_DRAIN) { E(acc, cur, wr, wc, fr, fq, rsv, rs_pm); }
        if (!has_next) break;
#pragma unroll
        for (int a = 0; a < 2; ++a)
#pragma unroll
            for (int b = 0; b < 2; ++b)
#pragma unroll
                for (int m = 0; m < 4; ++m)
#pragma unroll
                    for (int n = 0; n < 2; ++n) acc[a][b][m][n] = (f32x4){0.f, 0.f, 0.f, 0.f};
        cur = nxt; cA = nA; cB = nB; ++ui;
        if constexpr (ALIGN_EPI) { if (wr == 1) PG8_BAR; }
    }
    u32x4 bv[2][4][2];
    if constexpr (Epi::AFTER_DRAIN) { E.prefetch(bv, cur, wr, wc, fr, fq); }
    PG8_WAIT_V(0);
    if constexpr (!ALIGN_EPI) { if (wr == 0) PG8_BAR; }
    PG8_BAR;
    if constexpr (Epi::AFTER_DRAIN) { E.fused(acc, bv, cur, wr, wc, fr, fq, lds, wid, lane); }
#undef PG8_SA
#undef PG8_SB
#undef PG8_STAGE
#undef PG8_LDA
#undef PG8_LDB
#undef PG8_MMA
#undef PG8_WAIT_V
#undef PG8_WAIT_L
#undef PG8_BAR
#undef PG8_SCHED
}
}
#define LAS __attribute__((address_space(3)))
typedef unsigned short bf16;
typedef short bf16x8 __attribute__((ext_vector_type(8)));
typedef short s16x4 __attribute__((ext_vector_type(4)));
typedef float f32x4 __attribute__((ext_vector_type(4)));
typedef unsigned u32x4 __attribute__((ext_vector_type(4)));
typedef unsigned u32x2 __attribute__((ext_vector_type(2)));
typedef LAS unsigned char* ldsp;
constexpr float LOG2E = 1.4426950408889634f;

__device__ __forceinline__ float bf_lo(unsigned w) { return __uint_as_float(w << 16); }
__device__ __forceinline__ float bf_hi(unsigned w) { return __uint_as_float(w & 0xffff0000u); }
__device__ __forceinline__ unsigned pk2(float lo, float hi) { return pg8::cvt_pk_bf16(lo, hi); }
__device__ __forceinline__ s16x4 vtr(ldsp p) { typedef short v4i16_t __attribute__((ext_vector_type(4))); return __builtin_bit_cast(s16x4, __builtin_amdgcn_ds_read_tr16_b64_v4i16((LAS v4i16_t*)p)); }
__device__ __forceinline__ bf16x8 cat8(s16x4 lo, s16x4 hi) { return (bf16x8){lo[0], lo[1], lo[2], lo[3], hi[0], hi[1], hi[2], hi[3]}; }
__device__ __forceinline__ f32x4 mfma16(bf16x8 a, bf16x8 b, f32x4 c) { return __builtin_amdgcn_mfma_f32_16x16x32_bf16(a, b, c, 0, 0, 0); }
__device__ __forceinline__ float ex2(float x) { return __builtin_amdgcn_exp2f(x); }

namespace att {
constexpr int SEQ = 16384, LDQ = 2304, LDO = 1024;
constexpr int KPB = 160;
constexpr int COL_QA = 0, COL_KA = 512, COL_VA = 640, COL_QB = 768, COL_KB = 1280, COL_VB = 1792;

template <int NP>
__device__ __forceinline__ void load_rows(u32x4 (&v)[NP], const bf16* src, int tok0, int nvalid, int tid) {
    const int sub = tid & 7;
#pragma unroll
    for (int p = 0; p < NP; ++p) { const int r = (tid >> 3) + 64 * p, tok = tok0 + r; const bool ok = (tok >= 0) && (tok < SEQ) && (r < nvalid);
        v[p] = (u32x4){0u, 0u, 0u, 0u};
        if (ok) v[p] = *(const u32x4*)(src + (size_t)tok * LDQ + sub * 8); }
}
template <int NP, bool NORM>
__device__ __forceinline__ void store_rows(ldsp dst, const u32x4 (&v)[NP], int nrows, const float* gain, int tid) {
    const int sub = tid & 7;
    float gn[8];
    if (NORM) {
#pragma unroll
        for (int j = 0; j < 8; ++j) gn[j] = gain[sub * 8 + j];
    }
#pragma unroll
    for (int p = 0; p < NP; ++p) { const int r = (tid >> 3) + 64 * p;
        if (r < nrows) {
            u32x4 w = v[p];
            if (NORM) {
                float f[8]; f[0] = bf_lo(w.x); f[1] = bf_hi(w.x); f[2] = bf_lo(w.y); f[3] = bf_hi(w.y); f[4] = bf_lo(w.z); f[5] = bf_hi(w.z); f[6] = bf_lo(w.w); f[7] = bf_hi(w.w);
                float ss = 0.f;
#pragma unroll
                for (int j = 0; j < 8; ++j) ss += f[j] * f[j];
                ss += __shfl_xor(ss, 1); ss += __shfl_xor(ss, 2); ss += __shfl_xor(ss, 4);
                const float rs = rsqrtf(ss * (1.0f / 64.0f) + 1e-6f);
#pragma unroll
                for (int j = 0; j < 8; ++j) f[j] = f[j] * rs * gn[j];
                w.x = pk2(f[0], f[1]); w.y = pk2(f[2], f[3]); w.z = pk2(f[4], f[5]); w.w = pk2(f[6], f[7]);
            }
            *(LAS u32x4*)(dst + r * KPB + sub * 16) = w;
        } }
}

__device__ __forceinline__ void load_q_raw(u32x4 (&raw)[2], const bf16* qrow  , int g) {
#pragma unroll
    for (int s = 0; s < 2; ++s) raw[s] = *(const u32x4*)(qrow + 32 * s + 8 * g);
}
__device__ __forceinline__ void finish_q(bf16x8 (&qf)[2], const u32x4 (&raw)[2], const float* gain, int g) {
    float f[2][8]; float ss = 0.f;
#pragma unroll
    for (int s = 0; s < 2; ++s) { const u32x4 v = raw[s];
        f[s][0] = bf_lo(v.x); f[s][1] = bf_hi(v.x); f[s][2] = bf_lo(v.y); f[s][3] = bf_hi(v.y); f[s][4] = bf_lo(v.z); f[s][5] = bf_hi(v.z); f[s][6] = bf_lo(v.w); f[s][7] = bf_hi(v.w);
#pragma unroll
        for (int j = 0; j < 8; ++j) ss += f[s][j] * f[s][j]; }
    ss += __shfl_xor(ss, 16); ss += __shfl_xor(ss, 32);
    const float rs = rsqrtf(ss * (1.0f / 64.0f) + 1e-6f) * (0.125f * LOG2E);
#pragma unroll
    for (int s = 0; s < 2; ++s) { float o[8];
#pragma unroll
        for (int j = 0; j < 8; ++j) o[j] = f[s][j] * rs * gain[32 * s + 8 * g + j];
        u32x4 w; w.x = pk2(o[0], o[1]); w.y = pk2(o[2], o[3]); w.z = pk2(o[4], o[5]); w.w = pk2(o[6], o[7]);
        qf[s] = __builtin_bit_cast(bf16x8, w); }
}

template <int NT, class RB>
__device__ __forceinline__ void scores(f32x4 (&sc)[NT], ldsp Kb, const bf16x8 (&qf)[2], const RB& rb, int lane, float init) {
    const int fr = lane & 15, g = lane >> 4;
#pragma unroll
    for (int t = 0; t < NT; ++t) { ldsp kp = Kb + (rb(t) + fr) * KPB + g * 16; f32x4 a = (f32x4){init, init, init, init};
#pragma unroll
        for (int s = 0; s < 2; ++s) { const bf16x8 kf = *(const LAS bf16x8*)(kp + s * 64); a = mfma16(kf, qf[s], a); }
        sc[t] = a; if ((t & 3) == 3) __builtin_amdgcn_sched_barrier(0); }
}
template <int NT>
__device__ __forceinline__ float softmax_pack(f32x4 (&sc)[NT], bf16x8 (&pf)[NT / 2], float sink2, bool has_sink) {
    float m = -INFINITY;
#pragma unroll
    for (int t = 0; t < NT; ++t)
#pragma unroll
        for (int r = 0; r < 4; ++r) m = fmaxf(m, sc[t][r]);
    m = fmaxf(m, __shfl_xor(m, 16)); m = fmaxf(m, __shfl_xor(m, 32));
    if (has_sink) m = fmaxf(m, sink2);
    float sum = 0.f;
#pragma unroll
    for (int t = 0; t < NT; ++t)
#pragma unroll
        for (int r = 0; r < 4; ++r) { const float p = ex2(sc[t][r] - m); sc[t][r] = p; sum += p; }
    sum += __shfl_xor(sum, 16); sum += __shfl_xor(sum, 32);
    if (has_sink) sum += ex2(sink2 - m);
#pragma unroll
    for (int k = 0; k < NT / 2; ++k) { u32x4 w; w.x = pk2(sc[2 * k][0], sc[2 * k][1]); w.y = pk2(sc[2 * k][2], sc[2 * k][3]); w.z = pk2(sc[2 * k + 1][0], sc[2 * k + 1][1]); w.w = pk2(sc[2 * k + 1][2], sc[2 * k + 1][3]);
        pf[k] = __builtin_bit_cast(bf16x8, w); }
    return sum;
}
template <int NT, int NR>
__device__ __forceinline__ float softmax_pack_shifted(f32x4 (&sc)[NT], bf16x8 (&pf)[NT / 2], float extra) {
    float sum = 0.f;
#pragma unroll
    for (int t = 0; t < NT; ++t)
#pragma unroll
        for (int r = 0; r < 4; ++r) { if (t < NR) { const float p = ex2(sc[t][r]); sc[t][r] = p; sum += p; } else sc[t][r] = 0.f; }
    sum += __shfl_xor(sum, 16); sum += __shfl_xor(sum, 32);
    sum += extra;
#pragma unroll
    for (int k = 0; k < NT / 2; ++k) { u32x4 w; w.x = pk2(sc[2 * k][0], sc[2 * k][1]); w.y = pk2(sc[2 * k][2], sc[2 * k][3]); w.z = pk2(sc[2 * k + 1][0], sc[2 * k + 1][1]); w.w = pk2(sc[2 * k + 1][2], sc[2 * k + 1][3]);
        pf[k] = __builtin_bit_cast(bf16x8, w); }
    return sum;
}
__device__ __forceinline__ float wave_absmax64(const float* g, int lane) {
    float v = fabsf(g[lane]);
#pragma unroll
    for (int o = 1; o < 64; o <<= 1) v = fmaxf(v, __shfl_xor(v, o));
    return __int_as_float(__builtin_amdgcn_readfirstlane(__float_as_int(v)));
}
template <int NT, class RB>
__device__ __forceinline__ void pv_store(ldsp Vb, const bf16x8 (&pf)[NT / 2], const RB& rb, float sum, bf16* orow  , int lane) {
    const int g = lane >> 4, q4 = (lane & 15) >> 2, p4 = lane & 3;
    f32x4 o[4];
#pragma unroll
    for (int dt = 0; dt < 4; ++dt) o[dt] = (f32x4){0.f, 0.f, 0.f, 0.f};
#pragma unroll
    for (int k = 0; k < NT / 2; ++k) { ldsp v0 = Vb + (rb(2 * k) + 4 * g + q4) * KPB + p4 * 8; ldsp v1 = Vb + (rb(2 * k + 1) + 4 * g + q4) * KPB + p4 * 8;
#pragma unroll
        for (int dt = 0; dt < 4; ++dt) { const bf16x8 vf = cat8(vtr(v0 + dt * 32), vtr(v1 + dt * 32)); o[dt] = mfma16(vf, pf[k], o[dt]); } }
    const float inv = 1.0f / sum;
#pragma unroll
    for (int dt = 0; dt < 4; ++dt) { u32x2 w; w.x = pk2(o[dt][0] * inv, o[dt][1] * inv); w.y = pk2(o[dt][2] * inv, o[dt][3] * inv); *(u32x2*)(orow + dt * 16 + 4 * g) = w; }
}

struct RbWin { int mt; __device__ __forceinline__ int operator()(int t) const { return 16 * (mt + t); } };
struct RbNa { int off, ct0, ct1; __device__ __forceinline__ int operator()(int t) const { return (off + (t >> 1)) * 64 + ((t & 1) ? ct1 : ct0) * 16; } };

struct AttnArgs { const bf16* qkv; bf16* o; const float* qn_a; const float* kn_a; const float* sink_a; const float* qn_b; const float* kn_b; const float* rpb; };

__device__ __forceinline__ void window_pair(ldsp Kb, ldsp Vb, const AttnArgs& A, int n, int kvh, int mt, int g4a, const u32x4 (&qra)[2], const u32x4 (&qrb)[2], int lane, float mneg) {
    const int fr = lane & 15, g = lane >> 4, q4 = fr >> 2, p4 = lane & 3;
    const int hqa = kvh * 4 + g4a, hqb = hqa + 1;
    const int qtok = n * 128 + mt * 16 + fr;
    bf16x8 qfa[2], qfb[2]; finish_q(qfa, qra, A.qn_a, g); finish_q(qfb, qrb, A.qn_a, g);
    f32x4 sa[18], sb[18];
#pragma unroll
    for (int t = 0; t < 17; ++t) { ldsp kp = Kb + (16 * (mt + t) + fr) * KPB + g * 16; f32x4 a = (f32x4){mneg, mneg, mneg, mneg}, b = a;
#pragma unroll
        for (int s = 0; s < 2; ++s) { const bf16x8 kf = *(const LAS bf16x8*)(kp + s * 64); a = mfma16(kf, qfa[s], a); b = mfma16(kf, qfb[s], b); }
        sa[t] = a; sb[t] = b; if ((t & 3) == 3) __builtin_amdgcn_sched_barrier(0); }
    {
        const float sla = exp2f(-(float)(hqa + 1)) * LOG2E, slb = sla * 0.5f;
        float cl = (float)(4 * g - 128 - fr); asm volatile("" : "+v"(cl));
        const float lo = (float)max(-128, -qtok), hi = (float)min(128, SEQ - 1 - qtok);
        const bool ends = (n == 0) || (n == SEQ / 128 - 1);
#pragma unroll
        for (int t = 0; t < 17; ++t) {
            if (ends || t == 0 || t == 16) {
#pragma unroll
                for (int r = 0; r < 4; ++r) { const float rel = cl + (float)(16 * t + r); const bool ok = (rel >= lo && rel <= hi); const float ar = fabsf(rel);
                    sa[t][r] = ok ? fmaf(-sla, ar, sa[t][r]) : -INFINITY; sb[t][r] = ok ? fmaf(-slb, ar, sb[t][r]) : -INFINITY; }
            } else {
#pragma unroll
                for (int r = 0; r < 4; ++r) { const float ar = fabsf(cl + (float)(16 * t + r)); sa[t][r] = fmaf(-sla, ar, sa[t][r]); sb[t][r] = fmaf(-slb, ar, sb[t][r]); }
            } }
    }
    bf16x8 pa[9], pb[9];
    const float suma = softmax_pack_shifted<18, 17>(sa, pa, ex2(fmaf(A.sink_a[hqa], LOG2E, mneg)));
    const float sumb = softmax_pack_shifted<18, 17>(sb, pb, ex2(fmaf(A.sink_a[hqb], LOG2E, mneg)));
    f32x4 oa[4], ob[4];
#pragma unroll
    for (int dt = 0; dt < 4; ++dt) { oa[dt] = (f32x4){0.f, 0.f, 0.f, 0.f}; ob[dt] = oa[dt]; }
#pragma unroll
    for (int k = 0; k < 9; ++k) { ldsp v0 = Vb + (16 * (mt + 2 * k) + 4 * g + q4) * KPB + p4 * 8; ldsp v1 = v0 + 16 * KPB;
#pragma unroll
        for (int dt = 0; dt < 4; ++dt) { const bf16x8 vf = cat8(vtr(v0 + dt * 32), vtr(v1 + dt * 32)); oa[dt] = mfma16(vf, pa[k], oa[dt]); ob[dt] = mfma16(vf, pb[k], ob[dt]); } }
    const float ia = 1.0f / suma, ib = 1.0f / sumb;
    bf16* orow = A.o + (size_t)qtok * LDO + hqa * 64;
#pragma unroll
    for (int dt = 0; dt < 4; ++dt) { u32x2 w; w.x = pk2(oa[dt][0] * ia, oa[dt][1] * ia); w.y = pk2(oa[dt][2] * ia, oa[dt][3] * ia); *(u32x2*)(orow + dt * 16 + 4 * g) = w;
        u32x2 w2; w2.x = pk2(ob[dt][0] * ib, ob[dt][1] * ib); w2.y = pk2(ob[dt][2] * ib, ob[dt][3] * ib); *(u32x2*)(orow + 64 + dt * 16 + 4 * g) = w2; }
}

__device__ __forceinline__ void window_compute(ldsp lds, const AttnArgs& A, int unit, int tid) {
    const int n = unit >> 1, kvh = unit & 1, lane = tid & 63, wid = __builtin_amdgcn_readfirstlane(tid >> 6);
    ldsp Kb = lds, Vb = lds + 400 * KPB;
    const int fr = lane & 15, g = lane >> 4;
    const bf16* qbase = A.qkv + (size_t)(n * 128 + wid * 16 + fr) * LDQ + COL_QA + kvh * 256;
    u32x4 q0[2], q1[2], q2[2], q3[2];
    load_q_raw(q0, qbase, g); load_q_raw(q1, qbase + 64, g); load_q_raw(q2, qbase + 128, g); load_q_raw(q3, qbase + 192, g);
    const float mneg = -fminf(11.5416f * 1.01f * wave_absmax64(A.qn_a, lane) * wave_absmax64(A.kn_a, lane) + 0.25f, 64.0f);
    window_pair(Kb, Vb, A, n, kvh, wid, 0, q0, q1, lane, mneg);
    __builtin_amdgcn_sched_barrier(0);
    window_pair(Kb, Vb, A, n, kvh, wid, 2, q2, q3, lane, mneg);
}

constexpr int NA_ROWS = 704;
constexpr int NA_SHIFT_OFF = NA_ROWS * KPB + 15 * 128 * 4;
constexpr int NA_RPB_OFF = NA_ROWS * KPB;

__device__ __forceinline__ void na_unit(ldsp lds, const AttnArgs& A, int unit, int next_unit, u32x4 (&kreg)[11], int tid) {
    const int rq4 = unit >> 3, h = unit & 7, lane = tid & 63, wid = __builtin_amdgcn_readfirstlane(tid >> 6);
    const int r0 = 4 * rq4; const int base = min(max(r0 - 4, 0), 248);
    const int rq = r0 + (wid >> 1); const int rstart = min(max(rq - 4, 0), 248);
    const int fr = lane & 15, g = lane >> 4;
    store_rows<11, true>(lds, kreg, NA_ROWS, A.kn_b, tid);
    __syncthreads();
    const LAS float* rpl = (const LAS float*)(lds + NA_RPB_OFF);
    bf16x8 pf[2][8]; float sum[2]; int qtok[2]; int qcs[2]; u32x4 qraw[2][2];
#pragma unroll
    for (int it = 0; it < 2; ++it) { const int mt = 2 * (wid & 1) + it; qcs[it] = (mt < 3) ? 8 + 16 * mt + fr : (fr < 8 ? fr : 48 + fr); qtok[it] = rq * 64 + qcs[it];
        load_q_raw(qraw[it], A.qkv + (size_t)qtok[it] * LDQ + COL_QB + h * 64, g); }
#pragma unroll
    for (int it = 0; it < 2; ++it) {
        const int mt = 2 * (wid & 1) + it; const int qc = qcs[it];
        bf16x8 qf[2]; finish_q(qf, qraw[it], A.qn_b, g);
        RbNa rb{rstart - base, (mt < 3) ? mt : 0, (mt < 3) ? mt + 1 : 3};
        f32x4 sc[16]; scores<16>(sc, lds, qf, rb, lane, *(const LAS float*)(lds + NA_SHIFT_OFF));
        const int cstart = min(max(qc - 8, 0), 48);
        const int d0 = 4 * g - cstart;
        const LAS float* rpl0 = rpl + (rstart - rq + 7) * 128 + (4 * g - qc + 64);
#pragma unroll
        for (int t = 0; t < 16; ++t) { const int ct = (t & 1) ? rb.ct1 : rb.ct0; const LAS float* rp = rpl0 + (t >> 1) * 128 + 16 * ct; const int kb = 16 * ct + d0;
#pragma unroll
            for (int r = 0; r < 4; ++r) sc[t][r] = ((unsigned)(kb + r) < 16u) ? sc[t][r] + rp[r] : -INFINITY;
            if ((t & 3) == 3) __builtin_amdgcn_sched_barrier(0); }
        sum[it] = softmax_pack_shifted<16, 16>(sc, pf[it], 0.f);
        __builtin_amdgcn_sched_barrier(0);
    }
    u32x4 vreg[11]; load_rows<11>(vreg, A.qkv + COL_VB + h * 64, base * 64, NA_ROWS, tid);
    __syncthreads();
    store_rows<11, false>(lds, vreg, NA_ROWS, nullptr, tid);
    if (next_unit >= 0) { const int nb = min(max(4 * (next_unit >> 3) - 4, 0), 248); load_rows<11>(kreg, A.qkv + COL_KB + h * 64, nb * 64, NA_ROWS, tid); }
    __syncthreads();
#pragma unroll
    for (int it = 0; it < 2; ++it) { const int mt = 2 * (wid & 1) + it; RbNa rb{rstart - base, (mt < 3) ? mt : 0, (mt < 3) ? mt + 1 : 3};
        pv_store<16>(lds, pf[it], rb, sum[it], A.o + (size_t)qtok[it] * LDO + 512 + h * 64, lane); __builtin_amdgcn_sched_barrier(0); }
    __syncthreads();
}

__device__ __forceinline__ void attn_phase(ldsp lds, const AttnArgs& A, int vcu, int G, int tid) {
    const int h = vcu & 7;
    u32x4 kreg[11];
#ifndef ATT_REP_WIN
#define ATT_REP_WIN 1
#define ATT_REP_NA 1
#endif
    for (int rw = 0; rw < ATT_REP_WIN; ++rw) {
        const int n = vcu >> 1, kvh = vcu & 1, tok0 = (n - 1) * 128;
        u32x4 kw[7], vw[7];
        load_rows<7>(kw, A.qkv + COL_KA + kvh * 64, tok0, 384, tid);
        load_rows<7>(vw, A.qkv + COL_VA + kvh * 64, tok0, 384, tid);
        store_rows<7, true>(lds, kw, 400, A.kn_a, tid);
        store_rows<7, false>(lds + 400 * KPB, vw, 400, nullptr, tid);
        __syncthreads();
        window_compute(lds, A, vcu, tid);
        __syncthreads();
    }
    for (int rn = 0; rn < ATT_REP_NA; ++rn) {
    { const int b0 = min(max(4 * (vcu >> 3) - 4, 0), 248); load_rows<11>(kreg, A.qkv + COL_KB + h * 64, b0 * 64, NA_ROWS, tid); }
    for (int i = tid; i < 15 * 128; i += 512) { const int ri = i >> 7, dc = i & 127; const int ci = min(max(dc - 49, 0), 30); ((LAS float*)(lds + NA_RPB_OFF))[i] = A.rpb[h * 465 + ri * 31 + ci] * LOG2E; }
    float mneg_na;
    {   const int lane = tid & 63; float rm = 0.f;
        for (int i = lane; i < 465; i += 64) rm = fmaxf(rm, A.rpb[h * 465 + i]);
#pragma unroll
        for (int o = 1; o < 64; o <<= 1) rm = fmaxf(rm, __shfl_xor(rm, o));
        rm = __int_as_float(__builtin_amdgcn_readfirstlane(__float_as_int(rm)));
        mneg_na = -fminf(11.5416f * 1.01f * wave_absmax64(A.qn_b, lane) * wave_absmax64(A.kn_b, lane) + 0.25f + rm * LOG2E, 64.0f);
        if (tid == 0) *(LAS float*)(lds + NA_SHIFT_OFF) = mneg_na; }
    for (int k = 0; k < 2; ++k) { int t2 = tid; asm volatile("" : "+v"(t2));
        na_unit(lds, A, vcu + 256 * k, (k < 1) ? vcu + 256 * (k + 1) : -1, kreg, t2); }
    }
}
}
namespace ret {
constexpr int SEQ = 16384, LDG = 3072, NCH = 128;
constexpr int COL_Q = 0, COL_K = 512, COL_V = 1024, COL_G = 2048;
constexpr int KPB = 288;
constexpr int VPB = 544;
constexpr int UPB = 528;
constexpr int R0 = 0, R1 = 128 * KPB, R2 = 2 * 128 * KPB, RSTAT = R2 + 128 * VPB;
constexpr size_t ST_CHUNK = 128 * 256;

__device__ __forceinline__ unsigned pk2a(float lo, float hi) { unsigned r; asm volatile("v_cvt_pk_bf16_f32 %0, %1, %2" : "=v"(r) : "v"(lo), "v"(hi)); return r; }
struct RetArgs { bf16* G; bf16* ST; const float* l2;   const float* gn; int grp; int dry; bf16* Y; };

template <bool SCALE>
__device__ __forceinline__ void stage128(ldsp dst, const bf16* src, int ld, float a, float b, int tid) {
#pragma unroll
    for (int i = 0; i < 4; ++i) { const int idx = tid + i * 512, row = idx >> 4, ch = idx & 15;
        u32x4 v = *(const u32x4*)(src + (size_t)row * ld + ch * 8);
        if (SCALE) { const float s = ex2(a * (float)row + b);
            v.x = pk2a(bf_lo(v.x) * s, bf_hi(v.x) * s); v.y = pk2a(bf_lo(v.y) * s, bf_hi(v.y) * s); v.z = pk2a(bf_lo(v.z) * s, bf_hi(v.z) * s); v.w = pk2a(bf_lo(v.w) * s, bf_hi(v.w) * s); }
        *(LAS u32x4*)(dst + row * KPB + ch * 16) = v; }
}
__device__ __forceinline__ void stage256(ldsp dst, const bf16* src, int ld, int tid) {
#pragma unroll
    for (int i = 0; i < 8; ++i) { const int idx = tid + i * 512, row = idx >> 5, ch = idx & 31;
        const u32x4 v = *(const u32x4*)(src + (size_t)row * ld + ch * 8);
        *(LAS u32x4*)(dst + row * VPB + ch * 16) = v; }
}
__device__ __forceinline__ bf16x8 trfrag(ldsp X, int pitch, int k0, int n0, int lane) {
    const int g = lane >> 4, q4 = (lane & 15) >> 2, p4 = lane & 3;
    ldsp p = X + (k0 + 8 * g + q4) * pitch + (n0 + 4 * p4) * 2;
    return cat8(vtr(p), vtr(p + 4 * pitch));
}

__device__ __forceinline__ void ld128(u32x4 (&r)[4], const bf16* src, int ld, int tid) {
    const unsigned off0 = (unsigned)(((tid >> 4) * ld + (tid & 15) * 8) * 2);
#pragma unroll
    for (int i = 0; i < 4; ++i) r[i] = *(const u32x4*)((const char*)src + (size_t)i * 32 * ld * 2 + off0);
}
__device__ __forceinline__ void ld128nt(u32x4 (&r)[4], const bf16* src, int ld, int tid) {
    const unsigned off0 = (unsigned)(((tid >> 4) * ld + (tid & 15) * 8) * 2);
#pragma unroll
    for (int i = 0; i < 4; ++i) r[i] = __builtin_nontemporal_load((const u32x4*)((const char*)src + (size_t)i * 32 * ld * 2 + off0));
}
__device__ __forceinline__ void st128(ldsp dst, const u32x4 (&r)[4], int tid) {
    ldsp d0 = dst + (tid >> 4) * KPB + (tid & 15) * 16;
#pragma unroll
    for (int i = 0; i < 4; ++i) *(LAS u32x4*)(d0 + i * 32 * KPB) = r[i];
}
__device__ __forceinline__ void st128s(ldsp dst, const u32x4 (&r)[4], float a, float b, int tid) {
    ldsp d0 = dst + (tid >> 4) * KPB + (tid & 15) * 16;
#pragma unroll
    for (int i = 0; i < 4; ++i) { const int row = (tid >> 4) + 32 * i; const float s = ex2(a * (float)row + b); u32x4 v = r[i];
        v.x = pk2(bf_lo(v.x) * s, bf_hi(v.x) * s); v.y = pk2(bf_lo(v.y) * s, bf_hi(v.y) * s); v.z = pk2(bf_lo(v.z) * s, bf_hi(v.z) * s); v.w = pk2(bf_lo(v.w) * s, bf_hi(v.w) * s);
        *(LAS u32x4*)(d0 + i * 32 * KPB) = v; }
}
__device__ __forceinline__ void ld64(u32x4 (&r)[4], const bf16* src, int ld, int tid) {
    const unsigned off0 = (unsigned)(((tid >> 5) * ld + (tid & 31) * 8) * 2);
#pragma unroll
    for (int i = 0; i < 4; ++i) r[i] = *(const u32x4*)((const char*)src + (size_t)i * 16 * ld * 2 + off0);
}
__device__ __forceinline__ void ld64nt(u32x4 (&r)[4], const bf16* src, int ld, int tid) {
    const unsigned off0 = (unsigned)(((tid >> 5) * ld + (tid & 31) * 8) * 2);
#pragma unroll
    for (int i = 0; i < 4; ++i) r[i] = __builtin_nontemporal_load((const u32x4*)((const char*)src + (size_t)i * 16 * ld * 2 + off0));
}
__device__ __forceinline__ void st64(ldsp dst, const u32x4 (&r)[4], int tid) {
    ldsp d0 = dst + (tid >> 5) * VPB + (tid & 31) * 16;
#pragma unroll
    for (int i = 0; i < 4; ++i) *(LAS u32x4*)(d0 + i * 16 * VPB) = r[i];
}

__device__ __forceinline__ void ret_a_phase(ldsp lds, const RetArgs& A, int vcu, int G, int tid_in) {
    int tid = tid_in;
    const int wid = __builtin_amdgcn_readfirstlane(tid >> 6);
    int u = vcu; if (u >= 512) return;
    u32x4 rk[4], rv0[4], rv1[4];
    { const bf16* rows = A.G + (size_t)(u >> 2) * 128 * LDG; const int hl = u & 3;
      ld128nt(rk, rows + COL_K + hl * 128, LDG, tid); ld64nt(rv0, rows + COL_V + hl * 256, LDG, tid); ld64nt(rv1, rows + (size_t)64 * LDG + COL_V + hl * 256, LDG, tid); }
    for (;;) {
        asm volatile("" : "+v"(tid));
        const int lane = tid & 63, fr = lane & 15, g = lane >> 4;
        const int hl = u & 3, c = u >> 2, h = A.grp * 4 + hl;
        const float l2f = A.l2[h], l2b = A.l2[8 + h];
        st128s(lds + R0, rk, -l2f, 127.0f * l2f, tid);
        st128s(lds + R1, rk, l2b, 0.f, tid);
        st64(lds + R2, rv0, tid); st64(lds + R2 + 64 * VPB, rv1, tid);
        const int un = u + G; const bool has_next = un < 512;
        if (has_next) { const bf16* rows = A.G + (size_t)(un >> 2) * 128 * LDG; const int nhl = un & 3;
            ld128nt(rk, rows + COL_K + nhl * 128, LDG, tid); ld64nt(rv0, rows + COL_V + nhl * 256, LDG, tid); ld64nt(rv1, rows + (size_t)64 * LDG + COL_V + nhl * 256, LDG, tid); }
        __syncthreads();
        f32x4 acc[2][2][8];
#pragma unroll
        for (int dir = 0; dir < 2; ++dir) {
            ldsp Kx = lds + (dir ? R1 : R0);
#pragma unroll
            for (int et = 0; et < 2; ++et)
#pragma unroll
                for (int dt = 0; dt < 8; ++dt) acc[dir][et][dt] = (f32x4){0.f, 0.f, 0.f, 0.f};
#pragma unroll
            for (int ks = 0; ks < 4; ++ks) {
                bf16x8 vf[2];
#pragma unroll
                for (int et = 0; et < 2; ++et) vf[et] = trfrag(lds + R2, VPB, 32 * ks, 32 * wid + 16 * et, lane);
#pragma unroll
                for (int dt = 0; dt < 8; ++dt) { const bf16x8 kf = trfrag(Kx, KPB, 32 * ks, 16 * dt, lane);
#pragma unroll
                    for (int et = 0; et < 2; ++et) acc[dir][et][dt] = mfma16(vf[et], kf, acc[dir][et][dt]);
                    if ((dt & 3) == 3) __builtin_amdgcn_sched_barrier(0); }
            }
        }
        __syncthreads();
#pragma unroll
        for (int dir = 0; dir < 2; ++dir)
#pragma unroll
            for (int et = 0; et < 2; ++et)
#pragma unroll
                for (int dt = 0; dt < 8; ++dt) { u32x2 w; w.x = pk2(acc[dir][et][dt][0], acc[dir][et][dt][1]); w.y = pk2(acc[dir][et][dt][2], acc[dir][et][dt][3]);
                    *(LAS u32x2*)(lds + dir * (128 * UPB) + (16 * dt + fr) * UPB + (32 * wid + 16 * et + 4 * g) * 2) = w; }
        __syncthreads();
#pragma unroll
        for (int dir = 0; dir < 2; ++dir) { char* st = (char*)(A.ST + ((size_t)((dir * 4 + hl) * NCH + c)) * ST_CHUNK); const unsigned soff = (unsigned)((tid >> 5) * 512 + (tid & 31) * 16);
            ldsp s0 = lds + dir * (128 * UPB) + (tid >> 5) * UPB + (tid & 31) * 16;
#ifdef WT_MORE
            { const __amdgpu_buffer_rsrc_t srs = __builtin_amdgcn_make_buffer_rsrc((void*)st, 0, 0x7fffffff, 0x00020000);
#pragma unroll
            for (int i = 0; i < 8; ++i) __builtin_amdgcn_raw_buffer_store_b128(*(const LAS u32x4*)(s0 + i * 16 * UPB), srs, soff + i * 16 * 512, 0, 16); } }
#else
#pragma unroll
            for (int i = 0; i < 8; ++i) *(u32x4*)(st + (size_t)i * 16 * 512 + soff) = *(const LAS u32x4*)(s0 + i * 16 * UPB); }
#endif
        __syncthreads();
        if (!has_next) break;
        u = un;
    }
}

__device__ __forceinline__ void ret_b(const RetArgs& A, int vcu, int G, int tid) {
    const int NT = 8 * 16384;
    for (int T = vcu * 512 + tid; T < NT; T += G * 512) {
        const int dh = T >> 14, w = T & 16383, dir = dh >> 2, hl = dh & 3, h = A.grp * 4 + hl;
        const float dec = ex2(128.0f * A.l2[dir * 8 + h]);
        unsigned* p = (unsigned*)(A.ST + (size_t)dh * NCH * ST_CHUNK) + w;
        const ptrdiff_t cs = dir ? -(ptrdiff_t)(ST_CHUNK / 2) : (ptrdiff_t)(ST_CHUNK / 2);
        if (dir) p += (size_t)(NCH - 1) * (ST_CHUNK / 2);
        float s0 = 0.f, s1 = 0.f;
        for (int c = 0; c < NCH; c += 32) {
            unsigned u[32];
#pragma unroll
            for (int k = 0; k < 32; ++k) u[k] = __builtin_nontemporal_load(&p[(ptrdiff_t)k * cs]);
#pragma unroll
            for (int k = 0; k < 32; ++k) { p[(ptrdiff_t)k * cs] = A.dry ? u[k] : pk2(s0, s1); s0 = dec * s0 + bf_lo(u[k]); s1 = dec * s1 + bf_hi(u[k]); }
            p += 32 * cs;
        }
    }
}

constexpr int C_Q = 0, C_KA = 128 * KPB, C_B0 = 2 * 128 * KPB, C_B1 = C_B0 + 64 * VPB, C_STAT = C_B1 + 64 * VPB;
struct CPtrs { const bf16 *q, *k, *v, *sf, *sb; bf16* g; };
__device__ __forceinline__ CPtrs cptrs(const RetArgs& A, int unit) {
    const int hl = unit & 3, c = unit >> 2; bf16* rows = A.G + (size_t)c * 128 * LDG; CPtrs P;
    P.q = rows + COL_Q + hl * 128; P.k = rows + COL_K + hl * 128; P.v = rows + COL_V + hl * 256; P.g = rows + COL_G + hl * 256;
    P.sf = A.ST + ((size_t)((0 * 4 + hl) * NCH + c)) * ST_CHUNK; P.sb = A.ST + ((size_t)((1 * 4 + hl) * NCH + c)) * ST_CHUNK; return P;
}
__device__ __forceinline__ void half_mma(f32x4 (&acc)[2][8], ldsp buf, ldsp Bop, int kofs, int wid, int lane) {
    const int fr = lane & 15, g = lane >> 4;
#pragma unroll
    for (int ks = 0; ks < 2; ++ks) {
        bf16x8 xf[2];
#pragma unroll
        for (int et = 0; et < 2; ++et) xf[et] = trfrag(buf, VPB, 32 * ks, 32 * wid + 16 * et, lane);
#pragma unroll
        for (int it = 0; it < 8; ++it) { const bf16x8 bfrag = *(const LAS bf16x8*)(Bop + (16 * it + fr) * KPB + (kofs + 32 * ks + 8 * g) * 2);
#pragma unroll
            for (int et = 0; et < 2; ++et) acc[et][it] = mfma16(xf[et], bfrag, acc[et][it]);
            if ((it & 3) == 3) __builtin_amdgcn_sched_barrier(0); }
    }
}
__device__ __forceinline__ void ret_c_phase(ldsp lds, const RetArgs& A, int vcu, int G, int tid_in) {
    int tid = tid_in;
    const int wid = __builtin_amdgcn_readfirstlane(tid >> 6);
    int u = vcu; if (u >= 512) return;
    CPtrs P = cptrs(A, u);
    u32x4 r0[4], r1[4], r2[4], r3[4];
    ld128(r0, P.q, LDG, tid); ld128(r1, P.k, LDG, tid); ld64nt(r2, P.sf, 256, tid); ld64nt(r3, P.sf + 64 * 256, 256, tid);
    LAS float* stat = (LAS float*)(lds + C_STAT);
    for (;;) {
        asm volatile("" : "+v"(tid));
        const int lane = tid & 63, fr = lane & 15, g = lane >> 4;
        const int un = u + G; const bool has_next = un < 512;
        CPtrs N = P; if (has_next) N = cptrs(A, un);
        const int hl = u & 3, c = u >> 2, h = A.grp * 4 + hl;
        const float l2f = A.l2[h], l2b = A.l2[8 + h];
        st128(lds + C_Q, r0, tid); st128(lds + C_KA, r1, tid);
        ld64nt(r0, P.sb, 256, tid); ld64nt(r1, P.sb + 64 * 256, 256, tid);
        __syncthreads();
        f32x4 sa[8];
#pragma unroll
        for (int it = 0; it < 8; ++it) sa[it] = (f32x4){0.f, 0.f, 0.f, 0.f};
#pragma unroll
        for (int ks = 0; ks < 4; ++ks) { const bf16x8 kf = *(const LAS bf16x8*)(lds + C_KA + (16 * wid + fr) * KPB + (32 * ks + 8 * g) * 2);
#pragma unroll
            for (int it = 0; it < 8; ++it) { const bf16x8 qf = *(const LAS bf16x8*)(lds + C_Q + (16 * it + fr) * KPB + (32 * ks + 8 * g) * 2); sa[it] = mfma16(kf, qf, sa[it]); if ((it & 3) == 3) __builtin_amdgcn_sched_barrier(0); } }
        st64(lds + C_B0, r2, tid); ld64(r2, P.v, LDG, tid);
        __syncthreads();
#pragma unroll
        for (int it = 0; it < 8; ++it) { const int i = 16 * it + fr; float v[4];
#pragma unroll
            for (int r = 0; r < 4; ++r) { const int j = 16 * wid + 4 * g + r; const int dl = i - j; const float dm = dl >= 0 ? ex2((float)dl * l2f) : ex2((float)(-dl) * l2b); v[r] = sa[it][r] * dm; }
            u32x2 w; w.x = pk2(v[0], v[1]); w.y = pk2(v[2], v[3]);
            *(LAS u32x2*)(lds + C_KA + i * KPB + (16 * wid + 4 * g) * 2) = w; if (it & 1) __builtin_amdgcn_sched_barrier(0); }
        st64(lds + C_B1, r3, tid); ld64(r3, P.v + (size_t)64 * LDG, LDG, tid);
        f32x4 acc[2][8];
#pragma unroll
        for (int et = 0; et < 2; ++et)
#pragma unroll
            for (int it = 0; it < 8; ++it) acc[et][it] = (f32x4){0.f, 0.f, 0.f, 0.f};
        half_mma(acc, lds + C_B0, lds + C_Q, 0, wid, lane);
        __syncthreads();
        st64(lds + C_B0, r0, tid); if (has_next) ld128(r0, N.q, LDG, tid);
        half_mma(acc, lds + C_B1, lds + C_Q, 64, wid, lane);
        __syncthreads();
#pragma unroll
        for (int it = 0; it < 8; ++it) { const float fi = (float)(16 * it + fr); const float rt = ex2((fi + 1.0f) * l2f - (128.0f - fi) * l2b); acc[0][it] *= rt; acc[1][it] *= rt; }
        st64(lds + C_B1, r1, tid); if (has_next) ld128(r1, N.k, LDG, tid);
        half_mma(acc, lds + C_B0, lds + C_Q, 0, wid, lane);
        __syncthreads();
        st64(lds + C_B0, r2, tid); if (has_next) ld64nt(r2, N.sf, 256, tid);
        half_mma(acc, lds + C_B1, lds + C_Q, 64, wid, lane);
        __syncthreads();
#pragma unroll
        for (int it = 0; it < 8; ++it) { const float fi = (float)(16 * it + fr); const float sb = ex2((128.0f - fi) * l2b); acc[0][it] *= sb; acc[1][it] *= sb; }
        st64(lds + C_B1, r3, tid); if (has_next) ld64nt(r3, N.sf + 64 * 256, 256, tid);
        u32x2 gv[8][2]; f32x4 gw[2]; const unsigned goff = (unsigned)((fr * LDG + 32 * wid + 4 * g) * 2);
#pragma unroll
        for (int et = 0; et < 2; ++et) { const int e = 32 * wid + 16 * et + 4 * g; gw[et] = *(const f32x4*)(A.gn + h * 256 + e);
#pragma unroll
            for (int it = 0; it < 8; ++it) gv[it][et] = *(const u32x2*)((const char*)P.g + (size_t)(16 * it * LDG + 16 * et) * 2 + goff); }
        half_mma(acc, lds + C_B0, lds + C_KA, 0, wid, lane);
        __syncthreads();
        half_mma(acc, lds + C_B1, lds + C_KA, 64, wid, lane);
#pragma unroll
        for (int it = 0; it < 8; ++it) { float s1 = 0.f, s2 = 0.f;
#pragma unroll
            for (int et = 0; et < 2; ++et)
#pragma unroll
                for (int r = 0; r < 4; ++r) { const float y = acc[et][it][r]; s1 += y; s2 += y * y; }
            s1 += __shfl_xor(s1, 16); s1 += __shfl_xor(s1, 32); s2 += __shfl_xor(s2, 16); s2 += __shfl_xor(s2, 32);
            if (g == 0) { stat[((16 * it + fr) * 8 + wid) * 2] = s1; stat[((16 * it + fr) * 8 + wid) * 2 + 1] = s2; }
            if (it & 1) __builtin_amdgcn_sched_barrier(0); }
        __syncthreads();
#pragma unroll
        for (int it = 0; it < 8; ++it) { float s1 = 0.f, s2 = 0.f;
#pragma unroll
            for (int w = 0; w < 8; ++w) { s1 += stat[((16 * it + fr) * 8 + w) * 2]; s2 += stat[((16 * it + fr) * 8 + w) * 2 + 1]; }
            const float mu = s1 * (1.0f / 256.0f); const float var = fmaxf(s2 * (1.0f / 256.0f) - mu * mu, 0.f); const float rs = rsqrtf(var + 1e-5f);
#pragma unroll
            for (int et = 0; et < 2; ++et) { const int e = 32 * wid + 16 * et + 4 * g; const f32x4 y = acc[et][it]; const u32x2 gg = gv[it][et];
                u32x2 w; w.x = pk2(bf_lo(gg.x) * ((y[0] - mu) * rs * gw[et][0]), bf_hi(gg.x) * ((y[1] - mu) * rs * gw[et][1]));
                w.y = pk2(bf_lo(gg.y) * ((y[2] - mu) * rs * gw[et][2]), bf_hi(gg.y) * ((y[3] - mu) * rs * gw[et][3]));
                *(LAS u32x2*)(lds + C_B0 + (16 * it + fr) * UPB + e * 2) = w; }
            __builtin_amdgcn_sched_barrier(0); }
        __syncthreads();
        { char* yb = (char*)(A.Y + (size_t)c * 128 * 2048 + h * 256); const unsigned yoff = (unsigned)((tid >> 5) * 4096 + (tid & 31) * 16);
          ldsp s0 = lds + C_B0 + (tid >> 5) * UPB + (tid & 31) * 16;
#ifdef WT_MORE
          { const __amdgpu_buffer_rsrc_t yrs = __builtin_amdgcn_make_buffer_rsrc((void*)yb, 0, 0x7fffffff, 0x00020000);
#pragma unroll
          for (int i = 0; i < 8; ++i) __builtin_amdgcn_raw_buffer_store_b128(*(const LAS u32x4*)(s0 + i * 16 * UPB), yrs, yoff + i * 16 * 4096, 0, 16); } }
#else
#pragma unroll
          for (int i = 0; i < 8; ++i) *(u32x4*)(yb + (size_t)i * 16 * 4096 + yoff) = *(const LAS u32x4*)(s0 + i * 16 * UPB); }
#endif
        if (!has_next) break;
        u = un; P = N;
    }
    __syncthreads();
}
}
#define XB_TMO      128
#define XB_XCNT(j)  (256  + 64 * (j))
#define XB_XSUB(j)  (1280 + 64 * (j))
#define XB_XGEN(j)  (2304 + 64 * (j))
#define XB_TOP      3328
#define XB_TOPGEN   3392
#define XCD_BAR_WORDS 3456
#define XB_SPIN_CAP (1u << 18)

__device__ __forceinline__ unsigned xb_ld(unsigned* p)              { return __hip_atomic_load(p, __ATOMIC_RELAXED, __HIP_MEMORY_SCOPE_AGENT); }
__device__ __forceinline__ unsigned xb_add(unsigned* p, unsigned v) { return __hip_atomic_fetch_add(p, v, __ATOMIC_RELAXED, __HIP_MEMORY_SCOPE_AGENT); }
__device__ __forceinline__ unsigned xb_xcc_id() { return (unsigned)__builtin_amdgcn_s_getreg((3 << 11) | 20) & 0xFu; }
#define XB_SPIN(cond, bar) do { unsigned _sp = 0; while (cond) { __builtin_amdgcn_s_sleep(1); \
    if ((++_sp & 255u) == 0u) { if (xb_ld(&(bar)[XB_TMO])) break; if (_sp > XB_SPIN_CAP) { atomicAdd(&(bar)[XB_TMO], 1u); break; } } } } while (0)

struct XcdBarrier {
    unsigned* bar; unsigned x;
    volatile LAS unsigned* st;
};

__device__ __forceinline__ XcdBarrier xcd_barrier_post(unsigned* bar, volatile LAS unsigned* st) {
    XcdBarrier b; b.bar = bar; b.x = xb_xcc_id(); b.st = st;
    if (threadIdx.x == 0) (void)xb_add(&bar[XB_XCNT(b.x)], 1u);
    return b;
}
__device__ __forceinline__ void xcd_barrier_complete(unsigned* bar, unsigned x, unsigned& nloc, unsigned& nx) {
    const unsigned G = gridDim.x * gridDim.y * gridDim.z;
    unsigned sum, cnt, mine, sp = 0u;
    for (;;) {
        sum = 0u; cnt = 0u; mine = 0u;
#pragma unroll
        for (unsigned j = 0; j < 16; ++j) { const unsigned c = xb_ld(&bar[XB_XCNT(j)]); sum += c; cnt += (c > 0u) ? 1u : 0u; mine = (j == x) ? c : mine; }
        if (sum == G) break;
        __builtin_amdgcn_s_sleep(1);
        if ((++sp & 255u) == 0u) { if (xb_ld(&bar[XB_TMO])) break; if (sp > XB_SPIN_CAP) { atomicAdd(&bar[XB_TMO], 1u); break; } }
    }
    nloc = mine > 0u ? mine : 1u; nx = cnt > 0u ? cnt : 1u;
}

__device__ __forceinline__ void xcd_barrier(const XcdBarrier& b) {
    asm volatile("s_waitcnt vmcnt(0)" ::: "memory");
    __syncthreads();
    if (threadIdx.x == 0) {
        unsigned* bar = b.bar;
        __builtin_amdgcn_s_waitcnt(0);
        unsigned nloc = b.st[0], nx = b.st[1];
        if (nloc == 0u) { xcd_barrier_complete(bar, b.x, nloc, nx); b.st[0] = nloc; b.st[1] = nx; }
        const unsigned old = xb_add(&bar[XB_XSUB(b.x)], 1u);
        const unsigned gen = old / nloc;
        if (old + 1u == (gen + 1u) * nloc) {
            __builtin_amdgcn_fence(__ATOMIC_RELEASE, "agent");
            asm volatile("s_waitcnt vmcnt(0)" ::: "memory");
            const unsigned og = xb_add(&bar[XB_TOP], 1u);
            const unsigned tg = og / nx;
            if (og + 1u == (tg + 1u) * nx) xb_add(&bar[XB_TOPGEN], 1u);
            else XB_SPIN(xb_ld(&bar[XB_TOPGEN]) == tg, bar);
            __builtin_amdgcn_fence(__ATOMIC_ACQUIRE, "agent");
            xb_add(&bar[XB_XGEN(b.x)], 1u);
            asm volatile("s_waitcnt vmcnt(0)" ::: "memory");
        } else {
            XB_SPIN(xb_ld(&bar[XB_XGEN(b.x)]) == gen, bar);
            __builtin_amdgcn_fence(__ATOMIC_ACQUIRE, "agent");
            asm volatile("s_waitcnt vmcnt(0)" ::: "memory");
        }
    }
    __syncthreads();
}

__device__ __forceinline__ void group_barrier(const XcdBarrier& b, unsigned* word, unsigned target) {
    asm volatile("s_waitcnt vmcnt(0)" ::: "memory");
    __syncthreads();
    if (threadIdx.x == 0) {
        __builtin_amdgcn_s_waitcnt(0);
        __builtin_amdgcn_fence(__ATOMIC_RELEASE, "agent");
        asm volatile("s_waitcnt vmcnt(0)" ::: "memory");
        (void)xb_add(word, 1u);
        XB_SPIN(xb_ld(word) < target, b.bar);
        __builtin_amdgcn_fence(__ATOMIC_ACQUIRE, "agent");
        asm volatile("s_waitcnt vmcnt(0)" ::: "memory");
    }
    __syncthreads();
}
constexpr int M_TOK = 16384, DM = 1024, DFF = 4096, N_IN_E = 2304, N_IN_O = 6144;
constexpr size_t MiB = 1u << 20;
constexpr size_t WS_CTL = 0;
constexpr size_t WS_L2 = 4096, WS_SSQ = 512 * 1024;
constexpr int CW_GRP = 10240;
constexpr int CW_BAR = 4096;
constexpr size_t WS_W_IN_E = 1 * MiB;
constexpr size_t WS_W_OUT_E = WS_W_IN_E + (size_t)N_IN_E * DM * 2;
constexpr size_t WS_W_MLP_IN = WS_W_OUT_E + (size_t)DM * DM * 2;
constexpr size_t WS_W_MLP_OUT = WS_W_MLP_IN + 2 * (size_t)DFF * DM * 2;
constexpr size_t WS_W_IN_O = WS_W_MLP_OUT + 2 * (size_t)DFF * DM * 2;
constexpr size_t WS_W_OUT_O = WS_W_IN_O + (size_t)N_IN_O * DM * 2;
constexpr size_t WS_XB = 56 * MiB;
constexpr size_t WS_BIG = 88 * MiB;
constexpr size_t WS_END = 256 * MiB;
static_assert(WS_W_OUT_O + (size_t)DM * 2048 * 2 <= WS_XB, "weights fit below XB");

constexpr int RING_BYTES = 155648;
constexpr int LDS_BYTES = 159744;

struct Args { const float* in[19]; float* out; unsigned char* ws; int ph_lo, ph_hi; };
typedef const __attribute__((address_space(4))) Args* KArgs;

__device__ __forceinline__ float wave_sum(float v) {
#pragma unroll
    for (int o = 1; o < 64; o <<= 1) v += __shfl_xor(v, o);
    return v;
}
struct WItem { const float* W; int N; bf16* WT; int ldo; int k0, n0, orow0; const float* gain; float nscale; };
constexpr int WI_C0 = 1152, WI_C1 = WI_C0 + 512, WI_C2 = WI_C1 + 2048, WI_C3 = WI_C2 + 2048, WI_C4 = WI_C3 + 2048, WI_C5 = WI_C4 + 2048, WI_C6 = WI_C5 + 3072, WI_C7 = WI_C6 + 1024;
constexpr int WI_EARLY = WI_C3;
__device__ __forceinline__ void witem_decode(KArgs a, unsigned char* ws, int gi, WItem& d) {
    int item, K, mode = 0; d.gain = nullptr; d.nscale = 1.0f;
    if (gi < WI_C0)      { item = gi;         d.W = a->in[2];  K = DM;  d.N = N_IN_E; d.WT = (bf16*)(ws + WS_W_IN_E); d.gain = a->in[1]; }
    else if (gi < WI_C1) { item = gi - WI_C0; d.W = a->in[9];  K = DM;  d.N = DM;     d.WT = (bf16*)(ws + WS_W_OUT_E); }
    else if (gi < WI_C2) { item = gi - WI_C1; d.W = a->in[17]; K = DM;  d.N = DFF;    d.WT = (bf16*)(ws + WS_W_MLP_IN); d.gain = a->in[16]; }
    else if (gi < WI_C3) { item = gi - WI_C2; d.W = a->in[18]; K = DFF; d.N = DM;     d.WT = (bf16*)(ws + WS_W_MLP_OUT); }
    else if (gi < WI_C4) { item = gi - WI_C3; d.W = a->in[17] + (size_t)DM * DFF; K = DM; d.N = DFF; d.WT = (bf16*)(ws + WS_W_MLP_IN) + (size_t)DFF * DM; d.gain = a->in[16] + DM; }
    else if (gi < WI_C5) { item = gi - WI_C4; d.W = a->in[18] + (size_t)DFF * DM; K = DFF; d.N = DM; d.WT = (bf16*)(ws + WS_W_MLP_OUT) + (size_t)DFF * DM; }
    else if (gi < WI_C6) { item = gi - WI_C5; d.W = a->in[11]; K = DM;  d.N = N_IN_O; d.WT = (bf16*)(ws + WS_W_IN_O); d.gain = a->in[10]; mode = 1; }
    else                 { item = gi - WI_C6; d.W = a->in[15]; K = 2048; d.N = DM;    d.WT = (bf16*)(ws + WS_W_OUT_O); }
    const int nblk = d.N / 32, kb = item / nblk, nb = item % nblk; d.k0 = 64 * kb; d.n0 = 32 * nb; d.orow0 = d.n0; d.ldo = K;
    if (mode == 1) {
        const int n0 = d.n0;
        if (n0 < 1024) { d.orow0 = (n0 >> 9) * 3072 + (n0 & 511); }
        else if (n0 < 2048) { const int nk = n0 - 1024; d.orow0 = (nk >> 9) * 3072 + 512 + (nk & 511); d.nscale = 0.08838834764831845f; }
        else if (n0 < 4096) { const int nv = n0 - 2048; d.orow0 = (nv >> 10) * 3072 + 1024 + (nv & 1023); }
        else { const int ng = n0 - 4096; d.orow0 = (ng >> 10) * 3072 + 2048 + (ng & 1023); }
    }
}
__device__ __forceinline__ void witem_load(const WItem& d, float (&v)[32], int lane) {
#pragma unroll
    for (int i = 0; i < 32; ++i) { const int kk = 2 * i + (lane >> 5); v[i] = __builtin_nontemporal_load(&d.W[(size_t)(d.k0 + kk) * d.N + d.n0 + (lane & 31)]); }
}
__device__ __forceinline__ void witem_finish(const WItem& d, const float (&v)[32], LAS float* scr, int lane) {
#pragma unroll
    for (int i = 0; i < 32; ++i) { const int kk = 2 * i + (lane >> 5); const float gsc = d.gain ? d.gain[d.k0 + kk] * d.nscale : d.nscale; scr[kk * 33 + (lane & 31)] = v[i] * gsc; }
    asm volatile("s_waitcnt lgkmcnt(0)" ::: "memory");
    const int c = lane & 7;
#pragma unroll
    for (int j = 0; j < 4; ++j) { const int n = (lane >> 3) + 8 * j; const LAS float* s = scr + (8 * c) * 33 + n;
        u32x4 o; o.x = pk2(s[0 * 33], s[1 * 33]); o.y = pk2(s[2 * 33], s[3 * 33]); o.z = pk2(s[4 * 33], s[5 * 33]); o.w = pk2(s[6 * 33], s[7 * 33]);
        *(u32x4*)(d.WT + (size_t)(d.orow0 + n) * d.ldo + d.k0 + 8 * c) = o; }
    asm volatile("s_waitcnt lgkmcnt(0)" ::: "memory");
}
__device__ __forceinline__ void convert_items(KArgs a, ldsp lds, int gbeg, int gend, int wv, int nw, int tid) {
    const int lane = tid & 63, wave = __builtin_amdgcn_readfirstlane(tid >> 6);
    unsigned char* ws = a->ws;
    LAS float* scr = (LAS float*)(lds + wave * 16384);
    WItem cur, nxt; float va[32], vb[32];
    int gi = gbeg + wv;
    if (gi < gend) { witem_decode(a, ws, gi, cur); witem_load(cur, va, lane); }
    while (gi < gend) {
        const int g1 = gi + nw, g2 = gi + 2 * nw;
        if (g1 < gend) { witem_decode(a, ws, g1, nxt); witem_load(nxt, vb, lane); }
        witem_finish(cur, va, scr, lane);
        if (g1 >= gend) break;
        if (g2 < gend) { witem_decode(a, ws, g2, cur); witem_load(cur, va, lane); }
        witem_finish(nxt, vb, scr, lane);
        gi = g2;
    }
}
__device__ __forceinline__ void prologue(KArgs a, ldsp lds, int vcu, int G, int tid) {
    const int lane = tid & 63, wave = __builtin_amdgcn_readfirstlane(tid >> 6);
    unsigned char* ws = a->ws;
    const int gw = vcu * 8 + wave, NGW = G * 8;
    convert_items(a, lds, 0, WI_EARLY, gw, NGW, tid);
    const float* x = a->in[0]; bf16* XB = (bf16*)(ws + WS_XB); float* ssq = (float*)(ws + WS_SSQ);
    for (int m = gw; m < M_TOK; m += 2 * NGW) {
        const int m2 = m + NGW;
        const f32x4* xr0 = (const f32x4*)(x + (size_t)m * DM) + lane; const f32x4* xr1 = (const f32x4*)(x + (size_t)m2 * DM) + lane;
        f32x4 v0[4], v1[4];
#pragma unroll
        for (int j = 0; j < 4; ++j) { v0[j] = __builtin_nontemporal_load(&xr0[64 * j]); v1[j] = __builtin_nontemporal_load(&xr1[64 * j]); }
        unsigned long long* o0 = (unsigned long long*)(XB + (size_t)m * DM) + lane; unsigned long long* o1 = (unsigned long long*)(XB + (size_t)m2 * DM) + lane;
        float s0 = 0.f, s1 = 0.f;
#pragma unroll
        for (int j = 0; j < 4; ++j) { s0 += (v0[j][0] * v0[j][0] + v0[j][1] * v0[j][1]) + (v0[j][2] * v0[j][2] + v0[j][3] * v0[j][3]);
            s1 += (v1[j][0] * v1[j][0] + v1[j][1] * v1[j][1]) + (v1[j][2] * v1[j][2] + v1[j][3] * v1[j][3]);
            o0[64 * j] = (unsigned long long)pk2(v0[j][0], v0[j][1]) | ((unsigned long long)pk2(v0[j][2], v0[j][3]) << 32);
            o1[64 * j] = (unsigned long long)pk2(v1[j][0], v1[j][1]) | ((unsigned long long)pk2(v1[j][2], v1[j][3]) << 32); }
        s0 = wave_sum(s0); s1 = wave_sum(s1);
        if (lane == 0) { *(f32x4*)(ssq + 4 * (size_t)m) = (f32x4){s0, 0.f, 0.f, 0.f}; *(f32x4*)(ssq + 4 * (size_t)m2) = (f32x4){s1, 0.f, 0.f, 0.f}; }
    }
    if (vcu == 0 && tid < 16) { const float d = (tid < 8 ? a->in[12] : a->in[13])[tid & 7]; const float e = __expf(-d);
        const float l1p = (e < 0.0625f) ? e * (1.0f - e * (0.5f - e * ((1.0f / 3.0f) - e * (0.25f - e * 0.2f)))) : __logf(1.0f + e);
        ((float*)(ws + WS_L2))[tid] = -l1p * LOG2E; }
}

#ifndef DBG_DUMP
#define DBG_DUMP 0
#endif
#ifndef TS_T0
#define TS_T0 0
#define TS_GAIN 1e-3f
#endif
#ifndef GROUP_SEAMS
#define GROUP_SEAMS 1
#endif
#ifndef GEMM_ALIGN
#define GEMM_ALIGN true
#endif
#ifndef GEMM_SP2
#define GEMM_SP2 true
#endif
#ifndef REP_PH
#define REP_PH (-1)
#define REP_N 0
#endif
#ifndef REP_COND
#define REP_COND true
#endif
#ifndef DBG_STRIDE
#define DBG_STRIDE 1
#endif
#ifndef DBG_HI
#define DBG_HI PH_COUNT
#endif
#ifndef DBG_LO
#define DBG_LO 0
#endif
#ifndef DBG_AOFF
#define DBG_AOFF 2048
#endif
#ifndef DBG_LDA
#define DBG_LDA 3072
#endif
#ifndef DBG_LDB
#define DBG_LDB 2048
#endif
#ifndef DBG_K
#define DBG_K 1024
#endif
enum { PH_PRO = 0, PH_IN_E, PH_ATTN, PH_OUT_E, PH_MLP_IN0, PH_MLP_OUT0, PH_IN_O0, PH_RA0, PH_RB0, PH_RC0, PH_IN_O1, PH_RA1, PH_RB1, PH_RC1, PH_OUT_O, PH_MLP_IN1, PH_MLP_OUT1, PH_COUNT };

__global__ void __launch_bounds__(512, 2) mk_fwd(Args a_unused) {
    extern __shared__ __attribute__((aligned(16))) unsigned char lds_raw[];
    cg::grid_group grid = cg::this_grid();
    const ldsp lds = (ldsp)lds_raw;
    volatile LAS unsigned* MISC = (volatile LAS unsigned*)(lds + RING_BYTES);
    if (threadIdx.x < 32) MISC[threadIdx.x] = 0u;
    __syncthreads();
    const XcdBarrier bar = xcd_barrier_post((unsigned*)(((KArgs)__builtin_amdgcn_kernarg_segment_ptr())->ws + WS_CTL) + CW_BAR, MISC + 8);
    const int G = gridDim.x;
    int repcnt = 0;
#ifdef TS_PH
    if (blockIdx.x == 0 && threadIdx.x == 0) ((volatile unsigned long long*)(((KArgs)__builtin_amdgcn_kernarg_segment_ptr())->ws + 32768))[0] = __builtin_amdgcn_s_memrealtime();
#endif
    const int ph_lo = ((KArgs)__builtin_amdgcn_kernarg_segment_ptr())->ph_lo, ph_hi = ((KArgs)__builtin_amdgcn_kernarg_segment_ptr())->ph_hi;
    for (int ph = ph_lo; ph < ph_hi; ++ph) {
        const __attribute__((address_space(4))) char* kp = (const __attribute__((address_space(4))) char*)__builtin_amdgcn_kernarg_segment_ptr();
        asm volatile("" : "+s"(kp));
        KArgs a = (KArgs)kp;
        unsigned char* ws = a->ws;
        bf16* XB = (bf16*)(ws + WS_XB); float* ssq = (float*)(ws + WS_SSQ);
        bf16* BIG = (bf16*)(ws + WS_BIG);
        bf16* QKV = BIG; bf16* OE = (bf16*)a->out; bf16* HM = BIG;     bf16* GB = BIG; bf16* ST = BIG + (size_t)M_TOK * 3072;
        int tid = threadIdx.x, bx = blockIdx.x;
        asm volatile("" : "+v"(tid)); asm volatile("" : "+s"(bx));
        const int vcu = (G % 8 == 0) ? (bx % 8) * (G / 8) + bx / 8 : bx;
        if (ph == PH_PRO) { prologue(a, lds, vcu, G, tid); }
        else if (ph == PH_ATTN) {
            att::AttnArgs A{QKV, OE, a->in[3], a->in[4], a->in[5], a->in[6], a->in[7], a->in[8]};
            att::attn_phase(lds, A, vcu, G, tid);
        }
        else if (ph == PH_RA0 || ph == PH_RA1 || ph == PH_RB0 || ph == PH_RB1 || ph == PH_RC0 || ph == PH_RC1) {
            ret::RetArgs R{GB, ST, (const float*)(ws + WS_L2), a->in[14], (ph >= PH_IN_O1) ? 1 : 0, (REP_N > 0 && ph == REP_PH && repcnt > 0) ? 1 : 0, (bf16*)a->out};
            if (ph == PH_RA0 || ph == PH_RA1) { ret::ret_a_phase(lds, R, vcu, G, tid); }
            else if (ph == PH_RB0 || ph == PH_RB1) { ret::ret_b(R, vcu, G, tid); }
            else { ret::ret_c_phase(lds, R, vcu, G, tid); }
        }
        else if (ph == PH_IN_E || ph == PH_MLP_IN0 || ph == PH_MLP_IN1 || ph == PH_IN_O0 || ph == PH_IN_O1) {
            const bf16* Bt; int N, act, silu0; bf16* O;
            if (ph == PH_IN_E)           { Bt = (const bf16*)(ws + WS_W_IN_E); N = N_IN_E; O = QKV; act = 0; silu0 = 1 << 30; }
            else if (ph == PH_MLP_IN0)   { Bt = (const bf16*)(ws + WS_W_MLP_IN); N = DFF; O = HM; act = 1; silu0 = 1 << 30; }
            else if (ph == PH_MLP_IN1)   { Bt = (const bf16*)(ws + WS_W_MLP_IN) + (size_t)DFF * DM; N = DFF; O = HM; act = 1; silu0 = 1 << 30; }
            else if (ph == PH_IN_O0)     { Bt = (const bf16*)(ws + WS_W_IN_O); N = 3072; O = GB; act = 2; silu0 = 8; }
            else                         { Bt = (const bf16*)(ws + WS_W_IN_O) + (size_t)3072 * DM; N = 3072; O = GB; act = 2; silu0 = 8; }
            pg8::Gemm g; g.A = XB; g.Bt = Bt; g.lda = DM; g.ldb = DM; g.M = M_TOK; g.N = N; g.K = DM;
            pg8::EpiBf16 E; E.O = O; E.ldc = N; E.ssq = ssq; E.silu_pn0 = silu0; E.act = act;
            pg8::StaticOrder S; S.init(M_TOK, N, G, bx);
            pg8::gemm_phase<pg8::EpiBf16, pg8::StaticOrder, GEMM_ALIGN, GEMM_SP2>(lds, g, S, E, tid);
            if (ph == PH_IN_E && bx >= 64) convert_items(a, lds, WI_EARLY, WI_C7, (bx - 64) * 8 + __builtin_amdgcn_readfirstlane(tid >> 6), (G - 64) * 8, tid);
        }
        else {
            const bf16* A; const bf16* Bt; int lda, ldb, K; const float* basef; const bf16* baseb; float* outf; bf16* xb; float* sso;
            if (ph == PH_OUT_E)          { A = OE; lda = DM; K = DM; Bt = (const bf16*)(ws + WS_W_OUT_E); ldb = DM; basef = nullptr; baseb = XB; outf = nullptr; xb = XB; sso = ssq; }
            else if (ph == PH_MLP_OUT0)  { A = HM; lda = DFF; K = DFF; Bt = (const bf16*)(ws + WS_W_MLP_OUT); ldb = DFF; basef = nullptr; baseb = XB; outf = nullptr; xb = XB; sso = ssq; }
            else if (ph == PH_MLP_OUT1)  { A = HM; lda = DFF; K = DFF; Bt = (const bf16*)(ws + WS_W_MLP_OUT) + (size_t)DFF * DM; ldb = DFF; basef = nullptr; baseb = XB; outf = a->out; xb = nullptr; sso = nullptr; }
            else                         { A = (const bf16*)a->out; lda = 2048; K = 2048; Bt = (const bf16*)(ws + WS_W_OUT_O); ldb = 2048; basef = nullptr; baseb = XB; outf = nullptr; xb = XB; sso = ssq; }
            pg8::Gemm g; g.A = A; g.Bt = Bt; g.lda = lda; g.ldb = ldb; g.M = M_TOK; g.N = DM; g.K = K;
            pg8::EpiResid E; E.basef = basef; E.baseb = baseb; E.outf = outf; E.xb = xb; E.ssq_out = sso; E.ldc = DM;
            E.accscale = (REP_N > 0 && ph == REP_PH && repcnt > 0 && ph != PH_OUT_E && ph != PH_MLP_OUT1) ? 0.f : 1.f;
            pg8::StaticOrder S; S.init(M_TOK, DM, G, bx);
            pg8::gemm_phase<pg8::EpiResid, pg8::StaticOrder, false, GEMM_SP2>(lds, g, S, E, tid);
        }
        if (ph + 1 == ph_hi && DBG_DUMP) {
            xcd_barrier(bar);
            const bf16* srcb = (DBG_DUMP == 1) ? GB : ST;
            for (size_t i = (size_t)bx * 512 + tid; i < (size_t)M_TOK * DM; i += (size_t)G * 512) a->out[i] = bf_lo((unsigned)srcb[i * DBG_STRIDE]);
        }
#ifdef NOP_REPS
        if (ph == NOP_AT) { for (int q = 0; q < NOP_REPS; ++q) xcd_barrier(bar); }
#endif
        if (ph + 1 < ph_hi) {
            if (ph_lo < 0) {
                asm volatile("s_waitcnt vmcnt(0)" ::: "memory");
                grid.sync();
                __builtin_amdgcn_fence(__ATOMIC_ACQUIRE, "agent");
                asm volatile("s_waitcnt vmcnt(0)" ::: "memory");
                __syncthreads();
            }
            const int gk = (ph == PH_OUT_E) ? 1 : (ph == PH_MLP_IN0) ? 2 : (ph == PH_OUT_O) ? 3 : (ph == PH_MLP_IN1) ? 4 : 0;
            if (GROUP_SEAMS && gk != 0 && G == 256) group_barrier(bar, (unsigned*)(ws + WS_CTL) + CW_GRP + 32 * (bx & 63), 4u * (unsigned)gk);
            else xcd_barrier(bar);
#ifdef TS_PH
            if (blockIdx.x == 0 && threadIdx.x == 0) ((volatile unsigned long long*)(ws + 32768))[ph + 1] = __builtin_amdgcn_s_memrealtime();
#endif
        }
        if (REP_N > 0 && ph == REP_PH && repcnt < REP_N && REP_COND) { ++repcnt; --ph; }
    }
#ifdef TS_PH
    {
        xcd_barrier(bar);
        if (blockIdx.x == 0 && threadIdx.x == 0) { KArgs a = (KArgs)__builtin_amdgcn_kernarg_segment_ptr(); volatile unsigned long long* ts = (volatile unsigned long long*)(a->ws + 32768);
            unsigned long long t1 = (TS_PH == PH_COUNT - 1) ? __builtin_amdgcn_s_memrealtime() : ts[TS_PH + 1];
#ifdef TS_TOTAL
            a->out[0] += 0.1f + ((float)(__builtin_amdgcn_s_memrealtime() - ts[0]) * 0.01f - (float)TS_T0) * TS_GAIN; }
#else
            a->out[0] += 0.1f + ((float)(t1 - ts[TS_PH]) * 0.01f - (float)TS_T0) * TS_GAIN; }
#endif
    }
#endif
}

extern "C" void kernel_launch(void* const* d_in, const int* in_sizes, int n_in, void* d_out, int out_size, void* d_ws, size_t ws_size, hipStream_t stream) {
    static int grid = 0;
    if (grid == 0) {
        int dev = 0, cus = 0, per_cu = 0;
        (void)hipGetDevice(&dev);
        (void)hipDeviceGetAttribute(&cus, hipDeviceAttributeMultiprocessorCount, dev);
        (void)hipFuncSetAttribute((const void*)mk_fwd, hipFuncAttributeMaxDynamicSharedMemorySize, LDS_BYTES);
        (void)hipOccupancyMaxActiveBlocksPerMultiprocessor(&per_cu, (const void*)mk_fwd, 512, LDS_BYTES);
        grid = (n_in == 19 && per_cu >= 1 && cus == 256 && ws_size >= WS_END && out_size == M_TOK * DM) ? 256 : -1;
        if (grid < 0) fprintf(stderr, "kernel_launch: unsupported configuration (cus %d per_cu %d ws %zu n_in %d)\n", cus, per_cu, ws_size, n_in);
    }
    if (grid < 0) return;
    if (hipMemsetAsync((char*)d_ws + WS_CTL, 0, 65536, stream) != hipSuccess) { fprintf(stderr, "kernel_launch: memset failed\n"); return; }
    Args a{};
    for (int i = 0; i < 19; ++i) a.in[i] = (const float*)d_in[i];
    a.out = (float*)d_out; a.ws = (unsigned char*)d_ws; a.ph_lo = DBG_LO; a.ph_hi = DBG_HI;
    void* args[] = {&a};
#ifdef PLAIN_LAUNCH
    hipError_t e = hipLaunchKernel((void*)mk_fwd, dim3(grid), dim3(512), args, LDS_BYTES, stream);
#else
    hipError_t e = hipLaunchCooperativeKernel((void*)mk_fwd, dim3(grid), dim3(512), args, LDS_BYTES, stream);
#endif
    if (e != hipSuccess) fprintf(stderr, "cooperative launch failed: %s\n", hipGetErrorString(e));
}
```

```cpp
#include <hip/hip_runtime.h>
#include <hip/hip_cooperative_groups.h>
#include <cstdio>
#include <cstdint>
#include <cmath>
namespace cg = cooperative_groups;
typedef unsigned xl_u32x2 __attribute__((ext_vector_type(2)));
__device__ __forceinline__ float xl_sum8(float s) {
    s += __int_as_float(__builtin_amdgcn_update_dpp(0, __float_as_int(s), 0xB1, 0xF, 0xF, true));
    s += __int_as_float(__builtin_amdgcn_update_dpp(0, __float_as_int(s), 0x4E, 0xF, 0xF, true));
    s += __int_as_float(__builtin_amdgcn_update_dpp(0, __float_as_int(s), 0x141, 0xF, 0xF, true));
    return s;
}
__device__ __forceinline__ float xl_sum_rows(float s) {
    const xl_u32x2 a = __builtin_amdgcn_permlane16_swap(__float_as_uint(s), __float_as_uint(s), false, false);
    s = __uint_as_float(a[0]) + __uint_as_float(a[1]);
    const xl_u32x2 b = __builtin_amdgcn_permlane32_swap(__float_as_uint(s), __float_as_uint(s), false, false);
    return __uint_as_float(b[0]) + __uint_as_float(b[1]);
}
__device__ __forceinline__ float xl_sum64(float s) {
    s = xl_sum8(s);
    s += __int_as_float(__builtin_amdgcn_update_dpp(0, __float_as_int(s), 0x140, 0xF, 0xF, true));
    return xl_sum_rows(s);
}
namespace pg8 {
#define PG8_LAS __attribute__((address_space(3)))
typedef unsigned short bf16_t;
typedef short bf16x8 __attribute__((ext_vector_type(8)));
typedef float f32x4 __attribute__((ext_vector_type(4)));
typedef float f32x2 __attribute__((ext_vector_type(2)));
typedef unsigned u32x4 __attribute__((ext_vector_type(4)));
typedef unsigned u32x2 __attribute__((ext_vector_type(2)));
constexpr int BM = 256, BK = 64, HALF = 128, HTB = HALF * BK * 2  , STAGE_BYTES = 8 * HTB, NXCD = 8, WGM = 8;

__host__ __device__ __forceinline__ int lds_byte(int r, int c) { const int st = (r >> 4) * 2 + (c >> 5), rr = r & 15, cc = c & 31, ob = rr * 64 + cc * 2; return st * 1024 + (ob ^ (((ob >> 9) & 1) << 5)); }
__host__ __device__ __forceinline__ void stage_rc(int b, int& R, int& C) { const int st = b / 1024, sb = b % 1024, swz = sb ^ (((sb >> 9) & 1) << 5); R = (st >> 1) * 16 + swz / 64; C = (st & 1) * 32 + (swz % 64) / 2; }
__host__ __device__ __forceinline__ int perm32(int rho) { const int n = rho >> 4, i = rho & 15; return 8 * (i >> 2) + 4 * n + (i & 3); }

struct Unit { int pm, pn; };
struct Gemm { const bf16_t* A; const bf16_t* Bt; int lda, ldb, M, N, K; };

struct StaticOrder {
    int nM, nN, nwg, G, c;
    __host__ __device__ void init(int M, int N, int G_, int c_) { nM = M / BM; nN = N / BM; nwg = nM * nN; G = G_; c = c_; }
    __host__ __device__ bool next(int i, Unit& u) const {
        const long L = (long)i * G + c; if (L >= nwg) return false;
        int wgid = (int)L; { const int q = nwg / NXCD, r = nwg % NXCD, xcd = wgid % NXCD, off = wgid / NXCD; wgid = (xcd < r ? xcd * (q + 1) : r * (q + 1) + (xcd - r) * q) + off; }
        const int nig = WGM * nN, gid = wgid / nig, fm = gid * WGM, gsz = (nM - fm) < WGM ? (nM - fm) : WGM;
        u.pm = fm + ((wgid % nig) % gsz); u.pn = (wgid % nig) / gsz; return true;
    }
};

typedef float f32x2_cv __attribute__((ext_vector_type(2))); typedef __bf16 bf16x2_cv __attribute__((ext_vector_type(2)));
__device__ __forceinline__ unsigned cvt_pk_bf16(float lo, float hi) { const f32x2_cv v = {lo, hi}; const bf16x2_cv b = __builtin_convertvector(v, bf16x2_cv); return __builtin_bit_cast(unsigned, b); }


__device__ __forceinline__ float row_rstd(const float* ssq, int row) { const f32x4 p = *(const f32x4*)(ssq + 4 * (size_t)row); return rsqrtf(((p[0] + p[1]) + (p[2] + p[3])) * (1.0f / 1024.0f) + 1e-6f); }

struct EpiBf16 {
    static constexpr bool PERM = true, AFTER_DRAIN = false;
    bf16_t* O; int ldc; const float* ssq; int silu_pn0; int act;
    int knorm; PG8_LAS unsigned char* spare;
    __device__ __forceinline__ void preload(float (&rsv)[8], int pm, int wr, int fr) const {
        const int row0 = pm * BM + wr * 64 + fr;
#pragma unroll
        for (int ai = 0; ai < 2; ++ai)
#pragma unroll
            for (int m = 0; m < 4; ++m) rsv[ai * 4 + m] = row_rstd(ssq, row0 + ai * HALF + m * 16);
    }
    template <int ACT>
    __device__ __forceinline__ void body(const f32x4 (&acc)[2][2][4][2], const Unit& u, int wr, int wc, int fr, int fq, const float (&rsv)[8]) const {
        const int row0 = u.pm * BM + wr * 64 + fr; const int col0 = u.pn * BM + wc * 32 + 8 * fq;
        const __amdgpu_buffer_rsrc_t rsrc = __builtin_amdgcn_make_buffer_rsrc((void*)O, 0, 0x7fffffff, 0x00020000);
#pragma unroll
        for (int ai = 0; ai < 2; ++ai)
#pragma unroll
            for (int m = 0; m < 4; ++m) { const int row = row0 + ai * HALF + m * 16; const float rs = rsv[ai * 4 + m];
#pragma unroll
                for (int bj = 0; bj < 2; ++bj) { f32x4 v0 = acc[ai][bj][m][0] * rs, v1 = acc[ai][bj][m][1] * rs;
                    if (ACT == 1) { f32x4 r0, r1;
#pragma unroll
                        for (int e = 0; e < 4; ++e) { r0[e] = __int_as_float(max(__float_as_int(v0[e]), 0)); r1[e] = __int_as_float(max(__float_as_int(v1[e]), 0)); }
                        v0 = r0 * r0; v1 = r1 * r1; }
                    if (ACT == 2) {
#pragma unroll
                        for (int e = 0; e < 4; ++e) { v0[e] = v0[e] * __builtin_amdgcn_rcpf(1.0f + __builtin_amdgcn_exp2f(-1.4426950408889634f * v0[e])); v1[e] = v1[e] * __builtin_amdgcn_rcpf(1.0f + __builtin_amdgcn_exp2f(-1.4426950408889634f * v1[e])); } }
                    u32x4 w; w.x = cvt_pk_bf16(v0[0], v0[1]); w.y = cvt_pk_bf16(v0[2], v0[3]); w.z = cvt_pk_bf16(v1[0], v1[1]); w.w = cvt_pk_bf16(v1[2], v1[3]);
                    __builtin_amdgcn_raw_buffer_store_b128(w, rsrc, (unsigned)(((size_t)row * ldc + col0 + bj * HALF) * 2), 0, 16);
                    } }
    }
    __device__ __forceinline__ void body_knorm(const f32x4 (&acc)[2][2][4][2], const Unit& u, int wr, int wc, int fr, int fq, const float (&rsv)[8]) const {
        const int row0 = u.pm * BM + wr * 64 + fr; const int col0 = u.pn * BM + wc * 32 + 8 * fq;
        const __amdgpu_buffer_rsrc_t rsrc = __builtin_amdgcn_make_buffer_rsrc((void*)O, 0, 0x7fffffff, 0x00020000);
        PG8_LAS float* P = (PG8_LAS float*)spare;
        const bool nb1 = (u.pn != 2);
#pragma unroll
        for (int ai = 0; ai < 2; ++ai)
#pragma unroll
            for (int m = 0; m < 4; ++m) { const float rs = rsv[ai * 4 + m]; const int rl = ai * HALF + wr * 64 + m * 16 + fr;
#pragma unroll
                for (int bj = 0; bj < 2; ++bj) { const f32x4 v0 = acc[ai][bj][m][0] * rs, v1 = acc[ai][bj][m][1] * rs;
                    float ss = ((v0[0] * v0[0] + v0[1] * v0[1]) + (v0[2] * v0[2] + v0[3] * v0[3])) + ((v1[0] * v1[0] + v1[1] * v1[1]) + (v1[2] * v1[2] + v1[3] * v1[3]));
                    ss = xl_sum_rows(ss);
                    if (fq == 0) P[(rl * 2 + bj) * 4 + wc] = ss; }
                __builtin_amdgcn_sched_barrier(0); }
        asm volatile("s_waitcnt lgkmcnt(0)" ::: "memory"); __builtin_amdgcn_s_barrier();
        const __attribute__((address_space(4))) char* kp = (const __attribute__((address_space(4))) char*)__builtin_amdgcn_kernarg_segment_ptr();
        const float* gsrc = *(const float* const __attribute__((address_space(4)))*)(kp + ((u.pn == 2) ? 32 : 56)); const int hc = (wc & 1) * 32 + 8 * fq;
        const f32x4 g0 = *(const f32x4*)(gsrc + hc), g1 = *(const f32x4*)(gsrc + hc + 4);
#pragma unroll
        for (int ai = 0; ai < 2; ++ai)
#pragma unroll
            for (int m = 0; m < 4; ++m) { const int row = row0 + ai * HALF + m * 16; const float rs = rsv[ai * 4 + m]; const int rl = ai * HALF + wr * 64 + m * 16 + fr;
#pragma unroll
                for (int bj = 0; bj < 2; ++bj) { f32x4 v0 = acc[ai][bj][m][0] * rs, v1 = acc[ai][bj][m][1] * rs;
                    if (bj == 0 || nb1) { const float tot = P[(rl * 2 + bj) * 4 + (wc & 2)] + P[(rl * 2 + bj) * 4 + (wc & 2) + 1]; const float rn = rsqrtf(tot * (1.0f / 64.0f) + 1e-6f);
                        v0 = v0 * rn * g0; v1 = v1 * rn * g1; }
                    u32x4 w; w.x = cvt_pk_bf16(v0[0], v0[1]); w.y = cvt_pk_bf16(v0[2], v0[3]); w.z = cvt_pk_bf16(v1[0], v1[1]); w.w = cvt_pk_bf16(v1[2], v1[3]);
                    __builtin_amdgcn_raw_buffer_store_b128(w, rsrc, (unsigned)(((size_t)row * ldc + col0 + bj * HALF) * 2), 0, 16); }
                __builtin_amdgcn_sched_barrier(0); }
        asm volatile("s_waitcnt lgkmcnt(0)" ::: "memory"); __builtin_amdgcn_s_barrier();
    }
    __device__ __forceinline__ void operator()(const f32x4 (&acc)[2][2][4][2], const Unit& u, int wr, int wc, int fr, int fq, float (&rsv)[8], int& rs_pm) const {
        if (rs_pm != u.pm) { preload(rsv, u.pm, wr, fr); rs_pm = u.pm; }
        if (knorm != 0 && (u.pn == 2 || u.pn == 5 || u.pn == 6)) { body_knorm(acc, u, wr, wc, fr, fq, rsv); return; }
        if (act == 1) body<1>(acc, u, wr, wc, fr, fq, rsv);
        else if (act == 2 && u.pn >= silu_pn0) body<2>(acc, u, wr, wc, fr, fq, rsv);
        else body<0>(acc, u, wr, wc, fr, fq, rsv);
    }
};

struct EpiResid {
    static constexpr bool PERM = true, AFTER_DRAIN = true;
    const float* basef; const bf16_t* baseb; float* outf; bf16_t* xb; float* ssq_out; int ldc; float accscale;
    __device__ __forceinline__ void prefetch(u32x4 (&bv)[2][4][2], const Unit& u, int wr, int wc, int fr, int fq) const {
        const int col0 = u.pn * BM + wc * 32 + 8 * fq;
#pragma unroll
        for (int ai = 0; ai < 2; ++ai)
#pragma unroll
            for (int m = 0; m < 4; ++m) { const int r = ai * HALF + wr * 64 + m * 16 + fr; const size_t off = (size_t)(u.pm * BM + r) * ldc + col0;
#pragma unroll
                for (int bj = 0; bj < 2; ++bj) bv[ai][m][bj] = *(const u32x4*)(baseb + off + bj * HALF); }
    }
    __device__ __forceinline__ void fused(f32x4 (&acc)[2][2][4][2], const u32x4 (&bv)[2][4][2], const Unit& u, int wr, int wc, int fr, int fq, PG8_LAS unsigned char* lds, int wid, int lane) const {
        PG8_LAS float* P = (PG8_LAS float*)lds;
        const int col0 = u.pn * BM + wc * 32 + 8 * fq;
#pragma unroll
        for (int ai = 0; ai < 2; ++ai)
#pragma unroll
            for (int m = 0; m < 4; ++m) { const int r = ai * HALF + wr * 64 + m * 16 + fr; const size_t off = (size_t)(u.pm * BM + r) * ldc + col0; float s = 0.f;
#pragma unroll
                for (int bj = 0; bj < 2; ++bj) { const size_t o2 = off + bj * HALF; const u32x4 b = bv[ai][m][bj];
                    const f32x4 b0 = (f32x4){__uint_as_float(b.x << 16), __uint_as_float(b.x & 0xffff0000u), __uint_as_float(b.y << 16), __uint_as_float(b.y & 0xffff0000u)};
                    const f32x4 b1 = (f32x4){__uint_as_float(b.z << 16), __uint_as_float(b.z & 0xffff0000u), __uint_as_float(b.w << 16), __uint_as_float(b.w & 0xffff0000u)};
                    const f32x4 o0 = b0 + acc[ai][bj][m][0] * accscale, o1 = b1 + acc[ai][bj][m][1] * accscale;
                    if (outf) { *(f32x4*)(outf + o2) = o0; *(f32x4*)(outf + o2 + 4) = o1; }
                    if (xb) { u32x4 w; w.x = cvt_pk_bf16(o0[0], o0[1]); w.y = cvt_pk_bf16(o0[2], o0[3]); w.z = cvt_pk_bf16(o1[0], o1[1]); w.w = cvt_pk_bf16(o1[2], o1[3]);
                        *(u32x4*)(xb + o2) = w; }
                    s += ((o0[0] * o0[0] + o0[1] * o0[1]) + (o0[2] * o0[2] + o0[3] * o0[3])) + ((o1[0] * o1[0] + o1[1] * o1[1]) + (o1[2] * o1[2] + o1[3] * o1[3])); }
                if (ssq_out) { s = xl_sum_rows(s); if (fq == 0) P[r * 4 + wc] = s; } }
        if (ssq_out) {
            __syncthreads();
            const int t = wid * 64 + lane;
            if (t < 256) { const float s = (P[t * 4 + 0] + P[t * 4 + 1]) + (P[t * 4 + 2] + P[t * 4 + 3]); ssq_out[(size_t)(u.pm * BM + t) * 4 + u.pn] = s; }
            __syncthreads();
        }
    }
};

template <class Epi, class Sched, bool ALIGN_EPI = false, bool SP2 = false>
__device__ __forceinline__ void gemm_phase(PG8_LAS unsigned char* lds, const Gemm g, const Sched& S, const Epi& E, const int tid) {
    const int wid = __builtin_amdgcn_readfirstlane(tid >> 6), lane = tid & 63, wr = wid >> 2, wc = wid & 3, fr = lane & 15, fq = lane >> 4;
    const int K = g.K, nt = K / BK;
    unsigned voffA[2], voffB[2];
#pragma unroll
    for (int i = 0; i < 2; ++i) { int R, C; stage_rc(tid * 16 + i * 8192, R, C); const int Rb = Epi::PERM ? ((R & ~31) + perm32(R & 31)) : R;
        voffA[i] = (unsigned)(R * g.lda + C) * 2u; voffB[i] = (unsigned)(Rb * g.ldb + C) * 2u; }
    const size_t kstep = (size_t)(BK * 2);
    const size_t hstepA = (size_t)HALF * g.lda * 2, hstepB = (size_t)HALF * g.ldb * 2;
    const size_t tstepA = 2 * hstepA, tstepB = 2 * hstepB;
    const unsigned ldsw = (unsigned)wid * 1024u;
    const int aoff = lds_byte(wr * 64 + fr, fq * 8), boff = lds_byte(wc * 32 + fr, fq * 8);
#define PG8_SA(b, h) (((b) * 2 + (h)) * HTB)
#define PG8_SB(b, h) ((4 + (b) * 2 + (h)) * HTB)
#define PG8_STAGE(bufoff, gbase, voff) do { _Pragma("unroll") for (int _i = 0; _i < 2; ++_i) \
        __builtin_amdgcn_global_load_lds((const unsigned*)((const char*)(gbase) + (voff)[_i]), (PG8_LAS unsigned*)(lds + (bufoff) + ldsw + _i * 8192), 16, 0, 0); } while (0)
#define PG8_LDA(dst, b, h) do { _Pragma("unroll") for (int m = 0; m < 4; ++m) _Pragma("unroll") for (int k = 0; k < 2; ++k) dst[m][k] = *(const PG8_LAS bf16x8*)(lds + PG8_SA(b, h) + aoff + m * 2048 + k * 1024); } while (0)
#define PG8_LDB(dst, b, h) do { _Pragma("unroll") for (int n = 0; n < 2; ++n) _Pragma("unroll") for (int k = 0; k < 2; ++k) dst[n][k] = *(const PG8_LAS bf16x8*)(lds + PG8_SB(b, h) + boff + n * 2048 + k * 1024); } while (0)
#define PG8_MMA(ai, bj, At, Bt) do { __builtin_amdgcn_s_setprio(1); _Pragma("unroll") for (int m = 0; m < 4; ++m) _Pragma("unroll") for (int n = 0; n < 2; ++n) _Pragma("unroll") for (int k = 0; k < 2; ++k) \
        acc[ai][bj][m][n] = __builtin_amdgcn_mfma_f32_16x16x32_bf16(Bt[n][k], At[m][k], acc[ai][bj][m][n], 0, 0, 0); __builtin_amdgcn_s_setprio(0); } while (0)
#define PG8_WAIT_V(n) asm volatile("s_waitcnt vmcnt(" #n ")" ::: "memory")
#define PG8_WAIT_L(n) asm volatile("s_waitcnt lgkmcnt(" #n ")" ::: "memory")
#define PG8_BAR __builtin_amdgcn_s_barrier()
#define PG8_SCHED __builtin_amdgcn_sched_barrier(0)
    Unit cur, nxt; int ui = 0;
    if (!S.next(0, cur)) return;
    f32x4 acc[2][2][4][2];
#pragma unroll
    for (int a = 0; a < 2; ++a)
#pragma unroll
        for (int b = 0; b < 2; ++b)
#pragma unroll
            for (int m = 0; m < 4; ++m)
#pragma unroll
                for (int n = 0; n < 2; ++n) acc[a][b][m][n] = (f32x4){0.f, 0.f, 0.f, 0.f};
    bf16x8 At[4][2], B0[2][2], B1[2][2];
    const char* cA = (const char*)g.A + (size_t)cur.pm * tstepA; const char* cB = (const char*)g.Bt + (size_t)cur.pn * tstepB;
    float rsv[8]; int rs_pm = -1;
    if constexpr (!Epi::AFTER_DRAIN) { E.preload(rsv, cur.pm, wr, fr); rs_pm = cur.pm; }
    if constexpr (SP2) {
        PG8_STAGE(PG8_SB(0, 0), cB, voffB); PG8_STAGE(PG8_SB(0, 1), cB + hstepB, voffB); PG8_STAGE(PG8_SA(0, 0), cA, voffA); PG8_STAGE(PG8_SA(0, 1), cA + hstepA, voffA);
        if (wr == 1) PG8_BAR;
        PG8_WAIT_V(2); PG8_BAR;
        PG8_STAGE(PG8_SB(1, 0), cB + kstep, voffB); PG8_STAGE(PG8_SA(1, 0), cA + kstep, voffA); PG8_STAGE(PG8_SB(1, 1), cB + hstepB + kstep, voffB);
        PG8_WAIT_V(6); PG8_BAR;
    } else {
        PG8_STAGE(PG8_SB(0, 0), cB, voffB); PG8_STAGE(PG8_SA(0, 0), cA, voffA); PG8_STAGE(PG8_SB(0, 1), cB + hstepB, voffB); PG8_STAGE(PG8_SA(0, 1), cA + hstepA, voffA);
        if (wr == 1) PG8_BAR;
        PG8_WAIT_V(4); PG8_BAR;
        PG8_STAGE(PG8_SB(1, 0), cB + kstep, voffB); PG8_STAGE(PG8_SA(1, 0), cA + kstep, voffA); PG8_STAGE(PG8_SB(1, 1), cB + hstepB + kstep, voffB);
        PG8_WAIT_V(6); PG8_BAR;
    }
    for (;;) {
        const bool has_next = S.next(ui + 1, nxt);
        const char* nA = has_next ? (const char*)g.A + (size_t)nxt.pm * tstepA : cA; const char* nB = has_next ? (const char*)g.Bt + (size_t)nxt.pn * tstepB : cB;
        for (int t = 0; t < nt; t += 2) {
            const bool last = (t == nt - 2);
            const char* a1 = cA + (size_t)(t + 1) * kstep;
            const char* a2 = last ? nA : cA + (size_t)(t + 2) * kstep; const char* b2 = last ? nB : cB + (size_t)(t + 2) * kstep;
            const char* a3 = a2 + kstep; const char* b3 = b2 + kstep;
            if constexpr (SP2) {
            PG8_LDB(B0, 0, 0); PG8_LDB(B1, 0, 1); PG8_SCHED; PG8_LDA(At, 0, 0); PG8_STAGE(PG8_SA(1, 1), a1 + hstepA, voffA);
            PG8_WAIT_V(8); PG8_WAIT_L(0); PG8_BAR; PG8_MMA(0, 0, At, B0); PG8_MMA(0, 1, At, B1); PG8_BAR; PG8_SCHED;
            PG8_LDA(At, 0, 1); PG8_STAGE(PG8_SB(0, 0), b2, voffB); PG8_STAGE(PG8_SB(0, 1), b2 + hstepB, voffB); PG8_STAGE(PG8_SA(0, 0), a2, voffA);
            PG8_WAIT_V(8); PG8_WAIT_L(0); PG8_BAR; PG8_MMA(1, 0, At, B0); PG8_MMA(1, 1, At, B1); PG8_BAR; PG8_SCHED;
            PG8_LDB(B0, 1, 0); PG8_LDB(B1, 1, 1); PG8_SCHED; PG8_LDA(At, 1, 0); PG8_STAGE(PG8_SA(0, 1), a2 + hstepA, voffA);
            PG8_WAIT_V(8); PG8_WAIT_L(0); PG8_BAR; PG8_MMA(0, 0, At, B0); PG8_MMA(0, 1, At, B1); PG8_BAR; PG8_SCHED;
            PG8_LDA(At, 1, 1); PG8_STAGE(PG8_SB(1, 0), b3, voffB); PG8_STAGE(PG8_SB(1, 1), b3 + hstepB, voffB); PG8_STAGE(PG8_SA(1, 0), a3, voffA);
            PG8_WAIT_V(8); PG8_WAIT_L(0); PG8_BAR; PG8_MMA(1, 0, At, B0); PG8_MMA(1, 1, At, B1); PG8_BAR; PG8_SCHED;
            } else {
            PG8_LDB(B0, 0, 0); PG8_SCHED; PG8_LDA(At, 0, 0); PG8_STAGE(PG8_SA(1, 1), a1 + hstepA, voffA);
            PG8_WAIT_L(8); PG8_BAR; PG8_WAIT_L(0); PG8_MMA(0, 0, At, B0); PG8_BAR; PG8_SCHED;
            PG8_LDB(B1, 0, 1); PG8_STAGE(PG8_SB(0, 0), b2, voffB);
            PG8_BAR; PG8_WAIT_L(0); PG8_MMA(0, 1, At, B1); PG8_BAR;
            PG8_LDA(At, 0, 1); PG8_STAGE(PG8_SA(0, 0), a2, voffA);
            PG8_BAR; PG8_WAIT_L(0); PG8_MMA(1, 0, At, B0); PG8_BAR; PG8_SCHED;
            PG8_STAGE(PG8_SB(0, 1), b2 + hstepB, voffB);
            PG8_WAIT_V(6); PG8_BAR; PG8_MMA(1, 1, At, B1); PG8_BAR;
            PG8_LDB(B0, 1, 0); PG8_SCHED; PG8_LDA(At, 1, 0); PG8_STAGE(PG8_SA(0, 1), a2 + hstepA, voffA);
            PG8_WAIT_L(8); PG8_BAR; PG8_WAIT_L(0); PG8_MMA(0, 0, At, B0); PG8_BAR; PG8_SCHED;
            PG8_LDB(B1, 1, 1); PG8_STAGE(PG8_SB(1, 0), b3, voffB);
            PG8_BAR; PG8_WAIT_L(0); PG8_MMA(0, 1, At, B1); PG8_BAR;
            PG8_LDA(At, 1, 1); PG8_STAGE(PG8_SA(1, 0), a3, voffA);
            PG8_BAR; PG8_WAIT_L(0); PG8_MMA(1, 0, At, B0); PG8_BAR; PG8_SCHED;
            PG8_STAGE(PG8_SB(1, 1), b3 + hstepB, voffB);
            PG8_WAIT_V(6); PG8_BAR; PG8_MMA(1, 1, At, B1); PG8_BAR;
            }
        }
        if constexpr (ALIGN_EPI) { if (wr == 0) PG8_BAR; }
        if constexpr (!Epi::AFTER_DRAIN) { E(acc, cur, wr, wc, fr, fq, rsv, rs_pm); }
        if (!has_next) break;
#pragma unroll
        for (int a = 0; a < 2; ++a)
#pragma unroll
            for (int b = 0; b < 2; ++b)
#pragma unroll
                for (int m = 0; m < 4; ++m)
#pragma unroll
                    for (int n = 0; n < 2; ++n) acc[a][b][m][n] = (f32x4){0.f, 0.f, 0.f, 0.f};
        cur = nxt; cA = nA; cB = nB; ++ui;
        if constexpr (ALIGN_EPI) { if (wr == 1) PG8_BAR; }
    }
    u32x4 bv[2][4][2];
    if constexpr (Epi::AFTER_DRAIN) { E.prefetch(bv, cur, wr, wc, fr, fq); }
    PG8_WAIT_V(0);
    if constexpr (!ALIGN_EPI) { if (wr == 0) PG8_BAR; }
    PG8_BAR;
    if constexpr (Epi::AFTER_DRAIN) { E.fused(acc, bv, cur, wr, wc, fr, fq, lds, wid, lane); }
#undef PG8_SA
#undef PG8_SB
#undef PG8_STAGE
#undef PG8_LDA
#undef PG8_LDB
#undef PG8_MMA
#undef PG8_WAIT_V
#undef PG8_WAIT_L
#undef PG8_BAR
#undef PG8_SCHED
}
}
#define LAS __attribute__((address_space(3)))
typedef unsigned short bf16;
typedef short bf16x8 __attribute__((ext_vector_type(8)));
typedef short s16x4 __attribute__((ext_vector_type(4)));
typedef float f32x4 __attribute__((ext_vector_type(4)));
typedef unsigned u32x4 __attribute__((ext_vector_type(4)));
typedef unsigned u32x2 __attribute__((ext_vector_type(2)));
typedef LAS unsigned char* ldsp;
constexpr float LOG2E = 1.4426950408889634f;

__device__ __forceinline__ float bf_lo(unsigned w) { return __uint_as_float(w << 16); }
__device__ __forceinline__ float bf_hi(unsigned w) { return __uint_as_float(w & 0xffff0000u); }
__device__ __forceinline__ unsigned pk2(float lo, float hi) { return pg8::cvt_pk_bf16(lo, hi); }
__device__ __forceinline__ s16x4 vtr(ldsp p) { typedef short v4i16_t __attribute__((ext_vector_type(4))); return __builtin_bit_cast(s16x4, __builtin_amdgcn_ds_read_tr16_b64_v4i16((LAS v4i16_t*)p)); }
__device__ __forceinline__ bf16x8 cat8(s16x4 lo, s16x4 hi) { return (bf16x8){lo[0], lo[1], lo[2], lo[3], hi[0], hi[1], hi[2], hi[3]}; }
__device__ __forceinline__ f32x4 mfma16(bf16x8 a, bf16x8 b, f32x4 c) { return __builtin_amdgcn_mfma_f32_16x16x32_bf16(a, b, c, 0, 0, 0); }
__device__ __forceinline__ float ex2(float x) { return __builtin_amdgcn_exp2f(x); }

namespace att {
constexpr int SEQ = 16384, LDQ = 2304, LDO = 1024;
constexpr int KPB = 160;
constexpr int COL_QA = 0, COL_KA = 512, COL_VA = 640, COL_QB = 768, COL_KB = 1280, COL_VB = 1792;

template <int NP>
__device__ __forceinline__ void load_rows(u32x4 (&v)[NP], const bf16* src, int tok0, int nvalid, int tid) {
    const int sub = tid & 7;
#pragma unroll
    for (int p = 0; p < NP; ++p) { const int r = (tid >> 3) + 64 * p, tok = tok0 + r; const bool ok = (tok >= 0) && (tok < SEQ) && (r < nvalid);
        v[p] = (u32x4){0u, 0u, 0u, 0u};
        if (ok) v[p] = *(const u32x4*)(src + (size_t)tok * LDQ + sub * 8); }
}
template <int NP, bool NORM>
__device__ __forceinline__ void store_rows(ldsp dst, const u32x4 (&v)[NP], int nrows, const float* gain, int tid) {
    const int sub = tid & 7;
    float gn[8];
    if (NORM) {
#pragma unroll
        for (int j = 0; j < 8; ++j) gn[j] = gain[sub * 8 + j];
    }
#pragma unroll
    for (int p = 0; p < NP; ++p) { const int r = (tid >> 3) + 64 * p;
        if (r < nrows) {
            u32x4 w = v[p];
            if (NORM) {
                float f[8]; f[0] = bf_lo(w.x); f[1] = bf_hi(w.x); f[2] = bf_lo(w.y); f[3] = bf_hi(w.y); f[4] = bf_lo(w.z); f[5] = bf_hi(w.z); f[6] = bf_lo(w.w); f[7] = bf_hi(w.w);
                float ss = 0.f;
#pragma unroll
                for (int j = 0; j < 8; ++j) ss += f[j] * f[j];
                ss = xl_sum8(ss);
                const float rs = rsqrtf(ss * (1.0f / 64.0f) + 1e-6f);
#pragma unroll
                for (int j = 0; j < 8; ++j) f[j] = f[j] * rs * gn[j];
                w.x = pk2(f[0], f[1]); w.y = pk2(f[2], f[3]); w.z = pk2(f[4], f[5]); w.w = pk2(f[6], f[7]);
            }
            *(LAS u32x4*)(dst + r * KPB + sub * 16) = w;
        } }
}

__device__ __forceinline__ void load_q_raw(u32x4 (&raw)[2], const bf16* qrow  , int g) {
#pragma unroll
    for (int s = 0; s < 2; ++s) raw[s] = *(const u32x4*)(qrow + 32 * s + 8 * g);
}
__device__ __forceinline__ void finish_q(bf16x8 (&qf)[2], const u32x4 (&raw)[2], const float* gain, int g) {
    float f[2][8]; float ss = 0.f;
#pragma unroll
    for (int s = 0; s < 2; ++s) { const u32x4 v = raw[s];
        f[s][0] = bf_lo(v.x); f[s][1] = bf_hi(v.x); f[s][2] = bf_lo(v.y); f[s][3] = bf_hi(v.y); f[s][4] = bf_lo(v.z); f[s][5] = bf_hi(v.z); f[s][6] = bf_lo(v.w); f[s][7] = bf_hi(v.w);
#pragma unroll
        for (int j = 0; j < 8; ++j) ss += f[s][j] * f[s][j]; }
    ss = xl_sum_rows(ss);
    const float rs = rsqrtf(ss * (1.0f / 64.0f) + 1e-6f) * (0.125f * LOG2E);
#pragma unroll
    for (int s = 0; s < 2; ++s) { float o[8];
#pragma unroll
        for (int j = 0; j < 8; ++j) o[j] = f[s][j] * rs * gain[32 * s + 8 * g + j];
        u32x4 w; w.x = pk2(o[0], o[1]); w.y = pk2(o[2], o[3]); w.z = pk2(o[4], o[5]); w.w = pk2(o[6], o[7]);
        qf[s] = __builtin_bit_cast(bf16x8, w); }
}

template <int NT, class RB>
__device__ __forceinline__ void scores(f32x4 (&sc)[NT], ldsp Kb, const bf16x8 (&qf)[2], const RB& rb, int lane, float init) {
    const int fr = lane & 15, g = lane >> 4;
#pragma unroll
    for (int t = 0; t < NT; ++t) { ldsp kp = Kb + (rb(t) + fr) * KPB + g * 16; f32x4 a = (f32x4){init, init, init, init};
#pragma unroll
        for (int s = 0; s < 2; ++s) { const bf16x8 kf = *(const LAS bf16x8*)(kp + s * 64); a = mfma16(kf, qf[s], a); }
        sc[t] = a; if ((t & 3) == 3) { asm volatile("" : "+v"(sc[t - 3]), "+v"(sc[t - 2]), "+v"(sc[t - 1]), "+v"(sc[t])); __builtin_amdgcn_sched_barrier(0); } }
}
template <int NT>
__device__ __forceinline__ float softmax_pack(f32x4 (&sc)[NT], bf16x8 (&pf)[NT / 2], float sink2, bool has_sink) {
    float m = -INFINITY;
#pragma unroll
    for (int t = 0; t < NT; ++t)
#pragma unroll
        for (int r = 0; r < 4; ++r) m = fmaxf(m, sc[t][r]);
    m = fmaxf(m, __shfl_xor(m, 16)); m = fmaxf(m, __shfl_xor(m, 32));
    if (has_sink) m = fmaxf(m, sink2);
    float sum = 0.f;
#pragma unroll
    for (int t = 0; t < NT; ++t)
#pragma unroll
        for (int r = 0; r < 4; ++r) { const float p = ex2(sc[t][r] - m); sc[t][r] = p; sum += p; }
    sum = xl_sum_rows(sum);
    if (has_sink) sum += ex2(sink2 - m);
#pragma unroll
    for (int k = 0; k < NT / 2; ++k) { u32x4 w; w.x = pk2(sc[2 * k][0], sc[2 * k][1]); w.y = pk2(sc[2 * k][2], sc[2 * k][3]); w.z = pk2(sc[2 * k + 1][0], sc[2 * k + 1][1]); w.w = pk2(sc[2 * k + 1][2], sc[2 * k + 1][3]);
        pf[k] = __builtin_bit_cast(bf16x8, w); }
    return sum;
}
template <int NT, int NR>
__device__ __forceinline__ float softmax_pack_shifted(f32x4 (&sc)[NT], bf16x8 (&pf)[NT / 2], float extra) {
    float sum = 0.f;
#pragma unroll
    for (int t = 0; t < NT; ++t)
#pragma unroll
        for (int r = 0; r < 4; ++r) { if (t < NR) { const float p = ex2(sc[t][r]); sc[t][r] = p; sum += p; } else sc[t][r] = 0.f; }
    sum = xl_sum_rows(sum);
    sum += extra;
#pragma unroll
    for (int k = 0; k < NT / 2; ++k) { u32x4 w; w.x = pk2(sc[2 * k][0], sc[2 * k][1]); w.y = pk2(sc[2 * k][2], sc[2 * k][3]); w.z = pk2(sc[2 * k + 1][0], sc[2 * k + 1][1]); w.w = pk2(sc[2 * k + 1][2], sc[2 * k + 1][3]);
        pf[k] = __builtin_bit_cast(bf16x8, w); }
    return sum;
}
__device__ __forceinline__ float wave_absmax64(const float* g, int lane) {
    float v = fabsf(g[lane]);
#pragma unroll
    for (int o = 1; o < 64; o <<= 1) v = fmaxf(v, __shfl_xor(v, o));
    return __int_as_float(__builtin_amdgcn_readfirstlane(__float_as_int(v)));
}
template <int NT, class RB>
__device__ __forceinline__ void pv_store(ldsp Vb, const bf16x8 (&pf)[NT / 2], const RB& rb, float sum, bf16* orow  , int lane) {
    const int g = lane >> 4, q4 = (lane & 15) >> 2, p4 = lane & 3;
    f32x4 o[4];
#pragma unroll
    for (int dt = 0; dt < 4; ++dt) o[dt] = (f32x4){0.f, 0.f, 0.f, 0.f};
#pragma unroll
    for (int k = 0; k < NT / 2; ++k) { ldsp v0 = Vb + (rb(2 * k) + 4 * g + q4) * KPB + p4 * 8; ldsp v1 = Vb + (rb(2 * k + 1) + 4 * g + q4) * KPB + p4 * 8;
#pragma unroll
        for (int dt = 0; dt < 4; ++dt) { const bf16x8 vf = cat8(vtr(v0 + dt * 32), vtr(v1 + dt * 32)); o[dt] = mfma16(vf, pf[k], o[dt]); } }
    const float inv = 1.0f / sum;
#pragma unroll
    for (int dt = 0; dt < 4; ++dt) { u32x2 w; w.x = pk2(o[dt][0] * inv, o[dt][1] * inv); w.y = pk2(o[dt][2] * inv, o[dt][3] * inv); *(u32x2*)(orow + dt * 16 + 4 * g) = w; }
}

struct RbWin { int mt; __device__ __forceinline__ int operator()(int t) const { return 16 * (mt + t); } };
struct RbNa { int off, ct0, ct1; __device__ __forceinline__ int operator()(int t) const { return (off + (t >> 1)) * 64 + ((t & 1) ? ct1 : ct0) * 16; } };

struct AttnArgs { const bf16* qkv; bf16* o; const float* qn_a; const float* kn_a; const float* sink_a; const float* qn_b; const float* kn_b; const float* rpb; };

__device__ __forceinline__ void window_pair(ldsp Kb, ldsp Vb, const AttnArgs& A, int n, int kvh, int mt, int g4a, const u32x4 (&qra)[2], const u32x4 (&qrb)[2], int lane, float mneg) {
    const int fr = lane & 15, g = lane >> 4, q4 = fr >> 2, p4 = lane & 3;
    const int hqa = kvh * 4 + g4a, hqb = hqa + 1;
    const int qtok = n * 128 + mt * 16 + fr;
    bf16x8 qfa[2], qfb[2]; finish_q(qfa, qra, A.qn_a, g); finish_q(qfb, qrb, A.qn_a, g);
    f32x4 sa[18], sb[18];
#pragma unroll
    for (int t = 0; t < 17; ++t) { ldsp kp = Kb + (16 * (mt + t) + fr) * KPB + g * 16; f32x4 a = (f32x4){mneg, mneg, mneg, mneg}, b = a;
#pragma unroll
        for (int s = 0; s < 2; ++s) { const bf16x8 kf = *(const LAS bf16x8*)(kp + s * 64); a = mfma16(kf, qfa[s], a); b = mfma16(kf, qfb[s], b); }
        sa[t] = a; sb[t] = b; if ((t & 3) == 3) __builtin_amdgcn_sched_barrier(0); }
    {
        const float sla = exp2f(-(float)(hqa + 1)) * LOG2E, slb = sla * 0.5f;
        float cl = (float)(4 * g - 128 - fr); asm volatile("" : "+v"(cl));
        const float lo = (float)max(-128, -qtok), hi = (float)min(128, SEQ - 1 - qtok);
        const bool ends = (n == 0) || (n == SEQ / 128 - 1);
#pragma unroll
        for (int t = 0; t < 17; ++t) {
            if (ends || t == 0 || t == 16) {
#pragma unroll
                for (int r = 0; r < 4; ++r) { const float rel = cl + (float)(16 * t + r); const bool ok = (rel >= lo && rel <= hi); const float ar = fabsf(rel);
                    sa[t][r] = ok ? fmaf(-sla, ar, sa[t][r]) : -INFINITY; sb[t][r] = ok ? fmaf(-slb, ar, sb[t][r]) : -INFINITY; }
            } else {
#pragma unroll
                for (int r = 0; r < 4; ++r) { const float ar = fabsf(cl + (float)(16 * t + r)); sa[t][r] = fmaf(-sla, ar, sa[t][r]); sb[t][r] = fmaf(-slb, ar, sb[t][r]); }
            } }
    }
    bf16x8 pa[9], pb[9];
    const float suma = softmax_pack_shifted<18, 17>(sa, pa, ex2(fmaf(A.sink_a[hqa], LOG2E, mneg)));
    const float sumb = softmax_pack_shifted<18, 17>(sb, pb, ex2(fmaf(A.sink_a[hqb], LOG2E, mneg)));
    f32x4 oa[4], ob[4];
#pragma unroll
    for (int dt = 0; dt < 4; ++dt) { oa[dt] = (f32x4){0.f, 0.f, 0.f, 0.f}; ob[dt] = oa[dt]; }
#pragma unroll
    for (int k = 0; k < 9; ++k) { ldsp v0 = Vb + (16 * (mt + 2 * k) + 4 * g + q4) * KPB + p4 * 8; ldsp v1 = v0 + 16 * KPB;
#pragma unroll
        for (int dt = 0; dt < 4; ++dt) { const bf16x8 vf = cat8(vtr(v0 + dt * 32), vtr(v1 + dt * 32)); oa[dt] = mfma16(vf, pa[k], oa[dt]); ob[dt] = mfma16(vf, pb[k], ob[dt]); } }
    const float ia = 1.0f / suma, ib = 1.0f / sumb;
    bf16* orow = A.o + (size_t)qtok * LDO + hqa * 64;
#pragma unroll
    for (int dt = 0; dt < 4; ++dt) { u32x2 w; w.x = pk2(oa[dt][0] * ia, oa[dt][1] * ia); w.y = pk2(oa[dt][2] * ia, oa[dt][3] * ia); *(u32x2*)(orow + dt * 16 + 4 * g) = w;
        u32x2 w2; w2.x = pk2(ob[dt][0] * ib, ob[dt][1] * ib); w2.y = pk2(ob[dt][2] * ib, ob[dt][3] * ib); *(u32x2*)(orow + 64 + dt * 16 + 4 * g) = w2; }
}

__device__ __forceinline__ void window_compute(ldsp lds, const AttnArgs& A, int unit, int tid) {
    const int n = unit >> 1, kvh = unit & 1, lane = tid & 63, wid = __builtin_amdgcn_readfirstlane(tid >> 6);
    ldsp Kb = lds, Vb = lds + 400 * KPB;
    const int fr = lane & 15, g = lane >> 4;
    const bf16* qbase = A.qkv + (size_t)(n * 128 + wid * 16 + fr) * LDQ + COL_QA + kvh * 256;
    u32x4 q0[2], q1[2], q2[2], q3[2];
    load_q_raw(q0, qbase, g); load_q_raw(q1, qbase + 64, g); load_q_raw(q2, qbase + 128, g); load_q_raw(q3, qbase + 192, g);
    const float mneg = -fminf(11.5416f * 1.01f * wave_absmax64(A.qn_a, lane) * wave_absmax64(A.kn_a, lane) + 0.25f, 64.0f);
    window_pair(Kb, Vb, A, n, kvh, wid, 0, q0, q1, lane, mneg);
    __builtin_amdgcn_sched_barrier(0);
    window_pair(Kb, Vb, A, n, kvh, wid, 2, q2, q3, lane, mneg);
}

constexpr int NA_ROWS = 704;
constexpr int NA_SHIFT_OFF = 147840 + 15 * 128 * 4;
constexpr int NA_RPB_OFF = 147840;

__device__ __forceinline__ void na_unit(ldsp lds, const AttnArgs& A, int unit, int next_unit, u32x4 (&kreg)[11], int tid) {
    const int rq4 = unit >> 3, h = unit & 7, lane = tid & 63, wid = __builtin_amdgcn_readfirstlane(tid >> 6);
    const int r0 = 4 * rq4; const int base = min(max(r0 - 4, 0), 248);
    const int rq = r0 + (wid >> 1); const int rstart = min(max(rq - 4, 0), 248);
    const int fr = lane & 15, g = lane >> 4;
    bf16x8 pf[2][8]; float sum[2]; int qtok[2]; int qcs[2]; u32x4 qraw[2][2];
#pragma unroll
    for (int it = 0; it < 2; ++it) { const int mt = 2 * (wid & 1) + it; qcs[it] = (mt < 3) ? 8 + 16 * mt + fr : (fr < 8 ? fr : 48 + fr); qtok[it] = rq * 64 + qcs[it];
        load_q_raw(qraw[it], A.qkv + (size_t)qtok[it] * LDQ + COL_QB + h * 64, g); }
    store_rows<11, false>(lds, kreg, NA_ROWS, nullptr, tid);
    __syncthreads();
    const LAS float* rpl = (const LAS float*)(lds + NA_RPB_OFF);
#pragma unroll
    for (int it = 0; it < 2; ++it) {
        const int mt = 2 * (wid & 1) + it; const int qc = qcs[it];
        bf16x8 qf[2]; finish_q(qf, qraw[it], A.qn_b, g);
        RbNa rb{rstart - base, (mt < 3) ? mt : 0, (mt < 3) ? mt + 1 : 3};
        f32x4 sc[16]; scores<16>(sc, lds, qf, rb, lane, *(const LAS float*)(lds + NA_SHIFT_OFF));
        const LAS float* rpl0 = rpl + (rstart - rq + 7) * 128 + (4 * g - qc + 64);
        const int thr = (mt < 3) ? fr - 4 * g : ((fr < 8) ? -100 : 100);
        const int cto = 16 * (rb.ct1 - rb.ct0);
        float m0[4]; const LAS float* rps[4];
#pragma unroll
        for (int r = 0; r < 4; ++r) { const bool v0 = r >= thr; m0[r] = v0 ? 1.0f : 0.0f; rps[r] = rpl0 + 16 * rb.ct0 + r + (v0 ? 0 : cto); }
        float sm = 0.f;
#pragma unroll
        for (int kr = 0; kr < 8; ++kr) { const f32x4 a0 = sc[2 * kr], a1 = sc[2 * kr + 1]; f32x4 o0, o1;
#pragma unroll
            for (int r = 0; r < 4; ++r) { const float sv = fmaf(m0[r], a0[r] - a1[r], a1[r]) + rps[r][kr * 128]; const float pp = ex2(sv); sm += pp; o0[r] = pp * m0[r]; o1[r] = pp - o0[r]; }
            sc[2 * kr] = o0; sc[2 * kr + 1] = o1;
            if ((kr & 1) == 1) __builtin_amdgcn_sched_barrier(0); }
        sm = xl_sum_rows(sm);
        sum[it] = sm;
#pragma unroll
        for (int k = 0; k < 8; ++k) { u32x4 w; w.x = pk2(sc[2 * k][0], sc[2 * k][1]); w.y = pk2(sc[2 * k][2], sc[2 * k][3]); w.z = pk2(sc[2 * k + 1][0], sc[2 * k + 1][1]); w.w = pk2(sc[2 * k + 1][2], sc[2 * k + 1][3]);
            pf[it][k] = __builtin_bit_cast(bf16x8, w); }
        __builtin_amdgcn_sched_barrier(0);
    }
    u32x4 vreg[11]; load_rows<11>(vreg, A.qkv + COL_VB + h * 64, base * 64, NA_ROWS, tid);
    __syncthreads();
    store_rows<11, false>(lds, vreg, NA_ROWS, nullptr, tid);
    if (next_unit >= 0) { const int nb = min(max(4 * (next_unit >> 3) - 4, 0), 248); load_rows<11>(kreg, A.qkv + COL_KB + h * 64, nb * 64, NA_ROWS, tid); }
    __syncthreads();
#pragma unroll
    for (int it = 0; it < 2; ++it) { const int mt = 2 * (wid & 1) + it; RbNa rb{rstart - base, (mt < 3) ? mt : 0, (mt < 3) ? mt + 1 : 3};
        pv_store<16>(lds, pf[it], rb, sum[it], A.o + (size_t)qtok[it] * LDO + 512 + h * 64, lane); __builtin_amdgcn_sched_barrier(0); }
    __syncthreads();
}

__device__ __forceinline__ void attn_phase(ldsp lds, const AttnArgs& A, int vcu, int G, int tid) {
    const int h = vcu & 7;
    u32x4 kreg[11];
#ifndef ATT_REP_WIN
#define ATT_REP_WIN 1
#define ATT_REP_NA 1
#endif
    for (int rw = 0; rw < ATT_REP_WIN; ++rw) {
        const int n = vcu >> 1, kvh = vcu & 1, tok0 = (n - 1) * 128;
        u32x4 kw[7], vw[7];
        load_rows<7>(kw, A.qkv + COL_KA + kvh * 64, tok0, 384, tid);
        load_rows<7>(vw, A.qkv + COL_VA + kvh * 64, tok0, 384, tid);
        if (rw == 0) {
            float tb[4], mx[8]; const int lane = tid & 63;
#pragma unroll
            for (int j = 0; j < 4; ++j) { const int i = tid + 512 * j; const int ri = i >> 7, dc = i & 127; const int ci = min(max(dc - 49, 0), 30); tb[j] = (i < 15 * 128) ? A.rpb[h * 465 + ri * 31 + ci] : 0.f; }
#pragma unroll
            for (int j = 0; j < 8; ++j) { const int i = lane + 64 * j; mx[j] = (i < 465) ? A.rpb[h * 465 + i] : 0.f; }
            const float gq = wave_absmax64(A.qn_b, lane), gk = wave_absmax64(A.kn_b, lane);
#pragma unroll
            for (int j = 0; j < 4; ++j) { const int i = tid + 512 * j; if (i < 15 * 128) ((LAS float*)(lds + NA_RPB_OFF))[i] = tb[j] * LOG2E; }
            float rm = 0.f;
#pragma unroll
            for (int j = 0; j < 8; ++j) rm = fmaxf(rm, mx[j]);
#pragma unroll
            for (int o = 1; o < 64; o <<= 1) rm = fmaxf(rm, __shfl_xor(rm, o));
            if (tid == 0) *(LAS float*)(lds + NA_SHIFT_OFF) = -fminf(11.5416f * 1.01f * gq * gk + 0.25f + rm * LOG2E, 64.0f); }
        store_rows<7, false>(lds, kw, 400, nullptr, tid);
        store_rows<7, false>(lds + 400 * KPB, vw, 400, nullptr, tid);
        __syncthreads();
        window_compute(lds, A, vcu, tid);
        __syncthreads();
    }
    for (int rn = 0; rn < ATT_REP_NA; ++rn) {
    { const int b0 = min(max(4 * (vcu >> 3) - 4, 0), 248); load_rows<11>(kreg, A.qkv + COL_KB + h * 64, b0 * 64, NA_ROWS, tid); }
    for (int k = 0; k < 2; ++k) { int t2 = tid; asm volatile("" : "+v"(t2));
        na_unit(lds, A, vcu + 256 * k, (k < 1) ? vcu + 256 * (k + 1) : -1, kreg, t2); }
    }
}
}
namespace ret {
constexpr int SEQ = 16384, LDG = 3072, NCH = 128;
constexpr int COL_Q = 0, COL_K = 512, COL_V = 1024, COL_G = 2048;
constexpr int KPB = 288;
constexpr int VPB = 544;
constexpr int UPB = 528;
constexpr int R0 = 0, R1 = 128 * KPB, R2 = 2 * 128 * KPB, RSTAT = R2 + 128 * VPB;
constexpr size_t ST_CHUNK = 128 * 256;

__device__ __forceinline__ unsigned pk2a(float lo, float hi) { unsigned r; asm volatile("v_cvt_pk_bf16_f32 %0, %1, %2" : "=v"(r) : "v"(lo), "v"(hi)); return r; }
struct RetArgs { bf16* G; bf16* ST; const float* l2;   const float* gn; int grp; int dry; bf16* Y; };

template <bool SCALE>
__device__ __forceinline__ void stage128(ldsp dst, const bf16* src, int ld, float a, float b, int tid) {
#pragma unroll
    for (int i = 0; i < 4; ++i) { const int idx = tid + i * 512, row = idx >> 4, ch = idx & 15;
        u32x4 v = *(const u32x4*)(src + (size_t)row * ld + ch * 8);
        if (SCALE) { const float s = ex2(a * (float)row + b);
            v.x = pk2a(bf_lo(v.x) * s, bf_hi(v.x) * s); v.y = pk2a(bf_lo(v.y) * s, bf_hi(v.y) * s); v.z = pk2a(bf_lo(v.z) * s, bf_hi(v.z) * s); v.w = pk2a(bf_lo(v.w) * s, bf_hi(v.w) * s); }
        *(LAS u32x4*)(dst + row * KPB + ch * 16) = v; }
}
__device__ __forceinline__ void stage256(ldsp dst, const bf16* src, int ld, int tid) {
#pragma unroll
    for (int i = 0; i < 8; ++i) { const int idx = tid + i * 512, row = idx >> 5, ch = idx & 31;
        const u32x4 v = *(const u32x4*)(src + (size_t)row * ld + ch * 8);
        *(LAS u32x4*)(dst + row * VPB + ch * 16) = v; }
}
__device__ __forceinline__ bf16x8 trfrag(ldsp X, int pitch, int k0, int n0, int lane) {
    const int g = lane >> 4, q4 = (lane & 15) >> 2, p4 = lane & 3;
    ldsp p = X + (k0 + 8 * g + q4) * pitch + (n0 + 4 * p4) * 2;
    return cat8(vtr(p), vtr(p + 4 * pitch));
}

__device__ __forceinline__ void ld128(u32x4 (&r)[4], const bf16* src, int ld, int tid) {
    const unsigned off0 = (unsigned)(((tid >> 4) * ld + (tid & 15) * 8) * 2);
#pragma unroll
    for (int i = 0; i < 4; ++i) r[i] = *(const u32x4*)((const char*)src + (size_t)i * 32 * ld * 2 + off0);
}
__device__ __forceinline__ void ld128nt(u32x4 (&r)[4], const bf16* src, int ld, int tid) {
    const unsigned off0 = (unsigned)(((tid >> 4) * ld + (tid & 15) * 8) * 2);
#pragma unroll
    for (int i = 0; i < 4; ++i) r[i] = __builtin_nontemporal_load((const u32x4*)((const char*)src + (size_t)i * 32 * ld * 2 + off0));
}
__device__ __forceinline__ void st128(ldsp dst, const u32x4 (&r)[4], int tid) {
    ldsp d0 = dst + (tid >> 4) * KPB + (tid & 15) * 16;
#pragma unroll
    for (int i = 0; i < 4; ++i) *(LAS u32x4*)(d0 + i * 32 * KPB) = r[i];
}
__device__ __forceinline__ void st128s(ldsp dst, const u32x4 (&r)[4], float a, float b, int tid) {
    ldsp d0 = dst + (tid >> 4) * KPB + (tid & 15) * 16;
#pragma unroll
    for (int i = 0; i < 4; ++i) { const int row = (tid >> 4) + 32 * i; const float s = ex2(a * (float)row + b); u32x4 v = r[i];
        v.x = pk2(bf_lo(v.x) * s, bf_hi(v.x) * s); v.y = pk2(bf_lo(v.y) * s, bf_hi(v.y) * s); v.z = pk2(bf_lo(v.z) * s, bf_hi(v.z) * s); v.w = pk2(bf_lo(v.w) * s, bf_hi(v.w) * s);
        *(LAS u32x4*)(d0 + i * 32 * KPB) = v; }
}
template <int AUX>
__device__ __forceinline__ void ld128b(u32x4 (&r)[4], __amdgpu_buffer_rsrc_t rs, unsigned base, int ld, int tid, bool valid) {
    const unsigned off0 = valid ? base + (unsigned)(((tid >> 4) * ld + (tid & 15) * 8) * 2) : 0xFFFF0000u;
#pragma unroll
    for (int i = 0; i < 4; ++i) r[i] = __builtin_amdgcn_raw_buffer_load_b128(rs, off0 + (valid ? (unsigned)(i * 32 * ld * 2) : 0u), 0, AUX);
}
template <int AUX>
__device__ __forceinline__ void ld64b(u32x4 (&r)[4], __amdgpu_buffer_rsrc_t rs, unsigned base, int ld, int tid, bool valid) {
    const unsigned off0 = valid ? base + (unsigned)(((tid >> 5) * ld + (tid & 31) * 8) * 2) : 0xFFFF0000u;
#pragma unroll
    for (int i = 0; i < 4; ++i) r[i] = __builtin_amdgcn_raw_buffer_load_b128(rs, off0 + (valid ? (unsigned)(i * 16 * ld * 2) : 0u), 0, AUX);
}
__device__ __forceinline__ void ld64(u32x4 (&r)[4], const bf16* src, int ld, int tid) {
    const unsigned off0 = (unsigned)(((tid >> 5) * ld + (tid & 31) * 8) * 2);
#pragma unroll
    for (int i = 0; i < 4; ++i) r[i] = *(const u32x4*)((const char*)src + (size_t)i * 16 * ld * 2 + off0);
}
__device__ __forceinline__ void ld64nt(u32x4 (&r)[4], const bf16* src, int ld, int tid) {
    const unsigned off0 = (unsigned)(((tid >> 5) * ld + (tid & 31) * 8) * 2);
#pragma unroll
    for (int i = 0; i < 4; ++i) r[i] = __builtin_nontemporal_load((const u32x4*)((const char*)src + (size_t)i * 16 * ld * 2 + off0));
}
__device__ __forceinline__ void st64(ldsp dst, const u32x4 (&r)[4], int tid) {
    ldsp d0 = dst + (tid >> 5) * VPB + (tid & 31) * 16;
#pragma unroll
    for (int i = 0; i < 4; ++i) *(LAS u32x4*)(d0 + i * 16 * VPB) = r[i];
}

__device__ __forceinline__ void ret_a_phase(ldsp lds, const RetArgs& A, int vcu, int G, int tid_in) {
    int tid = tid_in;
    const int wid = __builtin_amdgcn_readfirstlane(tid >> 6);
    int u = vcu; if (u >= 512) return;
    u32x4 rk[4], rv0[4], rv1[4];
    const __amdgpu_buffer_rsrc_t rsG = __builtin_amdgcn_make_buffer_rsrc((void*)A.G, 0, 0x06000000, 0x00020000);
    { const bf16* rows = A.G + (size_t)(u >> 2) * 128 * LDG; const int hl = u & 3;
      ld128nt(rk, rows + COL_K + hl * 128, LDG, tid); ld64nt(rv0, rows + COL_V + hl * 256, LDG, tid); ld64nt(rv1, rows + (size_t)64 * LDG + COL_V + hl * 256, LDG, tid); }
    for (;;) {
        asm volatile("" : "+v"(tid));
        const int lane = tid & 63, fr = lane & 15, g = lane >> 4;
        const int hl = u & 3, c = u >> 2, h = A.grp * 4 + hl;
        const float l2f = A.l2[h], l2b = A.l2[8 + h];
        st128s(lds + R0, rk, -l2f, 127.0f * l2f, tid);
        st128s(lds + R1, rk, l2b, 0.f, tid);
        st64(lds + R2, rv0, tid); st64(lds + R2 + 64 * VPB, rv1, tid);
        const int un = u + G; const bool has_next = un < 512;
        { const unsigned rb0 = (unsigned)(un >> 2) * (128u * LDG * 2u); const int nhl = un & 3;
            ld128b<2>(rk, rsG, rb0 + (unsigned)(COL_K + nhl * 128) * 2u, LDG, tid, has_next); ld64b<2>(rv0, rsG, rb0 + (unsigned)(COL_V + nhl * 256) * 2u, LDG, tid, has_next); ld64b<2>(rv1, rsG, rb0 + (unsigned)(64 * LDG + COL_V + nhl * 256) * 2u, LDG, tid, has_next); }
        __syncthreads();
        f32x4 acc[2][2][8];
#pragma unroll
        for (int dir = 0; dir < 2; ++dir) {
            ldsp Kx = lds + (dir ? R1 : R0);
#pragma unroll
            for (int et = 0; et < 2; ++et)
#pragma unroll
                for (int dt = 0; dt < 8; ++dt) acc[dir][et][dt] = (f32x4){0.f, 0.f, 0.f, 0.f};
            {
                bf16x8 vf[2][2], kq[2][4];
#pragma unroll
                for (int et = 0; et < 2; ++et) vf[0][et] = trfrag(lds + R2, VPB, 0, 32 * wid + 16 * et, lane);
#pragma unroll
                for (int j = 0; j < 4; ++j) kq[0][j] = trfrag(Kx, KPB, 0, 16 * j, lane);
#pragma unroll
                for (int q = 0; q < 8; ++q) { const int ks = q >> 1, h4 = (q & 1) * 4, cur = q & 1;
                    if (q < 7) { const int nks = (q + 1) >> 1, nh4 = ((q + 1) & 1) * 4;
                        if (nh4 == 0) {
#pragma unroll
                            for (int et = 0; et < 2; ++et) vf[nks & 1][et] = trfrag(lds + R2, VPB, 32 * nks, 32 * wid + 16 * et, lane); }
#pragma unroll
                        for (int j = 0; j < 4; ++j) kq[cur ^ 1][j] = trfrag(Kx, KPB, 32 * nks, 16 * (nh4 + j), lane); }
#pragma unroll
                    for (int j = 0; j < 4; ++j)
#pragma unroll
                        for (int et = 0; et < 2; ++et) acc[dir][et][h4 + j] = mfma16(vf[ks & 1][et], kq[cur][j], acc[dir][et][h4 + j]);
                    asm volatile("" : "+v"(acc[dir][0][h4]), "+v"(acc[dir][0][h4 + 1]), "+v"(acc[dir][0][h4 + 2]), "+v"(acc[dir][0][h4 + 3]), "+v"(acc[dir][1][h4]), "+v"(acc[dir][1][h4 + 1]), "+v"(acc[dir][1][h4 + 2]), "+v"(acc[dir][1][h4 + 3]));
                    __builtin_amdgcn_sched_barrier(0); } }
        }
        __syncthreads();
#pragma unroll
        for (int dir = 0; dir < 2; ++dir)
#pragma unroll
            for (int et = 0; et < 2; ++et)
#pragma unroll
                for (int dt = 0; dt < 8; ++dt) { u32x2 w; w.x = pk2(acc[dir][et][dt][0], acc[dir][et][dt][1]); w.y = pk2(acc[dir][et][dt][2], acc[dir][et][dt][3]);
                    *(LAS u32x2*)(lds + dir * (128 * UPB) + (16 * dt + fr) * UPB + (32 * wid + 16 * et + 4 * g) * 2) = w; }
        __syncthreads();
#pragma unroll
        for (int dir = 0; dir < 2; ++dir) { char* st = (char*)(A.ST + ((size_t)((dir * 4 + hl) * NCH + c)) * ST_CHUNK); const unsigned soff = (unsigned)((tid >> 5) * 512 + (tid & 31) * 16);
            ldsp s0 = lds + dir * (128 * UPB) + (tid >> 5) * UPB + (tid & 31) * 16;
#ifdef WT_MORE
            { const __amdgpu_buffer_rsrc_t srs = __builtin_amdgcn_make_buffer_rsrc((void*)st, 0, 0x7fffffff, 0x00020000);
#pragma unroll
            for (int i = 0; i < 8; ++i) __builtin_amdgcn_raw_buffer_store_b128(*(const LAS u32x4*)(s0 + i * 16 * UPB), srs, soff + i * 16 * 512, 0, 16); } }
#else
#pragma unroll
            for (int i = 0; i < 8; ++i) *(u32x4*)(st + (size_t)i * 16 * 512 + soff) = *(const LAS u32x4*)(s0 + i * 16 * UPB); }
#endif
        __syncthreads();
        if (!has_next) break;
        u = un;
    }
}

__device__ __forceinline__ void ret_b(const RetArgs& A, int vcu, int G, int tid) {
    const int NT = 8 * 16384;
    for (int T = vcu * 512 + tid; T < NT; T += G * 512) {
        const int dh = T >> 14, w = T & 16383, dir = dh >> 2, hl = dh & 3, h = A.grp * 4 + hl;
        const float dec = ex2(128.0f * A.l2[dir * 8 + h]);
        unsigned* p = (unsigned*)(A.ST + (size_t)dh * NCH * ST_CHUNK) + w;
        const ptrdiff_t cs = dir ? -(ptrdiff_t)(ST_CHUNK / 2) : (ptrdiff_t)(ST_CHUNK / 2);
        if (dir) p += (size_t)(NCH - 1) * (ST_CHUNK / 2);
        float s0 = 0.f, s1 = 0.f;
        for (int c = 0; c < NCH; c += 32) {
            unsigned u[32];
#pragma unroll
            for (int k = 0; k < 32; ++k) u[k] = __builtin_nontemporal_load(&p[(ptrdiff_t)k * cs]);
#pragma unroll
            for (int k = 0; k < 32; ++k) { p[(ptrdiff_t)k * cs] = A.dry ? u[k] : pk2(s0, s1); s0 = dec * s0 + bf_lo(u[k]); s1 = dec * s1 + bf_hi(u[k]); }
            p += 32 * cs;
        }
    }
}

constexpr int C_Q = 0, C_KA = 128 * KPB, C_B0 = 2 * 128 * KPB, C_B1 = C_B0 + 64 * VPB, C_STAT = C_B1 + 64 * VPB;
struct CPtrs { const bf16 *q, *k, *v, *sf, *sb; bf16* g; };
__device__ __forceinline__ CPtrs cptrs(const RetArgs& A, int unit) {
    const int hl = unit & 3, c = unit >> 2; bf16* rows = A.G + (size_t)c * 128 * LDG; CPtrs P;
    P.q = rows + COL_Q + hl * 128; P.k = rows + COL_K + hl * 128; P.v = rows + COL_V + hl * 256; P.g = rows + COL_G + hl * 256;
    P.sf = A.ST + ((size_t)((0 * 4 + hl) * NCH + c)) * ST_CHUNK; P.sb = A.ST + ((size_t)((1 * 4 + hl) * NCH + c)) * ST_CHUNK; return P;
}
__device__ __forceinline__ void half_mma(f32x4 (&acc)[2][8], ldsp buf, ldsp Bop, int kofs, int wid, int lane) {
    const int fr = lane & 15, g = lane >> 4;
    bf16x8 xf[2][2], bq[2][4];
#pragma unroll
    for (int et = 0; et < 2; ++et) xf[0][et] = trfrag(buf, VPB, 0, 32 * wid + 16 * et, lane);
#pragma unroll
    for (int j = 0; j < 4; ++j) bq[0][j] = *(const LAS bf16x8*)(Bop + (16 * j + fr) * KPB + (kofs + 8 * g) * 2);
#pragma unroll
    for (int q = 0; q < 4; ++q) { const int ks = q >> 1, h4 = (q & 1) * 4, cur = q & 1;
        if (q < 3) { const int nks = (q + 1) >> 1, nh4 = ((q + 1) & 1) * 4;
            if (nh4 == 0) {
#pragma unroll
                for (int et = 0; et < 2; ++et) xf[nks][et] = trfrag(buf, VPB, 32 * nks, 32 * wid + 16 * et, lane); }
#pragma unroll
            for (int j = 0; j < 4; ++j) bq[cur ^ 1][j] = *(const LAS bf16x8*)(Bop + (16 * (nh4 + j) + fr) * KPB + (kofs + 32 * nks + 8 * g) * 2); }
#pragma unroll
        for (int j = 0; j < 4; ++j)
#pragma unroll
            for (int et = 0; et < 2; ++et) acc[et][h4 + j] = mfma16(xf[ks][et], bq[cur][j], acc[et][h4 + j]);
        asm volatile("" : "+v"(acc[0][h4]), "+v"(acc[0][h4 + 1]), "+v"(acc[0][h4 + 2]), "+v"(acc[0][h4 + 3]), "+v"(acc[1][h4]), "+v"(acc[1][h4 + 1]), "+v"(acc[1][h4 + 2]), "+v"(acc[1][h4 + 3]));
        __builtin_amdgcn_sched_barrier(0); }
}
__device__ __forceinline__ void ret_c_phase(ldsp lds, const RetArgs& A, int vcu, int G, int tid_in) {
    int tid = tid_in;
    const int wid = __builtin_amdgcn_readfirstlane(tid >> 6);
    int u = vcu; if (u >= 512) return;
    CPtrs P = cptrs(A, u);
    u32x4 r0[4], r1[4], r2[4], r3[4];
    ld128(r0, P.q, LDG, tid); ld128(r1, P.k, LDG, tid); ld64nt(r2, P.sf, 256, tid); ld64nt(r3, P.sf + 64 * 256, 256, tid);
    LAS float* stat = (LAS float*)(lds + C_STAT);
    const __amdgpu_buffer_rsrc_t rsG = __builtin_amdgcn_make_buffer_rsrc((void*)A.G, 0, 0x06000000, 0x00020000), rsS = __builtin_amdgcn_make_buffer_rsrc((void*)A.ST, 0, 0x04000000, 0x00020000);
    for (;;) {
        asm volatile("" : "+v"(tid));
        const int lane = tid & 63, fr = lane & 15, g = lane >> 4;
        const int un = u + G; const bool has_next = un < 512;
        CPtrs N = P; if (has_next) N = cptrs(A, un);
        const int hl = u & 3, c = u >> 2, h = A.grp * 4 + hl;
        const float l2f = A.l2[h], l2b = A.l2[8 + h];
        st128(lds + C_Q, r0, tid); st128(lds + C_KA, r1, tid);
        ld64nt(r0, P.sb, 256, tid); ld64nt(r1, P.sb + 64 * 256, 256, tid);
        __syncthreads();
        f32x4 sa[8];
#pragma unroll
        for (int it = 0; it < 8; ++it) sa[it] = (f32x4){0.f, 0.f, 0.f, 0.f};
        {
            bf16x8 kfr[4], qb[2][4];
#pragma unroll
            for (int ks = 0; ks < 4; ++ks) kfr[ks] = *(const LAS bf16x8*)(lds + C_KA + (16 * wid + fr) * KPB + (32 * ks + 8 * g) * 2);
#pragma unroll
            for (int j = 0; j < 4; ++j) qb[0][j] = *(const LAS bf16x8*)(lds + C_Q + (16 * j + fr) * KPB + (8 * g) * 2);
#pragma unroll
            for (int q = 0; q < 8; ++q) { const int ks = q >> 1, h4 = (q & 1) * 4, cur = q & 1;
                if (q < 7) { const int nks = (q + 1) >> 1, nh4 = ((q + 1) & 1) * 4;
#pragma unroll
                    for (int j = 0; j < 4; ++j) qb[cur ^ 1][j] = *(const LAS bf16x8*)(lds + C_Q + (16 * (nh4 + j) + fr) * KPB + (32 * nks + 8 * g) * 2); }
#pragma unroll
                for (int j = 0; j < 4; ++j) sa[h4 + j] = mfma16(kfr[ks], qb[cur][j], sa[h4 + j]);
                asm volatile("" : "+v"(sa[h4]), "+v"(sa[h4 + 1]), "+v"(sa[h4 + 2]), "+v"(sa[h4 + 3]));
                __builtin_amdgcn_sched_barrier(0); } }
        st64(lds + C_B0, r2, tid); ld64(r2, P.v, LDG, tid);
        __syncthreads();
#pragma unroll
        for (int it = 0; it < 8; ++it) { const int i = 16 * it + fr; float v[4];
#pragma unroll
            for (int r = 0; r < 4; ++r) { const int j = 16 * wid + 4 * g + r; const int dl = i - j; const float dm = dl >= 0 ? ex2((float)dl * l2f) : ex2((float)(-dl) * l2b); v[r] = sa[it][r] * dm; }
            u32x2 w; w.x = pk2(v[0], v[1]); w.y = pk2(v[2], v[3]);
            *(LAS u32x2*)(lds + C_KA + i * KPB + (16 * wid + 4 * g) * 2) = w; if (it & 1) __builtin_amdgcn_sched_barrier(0); }
        st64(lds + C_B1, r3, tid); ld64(r3, P.v + (size_t)64 * LDG, LDG, tid);
        f32x4 acc[2][8];
#pragma unroll
        for (int et = 0; et < 2; ++et)
#pragma unroll
            for (int it = 0; it < 8; ++it) acc[et][it] = (f32x4){0.f, 0.f, 0.f, 0.f};
        half_mma(acc, lds + C_B0, lds + C_Q, 0, wid, lane);
        __syncthreads();
        st64(lds + C_B0, r0, tid); ld128b<0>(r0, rsG, (unsigned)((const char*)N.q - (const char*)A.G), LDG, tid, has_next);
        half_mma(acc, lds + C_B1, lds + C_Q, 64, wid, lane);
        __syncthreads();
#pragma unroll
        for (int it = 0; it < 8; ++it) { const float fi = (float)(16 * it + fr); const float rt = ex2((fi + 1.0f) * l2f - (128.0f - fi) * l2b); acc[0][it] *= rt; acc[1][it] *= rt; }
        st64(lds + C_B1, r1, tid); ld128b<0>(r1, rsG, (unsigned)((const char*)N.k - (const char*)A.G), LDG, tid, has_next);
        half_mma(acc, lds + C_B0, lds + C_Q, 0, wid, lane);
        __syncthreads();
        st64(lds + C_B0, r2, tid); ld64b<2>(r2, rsS, (unsigned)((const char*)N.sf - (const char*)A.ST), 256, tid, has_next);
        half_mma(acc, lds + C_B1, lds + C_Q, 64, wid, lane);
        __syncthreads();
#pragma unroll
        for (int it = 0; it < 8; ++it) { const float fi = (float)(16 * it + fr); const float sb = ex2((128.0f - fi) * l2b); acc[0][it] *= sb; acc[1][it] *= sb; }
        st64(lds + C_B1, r3, tid); ld64b<2>(r3, rsS, (unsigned)((const char*)N.sf - (const char*)A.ST) + 64u * 256u * 2u, 256, tid, has_next);
        u32x4 gv[8]; f32x4 gw[2]; const unsigned goff = (unsigned)((fr * LDG + 32 * wid + 8 * g) * 2);
#pragma unroll
        for (int et = 0; et < 2; ++et) { const int e = 32 * wid + 16 * et + 4 * g; gw[et] = *(const f32x4*)(A.gn + h * 256 + e); }
#pragma unroll
        for (int it = 0; it < 8; ++it) gv[it] = *(const u32x4*)((const char*)P.g + (size_t)(16 * it * LDG) * 2 + goff);
        half_mma(acc, lds + C_B0, lds + C_KA, 0, wid, lane);
        __syncthreads();
        half_mma(acc, lds + C_B1, lds + C_KA, 64, wid, lane);
#pragma unroll
        for (int it = 0; it < 8; ++it) { float s1 = 0.f, s2 = 0.f;
#pragma unroll
            for (int et = 0; et < 2; ++et)
#pragma unroll
                for (int r = 0; r < 4; ++r) { const float y = acc[et][it][r]; s1 += y; s2 += y * y; }
            s1 = xl_sum_rows(s1); s2 = xl_sum_rows(s2);
            if (g == 0) { stat[((16 * it + fr) * 8 + wid) * 2] = s1; stat[((16 * it + fr) * 8 + wid) * 2 + 1] = s2; }
            if (it & 1) __builtin_amdgcn_sched_barrier(0); }
        __syncthreads();
#pragma unroll
        for (int it = 0; it < 8; ++it) { float s1 = 0.f, s2 = 0.f;
#pragma unroll
            for (int w = 0; w < 8; ++w) { s1 += stat[((16 * it + fr) * 8 + w) * 2]; s2 += stat[((16 * it + fr) * 8 + w) * 2 + 1]; }
            const float mu = s1 * (1.0f / 256.0f); const float var = fmaxf(s2 * (1.0f / 256.0f) - mu * mu, 0.f); const float rs = rsqrtf(var + 1e-5f);
#pragma unroll
            for (int et = 0; et < 2; ++et) { const int e = 32 * wid + 16 * et + 4 * g; const f32x4 y = acc[et][it]; u32x2 gg; gg.x = et ? gv[it].z : gv[it].x; gg.y = et ? gv[it].w : gv[it].y;
                u32x2 w; w.x = pk2(bf_lo(gg.x) * ((y[0] - mu) * rs * gw[et][0]), bf_hi(gg.x) * ((y[1] - mu) * rs * gw[et][1]));
                w.y = pk2(bf_lo(gg.y) * ((y[2] - mu) * rs * gw[et][2]), bf_hi(gg.y) * ((y[3] - mu) * rs * gw[et][3]));
                *(LAS u32x2*)(lds + C_B0 + (16 * it + fr) * UPB + e * 2) = w; }
            __builtin_amdgcn_sched_barrier(0); }
        __syncthreads();
        { char* yb = (char*)(A.Y + (size_t)c * 128 * 2048 + h * 256); const unsigned yoff = (unsigned)((tid >> 5) * 4096 + (tid & 31) * 16);
          ldsp s0 = lds + C_B0 + (tid >> 5) * UPB + (tid & 31) * 16;
#ifdef WT_MORE
          { const __amdgpu_buffer_rsrc_t yrs = __builtin_amdgcn_make_buffer_rsrc((void*)yb, 0, 0x7fffffff, 0x00020000);
#pragma unroll
          for (int i = 0; i < 8; ++i) __builtin_amdgcn_raw_buffer_store_b128(*(const LAS u32x4*)(s0 + i * 16 * UPB), yrs, yoff + i * 16 * 4096, 0, 16); } }
#else
#pragma unroll
          for (int i = 0; i < 8; ++i) *(u32x4*)(yb + (size_t)i * 16 * 4096 + yoff) = *(const LAS u32x4*)(s0 + i * 16 * UPB); }
#endif
        if (!has_next) break;
        u = un; P = N;
    }
    __syncthreads();
}
}
#define XB_TMO      128
#define XB_XCNT(j)  (256  + 64 * (j))
#define XB_XSUB(j)  (1280 + 64 * (j))
#define XB_XGEN(j)  (2304 + 64 * (j))
#define XB_TOP      3328
#define XB_TOPGEN   3392
#define XCD_BAR_WORDS 3456
#define XB_SPIN_CAP (1u << 18)

__device__ __forceinline__ unsigned xb_ld(unsigned* p)              { return __hip_atomic_load(p, __ATOMIC_RELAXED, __HIP_MEMORY_SCOPE_AGENT); }
__device__ __forceinline__ unsigned xb_add(unsigned* p, unsigned v) { return __hip_atomic_fetch_add(p, v, __ATOMIC_RELAXED, __HIP_MEMORY_SCOPE_AGENT); }
__device__ __forceinline__ unsigned xb_xcc_id() { return (unsigned)__builtin_amdgcn_s_getreg((3 << 11) | 20) & 0xFu; }
#define XB_SPIN(cond, bar) do { unsigned _sp = 0; while (cond) { __builtin_amdgcn_s_sleep(1); \
    if ((++_sp & 255u) == 0u) { if (xb_ld(&(bar)[XB_TMO])) break; if (_sp > XB_SPIN_CAP) { atomicAdd(&(bar)[XB_TMO], 1u); break; } } } } while (0)

struct XcdBarrier {
    unsigned* bar; unsigned x;
    volatile LAS unsigned* st;
};

__device__ __forceinline__ XcdBarrier xcd_barrier_post(unsigned* bar, volatile LAS unsigned* st) {
    XcdBarrier b; b.bar = bar; b.x = xb_xcc_id(); b.st = st;
    if (threadIdx.x == 0) (void)xb_add(&bar[XB_XCNT(b.x)], 1u);
    return b;
}
__device__ __forceinline__ void xcd_barrier_complete(unsigned* bar, unsigned x, unsigned& nloc, unsigned& nx) {
    const unsigned G = gridDim.x * gridDim.y * gridDim.z;
    unsigned sum, cnt, mine, sp = 0u;
    for (;;) {
        sum = 0u; cnt = 0u; mine = 0u;
#pragma unroll
        for (unsigned j = 0; j < 16; ++j) { const unsigned c = xb_ld(&bar[XB_XCNT(j)]); sum += c; cnt += (c > 0u) ? 1u : 0u; mine = (j == x) ? c : mine; }
        if (sum == G) break;
        __builtin_amdgcn_s_sleep(1);
        if ((++sp & 255u) == 0u) { if (xb_ld(&bar[XB_TMO])) break; if (sp > XB_SPIN_CAP) { atomicAdd(&bar[XB_TMO], 1u); break; } }
    }
    nloc = mine > 0u ? mine : 1u; nx = cnt > 0u ? cnt : 1u;
}

__device__ __forceinline__ void xcd_barrier(const XcdBarrier& b) {
    asm volatile("s_waitcnt vmcnt(0)" ::: "memory");
    __syncthreads();
    if (threadIdx.x == 0) {
        unsigned* bar = b.bar;
        __builtin_amdgcn_s_waitcnt(0);
        unsigned nloc = b.st[0], nx = b.st[1];
        if (nloc == 0u) { xcd_barrier_complete(bar, b.x, nloc, nx); b.st[0] = nloc; b.st[1] = nx; }
        const unsigned old = xb_add(&bar[XB_XSUB(b.x)], 1u);
        const unsigned gen = old / nloc;
        if (old + 1u == (gen + 1u) * nloc) {
            __builtin_amdgcn_fence(__ATOMIC_RELEASE, "agent");
            asm volatile("s_waitcnt vmcnt(0)" ::: "memory");
            const unsigned og = xb_add(&bar[XB_TOP], 1u);
            const unsigned tg = og / nx;
            if (og + 1u == (tg + 1u) * nx) xb_add(&bar[XB_TOPGEN], 1u);
            else XB_SPIN(xb_ld(&bar[XB_TOPGEN]) == tg, bar);
            __builtin_amdgcn_fence(__ATOMIC_ACQUIRE, "agent");
            xb_add(&bar[XB_XGEN(b.x)], 1u);
            asm volatile("s_waitcnt vmcnt(0)" ::: "memory");
        } else {
            XB_SPIN(xb_ld(&bar[XB_XGEN(b.x)]) == gen, bar);
            __builtin_amdgcn_fence(__ATOMIC_ACQUIRE, "agent");
            asm volatile("s_waitcnt vmcnt(0)" ::: "memory");
        }
    }
    __syncthreads();
}

__device__ __forceinline__ void group_barrier(const XcdBarrier& b, unsigned* word, unsigned target) {
    asm volatile("s_waitcnt vmcnt(0)" ::: "memory");
    __syncthreads();
    if (threadIdx.x == 0) {
        __builtin_amdgcn_s_waitcnt(0);
        __builtin_amdgcn_fence(__ATOMIC_RELEASE, "agent");
        asm volatile("s_waitcnt vmcnt(0)" ::: "memory");
        (void)xb_add(word, 1u);
        XB_SPIN(xb_ld(word) < target, b.bar);
        __builtin_amdgcn_fence(__ATOMIC_ACQUIRE, "agent");
        asm volatile("s_waitcnt vmcnt(0)" ::: "memory");
    }
    __syncthreads();
}
constexpr int M_TOK = 16384, DM = 1024, DFF = 4096, N_IN_E = 2304, N_IN_O = 6144;
constexpr size_t MiB = 1u << 20;
constexpr size_t WS_CTL = 0;
constexpr size_t WS_L2 = 4096, WS_SSQ = 512 * 1024;
constexpr int CW_GRP = 10240;
constexpr int CW_BAR = 4096;
constexpr size_t WS_W_IN_E = 1 * MiB;
constexpr size_t WS_W_OUT_E = WS_W_IN_E + (size_t)N_IN_E * DM * 2;
constexpr size_t WS_W_MLP_IN = WS_W_OUT_E + (size_t)DM * DM * 2;
constexpr size_t WS_W_MLP_OUT = WS_W_MLP_IN + 2 * (size_t)DFF * DM * 2;
constexpr size_t WS_W_IN_O = WS_W_MLP_OUT + 2 * (size_t)DFF * DM * 2;
constexpr size_t WS_W_OUT_O = WS_W_IN_O + (size_t)N_IN_O * DM * 2;
constexpr size_t WS_XB = 56 * MiB;
constexpr size_t WS_BIG = 88 * MiB;
constexpr size_t WS_END = 256 * MiB;
static_assert(WS_W_OUT_O + (size_t)DM * 2048 * 2 <= WS_XB, "weights fit below XB");

constexpr int RING_BYTES = 155648;
constexpr int LDS_BYTES = 159744;

struct Args { const float* in[19]; float* out; unsigned char* ws; int ph_lo, ph_hi; };
typedef const __attribute__((address_space(4))) Args* KArgs;

__device__ __forceinline__ float wave_sum(float v) {
#pragma unroll
    for (int o = 1; o < 64; o <<= 1) v += __shfl_xor(v, o);
    return v;
}
struct WItem { const float* W; int N; bf16* WT; int ldo; int k0, n0, orow0; const float* gain; float nscale; int perm; };
constexpr int WI_C0 = 1152, WI_C1 = WI_C0 + 512, WI_C2 = WI_C1 + 2048, WI_C3 = WI_C2 + 2048, WI_C4 = WI_C3 + 2048, WI_C5 = WI_C4 + 2048, WI_C6 = WI_C5 + 3072, WI_C7 = WI_C6 + 1024;
constexpr int WI_EARLY = WI_C3;
__device__ __forceinline__ void witem_decode(KArgs a, unsigned char* ws, int gi, WItem& d) {
    int item, K, mode = 0; d.gain = nullptr; d.nscale = 1.0f; d.perm = 0;
    if (gi < WI_C0)      { item = gi;         d.W = a->in[2];  K = DM;  d.N = N_IN_E; d.WT = (bf16*)(ws + WS_W_IN_E); d.gain = a->in[1]; }
    else if (gi < WI_C1) { item = gi - WI_C0; d.W = a->in[9];  K = DM;  d.N = DM;     d.WT = (bf16*)(ws + WS_W_OUT_E); }
    else if (gi < WI_C2) { item = gi - WI_C1; d.W = a->in[17]; K = DM;  d.N = DFF;    d.WT = (bf16*)(ws + WS_W_MLP_IN); d.gain = a->in[16]; }
    else if (gi < WI_C3) { item = gi - WI_C2; d.W = a->in[18]; K = DFF; d.N = DM;     d.WT = (bf16*)(ws + WS_W_MLP_OUT); }
    else if (gi < WI_C4) { item = gi - WI_C3; d.W = a->in[17] + (size_t)DM * DFF; K = DM; d.N = DFF; d.WT = (bf16*)(ws + WS_W_MLP_IN) + (size_t)DFF * DM; d.gain = a->in[16] + DM; }
    else if (gi < WI_C5) { item = gi - WI_C4; d.W = a->in[18] + (size_t)DFF * DM; K = DFF; d.N = DM; d.WT = (bf16*)(ws + WS_W_MLP_OUT) + (size_t)DFF * DM; }
    else if (gi < WI_C6) { item = gi - WI_C5; d.W = a->in[11]; K = DM;  d.N = N_IN_O; d.WT = (bf16*)(ws + WS_W_IN_O); d.gain = a->in[10]; mode = 1; }
    else                 { item = gi - WI_C6; d.W = a->in[15]; K = 2048; d.N = DM;    d.WT = (bf16*)(ws + WS_W_OUT_O); }
    const int nblk = d.N / 32, kb = item / nblk, nb = item % nblk; d.k0 = 64 * kb; d.n0 = 32 * nb; d.orow0 = d.n0; d.ldo = K;
    if (mode == 1) {
        const int n0 = d.n0;
        if (n0 < 1024) { d.orow0 = (n0 >> 9) * 3072 + (n0 & 511); }
        else if (n0 < 2048) { const int nk = n0 - 1024; d.orow0 = (nk >> 9) * 3072 + 512 + (nk & 511); d.nscale = 0.08838834764831845f; }
        else if (n0 < 4096) { const int nv = n0 - 2048; d.orow0 = (nv >> 10) * 3072 + 1024 + (nv & 1023); }
        else { const int ng = n0 - 4096; d.orow0 = (ng >> 10) * 3072 + 2048 + (ng & 1023); d.perm = 1; }
    }
}
__device__ __forceinline__ void witem_load(const WItem& d, float (&v)[32], int lane) {
#pragma unroll
    for (int i = 0; i < 32; ++i) { const int kk = 2 * i + (lane >> 5); v[i] = __builtin_nontemporal_load(&d.W[(size_t)(d.k0 + kk) * d.N + d.n0 + (lane & 31)]); }
}
__device__ __forceinline__ void witem_finish(const WItem& d, const float (&v)[32], LAS float* scr, int lane) {
#pragma unroll
    for (int i = 0; i < 32; ++i) { const int kk = 2 * i + (lane >> 5); const float gsc = d.gain ? d.gain[d.k0 + kk] * d.nscale : d.nscale; scr[kk * 33 + (lane & 31)] = v[i] * gsc; }
    asm volatile("s_waitcnt lgkmcnt(0)" ::: "memory");
    const int c = lane & 7;
#pragma unroll
    for (int j = 0; j < 4; ++j) { const int n = (lane >> 3) + 8 * j; const LAS float* s = scr + (8 * c) * 33 + n;
        u32x4 o; o.x = pk2(s[0 * 33], s[1 * 33]); o.y = pk2(s[2 * 33], s[3 * 33]); o.z = pk2(s[4 * 33], s[5 * 33]); o.w = pk2(s[6 * 33], s[7 * 33]);
        const int np = d.perm ? (8 * ((n & 15) >> 2) + 4 * (n >> 4) + (n & 3)) : n;
        *(u32x4*)(d.WT + (size_t)(d.orow0 + np) * d.ldo + d.k0 + 8 * c) = o; }
    asm volatile("s_waitcnt lgkmcnt(0)" ::: "memory");
}
__device__ __forceinline__ void convert_items(KArgs a, ldsp lds, int gbeg, int gend, int wv, int nw, int tid) {
    const int lane = tid & 63, wave = __builtin_amdgcn_readfirstlane(tid >> 6);
    unsigned char* ws = a->ws;
    LAS float* scr = (LAS float*)(lds + wave * 16384);
    WItem cur, nxt; float va[32], vb[32];
    int gi = gbeg + wv;
    if (gi < gend) { witem_decode(a, ws, gi, cur); witem_load(cur, va, lane); }
    while (gi < gend) {
        const int g1 = gi + nw, g2 = gi + 2 * nw;
        if (g1 < gend) { witem_decode(a, ws, g1, nxt); witem_load(nxt, vb, lane); }
        witem_finish(cur, va, scr, lane);
        if (g1 >= gend) break;
        if (g2 < gend) { witem_decode(a, ws, g2, cur); witem_load(cur, va, lane); }
        witem_finish(nxt, vb, scr, lane);
        gi = g2;
    }
}
__device__ __forceinline__ void prologue(KArgs a, ldsp lds, int vcu, int G, int tid) {
    const int lane = tid & 63, wave = __builtin_amdgcn_readfirstlane(tid >> 6);
    unsigned char* ws = a->ws;
    const int gw = vcu * 8 + wave, NGW = G * 8;
    convert_items(a, lds, 0, WI_EARLY, gw, NGW, tid);
    const float* x = a->in[0]; bf16* XB = (bf16*)(ws + WS_XB); float* ssq = (float*)(ws + WS_SSQ);
    for (int m = gw; m < M_TOK; m += 4 * NGW) {
        f32x4 v[4][4];
#pragma unroll
        for (int q = 0; q < 4; ++q) { const f32x4* xr = (const f32x4*)(x + (size_t)(m + q * NGW) * DM) + lane;
#pragma unroll
            for (int j = 0; j < 4; ++j) v[q][j] = __builtin_nontemporal_load(&xr[64 * j]); }
#pragma unroll
        for (int q = 0; q < 4; ++q) { const int mq = m + q * NGW; unsigned long long* o = (unsigned long long*)(XB + (size_t)mq * DM) + lane; float sq = 0.f;
#pragma unroll
            for (int j = 0; j < 4; ++j) { sq += (v[q][j][0] * v[q][j][0] + v[q][j][1] * v[q][j][1]) + (v[q][j][2] * v[q][j][2] + v[q][j][3] * v[q][j][3]);
                o[64 * j] = (unsigned long long)pk2(v[q][j][0], v[q][j][1]) | ((unsigned long long)pk2(v[q][j][2], v[q][j][3]) << 32); }
            sq = wave_sum(sq);
            if (lane == 0) *(f32x4*)(ssq + 4 * (size_t)mq) = (f32x4){sq, 0.f, 0.f, 0.f}; }
    }
    if (vcu == 0 && tid < 16) { const float d = (tid < 8 ? a->in[12] : a->in[13])[tid & 7]; const float e = __expf(-d);
        const float l1p = (e < 0.0625f) ? e * (1.0f - e * (0.5f - e * ((1.0f / 3.0f) - e * (0.25f - e * 0.2f)))) : __logf(1.0f + e);
        ((float*)(ws + WS_L2))[tid] = -l1p * LOG2E; }
}

#ifndef DBG_DUMP
#define DBG_DUMP 0
#endif
#ifndef TS_T0
#define TS_T0 0
#define TS_GAIN 1e-3f
#endif
#ifndef GROUP_SEAMS
#define GROUP_SEAMS 1
#endif
#ifndef GEMM_ALIGN
#define GEMM_ALIGN true
#endif
#ifndef GEMM_SP2
#define GEMM_SP2 true
#endif
#ifndef REP_PH
#define REP_PH (-1)
#define REP_N 0
#endif
#ifndef REP_COND
#define REP_COND true
#endif
#ifndef DBG_STRIDE
#define DBG_STRIDE 1
#endif
#ifndef DBG_HI
#define DBG_HI PH_COUNT
#endif
#ifndef DBG_LO
#define DBG_LO 0
#endif
#ifndef DBG_AOFF
#define DBG_AOFF 2048
#endif
#ifndef DBG_LDA
#define DBG_LDA 3072
#endif
#ifndef DBG_LDB
#define DBG_LDB 2048
#endif
#ifndef DBG_K
#define DBG_K 1024
#endif
enum { PH_PRO = 0, PH_IN_E, PH_ATTN, PH_OUT_E, PH_MLP_IN0, PH_MLP_OUT0, PH_IN_O0, PH_RA0, PH_RB0, PH_RC0, PH_IN_O1, PH_RA1, PH_RB1, PH_RC1, PH_OUT_O, PH_MLP_IN1, PH_MLP_OUT1, PH_COUNT };

__global__ void __launch_bounds__(512, 2) mk_fwd(Args a_unused) {
    extern __shared__ __attribute__((aligned(16))) unsigned char lds_raw[];
    cg::grid_group grid = cg::this_grid();
    const ldsp lds = (ldsp)lds_raw;
    volatile LAS unsigned* MISC = (volatile LAS unsigned*)(lds + RING_BYTES);
    if (threadIdx.x < 32) MISC[threadIdx.x] = 0u;
    __syncthreads();
    const XcdBarrier bar = xcd_barrier_post((unsigned*)(((KArgs)__builtin_amdgcn_kernarg_segment_ptr())->ws + WS_CTL) + CW_BAR, MISC + 8);
    const int G = gridDim.x;
    int repcnt = 0;
#ifdef TS_PH
    if (blockIdx.x == 0 && threadIdx.x == 0) ((volatile unsigned long long*)(((KArgs)__builtin_amdgcn_kernarg_segment_ptr())->ws + 32768))[0] = __builtin_amdgcn_s_memrealtime();
#endif
    const int ph_lo = ((KArgs)__builtin_amdgcn_kernarg_segment_ptr())->ph_lo, ph_hi = ((KArgs)__builtin_amdgcn_kernarg_segment_ptr())->ph_hi;
    for (int ph = ph_lo; ph < ph_hi; ++ph) {
        const __attribute__((address_space(4))) char* kp = (const __attribute__((address_space(4))) char*)__builtin_amdgcn_kernarg_segment_ptr();
        asm volatile("" : "+s"(kp));
        KArgs a = (KArgs)kp;
        unsigned char* ws = a->ws;
        bf16* XB = (bf16*)(ws + WS_XB); float* ssq = (float*)(ws + WS_SSQ);
        bf16* BIG = (bf16*)(ws + WS_BIG);
        bf16* QKV = BIG; bf16* OE = (bf16*)a->out; bf16* HM = BIG;     bf16* GB = BIG; bf16* ST = BIG + (size_t)M_TOK * 3072;
        int tid = threadIdx.x, bx = blockIdx.x;
        asm volatile("" : "+v"(tid)); asm volatile("" : "+s"(bx));
        const int vcu = (G % 8 == 0) ? (bx % 8) * (G / 8) + bx / 8 : bx;
        if (ph == PH_PRO) { prologue(a, lds, vcu, G, tid); }
        else if (ph == PH_ATTN) {
            att::AttnArgs A{QKV, OE, a->in[3], a->in[4], a->in[5], a->in[6], a->in[7], a->in[8]};
            att::attn_phase(lds, A, vcu, G, tid);
        }
        else if (ph == PH_RA0 || ph == PH_RA1 || ph == PH_RB0 || ph == PH_RB1 || ph == PH_RC0 || ph == PH_RC1) {
            ret::RetArgs R{GB, ST, (const float*)(ws + WS_L2), a->in[14], (ph >= PH_IN_O1) ? 1 : 0, (REP_N > 0 && ph == REP_PH && repcnt > 0) ? 1 : 0, (bf16*)a->out};
            if (ph == PH_RA0 || ph == PH_RA1) { ret::ret_a_phase(lds, R, vcu, G, tid); }
            else if (ph == PH_RB0 || ph == PH_RB1) { ret::ret_b(R, vcu, G, tid); }
            else { ret::ret_c_phase(lds, R, vcu, G, tid); }
        }
        else if (ph == PH_IN_E || ph == PH_MLP_IN0 || ph == PH_MLP_IN1 || ph == PH_IN_O0 || ph == PH_IN_O1) {
            const bf16* Bt; int N, act, silu0; bf16* O;
            if (ph == PH_IN_E)           { Bt = (const bf16*)(ws + WS_W_IN_E); N = N_IN_E; O = QKV; act = 0; silu0 = 1 << 30; }
            else if (ph == PH_MLP_IN0)   { Bt = (const bf16*)(ws + WS_W_MLP_IN); N = DFF; O = HM; act = 1; silu0 = 1 << 30; }
            else if (ph == PH_MLP_IN1)   { Bt = (const bf16*)(ws + WS_W_MLP_IN) + (size_t)DFF * DM; N = DFF; O = HM; act = 1; silu0 = 1 << 30; }
            else if (ph == PH_IN_O0)     { Bt = (const bf16*)(ws + WS_W_IN_O); N = 3072; O = GB; act = 2; silu0 = 8; }
            else                         { Bt = (const bf16*)(ws + WS_W_IN_O) + (size_t)3072 * DM; N = 3072; O = GB; act = 2; silu0 = 8; }
            pg8::Gemm g; g.A = XB; g.Bt = Bt; g.lda = DM; g.ldb = DM; g.M = M_TOK; g.N = N; g.K = DM;
            pg8::EpiBf16 E; E.O = O; E.ldc = N; E.ssq = ssq; E.silu_pn0 = silu0; E.act = act;
            E.knorm = (ph == PH_IN_E) ? 1 : 0; E.spare = lds + 131072;
            pg8::StaticOrder S; S.init(M_TOK, N, G, bx);
            pg8::gemm_phase<pg8::EpiBf16, pg8::StaticOrder, GEMM_ALIGN, GEMM_SP2>(lds, g, S, E, tid);
            if (ph == PH_IN_E && bx >= 64) convert_items(a, lds, WI_EARLY, WI_C7, (bx - 64) * 8 + __builtin_amdgcn_readfirstlane(tid >> 6), (G - 64) * 8, tid);
        }
        else {
            const bf16* A; const bf16* Bt; int lda, ldb, K; const float* basef; const bf16* baseb; float* outf; bf16* xb; float* sso;
            if (ph == PH_OUT_E)          { A = OE; lda = DM; K = DM; Bt = (const bf16*)(ws + WS_W_OUT_E); ldb = DM; basef = nullptr; baseb = XB; outf = nullptr; xb = XB; sso = ssq; }
            else if (ph == PH_MLP_OUT0)  { A = HM; lda = DFF; K = DFF; Bt = (const bf16*)(ws + WS_W_MLP_OUT); ldb = DFF; basef = nullptr; baseb = XB; outf = nullptr; xb = XB; sso = ssq; }
            else if (ph == PH_MLP_OUT1)  { A = HM; lda = DFF; K = DFF; Bt = (const bf16*)(ws + WS_W_MLP_OUT) + (size_t)DFF * DM; ldb = DFF; basef = nullptr; baseb = XB; outf = a->out; xb = nullptr; sso = nullptr; }
            else                         { A = (const bf16*)a->out; lda = 2048; K = 2048; Bt = (const bf16*)(ws + WS_W_OUT_O); ldb = 2048; basef = nullptr; baseb = XB; outf = nullptr; xb = XB; sso = ssq; }
            pg8::Gemm g; g.A = A; g.Bt = Bt; g.lda = lda; g.ldb = ldb; g.M = M_TOK; g.N = DM; g.K = K;
            pg8::EpiResid E; E.basef = basef; E.baseb = baseb; E.outf = outf; E.xb = xb; E.ssq_out = sso; E.ldc = DM;
            E.accscale = (REP_N > 0 && ph == REP_PH && repcnt > 0 && ph != PH_OUT_E && ph != PH_MLP_OUT1) ? 0.f : 1.f;
            pg8::StaticOrder S; S.init(M_TOK, DM, G, bx);
            pg8::gemm_phase<pg8::EpiResid, pg8::StaticOrder, false, GEMM_SP2>(lds, g, S, E, tid);
        }
        if (ph + 1 == ph_hi && DBG_DUMP) {
            xcd_barrier(bar);
            const bf16* srcb = (DBG_DUMP == 1) ? GB : ST;
            for (size_t i = (size_t)bx * 512 + tid; i < (size_t)M_TOK * DM; i += (size_t)G * 512) a->out[i] = bf_lo((unsigned)srcb[i * DBG_STRIDE]);
        }
#ifdef NOP_REPS
        if (ph == NOP_AT) { for (int q = 0; q < NOP_REPS; ++q) xcd_barrier(bar); }
#endif
        if (ph + 1 < ph_hi) {
            if (ph_lo < 0) {
                asm volatile("s_waitcnt vmcnt(0)" ::: "memory");
                grid.sync();
                __builtin_amdgcn_fence(__ATOMIC_ACQUIRE, "agent");
                asm volatile("s_waitcnt vmcnt(0)" ::: "memory");
                __syncthreads();
            }
            const int gk = (ph == PH_OUT_E) ? 1 : (ph == PH_MLP_IN0) ? 2 : (ph == PH_OUT_O) ? 3 : (ph == PH_MLP_IN1) ? 4 : 0;
            if (GROUP_SEAMS && gk != 0 && G == 256) group_barrier(bar, (unsigned*)(ws + WS_CTL) + CW_GRP + 32 * (bx & 63), 4u * (unsigned)gk);
            else xcd_barrier(bar);
#ifdef TS_PH
            if (blockIdx.x == 0 && threadIdx.x == 0) ((volatile unsigned long long*)(ws + 32768))[ph + 1] = __builtin_amdgcn_s_memrealtime();
#endif
        }
        if (REP_N > 0 && ph == REP_PH && repcnt < REP_N && REP_COND) { ++repcnt; --ph; }
    }
#ifdef TS_PH
    {
        xcd_barrier(bar);
        if (blockIdx.x == 0 && threadIdx.x == 0) { KArgs a = (KArgs)__builtin_amdgcn_kernarg_segment_ptr(); volatile unsigned long long* ts = (volatile unsigned long long*)(a->ws + 32768);
            unsigned long long t1 = (TS_PH == PH_COUNT - 1) ? __builtin_amdgcn_s_memrealtime() : ts[TS_PH + 1];
#ifdef TS_TOTAL
            a->out[0] += 0.1f + ((float)(__builtin_amdgcn_s_memrealtime() - ts[0]) * 0.01f - (float)TS_T0) * TS_GAIN; }
#else
            a->out[0] += 0.1f + ((float)(t1 - ts[TS_PH]) * 0.01f - (float)TS_T0) * TS_GAIN; }
#endif
    }
#endif
}

extern "C" void kernel_launch(void* const* d_in, const int* in_sizes, int n_in, void* d_out, int out_size, void* d_ws, size_t ws_size, hipStream_t stream) {
    static int grid = 0;
    if (grid == 0) {
        int dev = 0, cus = 0, per_cu = 0;
        (void)hipGetDevice(&dev);
        (void)hipDeviceGetAttribute(&cus, hipDeviceAttributeMultiprocessorCount, dev);
        (void)hipFuncSetAttribute((const void*)mk_fwd, hipFuncAttributeMaxDynamicSharedMemorySize, LDS_BYTES);
        (void)hipOccupancyMaxActiveBlocksPerMultiprocessor(&per_cu, (const void*)mk_fwd, 512, LDS_BYTES);
        grid = (n_in == 19 && per_cu >= 1 && cus == 256 && ws_size >= WS_END && out_size == M_TOK * DM) ? 256 : -1;
        if (grid < 0) fprintf(stderr, "kernel_launch: unsupported configuration (cus %d per_cu %d ws %zu n_in %d)\n", cus, per_cu, ws_size, n_in);
    }
    if (grid < 0) return;
    if (hipMemsetAsync((char*)d_ws + WS_CTL, 0, 65536, stream) != hipSuccess) { fprintf(stderr, "kernel_launch: memset failed\n"); return; }
    Args a{};
    for (int i = 0; i < 19; ++i) a.in[i] = (const float*)d_in[i];
    a.out = (float*)d_out; a.ws = (unsigned char*)d_ws; a.ph_lo = DBG_LO; a.ph_hi = DBG_HI;
    void* args[] = {&a};
#ifdef PLAIN_LAUNCH
    hipError_t e = hipLaunchKernel((void*)mk_fwd, dim3(grid), dim3(512), args, LDS_BYTES, stream);
#else
    hipError_t e = hipLaunchCooperativeKernel((void*)mk_fwd, dim3(grid), dim3(512), args, LDS_BYTES, stream);
#endif
    if (e != hipSuccess) fprintf(stderr, "cooperative launch failed: %s\n", hipGetErrorString(e));
}
```
